# Optimizing an MI355X kernel written in HIP

```python
import math
import jax, jax.numpy as jnp
from jax import lax
import numpy as np

D_MODEL = 2048
BATCH = 8
SEQ = 2048
DEPTH = 2

F32 = jnp.float32
N_EVEN = (DEPTH + 1) // 2
N_ODD = DEPTH // 2
DN_ALPHA = float((2 * DEPTH) ** 0.25)
DN_BETA = float((8 * DEPTH) ** -0.25)
LN_EPS = 1e-5
RMS_EPS = 1e-6
NEG_INF = -1e30

SSM_HEAD_DIM = 64
SSM_INNER = D_MODEL
SSM_HEADS = SSM_INNER // SSM_HEAD_DIM
SSM_STATE = 128
SSM_GROUPS = 4
SSM_CONV = 4
SSM_CHUNK = 128
SSM_BC = SSM_GROUPS * SSM_STATE
SSM_CONV_DIM = SSM_INNER + 2 * SSM_BC

NSA_HEADS = 16
NSA_GROUPS = 2
NSA_HEAD_DIM = D_MODEL // NSA_HEADS
NSA_WIDTH = NSA_HEADS * NSA_HEAD_DIM
NSA_KV = NSA_GROUPS * NSA_HEAD_DIM
NSA_CMP_BLOCK = 32
NSA_CMP_STRIDE = 16
NSA_SEL_BLOCK = 64
NSA_TOP_N = 8
NSA_WINDOW = 512
NSA_WIN_Q_BLOCK = 128
NSA_SEL_Q_BLOCK = 64
NSA_FORCED = 1e6

AB_SIZES = (SSM_INNER, SSM_CONV_DIM, SSM_HEADS, NSA_WIDTH, 6 * NSA_KV, 3 * NSA_HEADS)
AB_IN = sum(AB_SIZES)
AB_MIX = SSM_INNER + NSA_WIDTH

MLA_HEADS = 16
MLA_Q_RANK = 512
MLA_KV_RANK = 512
MLA_NOPE = 128
MLA_ROPE = 64
MLA_V = 128
ROPE_THETA = 10000.0
ATTN_Q_BLOCK = 128

HGRN_HEADS = 16
HGRN_KEY = 128
HGRN_VAL = 128
HGRN_CHUNK = 64
HGRN_FDIM = HGRN_HEADS * HGRN_KEY
HGRN_WIDTH = HGRN_HEADS * HGRN_VAL

CD_SIZES = (MLA_Q_RANK, MLA_KV_RANK, MLA_ROPE, HGRN_FDIM, HGRN_FDIM, HGRN_WIDTH, HGRN_WIDTH)
CD_IN = sum(CD_SIZES)
CD_MIX = MLA_HEADS * MLA_V + HGRN_WIDTH

N_EXPERTS = 64
TOP_K = 8
N_EXPERT_GROUPS = 8
TOP_GROUPS = 4
EXPERT_FF = 512
SHARED_FF = 512
ROUTED_SCALE = 2.5
MOE_ROW_BLOCK = 256

kernel_name = 'hybrid_ssd_nsa_mla_hgrn2_moe_deepnorm'


def split_cols(h, sizes):
    offs = [int(o) for o in np.cumsum(sizes)[:-1]]
    return jnp.split(h, offs, axis=-1)


def layer_norm(x, g, b):
    xf = x.astype(F32)
    mu = jnp.mean(xf, -1, keepdims=True)
    var = jnp.mean(jnp.square(xf - mu), -1, keepdims=True)
    return ((xf - mu) * lax.rsqrt(var + LN_EPS)).astype(x.dtype) * g + b


def rms_norm(x, w):
    xf = x.astype(F32)
    return (xf * lax.rsqrt(jnp.mean(xf * xf, -1, keepdims=True) + RMS_EPS)).astype(x.dtype) * w


def masked_softmax(s, mask):
    return jax.nn.softmax(jnp.where(mask, s.astype(F32), NEG_INF), axis=-1)


def causal_depthwise_conv(u, w, b):
    width, ch = w.shape
    out = lax.conv_general_dilated(u, w[:, None, :], window_strides=(1,), padding=[(width - 1, 0)],
                                   dimension_numbers=('NWC', 'WIO', 'NWC'), feature_group_count=ch)
    return out + b


def segsum(a):
    t = a.shape[-1]
    cs = jnp.cumsum(a, -1)
    diff = cs[..., :, None] - cs[..., None, :]
    return jnp.where(jnp.tril(jnp.ones((t, t), bool)), diff, -jnp.inf)


def ssd_chunked_scan(xh, dt, a, bm, cm):
    bsz, seq, nh, hp = xh.shape
    ng, ns = bm.shape[2], bm.shape[3]
    hg = nh // ng
    L = SSM_CHUNK
    nc = seq // L
    x = (xh.astype(F32) * dt[..., None]).reshape(bsz, nc, L, ng, hg, hp)
    adt = (dt * a).reshape(bsz, nc, L, ng, hg).transpose(0, 1, 3, 4, 2)
    bmf = bm.astype(F32).reshape(bsz, nc, L, ng, ns)
    cmf = cm.astype(F32).reshape(bsz, nc, L, ng, ns)
    a_cs = jnp.cumsum(adt, -1)
    lmat = jnp.exp(segsum(adt))
    cb = jnp.einsum('bclgn,bcsgn->bcgls', cmf, bmf)
    y_diag = jnp.einsum('bcgls,bcghls,bcsghp->bclghp', cb, lmat, x)
    decay_states = jnp.exp(a_cs[..., -1:] - a_cs)
    states = jnp.einsum('bclgn,bcghl,bclghp->bcghpn', bmf, decay_states, x)
    chunk_a = jnp.moveaxis(a_cs[..., -1], 1, -1)
    decay_chunk = jnp.exp(segsum(jnp.pad(chunk_a, ((0, 0), (0, 0), (0, 0), (1, 0)))))
    states0 = jnp.concatenate([jnp.zeros_like(states[:, :1]), states], axis=1)
    new_states = jnp.einsum('bghzc,bcghpn->bzghpn', decay_chunk, states0)
    prev_states = new_states[:, :-1]
    y_off = jnp.einsum('bclgn,bcghpn,bcghl->bclghp', cmf, prev_states, jnp.exp(a_cs))
    return (y_diag + y_off).reshape(bsz, seq, nh, hp)


def mamba2_mixer(z, xbc, dt_raw, conv_w, conv_b, dt_bias, a_log, d_skip, norm_w):
    bsz, seq, _ = z.shape
    xbc = jax.nn.silu(causal_depthwise_conv(xbc, conv_w, conv_b))
    xs, bm, cm = jnp.split(xbc, [SSM_INNER, SSM_INNER + SSM_BC], axis=-1)
    xh = xs.reshape(bsz, seq, SSM_HEADS, SSM_HEAD_DIM)
    dt = jax.nn.softplus(dt_raw.astype(F32) + dt_bias.astype(F32))
    a = -jnp.exp(a_log.astype(F32))
    y = ssd_chunked_scan(xh, dt, a, bm.reshape(bsz, seq, SSM_GROUPS, SSM_STATE),
                         cm.reshape(bsz, seq, SSM_GROUPS, SSM_STATE))
    y = y + xh.astype(F32) * d_skip.astype(F32)[:, None]
    y = y.reshape(bsz, seq, SSM_INNER).astype(z.dtype)
    return rms_norm(y * jax.nn.silu(z), norm_w)


def nsa_mixer(q, kv, gates, cmp_pos, cmp_w):
    bsz, seq, _ = q.shape
    G, hg, dh = NSA_GROUPS, NSA_HEADS // NSA_GROUPS, NSA_HEAD_DIM
    scale = dh ** -0.5
    q = q.reshape(bsz, seq, G, hg, dh)
    k_cmp, v_cmp, k_sel, v_sel, k_win, v_win = [t.reshape(bsz, seq, G, dh) for t in jnp.split(kv, 6, axis=-1)]
    t_pos = jnp.arange(seq)

    n_cmp = (seq - NSA_CMP_BLOCK) // NSA_CMP_STRIDE + 1
    blk = np.arange(n_cmp)[:, None] * NSA_CMP_STRIDE + np.arange(NSA_CMP_BLOCK)[None, :]

    def compress(t, pos, w):
        blocks = t[:, blk] + pos[:, None, :]
        return jnp.einsum('bilgd,lde->bige', blocks, w.reshape(NSA_CMP_BLOCK, dh, dh))

    kc = compress(k_cmp, cmp_pos[0], cmp_w[0])
    vc = compress(v_cmp, cmp_pos[1], cmp_w[1])
    s_cmp = jnp.einsum('bsghd,bigd->bghsi', q, kc).astype(F32) * scale
    cmask = jnp.asarray(np.arange(n_cmp) * NSA_CMP_STRIDE + NSA_CMP_BLOCK - 1)[None, :] <= t_pos[:, None]
    p_cmp = masked_softmax(s_cmp, cmask) * jnp.any(cmask, -1)[:, None].astype(F32)
    o_cmp = jnp.einsum('bghsi,bigd->bsghd', p_cmp.astype(vc.dtype), vc)

    n_sel = seq // NSA_SEL_BLOCK
    top_n = min(NSA_TOP_N, n_sel)
    ci = np.arange(n_cmp)[:, None]
    sj = np.arange(n_sel)[None, :]
    ov = np.clip(np.minimum(ci * NSA_CMP_STRIDE + NSA_CMP_BLOCK, sj * NSA_SEL_BLOCK + NSA_SEL_BLOCK)
                 - np.maximum(ci * NSA_CMP_STRIDE, sj * NSA_SEL_BLOCK), 0, None) / NSA_CMP_BLOCK
    imp = jnp.einsum('bghsi,ij->bgsj', p_cmp, jnp.asarray(ov, F32))
    jb = jnp.arange(n_sel)[None, :]
    cur = (t_pos // NSA_SEL_BLOCK)[:, None]
    causal_blk = jb * NSA_SEL_BLOCK <= t_pos[:, None]
    forced = (jb == 0) | (jb == cur) | (jb == cur - 1)
    imp = jnp.where(forced, NSA_FORCED, jnp.where(causal_blk, imp, -1.0))
    _, sel_idx = lax.top_k(imp, top_n)
    ksb = k_sel.reshape(bsz, n_sel, NSA_SEL_BLOCK, G, dh).transpose(0, 3, 1, 2, 4)
    vsb = v_sel.reshape(bsz, n_sel, NSA_SEL_BLOCK, G, dh).transpose(0, 3, 1, 2, 4)
    bi = jnp.arange(bsz)[:, None, None, None]
    gi = jnp.arange(G)[None, :, None, None]
    qbs = NSA_SEL_Q_BLOCK

    def sel_block(qb):
        q0 = qb * qbs
        qblk = lax.dynamic_slice_in_dim(q, q0, qbs, axis=1)
        iblk = lax.dynamic_slice_in_dim(sel_idx, q0, qbs, axis=2)
        kg = ksb[bi, gi, iblk]
        vg = vsb[bi, gi, iblk]
        tq = q0 + jnp.arange(qbs)
        kpos = iblk[..., None] * NSA_SEL_BLOCK + jnp.arange(NSA_SEL_BLOCK)
        m = kpos <= tq[None, None, :, None, None]
        s = jnp.einsum('bqghd,bgqnld->bghqnl', qblk, kg).astype(F32) * scale
        s = jnp.where(m[:, :, None], s, NEG_INF)
        p = jax.nn.softmax(s.reshape(s.shape[:4] + (-1,)), axis=-1).reshape(s.shape)
        return jnp.einsum('bghqnl,bgqnld->bqghd', p.astype(vg.dtype), vg)

    o_sel = lax.map(sel_block, jnp.arange(seq // qbs))
    o_sel = jnp.moveaxis(o_sel, 0, 1).reshape(bsz, seq, G, hg, dh)

    W, qbw = NSA_WINDOW, NSA_WIN_Q_BLOCK
    kwp = jnp.pad(k_win, ((0, 0), (W, 0), (0, 0), (0, 0)))
    vwp = jnp.pad(v_win, ((0, 0), (W, 0), (0, 0), (0, 0)))

    def win_block(qb):
        q0 = qb * qbw
        qblk = lax.dynamic_slice_in_dim(q, q0, qbw, axis=1)
        kblk = lax.dynamic_slice_in_dim(kwp, q0, W + qbw, axis=1)
        vblk = lax.dynamic_slice_in_dim(vwp, q0, W + qbw, axis=1)
        tq = (q0 + jnp.arange(qbw))[:, None]
        tk = (q0 - W + jnp.arange(W + qbw))[None, :]
        m = (tk <= tq) & (tk > tq - W) & (tk >= 0)
        s = jnp.einsum('bqghd,bkgd->bghqk', qblk, kblk).astype(F32) * scale
        p = masked_softmax(s, m)
        return jnp.einsum('bghqk,bkgd->bqghd', p.astype(vblk.dtype), vblk)

    o_win = lax.map(win_block, jnp.arange(seq // qbw))
    o_win = jnp.moveaxis(o_win, 0, 1).reshape(bsz, seq, G, hg, dh)

    g = jax.nn.sigmoid(gates.astype(F32)).astype(q.dtype).reshape(bsz, seq, G, hg, 3)
    o = g[..., 0:1] * o_cmp + g[..., 1:2] * o_sel + g[..., 2:3] * o_win
    return o.reshape(bsz, seq, NSA_WIDTH)


def rope_angles(positions):
    inv = 1.0 / (ROPE_THETA ** (jnp.arange(0, MLA_ROPE, 2, dtype=F32) / MLA_ROPE))
    ang = positions.astype(F32)[..., None] * inv
    return jnp.cos(ang), jnp.sin(ang)


def apply_rope(t, cos, sin):
    t1, t2 = jnp.split(t.astype(F32), 2, axis=-1)
    return jnp.concatenate([t1 * cos - t2 * sin, t1 * sin + t2 * cos], -1).astype(t.dtype)


def mla_mixer(c_q, c_kv, k_rope, positions, q_norm_w, w_uq, kv_norm_w, w_ukv):
    bsz, seq, _ = c_q.shape
    H = MLA_HEADS
    q = (rms_norm(c_q, q_norm_w) @ w_uq).reshape(bsz, seq, H, MLA_NOPE + MLA_ROPE)
    q_nope, q_rope = jnp.split(q, [MLA_NOPE], axis=-1)
    kv = (rms_norm(c_kv, kv_norm_w) @ w_ukv).reshape(bsz, seq, H, MLA_NOPE + MLA_V)
    k_nope, v = jnp.split(kv, [MLA_NOPE], axis=-1)
    cos, sin = rope_angles(positions)
    q_rope = apply_rope(q_rope, cos[:, :, None], sin[:, :, None])
    k_rope = apply_rope(k_rope, cos, sin)
    scale = (MLA_NOPE + MLA_ROPE) ** -0.5
    qb_len = ATTN_Q_BLOCK
    kidx = jnp.arange(seq)[None, :]

    def attn_block(qb):
        q0 = qb * qb_len
        qn = lax.dynamic_slice_in_dim(q_nope, q0, qb_len, axis=1)
        qr = lax.dynamic_slice_in_dim(q_rope, q0, qb_len, axis=1)
        s = (jnp.einsum('bqhd,bkhd->bhqk', qn, k_nope)
             + jnp.einsum('bqhd,bkd->bhqk', qr, k_rope)).astype(F32) * scale
        m = kidx <= (q0 + jnp.arange(qb_len))[:, None]
        p = masked_softmax(s, m)
        return jnp.einsum('bhqk,bkhd->bqhd', p.astype(v.dtype), v)

    o = lax.map(attn_block, jnp.arange(seq // qb_len))
    return jnp.moveaxis(o, 0, 1).reshape(bsz, seq, H * MLA_V)


def chunk_gated_linear(q, k, v, log_f):
    bsz, seq, nh, dk = q.shape
    dv = v.shape[-1]
    C = HGRN_CHUNK
    nc = seq // C
    q, k, log_f = [t.reshape(bsz, nc, C, nh, dk) for t in (q, k, log_f)]
    v = v.reshape(bsz, nc, C, nh, dv)
    b = jnp.cumsum(log_f, axis=2)
    b_last = b[:, :, -1:]
    q_t = q * jnp.exp(b)
    k_t = k * jnp.exp(-b)
    k_end = k * jnp.exp(b_last - b)
    att = jnp.einsum('bnthd,bnshd->bnhts', q_t, k_t)
    att = jnp.where(jnp.tril(jnp.ones((C, C), bool)), att, 0.0)
    o_intra = jnp.einsum('bnhts,bnshv->bnthv', att, v)
    d_state = jnp.einsum('bnshd,bnshv->bnhdv', k_end, v)
    decay = jnp.exp(b_last[:, :, 0])

    def step(s_prev, inp):
        d_n, ds_n = inp
        return d_n[..., None] * s_prev + ds_n, s_prev

    _, s_start = lax.scan(step, jnp.zeros((bsz, nh, dk, dv), F32),
                          (jnp.moveaxis(decay, 1, 0), jnp.moveaxis(d_state, 1, 0)))
    s_start = jnp.moveaxis(s_start, 0, 1)
    o_inter = jnp.einsum('bnthd,bnhdv->bnthv', q_t, s_start)
    return (o_intra + o_inter).reshape(bsz, seq, nh, dv)


def hgrn2_mixer(h_q, h_f, h_i, h_g, lb, norm_w):
    bsz, seq, _ = h_q.shape
    q = jax.nn.silu(h_q.astype(F32)).reshape(bsz, seq, HGRN_HEADS, HGRN_KEY)
    hf = h_f.astype(F32)
    f = lb + (1.0 - lb) * jax.nn.sigmoid(hf)
    k = ((1.0 - lb) * jax.nn.sigmoid(-hf)).reshape(bsz, seq, HGRN_HEADS, HGRN_KEY)
    log_f = jnp.log(f).reshape(bsz, seq, HGRN_HEADS, HGRN_KEY)
    v = h_i.astype(F32).reshape(bsz, seq, HGRN_HEADS, HGRN_VAL)
    o = chunk_gated_linear(q, k, v, log_f)
    o = rms_norm(o, norm_w.astype(F32)).reshape(bsz, seq, HGRN_WIDTH).astype(h_g.dtype)
    return o * jax.nn.silu(h_g)


def mixer_ab(x, w_in, conv_w, conv_b, dt_bias, a_log, d_skip, norm_w, cmp_pos, cmp_w, w_out):
    z, xbc, dt_raw, q, kv, gates = split_cols(x @ w_in, AB_SIZES)
    y_a = mamba2_mixer(z, xbc, dt_raw, conv_w, conv_b, dt_bias, a_log, d_skip, norm_w)
    y_b = nsa_mixer(q, kv, gates, cmp_pos, cmp_w)
    return jnp.concatenate([y_a, y_b], axis=-1) @ w_out


def mixer_cd(x, positions, w_in, q_norm_w, w_uq, kv_norm_w, w_ukv, lb, hgrn_norm_w, w_out):
    c_q, c_kv, k_rope, h_q, h_f, h_i, h_g = split_cols(x @ w_in, CD_SIZES)
    y_c = mla_mixer(c_q, c_kv, k_rope, positions, q_norm_w, w_uq, kv_norm_w, w_ukv)
    y_d = hgrn2_mixer(h_q, h_f, h_i, h_g, lb, hgrn_norm_w)
    return jnp.concatenate([y_c, y_d], axis=-1) @ w_out


def moe_ffn(x, w_router, router_bias, w_gate, w_up, w_down, ws_gate, ws_up, ws_down):
    bsz, seq, d = x.shape
    T = bsz * seq
    E = N_EXPERTS
    xf = x.reshape(T, d)
    scores = jax.nn.sigmoid((xf @ w_router).astype(F32))
    biased = scores + router_bias.astype(F32)
    grp_score = lax.top_k(biased.reshape(T, N_EXPERT_GROUPS, E // N_EXPERT_GROUPS), 2)[0].sum(-1)
    _, top_g = lax.top_k(grp_score, TOP_GROUPS)
    gmask = jnp.any(top_g[..., None] == jnp.arange(N_EXPERT_GROUPS), axis=1)
    masked = jnp.where(jnp.repeat(gmask, E // N_EXPERT_GROUPS, axis=1), biased, -jnp.inf)
    _, top_e = lax.top_k(masked, TOP_K)
    w = jnp.take_along_axis(scores, top_e, axis=1)
    w = w / jnp.sum(w, -1, keepdims=True) * ROUTED_SCALE
    A = T * TOP_K
    M = MOE_ROW_BLOCK
    NB = -(-A // M) + E
    P = NB * M
    flat_e = top_e.reshape(A)
    flat_tok = jnp.arange(A, dtype=jnp.int32) // TOP_K
    flat_w = w.reshape(A)
    order = jnp.argsort(flat_e)
    se = flat_e[order]
    counts = jnp.zeros((E,), jnp.int32).at[flat_e].add(1)
    starts = jnp.cumsum(counts) - counts
    pcounts = (counts + M - 1) // M * M
    pends = jnp.cumsum(pcounts)
    pstarts = pends - pcounts
    dest = pstarts[se] + (jnp.arange(A, dtype=jnp.int32) - starts[se])
    row_tok = jnp.full((P,), T, jnp.int32).at[dest].set(flat_tok[order])
    row_w = jnp.zeros((P,), F32).at[dest].set(flat_w[order])
    blk_e = jnp.minimum(jnp.searchsorted(pends, jnp.arange(NB, dtype=jnp.int32) * M, side='right'), E - 1)
    x_pad = jnp.concatenate([xf, jnp.zeros((1, d), xf.dtype)], axis=0)

    def body(i, acc):
        rows = lax.dynamic_slice_in_dim(row_tok, i * M, M)
        rw = lax.dynamic_slice_in_dim(row_w, i * M, M)
        e = blk_e[i]
        xb = x_pad[rows]
        h = jax.nn.silu(xb @ w_gate[e]) * (xb @ w_up[e])
        return acc.at[rows].add((h @ w_down[e]) * rw[:, None].astype(h.dtype))

    routed = lax.fori_loop(0, NB, body, jnp.zeros((T + 1, d), x.dtype))[:T]
    shared = (jax.nn.silu(xf @ ws_gate) * (xf @ ws_up)) @ ws_down
    return (shared + routed).reshape(bsz, seq, d)


def setup_inputs(seed: int = 0) -> dict:
    key = jax.random.key(seed)
    ks = iter(jax.random.split(key, 40))

    def nrm(shape, scale):
        return jax.random.normal(next(ks), shape, F32) * scale

    def gain(shape):
        return 1.0 + 0.02 * jax.random.normal(next(ks), shape, F32)

    x = jax.random.normal(next(ks), (BATCH, SEQ, D_MODEL), F32)
    offs = jax.random.randint(next(ks), (BATCH, 1), 0, 1024, jnp.int32)
    positions = offs + jnp.arange(SEQ, dtype=jnp.int32)[None, :]
    u = jax.random.uniform(next(ks), (N_EVEN, SSM_HEADS), F32)
    dt0 = jnp.exp(u * (math.log(0.1) - math.log(1e-3)) + math.log(1e-3))
    ssm_dt_bias = dt0 + jnp.log(-jnp.expm1(-dt0))
    ssm_a_log = jnp.log(jax.random.uniform(next(ks), (N_EVEN, SSM_HEADS), F32, 1.0, 16.0))
    return {
        'x': x,
        'positions': positions,
        'ab_w_in': nrm((N_EVEN, D_MODEL, AB_IN), D_MODEL ** -0.5),
        'ssm_conv_w': nrm((N_EVEN, SSM_CONV, SSM_CONV_DIM), SSM_CONV ** -0.5),
        'ssm_conv_b': nrm((N_EVEN, SSM_CONV_DIM), 0.01),
        'ssm_dt_bias': ssm_dt_bias,
        'ssm_a_log': ssm_a_log,
        'ssm_d': gain((N_EVEN, SSM_HEADS)),
        'ssm_norm_w': gain((N_EVEN, SSM_INNER)),
        'nsa_cmp_pos': nrm((N_EVEN, 2, NSA_CMP_BLOCK, NSA_HEAD_DIM), 0.02),
        'nsa_cmp_w': nrm((N_EVEN, 2, NSA_CMP_BLOCK * NSA_HEAD_DIM, NSA_HEAD_DIM), (NSA_CMP_BLOCK * NSA_HEAD_DIM) ** -0.5),
        'ab_w_out': nrm((N_EVEN, AB_MIX, D_MODEL), DN_BETA * AB_MIX ** -0.5),
        'cd_w_in': nrm((N_ODD, D_MODEL, CD_IN), D_MODEL ** -0.5),
        'mla_q_norm_w': gain((N_ODD, MLA_Q_RANK)),
        'mla_w_uq': nrm((N_ODD, MLA_Q_RANK, MLA_HEADS * (MLA_NOPE + MLA_ROPE)), MLA_Q_RANK ** -0.5),
        'mla_kv_norm_w': gain((N_ODD, MLA_KV_RANK)),
        'mla_w_ukv': nrm((N_ODD, MLA_KV_RANK, MLA_HEADS * (MLA_NOPE + MLA_V)), MLA_KV_RANK ** -0.5),
        'hgrn_lb_logits': nrm((DEPTH, HGRN_FDIM), 0.1),
        'hgrn_norm_w': gain((N_ODD, HGRN_VAL)),
        'cd_w_out': nrm((N_ODD, CD_MIX, D_MODEL), DN_BETA * CD_MIX ** -0.5),
        'ln_g': gain((DEPTH, 2, D_MODEL)),
        'ln_b': nrm((DEPTH, 2, D_MODEL), 0.01),
        'moe_w_router': nrm((DEPTH, D_MODEL, N_EXPERTS), D_MODEL ** -0.5),
        'moe_router_bias': nrm((DEPTH, N_EXPERTS), 0.01),
        'moe_w_gate': nrm((DEPTH, N_EXPERTS, D_MODEL, EXPERT_FF), D_MODEL ** -0.5),
        'moe_w_up': nrm((DEPTH, N_EXPERTS, D_MODEL, EXPERT_FF), D_MODEL ** -0.5),
        'moe_w_down': nrm((DEPTH, N_EXPERTS, EXPERT_FF, D_MODEL), DN_BETA * EXPERT_FF ** -0.5),
        'moe_shared_w_gate': nrm((DEPTH, D_MODEL, SHARED_FF), D_MODEL ** -0.5),
        'moe_shared_w_up': nrm((DEPTH, D_MODEL, SHARED_FF), D_MODEL ** -0.5),
        'moe_shared_w_down': nrm((DEPTH, SHARED_FF, D_MODEL), DN_BETA * SHARED_FF ** -0.5),
    }


def reference(x, positions, ab_w_in, ssm_conv_w, ssm_conv_b, ssm_dt_bias, ssm_a_log, ssm_d, ssm_norm_w,
              nsa_cmp_pos, nsa_cmp_w, ab_w_out, cd_w_in, mla_q_norm_w, mla_w_uq, mla_kv_norm_w, mla_w_ukv,
              hgrn_lb_logits, hgrn_norm_w, cd_w_out, ln_g, ln_b, moe_w_router, moe_router_bias,
              moe_w_gate, moe_w_up, moe_w_down, moe_shared_w_gate, moe_shared_w_up, moe_shared_w_down):
    lb_all = jnp.cumsum(jax.nn.softmax(hgrn_lb_logits.astype(F32), axis=0), axis=0)
    lb_all = lb_all - lb_all[0]
    for l in range(DEPTH):
        i = l // 2
        if l % 2 == 0:
            mix = mixer_ab(x, ab_w_in[i], ssm_conv_w[i], ssm_conv_b[i], ssm_dt_bias[i], ssm_a_log[i],
                           ssm_d[i], ssm_norm_w[i], nsa_cmp_pos[i], nsa_cmp_w[i], ab_w_out[i])
        else:
            mix = mixer_cd(x, positions, cd_w_in[i], mla_q_norm_w[i], mla_w_uq[i], mla_kv_norm_w[i],
                           mla_w_ukv[i], lb_all[l], hgrn_norm_w[i], cd_w_out[i])
        x = layer_norm(DN_ALPHA * x + mix, ln_g[l, 0], ln_b[l, 0])
        ffn = moe_ffn(x, moe_w_router[l], moe_router_bias[l], moe_w_gate[l], moe_w_up[l], moe_w_down[l],
                      moe_shared_w_gate[l], moe_shared_w_up[l], moe_shared_w_down[l])
        x = layer_norm(DN_ALPHA * x + ffn, ln_g[l, 1], ln_b[l, 1])
    return x
```

```cpp
#include <hip/hip_runtime.h>
#include <stdint.h>

#define DI __device__ __forceinline__

constexpr int T_TOK = 16384, DM = 2048, SEQ = 2048, NB = 8;
constexpr int AB_IN = 8784, CD_IN = 9280;
constexpr int AB_Z = 0, AB_XBC = 2048, AB_DT = 5120, AB_Q = 5152, AB_KV = 7200, AB_G = 8736;
constexpr int CD_CQ = 0, CD_CKV = 512, CD_KR = 1024, CD_HQ = 1088, CD_HF = 3136, CD_HI = 5184, CD_HG = 7232;
constexpr float DN_ALPHA = 1.41421356237309515f;
constexpr int NCMP = 127;
constexpr int MOE_TM = 128;
constexpr int MOE_SLOT_TOK = 8;
constexpr int MOE_NSLOT = T_TOK / MOE_SLOT_TOK;
constexpr int MOE_PMAX = T_TOK * 8 + 64 * MOE_TM;
constexpr int MOE_MAXTILES = MOE_PMAX / MOE_TM;

DI float sigmoidf_(float x) { return 1.f / (1.f + __expf(-x)); }
DI float siluf_(float x) { return x / (1.f + __expf(-x)); }
DI float softplusf_(float x) { return x > 20.f ? x : log1pf(__expf(x)); }

struct GemmArgs {
    const float* A; long lda;
    const float* W; long ldw; long wstride;
    float* C; long ldc;
    int M, N, K;
    const int* row_tok;
    const float* row_w;
    const int* tiles;
    const int* ntiles;
};

template <int MODE>
__global__ __launch_bounds__(256) void k_gemm(GemmArgs g) {
    __shared__ float As[8][132];
    __shared__ float Bs[8][132];
    const int tid = threadIdx.x;
    const int tn = blockIdx.x, tm = blockIdx.y;
    const float* W = g.W;
    long row0 = (long)tm * 128;
    int nrows = 128;
    if (MODE == 0) { nrows = g.M - (int)row0; if (nrows > 128) nrows = 128; }
    else {
        if (tm >= *g.ntiles) return;
        const int e = g.tiles[tm * 4 + 0]; row0 = g.tiles[tm * 4 + 1]; nrows = g.tiles[tm * 4 + 2];
        W += (long)e * g.wstride;
    }
    const int lr = tid >> 1, kq = (tid & 1) * 4;
    const float* arow = nullptr;
    if (lr < nrows) {
        const long r = row0 + lr;
        if (MODE == 1) { const int t = g.row_tok[r]; if (t >= 0) arow = g.A + (long)t * g.lda; }
        else arow = g.A + r * g.lda;
    }
    const int bk = tid >> 5, bn = (tid & 31) * 4;
    const int n0 = tn * 128;
    float acc[8][8];
#pragma unroll
    for (int i = 0; i < 8; ++i)
#pragma unroll
        for (int j = 0; j < 8; ++j) acc[i][j] = 0.f;
    const int ty = tid >> 4, tx = tid & 15;
    for (int k0 = 0; k0 < g.K; k0 += 8) {
        float4 av = make_float4(0.f, 0.f, 0.f, 0.f);
        if (arow) av = *(const float4*)(arow + k0 + kq);
        As[kq + 0][lr] = av.x; As[kq + 1][lr] = av.y; As[kq + 2][lr] = av.z; As[kq + 3][lr] = av.w;
        float4 bv = make_float4(0.f, 0.f, 0.f, 0.f);
        const float* wp = W + (long)(k0 + bk) * g.ldw + n0 + bn;
        if (n0 + bn + 3 < g.N) bv = *(const float4*)wp;
        else {
            if (n0 + bn + 0 < g.N) bv.x = wp[0];
            if (n0 + bn + 1 < g.N) bv.y = wp[1];
            if (n0 + bn + 2 < g.N) bv.z = wp[2];
        }
        *(float4*)&Bs[bk][bn] = bv;
        __syncthreads();
#pragma unroll
        for (int kk = 0; kk < 8; ++kk) {
            float a[8], b[8];
            const float4 a0 = *(const float4*)&As[kk][ty * 8], a1 = *(const float4*)&As[kk][ty * 8 + 4];
            const float4 b0 = *(const float4*)&Bs[kk][tx * 8], b1 = *(const float4*)&Bs[kk][tx * 8 + 4];
            a[0] = a0.x; a[1] = a0.y; a[2] = a0.z; a[3] = a0.w; a[4] = a1.x; a[5] = a1.y; a[6] = a1.z; a[7] = a1.w;
            b[0] = b0.x; b[1] = b0.y; b[2] = b0.z; b[3] = b0.w; b[4] = b1.x; b[5] = b1.y; b[6] = b1.z; b[7] = b1.w;
#pragma unroll
            for (int i = 0; i < 8; ++i)
#pragma unroll
                for (int j = 0; j < 8; ++j) acc[i][j] += a[i] * b[j];
        }
        __syncthreads();
    }
#pragma unroll
    for (int i = 0; i < 8; ++i) {
        const int lrow = ty * 8 + i;
        if (lrow >= nrows) continue;
        const long r = row0 + lrow;
        if (MODE == 2) {
            const int t = g.row_tok[r];
            if (t < 0) continue;
            const float w = g.row_w[r];
#pragma unroll
            for (int j = 0; j < 8; ++j) { const int n = n0 + tx * 8 + j; if (n < g.N) atomicAdd(g.C + (long)t * g.ldc + n, w * acc[i][j]); }
        } else {
#pragma unroll
            for (int j = 0; j < 8; ++j) { const int n = n0 + tx * 8 + j; if (n < g.N) g.C[r * g.ldc + n] = acc[i][j]; }
        }
    }
}

__global__ void k_conv_silu(const float* __restrict__ h, const float* __restrict__ cw, const float* __restrict__ cb, float* __restrict__ xbc) {
    const long idx = (long)blockIdx.x * blockDim.x + threadIdx.x;
    if (idx >= (long)T_TOK * 3072) return;
    const int c = (int)(idx % 3072); const int t = (int)(idx / 3072); const int s = t % SEQ;
    float acc = cb[c];
#pragma unroll
    for (int k = 0; k < 4; ++k) { const int ss = s - 3 + k; if (ss >= 0) acc += cw[k * 3072 + c] * h[(long)(t - 3 + k) * AB_IN + AB_XBC + c]; }
    xbc[idx] = siluf_(acc);
}

__global__ __launch_bounds__(64) void k_ssd_naive(const float* __restrict__ h, const float* __restrict__ xbc, const float* __restrict__ dt_bias,
                                                  const float* __restrict__ a_log, const float* __restrict__ dsk, float* __restrict__ mix) {
    const int b = blockIdx.x / 32, hd = blockIdx.x % 32, p = threadIdx.x, g = hd / 8;
    const float a = -__expf(a_log[hd]), dbias = dt_bias[hd], dskip = dsk[hd];
    float st[128];
#pragma unroll
    for (int n = 0; n < 128; ++n) st[n] = 0.f;
    for (int s = 0; s < SEQ; ++s) {
        const long t = (long)b * SEQ + s;
        const float dtv = softplusf_(h[t * AB_IN + AB_DT + hd] + dbias);
        const float dA = __expf(dtv * a);
        const float xv = xbc[t * 3072 + hd * 64 + p];
        const float xdt = xv * dtv;
        const float* Bp = xbc + t * 3072 + 2048 + g * 128;
        const float* Cp = xbc + t * 3072 + 2560 + g * 128;
        float y = 0.f;
#pragma unroll
        for (int n = 0; n < 128; ++n) { st[n] = st[n] * dA + xdt * Bp[n]; y += Cp[n] * st[n]; }
        y += xv * dskip;
        const float z = h[t * AB_IN + AB_Z + hd * 64 + p];
        mix[t * 4096 + hd * 64 + p] = y * siluf_(z);
    }
}

__global__ __launch_bounds__(256) void k_rmsnorm_rows(float* __restrict__ buf, long ld, int ncols, const float* __restrict__ w, float eps) {
    __shared__ float red[4];
    float* row = buf + (long)blockIdx.x * ld;
    float ss = 0.f;
    for (int c = threadIdx.x; c < ncols; c += 256) { const float v = row[c]; ss += v * v; }
    for (int o = 32; o > 0; o >>= 1) ss += __shfl_xor(ss, o);
    if ((threadIdx.x & 63) == 0) red[threadIdx.x >> 6] = ss;
    __syncthreads();
    const float tot = red[0] + red[1] + red[2] + red[3];
    const float r = rsqrtf(tot / ncols + eps);
    for (int c = threadIdx.x; c < ncols; c += 256) row[c] = row[c] * r * w[c];
}

__global__ __launch_bounds__(256) void k_rmsnorm_copy(const float* __restrict__ src, long lds_, int ncols, const float* __restrict__ w, float eps, float* __restrict__ dst, long ldd) {
    __shared__ float red[4];
    const float* row = src + (long)blockIdx.x * lds_;
    float ss = 0.f;
    for (int c = threadIdx.x; c < ncols; c += 256) { const float v = row[c]; ss += v * v; }
    for (int o = 32; o > 0; o >>= 1) ss += __shfl_xor(ss, o);
    if ((threadIdx.x & 63) == 0) red[threadIdx.x >> 6] = ss;
    __syncthreads();
    const float tot = red[0] + red[1] + red[2] + red[3];
    const float r = rsqrtf(tot / ncols + eps);
    for (int c = threadIdx.x; c < ncols; c += 256) dst[(long)blockIdx.x * ldd + c] = row[c] * r * w[c];
}

__global__ __launch_bounds__(128) void k_compress(const float* __restrict__ h, const float* __restrict__ pos, const float* __restrict__ w, float* __restrict__ out, int which) {
    const int e = threadIdx.x; int r = blockIdx.x; const int g = r % 2; r /= 2; const int i = r % NCMP; const int b = r / NCMP;
    const float* p = pos + (long)which * 32 * 128;
    const float* ww = w + (long)which * 4096 * 128;
    float acc = 0.f;
    for (int l = 0; l < 32; ++l) {
        const float* src = h + ((long)b * SEQ + 16 * i + l) * AB_IN + AB_KV + which * 256 + g * 128;
        for (int d = 0; d < 128; ++d) acc += (src[d] + p[l * 128 + d]) * ww[(long)(l * 128 + d) * 128 + e];
    }
    out[(((long)b * NCMP + i) * 2 + g) * 128 + e] = acc;
}

DI float dot128(const float* __restrict__ q, const float* __restrict__ k) {
    float a = 0.f;
#pragma unroll 8
    for (int d = 0; d < 128; d += 4) { const float4 kv = *(const float4*)(k + d); a += q[d] * kv.x + q[d + 1] * kv.y + q[d + 2] * kv.z + q[d + 3] * kv.w; }
    return a;
}

DI void softmax8(float (*sc)[512], int n, int tid) {
    const int hh = tid >> 5, l = tid & 31;
    float m = -3.0e38f;
    for (int i = l; i < n; i += 32) m = fmaxf(m, sc[hh][i]);
    for (int o = 16; o > 0; o >>= 1) m = fmaxf(m, __shfl_xor(m, o));
    float s = 0.f;
    for (int i = l; i < n; i += 32) { const float e = __expf(sc[hh][i] - m); sc[hh][i] = e; s += e; }
    for (int o = 16; o > 0; o >>= 1) s += __shfl_xor(s, o);
    const float inv = 1.f / s;
    for (int i = l; i < n; i += 32) sc[hh][i] *= inv;
}

__global__ __launch_bounds__(256) void k_nsa_naive(const float* __restrict__ h, const float* __restrict__ kc, const float* __restrict__ vc, float* __restrict__ mix) {
    __shared__ float qs[8][128];
    __shared__ float sc[8][512];
    __shared__ float imp[32];
    __shared__ int sel[8];
    const int tid = threadIdx.x;
    int r = blockIdx.x; const int s = r % SEQ; r /= SEQ; const int g = r % 2; const int b = r / 2;
    const long t = (long)b * SEQ + s;
    const float scale = 0.08838834764831845f;
    for (int i = tid; i < 1024; i += 256) qs[i >> 7][i & 127] = h[t * AB_IN + AB_Q + g * 1024 + i];
    __syncthreads();
    const int nvis = s >= 31 ? (s - 31) / 16 + 1 : 0;
    for (int idx = tid; idx < 8 * 128; idx += 256) {
        const int hh = idx >> 7, i = idx & 127;
        if (i < nvis) sc[hh][i] = scale * dot128(qs[hh], kc + (((long)b * NCMP + i) * 2 + g) * 128);
        else sc[hh][i] = 0.f;
    }
    __syncthreads();
    if (nvis > 0) softmax8(sc, nvis, tid);
    __syncthreads();
    float ocmp[4];
#pragma unroll
    for (int rr = 0; rr < 4; ++rr) {
        const int idx = tid + 256 * rr, hh = idx >> 7, d = idx & 127;
        float a = 0.f;
        for (int i = 0; i < nvis; ++i) a += sc[hh][i] * vc[(((long)b * NCMP + i) * 2 + g) * 128 + d];
        ocmp[rr] = a;
    }
    if (tid < 32) {
        const int j = tid; float a = 0.f;
        for (int hh = 0; hh < 8; ++hh) {
            a += sc[hh][4 * j] + sc[hh][4 * j + 1] + sc[hh][4 * j + 2];
            if (4 * j + 3 < NCMP) a += 0.5f * sc[hh][4 * j + 3];
            if (j > 0) a += 0.5f * sc[hh][4 * j - 1];
        }
        const int cur = s / 64;
        const bool forced = (j == 0) || (j == cur) || (j == cur - 1);
        imp[j] = forced ? 1.0e6f : (j <= cur ? a : -1.0f);
    }
    __syncthreads();
    if (tid == 0) {
        unsigned taken = 0u;
        for (int n = 0; n < 8; ++n) {
            int best = -1; float bv = 0.f;
            for (int j = 0; j < 32; ++j) { if (taken & (1u << j)) continue; if (best < 0 || imp[j] > bv) { best = j; bv = imp[j]; } }
            taken |= 1u << best; sel[n] = best;
        }
    }
    __syncthreads();
    for (int idx = tid; idx < 8 * 512; idx += 256) {
        const int hh = idx >> 9, kk = idx & 511, n = kk >> 6, l = kk & 63;
        const int kpos = sel[n] * 64 + l;
        sc[hh][kk] = (kpos <= s) ? scale * dot128(qs[hh], h + ((long)b * SEQ + kpos) * AB_IN + AB_KV + 2 * 256 + g * 128) : -1.0e30f;
    }
    __syncthreads();
    softmax8(sc, 512, tid);
    __syncthreads();
    float osel[4];
#pragma unroll
    for (int rr = 0; rr < 4; ++rr) {
        const int idx = tid + 256 * rr, hh = idx >> 7, d = idx & 127;
        float a = 0.f;
        for (int kk = 0; kk < 512; ++kk) {
            const int kpos = sel[kk >> 6] * 64 + (kk & 63);
            if (kpos <= s) a += sc[hh][kk] * h[((long)b * SEQ + kpos) * AB_IN + AB_KV + 3 * 256 + g * 128 + d];
        }
        osel[rr] = a;
    }
    __syncthreads();
    for (int idx = tid; idx < 8 * 512; idx += 256) {
        const int hh = idx >> 9, kk = idx & 511;
        const int kpos = s - 511 + kk;
        sc[hh][kk] = (kpos >= 0) ? scale * dot128(qs[hh], h + ((long)b * SEQ + kpos) * AB_IN + AB_KV + 4 * 256 + g * 128) : -1.0e30f;
    }
    __syncthreads();
    softmax8(sc, 512, tid);
    __syncthreads();
#pragma unroll
    for (int rr = 0; rr < 4; ++rr) {
        const int idx = tid + 256 * rr, hh = idx >> 7, d = idx & 127;
        float a = 0.f;
        for (int kk = 0; kk < 512; ++kk) {
            const int kpos = s - 511 + kk;
            if (kpos >= 0) a += sc[hh][kk] * h[((long)b * SEQ + kpos) * AB_IN + AB_KV + 5 * 256 + g * 128 + d];
        }
        const float* gp = h + t * AB_IN + AB_G + (g * 8 + hh) * 3;
        const float o = sigmoidf_(gp[0]) * ocmp[rr] + sigmoidf_(gp[1]) * osel[rr] + sigmoidf_(gp[2]) * a;
        mix[t * 4096 + 2048 + (g * 8 + hh) * 128 + d] = o;
    }
}

__global__ __launch_bounds__(256) void k_resid_ln(const float* xin, const float* __restrict__ add, const float* __restrict__ gg, const float* __restrict__ bb, float* out) {
    __shared__ float red[8];
    const long row = blockIdx.x;
    float v[8]; float s = 0.f;
#pragma unroll
    for (int i = 0; i < 8; ++i) { const int c = threadIdx.x + 256 * i; v[i] = DN_ALPHA * xin[row * DM + c] + add[row * DM + c]; s += v[i]; }
    for (int o = 32; o > 0; o >>= 1) s += __shfl_xor(s, o);
    if ((threadIdx.x & 63) == 0) red[threadIdx.x >> 6] = s;
    __syncthreads();
    const float mu = (red[0] + red[1] + red[2] + red[3]) / DM;
    float q = 0.f;
#pragma unroll
    for (int i = 0; i < 8; ++i) { const float d = v[i] - mu; q += d * d; }
    for (int o = 32; o > 0; o >>= 1) q += __shfl_xor(q, o);
    if ((threadIdx.x & 63) == 0) red[4 + (threadIdx.x >> 6)] = q;
    __syncthreads();
    const float var = (red[4] + red[5] + red[6] + red[7]) / DM;
    const float rs = rsqrtf(var + 1e-5f);
#pragma unroll
    for (int i = 0; i < 8; ++i) { const int c = threadIdx.x + 256 * i; out[row * DM + c] = (v[i] - mu) * rs * gg[c] + bb[c]; }
}

__global__ __launch_bounds__(256) void k_router(const float* __restrict__ x1, const float* __restrict__ wr, const float* __restrict__ rbias,
                                                int* __restrict__ top_e, float* __restrict__ top_w, int* __restrict__ lpos, int* __restrict__ cnt_tab) {
    const int lane = threadIdx.x & 63;
    const int gw = (blockIdx.x * blockDim.x + threadIdx.x) >> 6, nw = (gridDim.x * blockDim.x) >> 6;
    const float bias = rbias[lane];
    const int grp = lane >> 3;
    for (int slot = gw; slot < MOE_NSLOT; slot += nw) {
        int cnt = 0;
        for (int i = 0; i < MOE_SLOT_TOK; ++i) {
            const int t = slot * MOE_SLOT_TOK + i;
            const float* xr = x1 + (long)t * DM;
            float logit = 0.f;
            for (int k = 0; k < DM; k += 4) {
                const float4 xv = *(const float4*)(xr + k);
                logit += xv.x * wr[(long)(k + 0) * 64 + lane];
                logit += xv.y * wr[(long)(k + 1) * 64 + lane];
                logit += xv.z * wr[(long)(k + 2) * 64 + lane];
                logit += xv.w * wr[(long)(k + 3) * 64 + lane];
            }
            const float score = 1.f / (1.f + expf(-logit));
            const float biased = score + bias;
            float m1 = biased;
            m1 = fmaxf(m1, __shfl_xor(m1, 1)); m1 = fmaxf(m1, __shfl_xor(m1, 2)); m1 = fmaxf(m1, __shfl_xor(m1, 4));
            const unsigned long long bm = __ballot(biased == m1);
            const unsigned gb = (unsigned)((bm >> (8 * grp)) & 0xffull);
            const int first = __ffs(gb) - 1;
            float v2 = ((lane & 7) == first) ? -3.0e38f : biased;
            v2 = fmaxf(v2, __shfl_xor(v2, 1)); v2 = fmaxf(v2, __shfl_xor(v2, 2)); v2 = fmaxf(v2, __shfl_xor(v2, 4));
            const float gs = m1 + v2;
            int grank = 0;
#pragma unroll
            for (int g2 = 0; g2 < 8; ++g2) { const float o = __shfl(gs, g2 * 8); grank += (o > gs || (o == gs && g2 < grp)) ? 1 : 0; }
            const bool gsel = grank < 4;
            const float masked = gsel ? biased : -3.0e38f;
            int erank = 0;
            for (int e2 = 0; e2 < 64; ++e2) { const float o = __shfl(masked, e2); erank += (o > masked || (o == masked && e2 < lane)) ? 1 : 0; }
            const bool selected = gsel && erank < 8;
            float ws = selected ? score : 0.f;
            for (int o = 32; o > 0; o >>= 1) ws += __shfl_xor(ws, o);
            if (selected) {
                top_e[t * 8 + erank] = lane;
                top_w[t * 8 + erank] = score / ws * 2.5f;
                lpos[t * 8 + erank] = cnt;
                ++cnt;
            }
        }
        cnt_tab[slot * 64 + lane] = cnt;
    }
}

__global__ __launch_bounds__(256) void k_moe_scan(const int* __restrict__ cnt_tab, const int* __restrict__ top_e, const float* __restrict__ top_w, const int* __restrict__ lpos,
                                                  int* __restrict__ row_tok, float* __restrict__ row_w, int* __restrict__ pos_tab, int* __restrict__ tiles, int* __restrict__ ntiles) {
    __shared__ int part_b[4][64], part_a[4][64];
    __shared__ int total[64], base[64], pre[64], pc[64];
    const int tid = threadIdx.x, e = tid & 63, part = tid >> 6;
    const int spb = (MOE_NSLOT + gridDim.x - 1) / gridDim.x;
    const int s0 = blockIdx.x * spb, s1 = min(MOE_NSLOT, s0 + spb);
    int sb = 0, sa = 0;
    for (int sl = part; sl < MOE_NSLOT; sl += 4) { const int c = cnt_tab[sl * 64 + e]; sa += c; if (sl < s0) sb += c; }
    part_b[part][e] = sb; part_a[part][e] = sa;
    __syncthreads();
    if (tid < 64) {
        total[tid] = part_a[0][tid] + part_a[1][tid] + part_a[2][tid] + part_a[3][tid];
        pre[tid] = part_b[0][tid] + part_b[1][tid] + part_b[2][tid] + part_b[3][tid];
        pc[tid] = (total[tid] + MOE_TM - 1) / MOE_TM * MOE_TM;
    }
    __syncthreads();
    if (tid == 0) { int a = 0; for (int i = 0; i < 64; ++i) { base[i] = a; a += pc[i]; } }
    __syncthreads();
    for (int sl = s0; sl < s1; ++sl) {
        if (tid < 64) {
            const int t = sl * MOE_SLOT_TOK + (tid >> 3), k = tid & 7;
            const int ex = top_e[t * 8 + k];
            const int p = base[ex] + pre[ex] + lpos[t * 8 + k];
            row_tok[p] = t; row_w[p] = top_w[t * 8 + k]; pos_tab[t * 8 + k] = p;
        }
        __syncthreads();
        if (tid < 64) pre[tid] += cnt_tab[sl * 64 + tid];
        __syncthreads();
    }
    for (int ex = blockIdx.x; ex < 64; ex += gridDim.x)
        for (int p = base[ex] + total[ex] + tid; p < base[ex] + pc[ex]; p += 256) { row_tok[p] = -1; row_w[p] = 0.f; }
    if (blockIdx.x == 0) {
        if (tid < 64) {
            const int ex = tid, nt = pc[ex] / MOE_TM, t0 = base[ex] / MOE_TM;
            for (int j = 0; j < nt; ++j) {
                tiles[(t0 + j) * 4 + 0] = ex; tiles[(t0 + j) * 4 + 1] = base[ex] + j * MOE_TM;
                tiles[(t0 + j) * 4 + 2] = min(MOE_TM, total[ex] - j * MOE_TM); tiles[(t0 + j) * 4 + 3] = 0;
            }
            if (ex == 63) *ntiles = (base[63] + pc[63]) / MOE_TM;
        }
    }
}

__global__ void k_silu_mul(float* __restrict__ g, const float* __restrict__ u, long n) {
    const long i = (long)blockIdx.x * blockDim.x + threadIdx.x;
    if (i < n) g[i] = siluf_(g[i]) * u[i];
}

__global__ void k_rope(float* __restrict__ qm, const float* __restrict__ h, const int* __restrict__ positions, float* __restrict__ kr) {
    const long idx = (long)blockIdx.x * blockDim.x + threadIdx.x;
    if (idx >= (long)T_TOK * 17 * 32) return;
    const int j = (int)(idx % 32); const int hh = (int)((idx / 32) % 17); const int t = (int)(idx / (32 * 17));
    const float inv = powf(10000.f, -(float)(2 * j) / 64.f);
    const float ang = (float)positions[t] * inv;
    const float c = cosf(ang), sn = sinf(ang);
    if (hh < 16) {
        float* p = qm + (long)t * 3072 + hh * 192 + 128;
        const float t1 = p[j], t2 = p[j + 32];
        p[j] = t1 * c - t2 * sn; p[j + 32] = t1 * sn + t2 * c;
    } else {
        const float* p = h + (long)t * CD_IN + CD_KR;
        const float t1 = p[j], t2 = p[j + 32];
        kr[(long)t * 64 + j] = t1 * c - t2 * sn; kr[(long)t * 64 + j + 32] = t1 * sn + t2 * c;
    }
}

__global__ __launch_bounds__(256) void k_mla_naive(const float* __restrict__ qm, const float* __restrict__ kvm, const float* __restrict__ kr, float* __restrict__ mix) {
    __shared__ float q[192];
    __shared__ float sc[2048];
    __shared__ float red[8];
    __shared__ float osum[2][128];
    const int tid = threadIdx.x;
    int r = blockIdx.x; const int s = r % SEQ; r /= SEQ; const int hh = r % 16; const int b = r / 16;
    const long t = (long)b * SEQ + s;
    if (tid < 192) q[tid] = qm[t * 3072 + hh * 192 + tid];
    __syncthreads();
    const float scale = 0.07216878364870322f;
    float m = -3.0e38f;
    for (int k = tid; k <= s; k += 256) {
        const long tk = (long)b * SEQ + k;
        float a = dot128(q, kvm + tk * 4096 + hh * 256);
        const float* krp = kr + tk * 64;
#pragma unroll 8
        for (int d = 0; d < 64; ++d) a += q[128 + d] * krp[d];
        a *= scale; sc[k] = a; m = fmaxf(m, a);
    }
    for (int o = 32; o > 0; o >>= 1) m = fmaxf(m, __shfl_xor(m, o));
    if ((tid & 63) == 0) red[tid >> 6] = m;
    __syncthreads();
    m = fmaxf(fmaxf(red[0], red[1]), fmaxf(red[2], red[3]));
    float sm = 0.f;
    for (int k = tid; k <= s; k += 256) { const float e = __expf(sc[k] - m); sc[k] = e; sm += e; }
    for (int o = 32; o > 0; o >>= 1) sm += __shfl_xor(sm, o);
    if ((tid & 63) == 0) red[4 + (tid >> 6)] = sm;
    __syncthreads();
    const float inv = 1.f / (red[4] + red[5] + red[6] + red[7]);
    const int d = tid & 127, half = tid >> 7;
    float a = 0.f;
    for (int k = half; k <= s; k += 2) a += sc[k] * kvm[((long)b * SEQ + k) * 4096 + hh * 256 + 128 + d];
    osum[half][d] = a;
    __syncthreads();
    if (tid < 128) mix[t * 4096 + hh * 128 + tid] = (osum[0][tid] + osum[1][tid]) * inv;
}

__global__ __launch_bounds__(128) void k_hgrn_naive(const float* __restrict__ h, const float* __restrict__ lb_logits, float* __restrict__ obuf) {
    __shared__ float qs[128], fs[128], ks[128];
    const int b = blockIdx.x / 16, hh = blockIdx.x % 16, v = threadIdx.x;
    const int c = hh * 128 + v;
    const float l0 = lb_logits[c], l1 = lb_logits[2048 + c];
    const float lb = 1.f / (1.f + expf(l0 - l1));
    float st[128];
#pragma unroll
    for (int d = 0; d < 128; ++d) st[d] = 0.f;
    for (int s = 0; s < SEQ; ++s) {
        const long t = (long)b * SEQ + s;
        const float hq = h[t * CD_IN + CD_HQ + c], hf = h[t * CD_IN + CD_HF + c], hi = h[t * CD_IN + CD_HI + c];
        __syncthreads();
        qs[v] = siluf_(hq);
        fs[v] = lb + (1.f - lb) * sigmoidf_(hf);
        ks[v] = (1.f - lb) * sigmoidf_(-hf);
        __syncthreads();
        float o = 0.f;
#pragma unroll
        for (int d = 0; d < 128; ++d) { st[d] = st[d] * fs[d] + ks[d] * hi; o += qs[d] * st[d]; }
        obuf[t * 2048 + c] = o;
    }
}

__global__ __launch_bounds__(128) void k_hgrn_post(const float* __restrict__ obuf, const float* __restrict__ h, const float* __restrict__ nw, float* __restrict__ mix) {
    __shared__ float red[2];
    const long t = blockIdx.x / 16; const int hh = blockIdx.x % 16, v = threadIdx.x;
    const float o = obuf[t * 2048 + hh * 128 + v];
    float ss = o * o;
    for (int of = 32; of > 0; of >>= 1) ss += __shfl_xor(ss, of);
    if ((v & 63) == 0) red[v >> 6] = ss;
    __syncthreads();
    const float r = rsqrtf((red[0] + red[1]) / 128.f + 1e-6f);
    const float gte = h[t * CD_IN + CD_HG + hh * 128 + v];
    mix[t * 4096 + 2048 + hh * 128 + v] = o * r * nw[v] * siluf_(gte);
}

static void gemm_dense(hipStream_t st, const float* A, long lda, const float* W, long ldw, float* C, long ldc, int M, int N, int K) {
    GemmArgs g{}; g.A = A; g.lda = lda; g.W = W; g.ldw = ldw; g.wstride = 0; g.C = C; g.ldc = ldc; g.M = M; g.N = N; g.K = K;
    dim3 grid((N + 127) / 128, (M + 127) / 128);
    hipLaunchKernelGGL(k_gemm<0>, grid, dim3(256), 0, st, g);
}

struct MoeBufs { int* top_e; float* top_w; int* lpos; int* cnt_tab; int* row_tok; float* row_w; int* pos_tab; int* tiles; int* ntiles; float* G; float* U; };

static void moe_layer(hipStream_t st, const MoeBufs& mb, const float* x1, float* ffn, const float* w_router, const float* rbias,
                      const float* wg, const float* wu, const float* wd, const float* sg, const float* su, const float* sd) {
    hipLaunchKernelGGL(k_router, dim3(512), dim3(256), 0, st, x1, w_router, rbias, mb.top_e, mb.top_w, mb.lpos, mb.cnt_tab);
    hipLaunchKernelGGL(k_moe_scan, dim3(256), dim3(256), 0, st, mb.cnt_tab, mb.top_e, mb.top_w, mb.lpos, mb.row_tok, mb.row_w, mb.pos_tab, mb.tiles, mb.ntiles);
    for (int which = 0; which < 2; ++which) {
        GemmArgs g{}; g.A = x1; g.lda = DM; g.W = which ? wu : wg; g.ldw = 512; g.wstride = (long)DM * 512; g.C = which ? mb.U : mb.G; g.ldc = 512;
        g.M = MOE_PMAX; g.N = 512; g.K = DM; g.row_tok = mb.row_tok; g.row_w = mb.row_w; g.tiles = mb.tiles; g.ntiles = mb.ntiles;
        hipLaunchKernelGGL(k_gemm<1>, dim3(4, MOE_MAXTILES), dim3(256), 0, st, g);
    }
    gemm_dense(st, x1, DM, sg, 512, mb.G + (long)MOE_PMAX * 512, 512, T_TOK, 512, DM);
    gemm_dense(st, x1, DM, su, 512, mb.U + (long)MOE_PMAX * 512, 512, T_TOK, 512, DM);
    {
        const long n = (long)(MOE_PMAX + T_TOK) * 512;
        hipLaunchKernelGGL(k_silu_mul, dim3((unsigned)((n + 255) / 256)), dim3(256), 0, st, mb.G, mb.U, n);
    }
    gemm_dense(st, mb.G + (long)MOE_PMAX * 512, 512, sd, DM, ffn, DM, T_TOK, DM, 512);
    {
        GemmArgs g{}; g.A = mb.G; g.lda = 512; g.W = wd; g.ldw = DM; g.wstride = (long)512 * DM; g.C = ffn; g.ldc = DM;
        g.M = MOE_PMAX; g.N = DM; g.K = 512; g.row_tok = mb.row_tok; g.row_w = mb.row_w; g.tiles = mb.tiles; g.ntiles = mb.ntiles;
        hipLaunchKernelGGL(k_gemm<2>, dim3(16, MOE_MAXTILES), dim3(256), 0, st, g);
    }
}

extern "C" void kernel_launch(void* const* d_in, const int* in_sizes, int n_in, void* d_out, int out_size, void* d_ws, size_t ws_size, hipStream_t stream) {
    const float* x = (const float*)d_in[0];
    const int* positions = (const int*)d_in[1];
    const float* ab_w_in = (const float*)d_in[2];
    const float* ssm_conv_w = (const float*)d_in[3];
    const float* ssm_conv_b = (const float*)d_in[4];
    const float* ssm_dt_bias = (const float*)d_in[5];
    const float* ssm_a_log = (const float*)d_in[6];
    const float* ssm_d = (const float*)d_in[7];
    const float* ssm_norm_w = (const float*)d_in[8];
    const float* nsa_cmp_pos = (const float*)d_in[9];
    const float* nsa_cmp_w = (const float*)d_in[10];
    const float* ab_w_out = (const float*)d_in[11];
    const float* cd_w_in = (const float*)d_in[12];
    const float* mla_q_norm_w = (const float*)d_in[13];
    const float* mla_w_uq = (const float*)d_in[14];
    const float* mla_kv_norm_w = (const float*)d_in[15];
    const float* mla_w_ukv = (const float*)d_in[16];
    const float* hgrn_lb_logits = (const float*)d_in[17];
    const float* hgrn_norm_w = (const float*)d_in[18];
    const float* cd_w_out = (const float*)d_in[19];
    const float* ln_g = (const float*)d_in[20];
    const float* ln_b = (const float*)d_in[21];
    const float* moe_w_router = (const float*)d_in[22];
    const float* moe_router_bias = (const float*)d_in[23];
    const float* moe_w_gate = (const float*)d_in[24];
    const float* moe_w_up = (const float*)d_in[25];
    const float* moe_w_down = (const float*)d_in[26];
    const float* moe_sg = (const float*)d_in[27];
    const float* moe_su = (const float*)d_in[28];
    const float* moe_sd = (const float*)d_in[29];
    float* out = (float*)d_out;

    char* wp = (char*)d_ws;
    auto carve = [&](size_t bytes) { char* p = wp; wp += (bytes + 255) & ~(size_t)255; return p; };
    float* hbuf = (float*)carve((size_t)T_TOK * CD_IN * 4);
    float* xbc = (float*)carve((size_t)T_TOK * 3072 * 4);
    float* mix = (float*)carve((size_t)T_TOK * 4096 * 4);
    float* bufA = (float*)carve((size_t)T_TOK * DM * 4);
    float* bufB = (float*)carve((size_t)T_TOK * DM * 4);
    float* kc = (float*)carve((size_t)NB * NCMP * 2 * 128 * 4);
    float* vc = (float*)carve((size_t)NB * NCMP * 2 * 128 * 4);
    MoeBufs mb;
    mb.top_e = (int*)carve((size_t)T_TOK * 8 * 4); mb.top_w = (float*)carve((size_t)T_TOK * 8 * 4); mb.lpos = (int*)carve((size_t)T_TOK * 8 * 4);
    mb.cnt_tab = (int*)carve((size_t)MOE_NSLOT * 64 * 4); mb.row_tok = (int*)carve((size_t)MOE_PMAX * 4); mb.row_w = (float*)carve((size_t)MOE_PMAX * 4);
    mb.pos_tab = (int*)carve((size_t)T_TOK * 8 * 4); mb.tiles = (int*)carve((size_t)MOE_MAXTILES * 16); mb.ntiles = (int*)carve(256);
    mb.G = hbuf;
    mb.U = (float*)((char*)hbuf + (((size_t)(MOE_PMAX + T_TOK) * 512 * 4 + 255) & ~(size_t)255));
    float* kvm = mix;
    (void)kvm; (void)in_sizes; (void)n_in; (void)out_size; (void)ws_size;

    gemm_dense(stream, x, DM, ab_w_in, AB_IN, hbuf, AB_IN, T_TOK, AB_IN, DM);
    hipLaunchKernelGGL(k_conv_silu, dim3((unsigned)(((long)T_TOK * 3072 + 255) / 256)), dim3(256), 0, stream, hbuf, ssm_conv_w, ssm_conv_b, xbc);
    hipLaunchKernelGGL(k_ssd_naive, dim3(NB * 32), dim3(64), 0, stream, hbuf, xbc, ssm_dt_bias, ssm_a_log, ssm_d, mix);
    hipLaunchKernelGGL(k_rmsnorm_rows, dim3(T_TOK), dim3(256), 0, stream, mix, (long)4096, 2048, ssm_norm_w, 1e-6f);
    hipLaunchKernelGGL(k_compress, dim3(NB * NCMP * 2), dim3(128), 0, stream, hbuf, nsa_cmp_pos, nsa_cmp_w, kc, 0);
    hipLaunchKernelGGL(k_compress, dim3(NB * NCMP * 2), dim3(128), 0, stream, hbuf, nsa_cmp_pos, nsa_cmp_w, vc, 1);
    hipLaunchKernelGGL(k_nsa_naive, dim3(NB * 2 * SEQ), dim3(256), 0, stream, hbuf, kc, vc, mix);
    gemm_dense(stream, mix, 4096, ab_w_out, DM, bufA, DM, T_TOK, DM, 4096);
    hipLaunchKernelGGL(k_resid_ln, dim3(T_TOK), dim3(256), 0, stream, x, bufA, ln_g, ln_b, bufB);
    moe_layer(stream, mb, bufB, bufA, moe_w_router, moe_router_bias, moe_w_gate, moe_w_up, moe_w_down, moe_sg, moe_su, moe_sd);
    hipLaunchKernelGGL(k_resid_ln, dim3(T_TOK), dim3(256), 0, stream, bufB, bufA, ln_g + DM, ln_b + DM, bufB);

    gemm_dense(stream, bufB, DM, cd_w_in, CD_IN, hbuf, CD_IN, T_TOK, CD_IN, DM);
    hipLaunchKernelGGL(k_rmsnorm_copy, dim3(T_TOK), dim3(256), 0, stream, hbuf + CD_CQ, (long)CD_IN, 512, mla_q_norm_w, 1e-6f, bufA, (long)1024);
    hipLaunchKernelGGL(k_rmsnorm_copy, dim3(T_TOK), dim3(256), 0, stream, hbuf + CD_CKV, (long)CD_IN, 512, mla_kv_norm_w, 1e-6f, bufA + 512, (long)1024);
    float* qm = xbc;
    float* kvmat = mix;
    kvmat = (float*)carve((size_t)T_TOK * 4096 * 4);
    float* kr = (float*)carve((size_t)T_TOK * 64 * 4);
    float* obuf = (float*)carve((size_t)T_TOK * 2048 * 4);
    gemm_dense(stream, bufA, 1024, mla_w_uq, 3072, qm, 3072, T_TOK, 3072, 512);
    gemm_dense(stream, bufA + 512, 1024, mla_w_ukv, 4096, kvmat, 4096, T_TOK, 4096, 512);
    hipLaunchKernelGGL(k_rope, dim3((unsigned)(((long)T_TOK * 17 * 32 + 255) / 256)), dim3(256), 0, stream, qm, hbuf, positions, kr);
    hipLaunchKernelGGL(k_mla_naive, dim3(NB * 16 * SEQ), dim3(256), 0, stream, qm, kvmat, kr, mix);
    hipLaunchKernelGGL(k_hgrn_naive, dim3(NB * 16), dim3(128), 0, stream, hbuf, hgrn_lb_logits, obuf);
    hipLaunchKernelGGL(k_hgrn_post, dim3(T_TOK * 16), dim3(128), 0, stream, obuf, hbuf, hgrn_norm_w, mix);
    gemm_dense(stream, mix, 4096, cd_w_out, DM, bufA, DM, T_TOK, DM, 4096);
    float* x3 = (float*)carve((size_t)T_TOK * DM * 4);
    hipLaunchKernelGGL(k_resid_ln, dim3(T_TOK), dim3(256), 0, stream, bufB, bufA, ln_g + 2 * DM, ln_b + 2 * DM, x3);
    moe_layer(stream, mb, x3, bufA, moe_w_router + (long)DM * 64, moe_router_bias + 64,
              moe_w_gate + (long)64 * DM * 512, moe_w_up + (long)64 * DM * 512, moe_w_down + (long)64 * 512 * DM,
              moe_sg + (long)DM * 512, moe_su + (long)DM * 512, moe_sd + (long)512 * DM);
    hipLaunchKernelGGL(k_resid_ln, dim3(T_TOK), dim3(256), 0, stream, x3, bufA, ln_g + 3 * DM, ln_b + 3 * DM, out);
}
```

```cpp
#include <hip/hip_runtime.h>
#include <stdint.h>

#define DI __device__ __forceinline__

constexpr int T_TOK = 16384, DM = 2048, SEQ = 2048, NB = 8;
constexpr int AB_IN = 8784, CD_IN = 9280;
constexpr int AB_Z = 0, AB_XBC = 2048, AB_DT = 5120, AB_Q = 5152, AB_KV = 7200, AB_G = 8736;
constexpr int CD_CQ = 0, CD_CKV = 512, CD_KR = 1024, CD_HQ = 1088, CD_HF = 3136, CD_HI = 5184, CD_HG = 7232;
constexpr float DN_ALPHA = 1.41421356237309515f;
constexpr int NCMP = 127;
constexpr int MOE_TM = 256;
constexpr int MOE_SLOT_TOK = 8;
constexpr int MOE_NSLOT = T_TOK / MOE_SLOT_TOK;
constexpr int MOE_PMAX = T_TOK * 8 + 64 * MOE_TM;
constexpr int MOE_MAXTILES = MOE_PMAX / MOE_TM + T_TOK / MOE_TM;
constexpr int LDH_AB = AB_IN, LDH_CD = CD_IN;

typedef unsigned short bf16_t;
DI float ldh(const bf16_t* p, long i) { return __uint_as_float(((unsigned)p[i]) << 16); }
DI bf16_t f2bf(float f) { unsigned u = __float_as_uint(f); u += 0x7fffu + ((u >> 16) & 1u); return (bf16_t)(u >> 16); }
DI float sigmoidf_(float x) { return 1.f / (1.f + __expf(-x)); }
DI float siluf_(float x) { return x / (1.f + __expf(-x)); }
DI float softplusf_(float x) { return x > 20.f ? x : log1pf(__expf(x)); }

__global__ void k_conv_silu(const bf16_t* __restrict__ h, const float* __restrict__ cw, const float* __restrict__ cb, float* __restrict__ xbc) {
    const long idx = (long)blockIdx.x * blockDim.x + threadIdx.x;
    if (idx >= (long)T_TOK * 3072) return;
    const int c = (int)(idx % 3072); const int t = (int)(idx / 3072); const int s = t % SEQ;
    float acc = cb[c];
#pragma unroll
    for (int k = 0; k < 4; ++k) { const int ss = s - 3 + k; if (ss >= 0) acc += cw[k * 3072 + c] * ldh(h, (long)(t - 3 + k) * AB_IN + AB_XBC + c); }
    xbc[idx] = siluf_(acc);
}

__global__ __launch_bounds__(64) void k_ssd_naive(const bf16_t* __restrict__ h, const float* __restrict__ xbc, const float* __restrict__ dt_bias,
                                                  const float* __restrict__ a_log, const float* __restrict__ dsk, float* __restrict__ mix) {
    const int b = blockIdx.x / 32, hd = blockIdx.x % 32, p = threadIdx.x, g = hd / 8;
    const float a = -__expf(a_log[hd]), dbias = dt_bias[hd], dskip = dsk[hd];
    float st[128];
#pragma unroll
    for (int n = 0; n < 128; ++n) st[n] = 0.f;
    for (int s = 0; s < SEQ; ++s) {
        const long t = (long)b * SEQ + s;
        const float dtv = softplusf_(ldh(h, t * AB_IN + AB_DT + hd) + dbias);
        const float dA = __expf(dtv * a);
        const float xv = xbc[t * 3072 + hd * 64 + p];
        const float xdt = xv * dtv;
        const float* Bp = xbc + t * 3072 + 2048 + g * 128;
        const float* Cp = xbc + t * 3072 + 2560 + g * 128;
        float y = 0.f;
#pragma unroll
        for (int n = 0; n < 128; ++n) { st[n] = st[n] * dA + xdt * Bp[n]; y += Cp[n] * st[n]; }
        y += xv * dskip;
        const float z = ldh(h, t * AB_IN + AB_Z + hd * 64 + p);
        mix[t * 4096 + hd * 64 + p] = y * siluf_(z);
    }
}

__global__ __launch_bounds__(256) void k_rmsnorm_rows(float* __restrict__ buf, long ld, int ncols, const float* __restrict__ w, float eps) {
    __shared__ float red[4];
    float* row = buf + (long)blockIdx.x * ld;
    float ss = 0.f;
    for (int c = threadIdx.x; c < ncols; c += 256) { const float v = row[c]; ss += v * v; }
    for (int o = 32; o > 0; o >>= 1) ss += __shfl_xor(ss, o);
    if ((threadIdx.x & 63) == 0) red[threadIdx.x >> 6] = ss;
    __syncthreads();
    const float tot = red[0] + red[1] + red[2] + red[3];
    const float r = rsqrtf(tot / ncols + eps);
    for (int c = threadIdx.x; c < ncols; c += 256) row[c] = row[c] * r * w[c];
}

__global__ __launch_bounds__(256) void k_rmsnorm_copy(const bf16_t* __restrict__ src, long lds_, int ncols, const float* __restrict__ w, float eps, bf16_t* __restrict__ dst, long ldd) {
    __shared__ float red[4];
    const bf16_t* row = src + (long)blockIdx.x * lds_;
    float ss = 0.f;
    for (int c = threadIdx.x; c < ncols; c += 256) { const float v = ldh(row, c); ss += v * v; }
    for (int o = 32; o > 0; o >>= 1) ss += __shfl_xor(ss, o);
    if ((threadIdx.x & 63) == 0) red[threadIdx.x >> 6] = ss;
    __syncthreads();
    const float tot = red[0] + red[1] + red[2] + red[3];
    const float r = rsqrtf(tot / ncols + eps);
    for (int c = threadIdx.x; c < ncols; c += 256) dst[(long)blockIdx.x * ldd + c] = f2bf(ldh(row, c) * r * w[c]);
}

__global__ __launch_bounds__(128) void k_compress(const bf16_t* __restrict__ h, const float* __restrict__ pos, const float* __restrict__ w, float* __restrict__ out, int which) {
    const int e = threadIdx.x; int r = blockIdx.x; const int g = r % 2; r /= 2; const int i = r % NCMP; const int b = r / NCMP;
    const float* p = pos + (long)which * 32 * 128;
    const float* ww = w + (long)which * 4096 * 128;
    float acc = 0.f;
    for (int l = 0; l < 32; ++l) {
        const bf16_t* src = h + ((long)b * SEQ + 16 * i + l) * AB_IN + AB_KV + which * 256 + g * 128;
        for (int d = 0; d < 128; ++d) acc += (ldh(src, d) + p[l * 128 + d]) * ww[(long)(l * 128 + d) * 128 + e];
    }
    out[(((long)b * NCMP + i) * 2 + g) * 128 + e] = acc;
}

DI float dot128(const float* __restrict__ q, const float* __restrict__ k) {
    float a = 0.f;
#pragma unroll 8
    for (int d = 0; d < 128; d += 4) { const float4 kv = *(const float4*)(k + d); a += q[d] * kv.x + q[d + 1] * kv.y + q[d + 2] * kv.z + q[d + 3] * kv.w; }
    return a;
}

DI float dot128b(const float* __restrict__ q, const bf16_t* __restrict__ k) {
    float a = 0.f;
#pragma unroll 4
    for (int d = 0; d < 128; d += 8) {
        const uint4 kv = *(const uint4*)(k + d);
        a += q[d] * __uint_as_float(kv.x << 16) + q[d + 1] * __uint_as_float(kv.x & 0xffff0000u) + q[d + 2] * __uint_as_float(kv.y << 16) + q[d + 3] * __uint_as_float(kv.y & 0xffff0000u)
           + q[d + 4] * __uint_as_float(kv.z << 16) + q[d + 5] * __uint_as_float(kv.z & 0xffff0000u) + q[d + 6] * __uint_as_float(kv.w << 16) + q[d + 7] * __uint_as_float(kv.w & 0xffff0000u);
    }
    return a;
}

DI void softmax8(float (*sc)[512], int n, int tid) {
    const int hh = tid >> 5, l = tid & 31;
    float m = -3.0e38f;
    for (int i = l; i < n; i += 32) m = fmaxf(m, sc[hh][i]);
    for (int o = 16; o > 0; o >>= 1) m = fmaxf(m, __shfl_xor(m, o));
    float s = 0.f;
    for (int i = l; i < n; i += 32) { const float e = __expf(sc[hh][i] - m); sc[hh][i] = e; s += e; }
    for (int o = 16; o > 0; o >>= 1) s += __shfl_xor(s, o);
    const float inv = 1.f / s;
    for (int i = l; i < n; i += 32) sc[hh][i] *= inv;
}

__global__ __launch_bounds__(256) void k_nsa_naive(const bf16_t* __restrict__ h, const float* __restrict__ kc, const float* __restrict__ vc, float* __restrict__ mix) {
    __shared__ float qs[8][128];
    __shared__ float sc[8][512];
    __shared__ float imp[32];
    __shared__ int sel[8];
    const int tid = threadIdx.x;
    int r = blockIdx.x; const int s = r % SEQ; r /= SEQ; const int g = r % 2; const int b = r / 2;
    const long t = (long)b * SEQ + s;
    const float scale = 0.08838834764831845f;
    for (int i = tid; i < 1024; i += 256) qs[i >> 7][i & 127] = ldh(h, t * AB_IN + AB_Q + g * 1024 + i);
    __syncthreads();
    const int nvis = s >= 31 ? (s - 31) / 16 + 1 : 0;
    for (int idx = tid; idx < 8 * 128; idx += 256) {
        const int hh = idx >> 7, i = idx & 127;
        if (i < nvis) sc[hh][i] = scale * dot128(qs[hh], kc + (((long)b * NCMP + i) * 2 + g) * 128);
        else sc[hh][i] = 0.f;
    }
    __syncthreads();
    if (nvis > 0) softmax8(sc, nvis, tid);
    __syncthreads();
    float ocmp[4];
#pragma unroll
    for (int rr = 0; rr < 4; ++rr) {
        const int idx = tid + 256 * rr, hh = idx >> 7, d = idx & 127;
        float a = 0.f;
        for (int i = 0; i < nvis; ++i) a += sc[hh][i] * vc[(((long)b * NCMP + i) * 2 + g) * 128 + d];
        ocmp[rr] = a;
    }
    if (tid < 32) {
        const int j = tid; float a = 0.f;
        for (int hh = 0; hh < 8; ++hh) {
            a += sc[hh][4 * j] + sc[hh][4 * j + 1] + sc[hh][4 * j + 2];
            if (4 * j + 3 < NCMP) a += 0.5f * sc[hh][4 * j + 3];
            if (j > 0) a += 0.5f * sc[hh][4 * j - 1];
        }
        const int cur = s / 64;
        const bool forced = (j == 0) || (j == cur) || (j == cur - 1);
        imp[j] = forced ? 1.0e6f : (j <= cur ? a : -1.0f);
    }
    __syncthreads();
    if (tid == 0) {
        unsigned taken = 0u;
        for (int n = 0; n < 8; ++n) {
            int best = -1; float bv = 0.f;
            for (int j = 0; j < 32; ++j) { if (taken & (1u << j)) continue; if (best < 0 || imp[j] > bv) { best = j; bv = imp[j]; } }
            taken |= 1u << best; sel[n] = best;
        }
    }
    __syncthreads();
    for (int idx = tid; idx < 8 * 512; idx += 256) {
        const int hh = idx >> 9, kk = idx & 511, n = kk >> 6, l = kk & 63;
        const int kpos = sel[n] * 64 + l;
        sc[hh][kk] = (kpos <= s) ? scale * dot128b(qs[hh], h + ((long)b * SEQ + kpos) * AB_IN + AB_KV + 2 * 256 + g * 128) : -1.0e30f;
    }
    __syncthreads();
    softmax8(sc, 512, tid);
    __syncthreads();
    float osel[4];
#pragma unroll
    for (int rr = 0; rr < 4; ++rr) {
        const int idx = tid + 256 * rr, hh = idx >> 7, d = idx & 127;
        float a = 0.f;
        for (int kk = 0; kk < 512; ++kk) {
            const int kpos = sel[kk >> 6] * 64 + (kk & 63);
            if (kpos <= s) a += sc[hh][kk] * ldh(h, ((long)b * SEQ + kpos) * AB_IN + AB_KV + 3 * 256 + g * 128 + d);
        }
        osel[rr] = a;
    }
    __syncthreads();
    for (int idx = tid; idx < 8 * 512; idx += 256) {
        const int hh = idx >> 9, kk = idx & 511;
        const int kpos = s - 511 + kk;
        sc[hh][kk] = (kpos >= 0) ? scale * dot128b(qs[hh], h + ((long)b * SEQ + kpos) * AB_IN + AB_KV + 4 * 256 + g * 128) : -1.0e30f;
    }
    __syncthreads();
    softmax8(sc, 512, tid);
    __syncthreads();
#pragma unroll
    for (int rr = 0; rr < 4; ++rr) {
        const int idx = tid + 256 * rr, hh = idx >> 7, d = idx & 127;
        float a = 0.f;
        for (int kk = 0; kk < 512; ++kk) {
            const int kpos = s - 511 + kk;
            if (kpos >= 0) a += sc[hh][kk] * ldh(h, ((long)b * SEQ + kpos) * AB_IN + AB_KV + 5 * 256 + g * 128 + d);
        }
        const bf16_t* gp = h + t * AB_IN + AB_G + (g * 8 + hh) * 3;
        const float o = sigmoidf_(ldh(gp, 0)) * ocmp[rr] + sigmoidf_(ldh(gp, 1)) * osel[rr] + sigmoidf_(ldh(gp, 2)) * a;
        mix[t * 4096 + 2048 + (g * 8 + hh) * 128 + d] = o;
    }
}

__global__ __launch_bounds__(256) void k_resid_ln(const float* xin, const float* __restrict__ add, const float* __restrict__ gg, const float* __restrict__ bb, float* out, bf16_t* ob) {
    __shared__ float red[8];
    const long row = blockIdx.x;
    float v[8]; float s = 0.f;
#pragma unroll
    for (int i = 0; i < 8; ++i) { const int c = threadIdx.x + 256 * i; v[i] = DN_ALPHA * xin[row * DM + c] + add[row * DM + c]; s += v[i]; }
    for (int o = 32; o > 0; o >>= 1) s += __shfl_xor(s, o);
    if ((threadIdx.x & 63) == 0) red[threadIdx.x >> 6] = s;
    __syncthreads();
    const float mu = (red[0] + red[1] + red[2] + red[3]) / DM;
    float q = 0.f;
#pragma unroll
    for (int i = 0; i < 8; ++i) { const float d = v[i] - mu; q += d * d; }
    for (int o = 32; o > 0; o >>= 1) q += __shfl_xor(q, o);
    if ((threadIdx.x & 63) == 0) red[4 + (threadIdx.x >> 6)] = q;
    __syncthreads();
    const float var = (red[4] + red[5] + red[6] + red[7]) / DM;
    const float rs = rsqrtf(var + 1e-5f);
#pragma unroll
    for (int i = 0; i < 8; ++i) { const int c = threadIdx.x + 256 * i; const float o = (v[i] - mu) * rs * gg[c] + bb[c]; out[row * DM + c] = o; if (ob) ob[row * DM + c] = f2bf(o); }
}

__global__ __launch_bounds__(256) void k_router(const float* __restrict__ x1, const float* __restrict__ wr, const float* __restrict__ rbias,
                                                int* __restrict__ top_e, float* __restrict__ top_w, int* __restrict__ lpos, int* __restrict__ cnt_tab) {
    const int lane = threadIdx.x & 63;
    const int gw = (blockIdx.x * blockDim.x + threadIdx.x) >> 6, nw = (gridDim.x * blockDim.x) >> 6;
    const float bias = rbias[lane];
    const int grp = lane >> 3;
    for (int slot = gw; slot < MOE_NSLOT; slot += nw) {
        int cnt = 0;
        for (int i = 0; i < MOE_SLOT_TOK; ++i) {
            const int t = slot * MOE_SLOT_TOK + i;
            const float* xr = x1 + (long)t * DM;
            float logit = 0.f;
            for (int k = 0; k < DM; k += 4) {
                const float4 xv = *(const float4*)(xr + k);
                logit += xv.x * wr[(long)(k + 0) * 64 + lane];
                logit += xv.y * wr[(long)(k + 1) * 64 + lane];
                logit += xv.z * wr[(long)(k + 2) * 64 + lane];
                logit += xv.w * wr[(long)(k + 3) * 64 + lane];
            }
            const float score = 1.f / (1.f + expf(-logit));
            const float biased = score + bias;
            float m1 = biased;
            m1 = fmaxf(m1, __shfl_xor(m1, 1)); m1 = fmaxf(m1, __shfl_xor(m1, 2)); m1 = fmaxf(m1, __shfl_xor(m1, 4));
            const unsigned long long bm = __ballot(biased == m1);
            const unsigned gb = (unsigned)((bm >> (8 * grp)) & 0xffull);
            const int first = __ffs(gb) - 1;
            float v2 = ((lane & 7) == first) ? -3.0e38f : biased;
            v2 = fmaxf(v2, __shfl_xor(v2, 1)); v2 = fmaxf(v2, __shfl_xor(v2, 2)); v2 = fmaxf(v2, __shfl_xor(v2, 4));
            const float gs = m1 + v2;
            int grank = 0;
#pragma unroll
            for (int g2 = 0; g2 < 8; ++g2) { const float o = __shfl(gs, g2 * 8); grank += (o > gs || (o == gs && g2 < grp)) ? 1 : 0; }
            const bool gsel = grank < 4;
            const float masked = gsel ? biased : -3.0e38f;
            int erank = 0;
            for (int e2 = 0; e2 < 64; ++e2) { const float o = __shfl(masked, e2); erank += (o > masked || (o == masked && e2 < lane)) ? 1 : 0; }
            const bool selected = gsel && erank < 8;
            float ws = selected ? score : 0.f;
            for (int o = 32; o > 0; o >>= 1) ws += __shfl_xor(ws, o);
            if (selected) {
                top_e[t * 8 + erank] = lane;
                top_w[t * 8 + erank] = score / ws * 2.5f;
                lpos[t * 8 + erank] = cnt;
                ++cnt;
            }
        }
        cnt_tab[slot * 64 + lane] = cnt;
    }
}

__global__ __launch_bounds__(256) void k_moe_scan(const int* __restrict__ cnt_tab, const int* __restrict__ top_e, const float* __restrict__ top_w, const int* __restrict__ lpos,
                                                  int* __restrict__ row_tok, float* __restrict__ row_w, int* __restrict__ row_slot, int* __restrict__ tiles, int* __restrict__ ntiles) {
    __shared__ int part_b[4][64], part_a[4][64];
    __shared__ int total[64], base[64], pre[64], pc[64];
    const int tid = threadIdx.x, e = tid & 63, part = tid >> 6;
    const int spb = (MOE_NSLOT + gridDim.x - 1) / gridDim.x;
    const int s0 = blockIdx.x * spb, s1 = min(MOE_NSLOT, s0 + spb);
    int sb = 0, sa = 0;
    for (int sl = part; sl < MOE_NSLOT; sl += 4) { const int c = cnt_tab[sl * 64 + e]; sa += c; if (sl < s0) sb += c; }
    part_b[part][e] = sb; part_a[part][e] = sa;
    __syncthreads();
    if (tid < 64) {
        total[tid] = part_a[0][tid] + part_a[1][tid] + part_a[2][tid] + part_a[3][tid];
        pre[tid] = part_b[0][tid] + part_b[1][tid] + part_b[2][tid] + part_b[3][tid];
        pc[tid] = (total[tid] + MOE_TM - 1) / MOE_TM * MOE_TM;
    }
    __syncthreads();
    if (tid == 0) { int a = 0; for (int i = 0; i < 64; ++i) { base[i] = a; a += pc[i]; } }
    __syncthreads();
    for (int sl = s0; sl < s1; ++sl) {
        if (tid < 64) {
            const int t = sl * MOE_SLOT_TOK + (tid >> 3), k = tid & 7;
            const int ex = top_e[t * 8 + k];
            const int p = base[ex] + pre[ex] + lpos[t * 8 + k];
            row_tok[p] = t; row_w[p] = top_w[t * 8 + k]; row_slot[p] = t * 8 + k;
        }
        __syncthreads();
        if (tid < 64) pre[tid] += cnt_tab[sl * 64 + tid];
        __syncthreads();
    }
    for (int ex = blockIdx.x; ex < 64; ex += gridDim.x)
        for (int p = base[ex] + total[ex] + tid; p < base[ex] + pc[ex]; p += 256) { row_tok[p] = -1; row_w[p] = 0.f; row_slot[p] = -1; }
    for (int i = blockIdx.x * 256 + tid; i < T_TOK; i += gridDim.x * 256) { row_tok[MOE_PMAX + i] = i; row_w[MOE_PMAX + i] = 1.f; row_slot[MOE_PMAX + i] = T_TOK * 8 + i; }
    if (blockIdx.x == 0) {
        if (tid < 64) {
            const int ex = tid, nt = pc[ex] / MOE_TM, t0 = base[ex] / MOE_TM;
            for (int j = 0; j < nt; ++j) {
                tiles[(t0 + j) * 4 + 0] = ex; tiles[(t0 + j) * 4 + 1] = base[ex] + j * MOE_TM;
                tiles[(t0 + j) * 4 + 2] = min(MOE_TM, total[ex] - j * MOE_TM); tiles[(t0 + j) * 4 + 3] = 0;
            }
            if (ex == 63) *ntiles = (base[63] + pc[63]) / MOE_TM + T_TOK / MOE_TM;
            const int nr = (base[63] + pc[63]) / MOE_TM;
            for (int j = ex; j < T_TOK / MOE_TM; j += 64) { tiles[(nr + j) * 4 + 0] = 64; tiles[(nr + j) * 4 + 1] = MOE_PMAX + j * MOE_TM; tiles[(nr + j) * 4 + 2] = MOE_TM; tiles[(nr + j) * 4 + 3] = 0; }
        }
    }
}

__global__ void k_silu_mul(float* __restrict__ g, const float* __restrict__ u, long n) {
    const long i = (long)blockIdx.x * blockDim.x + threadIdx.x;
    if (i < n) g[i] = siluf_(g[i]) * u[i];
}

__global__ void k_rope(bf16_t* __restrict__ qm, const bf16_t* __restrict__ h, const int* __restrict__ positions, bf16_t* __restrict__ kr) {
    const long idx = (long)blockIdx.x * blockDim.x + threadIdx.x;
    if (idx >= (long)T_TOK * 17 * 32) return;
    const int j = (int)(idx % 32); const int hh = (int)((idx / 32) % 17); const int t = (int)(idx / (32 * 17));
    const float inv = powf(10000.f, -(float)(2 * j) / 64.f);
    const float ang = (float)positions[t] * inv;
    const float c = cosf(ang), sn = sinf(ang);
    if (hh < 16) {
        bf16_t* p = qm + (long)t * 3072 + hh * 192 + 128;
        const float t1 = ldh(p, j), t2 = ldh(p, j + 32);
        p[j] = f2bf(t1 * c - t2 * sn); p[j + 32] = f2bf(t1 * sn + t2 * c);
    } else {
        const bf16_t* p = h + (long)t * CD_IN + CD_KR;
        const float t1 = ldh(p, j), t2 = ldh(p, j + 32);
        kr[(long)t * 64 + j] = f2bf(t1 * c - t2 * sn); kr[(long)t * 64 + j + 32] = f2bf(t1 * sn + t2 * c);
    }
}

__global__ __launch_bounds__(256) void k_mla_naive(const bf16_t* __restrict__ qm, const bf16_t* __restrict__ kvm, const bf16_t* __restrict__ kr, float* __restrict__ mix) {
    __shared__ float q[192];
    __shared__ float sc[2048];
    __shared__ float red[8];
    __shared__ float osum[2][128];
    const int tid = threadIdx.x;
    int r = blockIdx.x; const int s = r % SEQ; r /= SEQ; const int hh = r % 16; const int b = r / 16;
    const long t = (long)b * SEQ + s;
    if (tid < 192) q[tid] = ldh(qm, t * 3072 + hh * 192 + tid);
    __syncthreads();
    const float scale = 0.07216878364870322f;
    float m = -3.0e38f;
    for (int k = tid; k <= s; k += 256) {
        const long tk = (long)b * SEQ + k;
        float a = dot128b(q, kvm + tk * 4096 + hh * 256);
        const bf16_t* krp = kr + tk * 64;
#pragma unroll 8
        for (int d = 0; d < 64; ++d) a += q[128 + d] * ldh(krp, d);
        a *= scale; sc[k] = a; m = fmaxf(m, a);
    }
    for (int o = 32; o > 0; o >>= 1) m = fmaxf(m, __shfl_xor(m, o));
    if ((tid & 63) == 0) red[tid >> 6] = m;
    __syncthreads();
    m = fmaxf(fmaxf(red[0], red[1]), fmaxf(red[2], red[3]));
    float sm = 0.f;
    for (int k = tid; k <= s; k += 256) { const float e = __expf(sc[k] - m); sc[k] = e; sm += e; }
    for (int o = 32; o > 0; o >>= 1) sm += __shfl_xor(sm, o);
    if ((tid & 63) == 0) red[4 + (tid >> 6)] = sm;
    __syncthreads();
    const float inv = 1.f / (red[4] + red[5] + red[6] + red[7]);
    const int d = tid & 127, half = tid >> 7;
    float a = 0.f;
    for (int k = half; k <= s; k += 2) a += sc[k] * ldh(kvm, ((long)b * SEQ + k) * 4096 + hh * 256 + 128 + d);
    osum[half][d] = a;
    __syncthreads();
    if (tid < 128) mix[t * 4096 + hh * 128 + tid] = (osum[0][tid] + osum[1][tid]) * inv;
}

__global__ __launch_bounds__(128) void k_hgrn_naive(const bf16_t* __restrict__ h, const float* __restrict__ lb_logits, float* __restrict__ obuf) {
    __shared__ float qs[128], fs[128], ks[128];
    const int b = blockIdx.x / 16, hh = blockIdx.x % 16, v = threadIdx.x;
    const int c = hh * 128 + v;
    const float l0 = lb_logits[c], l1 = lb_logits[2048 + c];
    const float lb = 1.f / (1.f + expf(l0 - l1));
    float st[128];
#pragma unroll
    for (int d = 0; d < 128; ++d) st[d] = 0.f;
    for (int s = 0; s < SEQ; ++s) {
        const long t = (long)b * SEQ + s;
        const float hq = ldh(h, t * CD_IN + CD_HQ + c), hf = ldh(h, t * CD_IN + CD_HF + c), hi = ldh(h, t * CD_IN + CD_HI + c);
        __syncthreads();
        qs[v] = siluf_(hq);
        fs[v] = lb + (1.f - lb) * sigmoidf_(hf);
        ks[v] = (1.f - lb) * sigmoidf_(-hf);
        __syncthreads();
        float o = 0.f;
#pragma unroll
        for (int d = 0; d < 128; ++d) { st[d] = st[d] * fs[d] + ks[d] * hi; o += qs[d] * st[d]; }
        obuf[t * 2048 + c] = o;
    }
}

__global__ __launch_bounds__(128) void k_hgrn_post(const float* __restrict__ obuf, const bf16_t* __restrict__ h, const float* __restrict__ nw, float* __restrict__ mix) {
    __shared__ float red[2];
    const long t = blockIdx.x / 16; const int hh = blockIdx.x % 16, v = threadIdx.x;
    const float o = obuf[t * 2048 + hh * 128 + v];
    float ss = o * o;
    for (int of = 32; of > 0; of >>= 1) ss += __shfl_xor(ss, of);
    if ((v & 63) == 0) red[v >> 6] = ss;
    __syncthreads();
    const float r = rsqrtf((red[0] + red[1]) / 128.f + 1e-6f);
    const float gte = ldh(h, t * CD_IN + CD_HG + hh * 128 + v);
    mix[t * 4096 + 2048 + hh * 128 + v] = o * r * nw[v] * siluf_(gte);
}


#define LAS __attribute__((address_space(3)))
typedef unsigned short bf16_t;
typedef short bf16x8 __attribute__((ext_vector_type(8)));
typedef float f32x4 __attribute__((ext_vector_type(4)));
typedef unsigned u32x2 __attribute__((ext_vector_type(2)));
typedef unsigned u32x4 __attribute__((ext_vector_type(4)));

DI unsigned pk_bf16(float lo, float hi) { unsigned r; asm("v_cvt_pk_bf16_f32 %0, %1, %2" : "=v"(r) : "v"(lo), "v"(hi)); return r; }
DI float bf2f(bf16_t b) { return __uint_as_float(((unsigned)b) << 16); }
DI float bflo(unsigned u) { return __uint_as_float(u << 16); }
DI float bfhi(unsigned u) { return __uint_as_float(u & 0xffff0000u); }

namespace gm {
constexpr int BM = 256, BK = 64, HALF = 128, HTB = HALF * BK * 2, STAGE_BYTES = 8 * HTB, NXCD = 8, WGM = 8;
DI int lds_byte(int r, int c) { const int st = (r >> 4) * 2 + (c >> 5), rr = r & 15, cc = c & 31, ob = rr * 64 + cc * 2; return st * 1024 + (ob ^ (((ob >> 9) & 1) << 5)); }
DI void stage_rc(int b, int& R, int& C) { const int st = b / 1024, sb = b % 1024, swz = sb ^ (((sb >> 9) & 1) << 5); R = (st >> 1) * 16 + swz / 64; C = (st & 1) * 32 + (swz % 64) / 2; }

struct Unit { int p, q; };

DI bool static_order(int i, int G, int c, int nM, int nN, Unit& u) {
    const int nwg = nM * nN;
    const long L = (long)i * G + c; if (L >= nwg) return false;
    int wgid = (int)L; { const int q = nwg / NXCD, r = nwg % NXCD, xcd = wgid % NXCD, off = wgid / NXCD; wgid = (xcd < r ? xcd * (q + 1) : r * (q + 1) + (xcd - r) * q) + off; }
    const int nig = WGM * nN, gid = wgid / nig, fm = gid * WGM, gsz = (nM - fm) < WGM ? (nM - fm) : WGM;
    u.p = fm + ((wgid % nig) % gsz); u.q = (wgid % nig) / gsz; return true;
}

struct DenseProb {
    const char* A; const char* Bt; unsigned lda, ldb;
    int K, nM, nN, G, c;
    struct AState { const char* base; };
    DI bool next(int i, Unit& u) const { return static_order(i, G, c, nM, nN, u); }
    DI void a_state(const Unit& u, int R0, int C, AState& s) const { s.base = A + (size_t)u.p * 256 * lda * 2; }
    DI const char* a_addr(const AState& s, int h, int i, int R0, int C, size_t koff) const { return s.base + koff + (size_t)h * 128 * lda * 2 + (size_t)((unsigned)(R0 + 64 * i) * lda + (unsigned)C) * 2u; }
    static DI AState sel(bool c, const AState& a, const AState& b) { AState r; r.base = c ? a.base : b.base; return r; }
    DI const char* b_ptr(const Unit& u, int h) const { return Bt + ((size_t)u.q * 256 + (size_t)h * 128) * ldb * 2; }
};

struct MoeG1Prob {
    const char* A; const char* WgT; const char* WuT; unsigned lda, ldb;
    int K, G, c;
    const int* tiles; const int* ntiles; const int* row_tok;
    struct AState { unsigned off[2][2]; };
    DI bool next(int i, Unit& u) const { const long L = (long)i * G + c; const int nt = *ntiles; if (L >= (long)nt * 4) return false; u.p = (int)(L >> 2); u.q = (int)(L & 3); return true; }
    DI void a_state(const Unit& u, int R0, int C, AState& s) const {
        const int row0 = tiles[u.p * 4 + 1];
#pragma unroll
        for (int h = 0; h < 2; ++h)
#pragma unroll
            for (int i = 0; i < 2; ++i) { int t = row_tok[row0 + h * 128 + R0 + 64 * i]; if (t < 0) t = T_TOK; s.off[h][i] = ((unsigned)t * lda + (unsigned)C) * 2u; }
    }
    DI const char* a_addr(const AState& s, int h, int i, int R0, int C, size_t koff) const { return A + koff + s.off[h][i]; }
    static DI AState sel(bool c, const AState& a, const AState& b) { AState r;
#pragma unroll
        for (int h = 0; h < 2; ++h)
#pragma unroll
            for (int i = 0; i < 2; ++i) r.off[h][i] = c ? a.off[h][i] : b.off[h][i];
        return r; }
    DI const char* b_ptr(const Unit& u, int h) const { const int e = tiles[u.p * 4 + 0]; return (h ? WuT : WgT) + ((size_t)e * 512 + (size_t)u.q * 128) * ldb * 2; }
};

struct MoeG2Prob {
    const char* A; const char* WdT; unsigned lda, ldb;
    int K, G, c;
    const int* tiles; const int* ntiles;
    struct AState { const char* base; };
    DI bool next(int i, Unit& u) const { const long L = (long)i * G + c; const int nt = *ntiles; if (L >= (long)nt * 8) return false; u.p = (int)(L >> 3); u.q = (int)(L & 7); return true; }
    DI void a_state(const Unit& u, int R0, int C, AState& s) const { const int row0 = tiles[u.p * 4 + 1]; s.base = A + (size_t)row0 * lda * 2; }
    DI const char* a_addr(const AState& s, int h, int i, int R0, int C, size_t koff) const { return s.base + koff + (size_t)h * 128 * lda * 2 + (size_t)((unsigned)(R0 + 64 * i) * lda + (unsigned)C) * 2u; }
    static DI AState sel(bool c, const AState& a, const AState& b) { AState r; r.base = c ? a.base : b.base; return r; }
    DI const char* b_ptr(const Unit& u, int h) const { const int e = tiles[u.p * 4 + 0]; return WdT + ((size_t)e * 2048 + (size_t)u.q * 256 + (size_t)h * 128) * ldb * 2; }
};

struct EpiF32 {
    float* C; long ldc; int N;
    DI void operator()(const f32x4 (&acc)[2][2][4][2], const Unit& u, int wr, int wc, int fr, int fq) const {
        const int row0 = u.p * 256 + wr * 64 + fr, col0 = u.q * 256 + wc * 32 + 4 * fq;
#pragma unroll
        for (int ai = 0; ai < 2; ++ai)
#pragma unroll
            for (int m = 0; m < 4; ++m) { float* rowp = C + (size_t)(row0 + ai * 128 + m * 16) * ldc;
#pragma unroll
                for (int bj = 0; bj < 2; ++bj)
#pragma unroll
                    for (int n = 0; n < 2; ++n) { const int col = col0 + bj * 128 + n * 16; if (col < N) *(f32x4*)(rowp + col) = acc[ai][bj][m][n]; } }
    }
};
struct EpiBf16 {
    bf16_t* C; long ldc; int N;
    DI void operator()(const f32x4 (&acc)[2][2][4][2], const Unit& u, int wr, int wc, int fr, int fq) const {
        const int row0 = u.p * 256 + wr * 64 + fr, col0 = u.q * 256 + wc * 32 + 4 * fq;
#pragma unroll
        for (int ai = 0; ai < 2; ++ai)
#pragma unroll
            for (int m = 0; m < 4; ++m) { bf16_t* rowp = C + (size_t)(row0 + ai * 128 + m * 16) * ldc;
#pragma unroll
                for (int bj = 0; bj < 2; ++bj)
#pragma unroll
                    for (int n = 0; n < 2; ++n) { const int col = col0 + bj * 128 + n * 16; const f32x4 v = acc[ai][bj][m][n];
                        if (col < N) { u32x2 o; o.x = pk_bf16(v[0], v[1]); o.y = pk_bf16(v[2], v[3]); *(u32x2*)(rowp + col) = o; } } }
    }
};
struct EpiSwiglu {
    bf16_t* H; const int* tiles;
    DI void operator()(const f32x4 (&acc)[2][2][4][2], const Unit& u, int wr, int wc, int fr, int fq) const {
        const int row0 = tiles[u.p * 4 + 1] + wr * 64 + fr, col0 = u.q * 128 + wc * 32 + 4 * fq;
#pragma unroll
        for (int ai = 0; ai < 2; ++ai)
#pragma unroll
            for (int m = 0; m < 4; ++m) { bf16_t* rowp = H + (size_t)(row0 + ai * 128 + m * 16) * 512 + col0;
#pragma unroll
                for (int n = 0; n < 2; ++n) { const f32x4 g = acc[ai][0][m][n], up = acc[ai][1][m][n]; float hv[4];
#pragma unroll
                    for (int j = 0; j < 4; ++j) hv[j] = g[j] / (1.f + __expf(-g[j])) * up[j];
                    u32x2 o; o.x = pk_bf16(hv[0], hv[1]); o.y = pk_bf16(hv[2], hv[3]); *(u32x2*)(rowp + n * 16) = o; } }
    }
};
struct EpiMoeDown {
    bf16_t* Y; const int* tiles; const int* row_slot; const float* row_w;
    DI void operator()(const f32x4 (&acc)[2][2][4][2], const Unit& u, int wr, int wc, int fr, int fq) const {
        const int row0 = tiles[u.p * 4 + 1] + wr * 64 + fr, col0 = u.q * 256 + wc * 32 + 4 * fq;
#pragma unroll
        for (int ai = 0; ai < 2; ++ai)
#pragma unroll
            for (int m = 0; m < 4; ++m) { const int row = row0 + ai * 128 + m * 16; const int slot = row_slot[row]; const float w = row_w[row];
                if (slot < 0) continue;
                bf16_t* rowp = Y + (size_t)slot * 2048 + col0;
#pragma unroll
                for (int bj = 0; bj < 2; ++bj)
#pragma unroll
                    for (int n = 0; n < 2; ++n) { const f32x4 v = acc[ai][bj][m][n]; u32x2 o; o.x = pk_bf16(w * v[0], w * v[1]); o.y = pk_bf16(w * v[2], w * v[3]); *(u32x2*)(rowp + bj * 128 + n * 16) = o; } }
    }
};

template <class Prob, class Epi>
DI void gemm_phase(LAS unsigned char* lds, const Prob& P, const Epi& E) {
    const int tid = threadIdx.x, wid = __builtin_amdgcn_readfirstlane(tid >> 6), lane = tid & 63, wr = wid >> 2, wc = wid & 3, fr = lane & 15, fq = lane >> 4;
    const int K = P.K, nt = K / BK;
    int R0, C; stage_rc(tid * 16, R0, C);
    unsigned voffB[2];
#pragma unroll
    for (int i = 0; i < 2; ++i) voffB[i] = ((unsigned)(R0 + 64 * i) * P.ldb + (unsigned)C) * 2u;
    const size_t kstep = (size_t)(BK * 2);
    const unsigned ldsw = (unsigned)wid * 1024u;
    const int aoff = lds_byte(wr * 64 + fr, fq * 8), boff = lds_byte(wc * 32 + fr, fq * 8);
#define GM_SA(b, h) (((b) * 2 + (h)) * HTB)
#define GM_SB(b, h) ((4 + (b) * 2 + (h)) * HTB)
#define GM_STAGE_B(bufoff, gbase) do { _Pragma("unroll") for (int _i = 0; _i < 2; ++_i) \
        __builtin_amdgcn_global_load_lds((const unsigned*)((const char*)(gbase) + voffB[_i]), (LAS unsigned*)(lds + (bufoff) + ldsw + _i * 8192), 16, 0, 0); } while (0)
#define GM_STAGE_A(bufoff, st, h, koff) do { _Pragma("unroll") for (int _i = 0; _i < 2; ++_i) \
        __builtin_amdgcn_global_load_lds((const unsigned*)(P.a_addr(st, h, _i, R0, C, koff)), (LAS unsigned*)(lds + (bufoff) + ldsw + _i * 8192), 16, 0, 0); } while (0)
#define GM_LDA(dst, b, h) do { _Pragma("unroll") for (int m = 0; m < 4; ++m) _Pragma("unroll") for (int k = 0; k < 2; ++k) dst[m][k] = *(const LAS bf16x8*)(lds + GM_SA(b, h) + aoff + m * 2048 + k * 1024); } while (0)
#define GM_LDB(dst, b, h) do { _Pragma("unroll") for (int n = 0; n < 2; ++n) _Pragma("unroll") for (int k = 0; k < 2; ++k) dst[n][k] = *(const LAS bf16x8*)(lds + GM_SB(b, h) + boff + n * 2048 + k * 1024); } while (0)
#define GM_MMA(ai, bj, At, Bt) do { __builtin_amdgcn_s_setprio(1); _Pragma("unroll") for (int m = 0; m < 4; ++m) _Pragma("unroll") for (int n = 0; n < 2; ++n) _Pragma("unroll") for (int k = 0; k < 2; ++k) \
        acc[ai][bj][m][n] = __builtin_amdgcn_mfma_f32_16x16x32_bf16(Bt[n][k], At[m][k], acc[ai][bj][m][n], 0, 0, 0); __builtin_amdgcn_s_setprio(0); } while (0)
#define GM_WAIT_V(n) asm volatile("s_waitcnt vmcnt(" #n ")" ::: "memory")
#define GM_WAIT_L(n) asm volatile("s_waitcnt lgkmcnt(" #n ")" ::: "memory")
#define GM_BAR __builtin_amdgcn_s_barrier()
#define GM_SCHED __builtin_amdgcn_sched_barrier(0)
    Unit cur, nxt; int ui = 0;
    if (!P.next(0, cur)) return;
    f32x4 acc[2][2][4][2];
#pragma unroll
    for (int a = 0; a < 2; ++a)
#pragma unroll
        for (int b = 0; b < 2; ++b)
#pragma unroll
            for (int m = 0; m < 4; ++m)
#pragma unroll
                for (int n = 0; n < 2; ++n) acc[a][b][m][n] = (f32x4){0.f, 0.f, 0.f, 0.f};
    bf16x8 At[4][2], B0[2][2], B1[2][2];
    typename Prob::AState cs, ns; P.a_state(cur, R0, C, cs);
    const char* cB0 = P.b_ptr(cur, 0); const char* cB1 = P.b_ptr(cur, 1);
    GM_STAGE_B(GM_SB(0, 0), cB0); GM_STAGE_A(GM_SA(0, 0), cs, 0, 0); GM_STAGE_B(GM_SB(0, 1), cB1); GM_STAGE_A(GM_SA(0, 1), cs, 1, 0);
    if (wr == 1) GM_BAR;
    GM_WAIT_V(4); GM_BAR;
    GM_STAGE_B(GM_SB(1, 0), cB0 + kstep); GM_STAGE_A(GM_SA(1, 0), cs, 0, kstep); GM_STAGE_B(GM_SB(1, 1), cB1 + kstep);
    GM_WAIT_V(6); GM_BAR;
    for (;;) {
        const bool has_next = P.next(ui + 1, nxt);
        if (has_next) P.a_state(nxt, R0, C, ns); else ns = cs;
        const char* nB0 = has_next ? P.b_ptr(nxt, 0) : cB0; const char* nB1 = has_next ? P.b_ptr(nxt, 1) : cB1;
        for (int t = 0; t < nt; t += 2) {
            const bool last = (t == nt - 2);
            const size_t k1 = (size_t)(t + 1) * kstep;
            const size_t k2 = last ? (size_t)0 : (size_t)(t + 2) * kstep, k3 = k2 + kstep;
            const typename Prob::AState s2 = Prob::sel(last, ns, cs);
            const char* b20 = last ? nB0 : cB0 + (size_t)(t + 2) * kstep; const char* b21 = last ? nB1 : cB1 + (size_t)(t + 2) * kstep;
            const char* b30 = b20 + kstep; const char* b31 = b21 + kstep;
            GM_LDB(B0, 0, 0); GM_SCHED; GM_LDA(At, 0, 0); GM_STAGE_A(GM_SA(1, 1), cs, 1, k1);
            GM_WAIT_L(8); GM_BAR; GM_WAIT_L(0); GM_MMA(0, 0, At, B0); GM_BAR; GM_SCHED;
            GM_LDB(B1, 0, 1); GM_STAGE_B(GM_SB(0, 0), b20);
            GM_BAR; GM_WAIT_L(0); GM_MMA(0, 1, At, B1); GM_BAR;
            GM_LDA(At, 0, 1); GM_STAGE_A(GM_SA(0, 0), s2, 0, k2);
            GM_BAR; GM_WAIT_L(0); GM_MMA(1, 0, At, B0); GM_BAR; GM_SCHED;
            GM_STAGE_B(GM_SB(0, 1), b21);
            GM_WAIT_V(6); GM_BAR; GM_MMA(1, 1, At, B1); GM_BAR;
            GM_LDB(B0, 1, 0); GM_SCHED; GM_LDA(At, 1, 0); GM_STAGE_A(GM_SA(0, 1), s2, 1, k2);
            GM_WAIT_L(8); GM_BAR; GM_WAIT_L(0); GM_MMA(0, 0, At, B0); GM_BAR; GM_SCHED;
            GM_LDB(B1, 1, 1); GM_STAGE_B(GM_SB(1, 0), b30);
            GM_BAR; GM_WAIT_L(0); GM_MMA(0, 1, At, B1); GM_BAR;
            GM_LDA(At, 1, 1); GM_STAGE_A(GM_SA(1, 0), s2, 0, k3);
            GM_BAR; GM_WAIT_L(0); GM_MMA(1, 0, At, B0); GM_BAR; GM_SCHED;
            GM_STAGE_B(GM_SB(1, 1), b31);
            GM_WAIT_V(6); GM_BAR; GM_MMA(1, 1, At, B1); GM_BAR;
        }
        E(acc, cur, wr, wc, fr, fq);
        if (!has_next) break;
#pragma unroll
        for (int a = 0; a < 2; ++a)
#pragma unroll
            for (int b = 0; b < 2; ++b)
#pragma unroll
                for (int m = 0; m < 4; ++m)
#pragma unroll
                    for (int n = 0; n < 2; ++n) acc[a][b][m][n] = (f32x4){0.f, 0.f, 0.f, 0.f};
        cur = nxt; cs = ns; cB0 = nB0; cB1 = nB1; ++ui;
    }
    GM_WAIT_V(0);
    if (wr == 0) GM_BAR;
    GM_BAR;
#undef GM_SA
#undef GM_SB
#undef GM_STAGE_A
#undef GM_STAGE_B
#undef GM_LDA
#undef GM_LDB
#undef GM_MMA
#undef GM_WAIT_V
#undef GM_WAIT_L
#undef GM_BAR
#undef GM_SCHED
}
}

template <class Prob, class Epi> __global__ __launch_bounds__(512, 2) void k_gemm_phase(Prob P, Epi E) {
    extern __shared__ __attribute__((aligned(16))) unsigned char shm[];
    Prob p = P; p.G = (int)gridDim.x; p.c = (int)blockIdx.x;
    gm::gemm_phase<Prob, Epi>((LAS unsigned char*)shm, p, E);
}

__global__ __launch_bounds__(256) void k_cvt_wT(const float* __restrict__ W, bf16_t* __restrict__ Wt, int K, int N, int Npad) {
    __shared__ float tile[64][65];
    const int n0 = blockIdx.x * 64, k0 = blockIdx.y * 64;
    const float* Wb = W + (size_t)blockIdx.z * K * N;
    bf16_t* Wtb = Wt + (size_t)blockIdx.z * Npad * K;
    const int tx = threadIdx.x & 63, ty = threadIdx.x >> 6;
#pragma unroll
    for (int i = 0; i < 16; ++i) { const int k = ty + 4 * i; const int n = n0 + tx; tile[k][tx] = (n < N) ? Wb[(size_t)(k0 + k) * N + n] : 0.f; }
    __syncthreads();
    const int kp = (threadIdx.x & 31) * 2, nr = threadIdx.x >> 5;
#pragma unroll
    for (int i = 0; i < 8; ++i) { const int n = nr + 8 * i; *(unsigned*)(Wtb + (size_t)(n0 + n) * K + k0 + kp) = pk_bf16(tile[kp][n], tile[kp + 1][n]); }
}
__global__ void k_cvt_rows(const float* __restrict__ src, long lds_, bf16_t* __restrict__ dst, long ldd, int ncols, long rows) {
    const long idx = (long)blockIdx.x * blockDim.x + threadIdx.x;
    const int c4 = ncols / 4;
    if (idx >= rows * c4) return;
    const long r = idx / c4; const int c = (int)(idx % c4) * 4;
    const float4 v = *(const float4*)(src + r * lds_ + c);
    u32x2 o; o.x = pk_bf16(v.x, v.y); o.y = pk_bf16(v.z, v.w);
    *(u32x2*)(dst + r * ldd + c) = o;
}
__global__ void k_zero_words(unsigned* p, int n) { const int i = blockIdx.x * blockDim.x + threadIdx.x; if (i < n) p[i] = 0u; }

__global__ __launch_bounds__(256) void k_moe_combine_ln(const float* x1, const bf16_t* __restrict__ Y, const float* __restrict__ gg, const float* __restrict__ bb, float* out, bf16_t* ob) {
    __shared__ float red[8];
    const long row = blockIdx.x;
    const int c0 = threadIdx.x * 8;
    float v[8];
    { const float4 a = *(const float4*)(x1 + row * DM + c0), b = *(const float4*)(x1 + row * DM + c0 + 4);
      v[0] = DN_ALPHA * a.x; v[1] = DN_ALPHA * a.y; v[2] = DN_ALPHA * a.z; v[3] = DN_ALPHA * a.w; v[4] = DN_ALPHA * b.x; v[5] = DN_ALPHA * b.y; v[6] = DN_ALPHA * b.z; v[7] = DN_ALPHA * b.w; }
#pragma unroll
    for (int k = 0; k < 9; ++k) {
        const size_t yr = (k < 8) ? (size_t)(row * 8 + k) : (size_t)((long)T_TOK * 8 + row);
        const u32x4 y = *(const u32x4*)(Y + yr * 2048 + c0);
        v[0] += bflo(y.x); v[1] += bfhi(y.x); v[2] += bflo(y.y); v[3] += bfhi(y.y); v[4] += bflo(y.z); v[5] += bfhi(y.z); v[6] += bflo(y.w); v[7] += bfhi(y.w);
    }
    float s = 0.f;
#pragma unroll
    for (int i = 0; i < 8; ++i) s += v[i];
    for (int o = 32; o > 0; o >>= 1) s += __shfl_xor(s, o);
    if ((threadIdx.x & 63) == 0) red[threadIdx.x >> 6] = s;
    __syncthreads();
    const float mu = (red[0] + red[1] + red[2] + red[3]) / DM;
    float q = 0.f;
#pragma unroll
    for (int i = 0; i < 8; ++i) { const float d = v[i] - mu; q += d * d; }
    for (int o = 32; o > 0; o >>= 1) q += __shfl_xor(q, o);
    if ((threadIdx.x & 63) == 0) red[4 + (threadIdx.x >> 6)] = q;
    __syncthreads();
    const float rs = rsqrtf((red[4] + red[5] + red[6] + red[7]) / DM + 1e-5f);
    float o8[8];
#pragma unroll
    for (int i = 0; i < 8; ++i) o8[i] = (v[i] - mu) * rs * gg[c0 + i] + bb[c0 + i];
    *(float4*)(out + row * DM + c0) = make_float4(o8[0], o8[1], o8[2], o8[3]);
    *(float4*)(out + row * DM + c0 + 4) = make_float4(o8[4], o8[5], o8[6], o8[7]);
    if (ob) { u32x4 p; p.x = pk_bf16(o8[0], o8[1]); p.y = pk_bf16(o8[2], o8[3]); p.z = pk_bf16(o8[4], o8[5]); p.w = pk_bf16(o8[6], o8[7]); *(u32x4*)(ob + row * DM + c0) = p; }
}

static int g_grid = 0;

template <class Prob, class Epi> static void launch_gemm(hipStream_t st, const Prob& P, const Epi& E) {
    static bool attr_done = false;
    if (!attr_done) { (void)hipFuncSetAttribute((const void*)k_gemm_phase<Prob, Epi>, hipFuncAttributeMaxDynamicSharedMemorySize, gm::STAGE_BYTES); attr_done = true; }
    hipLaunchKernelGGL((k_gemm_phase<Prob, Epi>), dim3(g_grid), dim3(512), gm::STAGE_BYTES, st, P, E);
}

static gm::DenseProb dense_prob(const bf16_t* A, unsigned lda, const bf16_t* Bt, unsigned ldb, int M, int Npad, int K) {
    gm::DenseProb p{}; p.A = (const char*)A; p.Bt = (const char*)Bt; p.lda = lda; p.ldb = ldb; p.K = K; p.nM = M / 256; p.nN = Npad / 256; p.G = 0; p.c = 0; return p;
}
static void gemm_f32(hipStream_t st, const bf16_t* A, unsigned lda, const bf16_t* Bt, int M, int N, int Npad, int K, float* C, long ldc) {
    gm::EpiF32 e{}; e.C = C; e.ldc = ldc; e.N = N; launch_gemm(st, dense_prob(A, lda, Bt, (unsigned)K, M, Npad, K), e);
}
static void gemm_bf16(hipStream_t st, const bf16_t* A, unsigned lda, const bf16_t* Bt, int M, int N, int Npad, int K, bf16_t* C, long ldc) {
    gm::EpiBf16 e{}; e.C = C; e.ldc = ldc; e.N = N; launch_gemm(st, dense_prob(A, lda, Bt, (unsigned)K, M, Npad, K), e);
}
static void cvt_wT(hipStream_t st, const float* W, bf16_t* Wt, int K, int N, int Npad, int batch) {
    hipLaunchKernelGGL(k_cvt_wT, dim3(Npad / 64, K / 64, batch), dim3(256), 0, st, W, Wt, K, N, Npad);
}
static void cvt_rows(hipStream_t st, const float* src, long lds_, bf16_t* dst, long ldd, int ncols, long rows) {
    const long n = rows * (ncols / 4);
    hipLaunchKernelGGL(k_cvt_rows, dim3((unsigned)((n + 255) / 256)), dim3(256), 0, st, src, lds_, dst, ldd, ncols, rows);
}

struct MoeBufs { int* top_e; float* top_w; int* lpos; int* cnt_tab; int* row_tok; float* row_w; int* row_slot; int* tiles; int* ntiles; bf16_t* H; bf16_t* Y; bf16_t* WgT; bf16_t* WuT; bf16_t* WdT; };

static void moe_convert_weights(hipStream_t st, const MoeBufs& mb, const float* wg, const float* wu, const float* wd, const float* sg, const float* su, const float* sd) {
    cvt_wT(st, wg, mb.WgT, DM, 512, 512, 64); cvt_wT(st, sg, mb.WgT + (size_t)64 * 512 * DM, DM, 512, 512, 1);
    cvt_wT(st, wu, mb.WuT, DM, 512, 512, 64); cvt_wT(st, su, mb.WuT + (size_t)64 * 512 * DM, DM, 512, 512, 1);
    cvt_wT(st, wd, mb.WdT, 512, DM, DM, 64);  cvt_wT(st, sd, mb.WdT + (size_t)64 * DM * 512, 512, DM, DM, 1);
}

static void moe_layer(hipStream_t st, const MoeBufs& mb, const float* x1, const bf16_t* x1b, const float* w_router, const float* rbias,
                      const float* gg, const float* bb, float* out, bf16_t* outb) {
    hipLaunchKernelGGL(k_router, dim3(512), dim3(256), 0, st, x1, w_router, rbias, mb.top_e, mb.top_w, mb.lpos, mb.cnt_tab);
    hipLaunchKernelGGL(k_moe_scan, dim3(256), dim3(256), 0, st, mb.cnt_tab, mb.top_e, mb.top_w, mb.lpos, mb.row_tok, mb.row_w, mb.row_slot, mb.tiles, mb.ntiles);
    {
        gm::MoeG1Prob p{}; p.A = (const char*)x1b; p.WgT = (const char*)mb.WgT; p.WuT = (const char*)mb.WuT; p.lda = DM; p.ldb = DM; p.K = DM; p.tiles = mb.tiles; p.ntiles = mb.ntiles; p.row_tok = mb.row_tok;
        gm::EpiSwiglu e{}; e.H = mb.H; e.tiles = mb.tiles;
        launch_gemm(st, p, e);
    }
    {
        gm::MoeG2Prob p{}; p.A = (const char*)mb.H; p.WdT = (const char*)mb.WdT; p.lda = 512; p.ldb = 512; p.K = 512; p.tiles = mb.tiles; p.ntiles = mb.ntiles;
        gm::EpiMoeDown e{}; e.Y = mb.Y; e.tiles = mb.tiles; e.row_slot = mb.row_slot; e.row_w = mb.row_w;
        launch_gemm(st, p, e);
    }
    hipLaunchKernelGGL(k_moe_combine_ln, dim3(T_TOK), dim3(256), 0, st, x1, mb.Y, gg, bb, out, outb);
}

extern "C" void kernel_launch(void* const* d_in, const int* in_sizes, int n_in, void* d_out, int out_size, void* d_ws, size_t ws_size, hipStream_t stream) {
    if (!g_grid) { int dev = 0, cus = 0; (void)hipGetDevice(&dev); (void)hipDeviceGetAttribute(&cus, hipDeviceAttributeMultiprocessorCount, dev); g_grid = cus > 0 ? cus : 256; }
    const float* x = (const float*)d_in[0];
    const int* positions = (const int*)d_in[1];
    const float* ab_w_in = (const float*)d_in[2];
    const float* ssm_conv_w = (const float*)d_in[3];
    const float* ssm_conv_b = (const float*)d_in[4];
    const float* ssm_dt_bias = (const float*)d_in[5];
    const float* ssm_a_log = (const float*)d_in[6];
    const float* ssm_d = (const float*)d_in[7];
    const float* ssm_norm_w = (const float*)d_in[8];
    const float* nsa_cmp_pos = (const float*)d_in[9];
    const float* nsa_cmp_w = (const float*)d_in[10];
    const float* ab_w_out = (const float*)d_in[11];
    const float* cd_w_in = (const float*)d_in[12];
    const float* mla_q_norm_w = (const float*)d_in[13];
    const float* mla_w_uq = (const float*)d_in[14];
    const float* mla_kv_norm_w = (const float*)d_in[15];
    const float* mla_w_ukv = (const float*)d_in[16];
    const float* hgrn_lb_logits = (const float*)d_in[17];
    const float* hgrn_norm_w = (const float*)d_in[18];
    const float* cd_w_out = (const float*)d_in[19];
    const float* ln_g = (const float*)d_in[20];
    const float* ln_b = (const float*)d_in[21];
    const float* moe_w_router = (const float*)d_in[22];
    const float* moe_router_bias = (const float*)d_in[23];
    const float* moe_w_gate = (const float*)d_in[24];
    const float* moe_w_up = (const float*)d_in[25];
    const float* moe_w_down = (const float*)d_in[26];
    const float* moe_sg = (const float*)d_in[27];
    const float* moe_su = (const float*)d_in[28];
    const float* moe_sd = (const float*)d_in[29];
    float* out = (float*)d_out;
    (void)in_sizes; (void)n_in; (void)out_size; (void)ws_size;

    char* wp = (char*)d_ws;
    auto carve = [&](size_t bytes) { char* p = wp; wp += (bytes + 255) & ~(size_t)255; return p; };
    bf16_t* WinABt = (bf16_t*)carve((size_t)8960 * DM * 2);
    bf16_t* WoutABt = (bf16_t*)carve((size_t)DM * 4096 * 2);
    bf16_t* WinCDt = (bf16_t*)carve((size_t)9472 * DM * 2);
    bf16_t* WoutCDt = (bf16_t*)carve((size_t)DM * 4096 * 2);
    bf16_t* Wuqt = (bf16_t*)carve((size_t)3072 * 512 * 2);
    bf16_t* Wukvt = (bf16_t*)carve((size_t)4096 * 512 * 2);
    MoeBufs mb;
    mb.WgT = (bf16_t*)carve((size_t)65 * 512 * DM * 2); mb.WuT = (bf16_t*)carve((size_t)65 * 512 * DM * 2); mb.WdT = (bf16_t*)carve((size_t)65 * DM * 512 * 2);
    char* big = carve((size_t)T_TOK * CD_IN * 2 + (size_t)T_TOK * 3072 * 4 + (size_t)T_TOK * 4096 * 4 + 1024);
    bf16_t* hbuf = (bf16_t*)big;
    float* xbc = (float*)(big + (((size_t)T_TOK * CD_IN * 2 + 255) & ~(size_t)255));
    float* mix = (float*)((char*)xbc + (size_t)T_TOK * 3072 * 4);
    mb.H = (bf16_t*)big;
    mb.Y = (bf16_t*)(big + (((size_t)(MOE_PMAX + T_TOK) * 512 * 2 + 255) & ~(size_t)255));
    bf16_t* mixb = (bf16_t*)carve((size_t)T_TOK * 4096 * 2);
    float* bufA = (float*)carve((size_t)T_TOK * DM * 4);
    float* bufB = (float*)carve((size_t)T_TOK * DM * 4);
    float* x3 = (float*)carve((size_t)T_TOK * DM * 4);
    bf16_t* xb = (bf16_t*)carve((size_t)(T_TOK + 1) * DM * 2);
    bf16_t* cqb = (bf16_t*)carve((size_t)T_TOK * 1024 * 2);
    bf16_t* kr = (bf16_t*)carve((size_t)T_TOK * 64 * 2);
    float* kc = (float*)carve((size_t)NB * NCMP * 2 * 128 * 4);
    float* vc = (float*)carve((size_t)NB * NCMP * 2 * 128 * 4);
    mb.top_e = (int*)carve((size_t)T_TOK * 8 * 4); mb.top_w = (float*)carve((size_t)T_TOK * 8 * 4); mb.lpos = (int*)carve((size_t)T_TOK * 8 * 4);
    mb.cnt_tab = (int*)carve((size_t)MOE_NSLOT * 64 * 4); mb.row_tok = (int*)carve((size_t)(MOE_PMAX + T_TOK) * 4); mb.row_w = (float*)carve((size_t)(MOE_PMAX + T_TOK) * 4);
    mb.row_slot = (int*)carve((size_t)(MOE_PMAX + T_TOK) * 4); mb.tiles = (int*)carve((size_t)MOE_MAXTILES * 16); mb.ntiles = (int*)carve(256);

    cvt_wT(stream, ab_w_in, WinABt, DM, AB_IN, 8960, 1);
    cvt_wT(stream, ab_w_out, WoutABt, 4096, DM, DM, 1);
    cvt_wT(stream, cd_w_in, WinCDt, DM, CD_IN, 9472, 1);
    cvt_wT(stream, cd_w_out, WoutCDt, 4096, DM, DM, 1);
    cvt_wT(stream, mla_w_uq, Wuqt, 512, 3072, 3072, 1);
    cvt_wT(stream, mla_w_ukv, Wukvt, 512, 4096, 4096, 1);
    moe_convert_weights(stream, mb, moe_w_gate, moe_w_up, moe_w_down, moe_sg, moe_su, moe_sd);
    cvt_rows(stream, x, DM, xb, DM, DM, T_TOK);
    hipLaunchKernelGGL(k_zero_words, dim3(4), dim3(256), 0, stream, (unsigned*)(xb + (size_t)T_TOK * DM), DM / 2);

    gemm_bf16(stream, xb, DM, WinABt, T_TOK, AB_IN, 8960, DM, hbuf, AB_IN);
    hipLaunchKernelGGL(k_conv_silu, dim3((unsigned)(((long)T_TOK * 3072 + 255) / 256)), dim3(256), 0, stream, hbuf, ssm_conv_w, ssm_conv_b, xbc);
    hipLaunchKernelGGL(k_ssd_naive, dim3(NB * 32), dim3(64), 0, stream, hbuf, xbc, ssm_dt_bias, ssm_a_log, ssm_d, mix);
    hipLaunchKernelGGL(k_rmsnorm_rows, dim3(T_TOK), dim3(256), 0, stream, mix, (long)4096, 2048, ssm_norm_w, 1e-6f);
    hipLaunchKernelGGL(k_compress, dim3(NB * NCMP * 2), dim3(128), 0, stream, hbuf, nsa_cmp_pos, nsa_cmp_w, kc, 0);
    hipLaunchKernelGGL(k_compress, dim3(NB * NCMP * 2), dim3(128), 0, stream, hbuf, nsa_cmp_pos, nsa_cmp_w, vc, 1);
    hipLaunchKernelGGL(k_nsa_naive, dim3(NB * 2 * SEQ), dim3(256), 0, stream, hbuf, kc, vc, mix);
    cvt_rows(stream, mix, 4096, mixb, 4096, 4096, T_TOK);
    gemm_f32(stream, mixb, 4096, WoutABt, T_TOK, DM, DM, 4096, bufA, DM);
    hipLaunchKernelGGL(k_resid_ln, dim3(T_TOK), dim3(256), 0, stream, x, bufA, ln_g, ln_b, bufB, xb);
    moe_layer(stream, mb, bufB, xb, moe_w_router, moe_router_bias, ln_g + DM, ln_b + DM, bufA, xb);

    moe_convert_weights(stream, mb, moe_w_gate + (size_t)64 * DM * 512, moe_w_up + (size_t)64 * DM * 512, moe_w_down + (size_t)64 * 512 * DM,
                        moe_sg + (size_t)DM * 512, moe_su + (size_t)DM * 512, moe_sd + (size_t)512 * DM);
    gemm_bf16(stream, xb, DM, WinCDt, T_TOK, CD_IN, 9472, DM, hbuf, CD_IN);
    hipLaunchKernelGGL(k_rmsnorm_copy, dim3(T_TOK), dim3(256), 0, stream, hbuf + CD_CQ, (long)CD_IN, 512, mla_q_norm_w, 1e-6f, cqb, (long)1024);
    hipLaunchKernelGGL(k_rmsnorm_copy, dim3(T_TOK), dim3(256), 0, stream, hbuf + CD_CKV, (long)CD_IN, 512, mla_kv_norm_w, 1e-6f, cqb + 512, (long)1024);
    bf16_t* qm = (bf16_t*)xbc;
    bf16_t* kvmat = (bf16_t*)bufB;
    float* obuf = x3;
    gemm_bf16(stream, cqb, 1024, Wuqt, T_TOK, 3072, 3072, 512, qm, 3072);
    gemm_bf16(stream, cqb + 512, 1024, Wukvt, T_TOK, 4096, 4096, 512, kvmat, 4096);
    hipLaunchKernelGGL(k_rope, dim3((unsigned)(((long)T_TOK * 17 * 32 + 255) / 256)), dim3(256), 0, stream, qm, hbuf, positions, kr);
    hipLaunchKernelGGL(k_mla_naive, dim3(NB * 16 * SEQ), dim3(256), 0, stream, qm, kvmat, kr, mix);
    hipLaunchKernelGGL(k_hgrn_naive, dim3(NB * 16), dim3(128), 0, stream, hbuf, hgrn_lb_logits, obuf);
    hipLaunchKernelGGL(k_hgrn_post, dim3(T_TOK * 16), dim3(128), 0, stream, obuf, hbuf, hgrn_norm_w, mix);
    cvt_rows(stream, mix, 4096, mixb, 4096, 4096, T_TOK);
    gemm_f32(stream, mixb, 4096, WoutCDt, T_TOK, DM, DM, 4096, bufB, DM);
    hipLaunchKernelGGL(k_resid_ln, dim3(T_TOK), dim3(256), 0, stream, bufA, bufB, ln_g + 2 * DM, ln_b + 2 * DM, x3, xb);
    moe_layer(stream, mb, x3, xb, moe_w_router + (size_t)DM * 64, moe_router_bias + 64, ln_g + 3 * DM, ln_b + 3 * DM, out, (bf16_t*)nullptr);
}
```

```cpp
#include <hip/hip_runtime.h>
#include <stdint.h>

#define DI __device__ __forceinline__

constexpr int T_TOK = 16384, DM = 2048, SEQ = 2048, NB = 8;
constexpr int AB_IN = 8784, CD_IN = 9280;
constexpr int AB_Z = 0, AB_XBC = 2048, AB_DT = 5120, AB_Q = 5152, AB_KV = 7200, AB_G = 8736;
constexpr int CD_CQ = 0, CD_CKV = 512, CD_KR = 1024, CD_HQ = 1088, CD_HF = 3136, CD_HI = 5184, CD_HG = 7232;
constexpr float DN_ALPHA = 1.41421356237309515f;
constexpr int NCMP = 127;
constexpr int MOE_TM = 256;
constexpr int MOE_SLOT_TOK = 8;
constexpr int MOE_NSLOT = T_TOK / MOE_SLOT_TOK;
constexpr int MOE_PMAX = T_TOK * 8 + 64 * MOE_TM;
constexpr int MOE_MAXTILES = MOE_PMAX / MOE_TM + T_TOK / MOE_TM;
constexpr int LDH_AB = AB_IN, LDH_CD = CD_IN;

typedef unsigned short bf16_t;
DI float ldh(const bf16_t* p, long i) { return __uint_as_float(((unsigned)p[i]) << 16); }
DI bf16_t f2bf(float f) { unsigned u = __float_as_uint(f); u += 0x7fffu + ((u >> 16) & 1u); return (bf16_t)(u >> 16); }
DI int tid_opaque() { int t = (int)threadIdx.x; asm volatile("" : "+v"(t)); return t; }
DI float sigmoidf_(float x) { return 1.f / (1.f + __expf(-x)); }
DI float siluf_(float x) { return x / (1.f + __expf(-x)); }
DI float softplusf_(float x) { return x > 20.f ? x : log1pf(__expf(x)); }
#define LAS __attribute__((address_space(3)))
typedef unsigned short bf16_t;
typedef short bf16x8 __attribute__((ext_vector_type(8)));
typedef float f32x4 __attribute__((ext_vector_type(4)));
typedef unsigned u32x2 __attribute__((ext_vector_type(2)));
typedef unsigned u32x4 __attribute__((ext_vector_type(4)));
typedef int i32x2 __attribute__((ext_vector_type(2)));

typedef float f32x2_t __attribute__((ext_vector_type(2)));
typedef __bf16 bf16x2_t __attribute__((ext_vector_type(2)));
DI unsigned pk_bf16(float lo, float hi) { const f32x2_t v = {lo, hi}; const bf16x2_t r = __builtin_convertvector(v, bf16x2_t); return __builtin_bit_cast(unsigned, r); }
DI float bf2f(bf16_t b) { return __uint_as_float(((unsigned)b) << 16); }
DI float bflo(unsigned u) { return __uint_as_float(u << 16); }
DI float bfhi(unsigned u) { return __uint_as_float(u & 0xffff0000u); }

namespace gm {
constexpr int BM = 256, BK = 64, HALF = 128, HTB = HALF * BK * 2, STAGE_BYTES = 8 * HTB, NXCD = 8, WGM = 8;
DI int lds_byte(int r, int c) { const int st = (r >> 4) * 2 + (c >> 5), rr = r & 15, cc = c & 31, ob = rr * 64 + cc * 2; return st * 1024 + (ob ^ (((ob >> 9) & 1) << 5)); }
DI void stage_rc(int b, int& R, int& C) { const int st = b / 1024, sb = b % 1024, swz = sb ^ (((sb >> 9) & 1) << 5); R = (st >> 1) * 16 + swz / 64; C = (st & 1) * 32 + (swz % 64) / 2; }

struct Unit { int p, q; };

DI bool static_order(int i, int G, int c, int nM, int nN, Unit& u) {
    const int nwg = nM * nN;
    const long L = (long)i * G + c; if (L >= nwg) return false;
    int wgid = (int)L; { const int q = nwg / NXCD, r = nwg % NXCD, xcd = wgid % NXCD, off = wgid / NXCD; wgid = (xcd < r ? xcd * (q + 1) : r * (q + 1) + (xcd - r) * q) + off; }
    const int nig = WGM * nN, gid = wgid / nig, fm = gid * WGM, gsz = (nM - fm) < WGM ? (nM - fm) : WGM;
    u.p = fm + ((wgid % nig) % gsz); u.q = (wgid % nig) / gsz; return true;
}

struct DenseProb {
    const char* A; const char* Bt; unsigned lda, ldb;
    int K, nM, nN, G, c;
    struct AState { const char* base; };
    DI bool next(int i, Unit& u) const { return static_order(i, G, c, nM, nN, u); }
    DI void a_state(const Unit& u, int R0, int C, AState& s) const { s.base = A + (size_t)u.p * 256 * lda * 2; }
    DI const char* a_addr(const AState& s, int h, int i, int R0, int C, size_t koff) const { return s.base + koff + (size_t)h * 128 * lda * 2 + (size_t)((unsigned)(R0 + 64 * i) * lda + (unsigned)C) * 2u; }
    static DI AState sel(bool c, const AState& a, const AState& b) { AState r; r.base = c ? a.base : b.base; return r; }
    DI size_t koff(int kt) const { return (size_t)kt * 128; }
    DI const char* b_ptr(const Unit& u, int h) const { return Bt + ((size_t)u.q * 256 + (size_t)h * 128) * ldb * 2; }
};

DI i32x2 lds_tab_read(const LAS i32x2* q) { i32x2 r; const unsigned a = (unsigned)(size_t)q; asm volatile("ds_read_b64 %0, %1\n\ts_waitcnt lgkmcnt(0)" : "=v"(r) : "v"(a) : "memory"); return r; }
struct MoeG1Prob {
    const char* A; const char* WgT; const char* WuT; unsigned lda, ldb;
    int K, G, c;
    const LAS i32x2* ttab; int ntl; const int* row_tok;
    struct AState { unsigned off[2][2]; };
    DI bool next(int i, Unit& u) const {
        if ((G & 7) == 0) { const int x = c & 7, W = G >> 3, tpx = (ntl + 7) >> 3; const int m = i * W + (c >> 3); const int tl = m >> 2; const int tile = x * tpx + tl;
            if (tl >= tpx || tile >= ntl) return false; u.p = tile; u.q = m & 3; return true; }
        const long L = (long)i * G + c; if (L >= (long)ntl * 4) return false; u.p = (int)(L >> 2); u.q = (int)(L & 3); return true; }
    DI void a_state(const Unit& u, int R0, int C, AState& s) const {
        const int row0 = lds_tab_read(ttab + u.p).y;
#pragma unroll
        for (int h = 0; h < 2; ++h)
#pragma unroll
            for (int i = 0; i < 2; ++i) { int t = row_tok[row0 + h * 128 + R0 + 64 * i]; if (t < 0) t = T_TOK; s.off[h][i] = ((unsigned)t * lda + (unsigned)C) * 2u; }
    }
    DI const char* a_addr(const AState& s, int h, int i, int R0, int C, size_t koff) const { return A + koff + s.off[h][i]; }
    static DI AState sel(bool c, const AState& a, const AState& b) { AState r;
#pragma unroll
        for (int h = 0; h < 2; ++h)
#pragma unroll
            for (int i = 0; i < 2; ++i) r.off[h][i] = c ? a.off[h][i] : b.off[h][i];
        return r; }
    DI size_t koff(int kt) const { return (size_t)kt * 128; }
    DI const char* b_ptr(const Unit& u, int h) const { const int e = lds_tab_read(ttab + u.p).x & 0xff; return (h ? WuT : WgT) + ((size_t)e * 512 + (size_t)u.q * 128) * ldb * 2; }
};

struct MoeG2Prob {
    const char* A; const char* WdT; unsigned lda, ldb;
    int K, G, c;
    const LAS i32x2* ttab; int ntl;
    struct AState { const char* base; };
    DI bool next(int i, Unit& u) const {
        if ((G & 7) == 0) { const int x = c & 7, W = G >> 3, tpx = (ntl + 7) >> 3; const int m = i * W + (c >> 3); const int tl = m >> 3; const int tile = x * tpx + tl;
            if (tl >= tpx || tile >= ntl) return false; u.p = tile; u.q = m & 7; return true; }
        const long L = (long)i * G + c; if (L >= (long)ntl * 8) return false; u.p = (int)(L >> 3); u.q = (int)(L & 7); return true; }
    DI void a_state(const Unit& u, int R0, int C, AState& s) const { const int row0 = lds_tab_read(ttab + u.p).y; s.base = A + (size_t)row0 * lda * 2; }
    DI const char* a_addr(const AState& s, int h, int i, int R0, int C, size_t koff) const { return s.base + koff + (size_t)h * 128 * lda * 2 + (size_t)((unsigned)(R0 + 64 * i) * lda + (unsigned)C) * 2u; }
    static DI AState sel(bool c, const AState& a, const AState& b) { AState r; r.base = c ? a.base : b.base; return r; }
    DI size_t koff(int kt) const { return (size_t)kt * 128; }
    DI const char* b_ptr(const Unit& u, int h) const { const int e = lds_tab_read(ttab + u.p).x & 0xff; return WdT + ((size_t)e * 2048 + (size_t)u.q * 256 + (size_t)h * 128) * ldb * 2; }
};

struct EpiF32 {
    static constexpr bool PERM = false;
    float* C; long ldc; int N;
    DI void operator()(const f32x4 (&acc)[2][2][4][2], const Unit& u, int wr, int wc, int fr, int fq) const {
        const int row0 = u.p * 256 + wr * 64 + fr, col0 = u.q * 256 + wc * 32 + 4 * fq;
#pragma unroll
        for (int ai = 0; ai < 2; ++ai)
#pragma unroll
            for (int m = 0; m < 4; ++m) { float* rowp = C + (size_t)(row0 + ai * 128 + m * 16) * ldc;
#pragma unroll
                for (int bj = 0; bj < 2; ++bj)
#pragma unroll
                    for (int n = 0; n < 2; ++n) { const int col = col0 + bj * 128 + n * 16; if (col < N) *(f32x4*)(rowp + col) = acc[ai][bj][m][n]; } }
    }
};
struct EpiBf16 {
    static constexpr bool PERM = true;
    bf16_t* C; long ldc; int N;
    DI void operator()(const f32x4 (&acc)[2][2][4][2], const Unit& u, int wr, int wc, int fr, int fq) const {
        const int row0 = u.p * 256 + wr * 64 + fr, col0 = u.q * 256 + wc * 32 + 8 * fq;
#pragma unroll
        for (int ai = 0; ai < 2; ++ai)
#pragma unroll
            for (int m = 0; m < 4; ++m) { bf16_t* rowp = C + (size_t)(row0 + ai * 128 + m * 16) * ldc;
#pragma unroll
                for (int bj = 0; bj < 2; ++bj) { const int col = col0 + bj * 128; const f32x4 v0 = acc[ai][bj][m][0], v1 = acc[ai][bj][m][1];
                    if (col < N) { u32x4 o; o.x = pk_bf16(v0[0], v0[1]); o.y = pk_bf16(v0[2], v0[3]); o.z = pk_bf16(v1[0], v1[1]); o.w = pk_bf16(v1[2], v1[3]); *(u32x4*)(rowp + col) = o; } } }
    }
};
DI int perm16(int s) { return (s & ~12) | ((s & 4) << 1) | ((s & 8) >> 1); }
DI int perm32(int s) { return (s & ~28) | ((s & 12) << 1) | ((s & 16) >> 2); }
struct EpiKV {
    static constexpr bool PERM = true;
    bf16_t* kf; bf16_t* vf;
    DI void operator()(const f32x4 (&acc)[2][2][4][2], const Unit& u, int wr, int wc, int fr, int fq) const {
        const int row0 = u.p * 256 + wr * 64 + fr, head = u.q, c = wc * 32 + 8 * fq;
#pragma unroll
        for (int ai = 0; ai < 2; ++ai)
#pragma unroll
            for (int m = 0; m < 4; ++m) { const int t = row0 + ai * 128 + m * 16; const int b = t >> 11, s = t & 2047;
                const int kt = s >> 5, r = s & 31, s2 = (s >> 4) & 1;
                const int p16 = perm16(s & 15);
                const size_t tb = (size_t)(b * 16 + head) * 64 + kt;
                { const f32x4 v0 = acc[ai][0][m][0], v1 = acc[ai][0][m][1]; u32x4 o; o.x = pk_bf16(v0[0], v0[1]); o.y = pk_bf16(v0[2], v0[3]); o.z = pk_bf16(v1[0], v1[1]); o.w = pk_bf16(v1[2], v1[3]);
                  *(u32x4*)(kf + (tb * 8 + (c >> 4)) * 512 + (((c >> 3) & 1) * 32 + r) * 8) = o; }
                { bf16_t* vp = vf + ((tb * 4 + (c >> 5)) * 2 + s2) * 512 + ((p16 >> 3) * 32 + (c & 31)) * 8 + (p16 & 7);
#pragma unroll
                  for (int n = 0; n < 2; ++n) { const f32x4 vv = acc[ai][1][m][n];
#pragma unroll
                      for (int j = 0; j < 4; ++j) vp[(n * 4 + j) * 8] = f2bf(vv[j]); } } }
    }
};
struct CmpProb {
    const char* hb; const char* Wt;
    unsigned ldb; int K, G, c;
    struct AState { unsigned off[2][2]; };
    DI bool next(int i, Unit& u) const { const int L = i * G + c; if (L >= 16) return false; u.p = L & 7; u.q = L >> 3; return true; }
    DI void a_state(const Unit& u, int R0, int C, AState& s) const {
#pragma unroll
        for (int h = 0; h < 2; ++h)
#pragma unroll
            for (int i = 0; i < 2; ++i) { const int m = u.p * 256 + h * 128 + R0 + 64 * i; const int bg = m >> 7; int ci = m & 127; if (ci > 126) ci = 126;
                s.off[h][i] = (unsigned)(((size_t)((bg >> 1) * SEQ + 16 * ci) * AB_IN + AB_KV + u.q * 256 + (bg & 1) * 128 + C) * 2); }
    }
    DI const char* a_addr(const AState& s, int h, int i, int R0, int C, size_t koff) const { return hb + koff + s.off[h][i]; }
    static DI AState sel(bool c, const AState& a, const AState& b) { AState r;
#pragma unroll
        for (int h = 0; h < 2; ++h)
#pragma unroll
            for (int i = 0; i < 2; ++i) r.off[h][i] = c ? a.off[h][i] : b.off[h][i];
        return r; }
    DI size_t koff(int kt) const { return (size_t)(kt >> 1) * (AB_IN * 2) + (size_t)(kt & 1) * 128; }
    DI const char* b_ptr(const Unit& u, int h) const { return Wt + ((size_t)u.q * 256 + (size_t)h * 128) * ldb * 2; }
};
struct EpiCmp {
    static constexpr bool PERM = false;
    bf16_t* kc; bf16_t* vcT; const float* cpart;
    DI void operator()(const f32x4 (&acc)[2][2][4][2], const Unit& u, int wr, int wc, int fr, int fq) const {
        const int which = u.q, row0 = u.p * 256 + wr * 64 + fr, c0 = wc * 32 + 4 * fq;
        f32x4 bias[2];
#pragma unroll
        for (int n = 0; n < 2; ++n) { f32x4 a = {0.f, 0.f, 0.f, 0.f};
            for (int l = 0; l < 128; ++l) { const f32x4 v = *(const f32x4*)(cpart + ((size_t)which * 128 + l) * 128 + c0 + n * 16); a += v; }
            bias[n] = a; }
#pragma unroll
        for (int ai = 0; ai < 2; ++ai)
#pragma unroll
            for (int m = 0; m < 4; ++m) { const int mm = row0 + ai * 128 + m * 16; const int bg = mm >> 7, ci = mm & 127;
#pragma unroll
                for (int n = 0; n < 2; ++n) { const int c = c0 + n * 16; const f32x4 v = acc[ai][0][m][n] + bias[n];
                    if (which == 0) { u32x2 o; o.x = pk_bf16(v[0], v[1]); o.y = pk_bf16(v[2], v[3]); *(u32x2*)(kc + (size_t)mm * 128 + c) = o; }
                    else { bf16_t* vp = vcT + ((size_t)bg * 128 + c) * 128 + perm16(ci);
#pragma unroll
                        for (int j = 0; j < 4; ++j) vp[(size_t)j * 128] = f2bf(v[j]); } } }
    }
};
struct EpiAB {
    static constexpr bool PERM = true;
    bf16_t* C; bf16_t* vselT; bf16_t* vwinT; bf16_t* ksf; bf16_t* kwf;
    DI void operator()(const f32x4 (&acc)[2][2][4][2], const Unit& u, int wr, int wc, int fr, int fq) const {
        const int row0 = u.p * 256 + wr * 64 + fr, col0 = u.q * 256 + wc * 32 + 8 * fq;
        const bool special = (u.q >= 30);
#pragma unroll
        for (int ai = 0; ai < 2; ++ai)
#pragma unroll
            for (int m = 0; m < 4; ++m) { const int t = row0 + ai * 128 + m * 16; const int b = t >> 11, sp = t & 2047;
                bf16_t* rowp = C + (size_t)t * AB_IN;
#pragma unroll
                for (int bj = 0; bj < 2; ++bj) { const int col = col0 + bj * 128; const f32x4 v0 = acc[ai][bj][m][0], v1 = acc[ai][bj][m][1];
                    u32x4 o; o.x = pk_bf16(v0[0], v0[1]); o.y = pk_bf16(v0[2], v0[3]); o.z = pk_bf16(v1[0], v1[1]); o.w = pk_bf16(v1[2], v1[3]);
                    if (col < AB_IN) *(u32x4*)(rowp + col) = o;
                    if (special) {
                        if (col >= AB_KV + 512 && col < AB_KV + 768) { const int cc = col - (AB_KV + 512); const int bg = b * 2 + (cc >> 7), d = cc & 127;
                            *(u32x4*)(ksf + ((((size_t)bg * 128 + (sp >> 4)) * 4 + (d >> 5)) * 64 + ((d >> 3) & 3) * 16 + (sp & 15)) * 8) = o; }
                        if (col >= AB_KV + 768 && col < AB_KV + 1024) { const int cc = col - (AB_KV + 768); const int bg = b * 2 + (cc >> 7), d = cc & 127;
                            const int p32 = perm32(sp & 31);
                            bf16_t* vp = vselT + ((((size_t)bg * 64 + (sp >> 5)) * 8 + (d >> 4)) * 64 + (p32 >> 3) * 16 + (d & 15)) * 8 + (p32 & 7);
#pragma unroll
                            for (int j = 0; j < 4; ++j) { vp[j * 8] = f2bf(v0[j]); vp[(4 + j) * 8] = f2bf(v1[j]); } }
                        if (col >= AB_KV + 1024 && col < AB_KV + 1280) { const int cc = col - (AB_KV + 1024); const int bg = b * 2 + (cc >> 7), d = cc & 127;
                            *(u32x4*)(kwf + ((((size_t)bg * 64 + (sp >> 5)) * 8 + (d >> 4)) * 64 + ((d >> 3) & 1) * 32 + (sp & 31)) * 8) = o; }
                        if (col >= AB_KV + 1280 && col < AB_KV + 1536) { const int cc = col - (AB_KV + 1280); const int bg = b * 2 + (cc >> 7), d = cc & 127;
                            const int p16 = perm16(sp & 15);
                            bf16_t* vp = vwinT + (((((size_t)bg * 64 + (sp >> 5)) * 4 + (d >> 5)) * 2 + ((sp >> 4) & 1)) * 64 + (p16 >> 3) * 32 + (d & 31)) * 8 + (p16 & 7);
#pragma unroll
                            for (int j = 0; j < 4; ++j) { vp[j * 8] = f2bf(v0[j]); vp[(4 + j) * 8] = f2bf(v1[j]); } }
                    } } }
    }
};
struct EpiCD {
    static constexpr bool PERM = true;
    bf16_t* C; bf16_t* viT;
    DI void operator()(const f32x4 (&acc)[2][2][4][2], const Unit& u, int wr, int wc, int fr, int fq) const {
        const int row0 = u.p * 256 + wr * 64 + fr, col0 = u.q * 256 + wc * 32 + 8 * fq;
        const bool special = (u.q >= 20 && u.q <= 28);
#pragma unroll
        for (int ai = 0; ai < 2; ++ai)
#pragma unroll
            for (int m = 0; m < 4; ++m) { const int t = row0 + ai * 128 + m * 16; const int b = t >> 11, sp = t & 2047;
                bf16_t* rowp = C + (size_t)t * CD_IN;
#pragma unroll
                for (int bj = 0; bj < 2; ++bj) { const int col = col0 + bj * 128; const f32x4 v0 = acc[ai][bj][m][0], v1 = acc[ai][bj][m][1];
                    if (col < CD_IN) { u32x4 o; o.x = pk_bf16(v0[0], v0[1]); o.y = pk_bf16(v0[2], v0[3]); o.z = pk_bf16(v1[0], v1[1]); o.w = pk_bf16(v1[2], v1[3]); *(u32x4*)(rowp + col) = o; }
                    if (special && col >= CD_HI && col < CD_HI + 2048) { const int cc = col - CD_HI;
                        bf16_t* vp = viT + ((size_t)(b * 16 + (cc >> 7)) * 128 + (cc & 127)) * 2048 + perm16(sp);
#pragma unroll
                        for (int j = 0; j < 4; ++j) { vp[(size_t)j * 2048] = f2bf(v0[j]); vp[(size_t)(4 + j) * 2048] = f2bf(v1[j]); } } } }
    }
};
struct RouterProb {
    const char* xhi; long dlo; const char* Bt;
    int K, G, c;
    struct AState { const char* base; };
    DI bool next(int i, Unit& u) const { const int L = i * G + c; if (L >= 256) return false; u.p = L >> 2; u.q = L & 3; return true; }
    DI void a_state(const Unit& u, int R0, int C, AState& s) const { s.base = xhi + (long)((u.q >> 1) & 1) * dlo + (size_t)u.p * 256 * 4096 + (size_t)(u.q & 1) * 2048; }
    DI const char* a_addr(const AState& s, int h, int i, int R0, int C, size_t koff) const { return s.base + koff + (size_t)h * 128 * 4096 + (size_t)((unsigned)(R0 + 64 * i) * 2048u + (unsigned)C) * 2u; }
    static DI AState sel(bool c, const AState& a, const AState& b) { AState r; r.base = c ? a.base : b.base; return r; }
    DI size_t koff(int kt) const { return (size_t)kt * 128; }
    DI const char* b_ptr(const Unit& u, int h) const { return Bt + ((size_t)h * 128 * 4096 + (size_t)u.q * 1024) * 2; }
    unsigned ldb;
};
struct EpiRouter {
    static constexpr bool PERM = false;
    float* Cpart;
    DI void operator()(const f32x4 (&acc)[2][2][4][2], const Unit& u, int wr, int wc, int fr, int fq) const {
        const int row0 = u.p * 256 + wr * 64 + fr, col0 = wc * 32 + 4 * fq;
#pragma unroll
        for (int ai = 0; ai < 2; ++ai)
#pragma unroll
            for (int m = 0; m < 4; ++m) { float* rowp = Cpart + ((size_t)u.q * T_TOK + (size_t)(row0 + ai * 128 + m * 16)) * 128 + col0;
#pragma unroll
                for (int n = 0; n < 2; ++n) *(f32x4*)(rowp + n * 16) = acc[ai][0][m][n]; }
    }
};
struct EpiSwiglu {
    static constexpr bool PERM = true;
    bf16_t* H; const LAS i32x2* ttab;
    DI void operator()(const f32x4 (&acc)[2][2][4][2], const Unit& u, int wr, int wc, int fr, int fq) const {
        const int row0 = lds_tab_read(ttab + u.p).y + wr * 64 + fr, col0 = u.q * 128 + wc * 32 + 8 * fq;
#pragma unroll
        for (int ai = 0; ai < 2; ++ai)
#pragma unroll
            for (int m = 0; m < 4; ++m) { bf16_t* rowp = H + (size_t)(row0 + ai * 128 + m * 16) * 512 + col0;
                float hv[8];
#pragma unroll
                for (int n = 0; n < 2; ++n) { const f32x4 g = acc[ai][0][m][n], up = acc[ai][1][m][n];
#pragma unroll
                    for (int j = 0; j < 4; ++j) hv[n * 4 + j] = g[j] / (1.f + __expf(-g[j])) * up[j]; }
                u32x4 o; o.x = pk_bf16(hv[0], hv[1]); o.y = pk_bf16(hv[2], hv[3]); o.z = pk_bf16(hv[4], hv[5]); o.w = pk_bf16(hv[6], hv[7]); *(u32x4*)rowp = o; }
    }
};
struct EpiMoeDown {
    static constexpr bool PERM = true;
    bf16_t* Y; const LAS i32x2* ttab;
    DI void operator()(const f32x4 (&acc)[2][2][4][2], const Unit& u, int wr, int wc, int fr, int fq) const {
        const i32x2 rec = lds_tab_read(ttab + u.p);
        const int nrows = ((rec.x >> 8) & 0xff) + 1, delta = (int)((unsigned)rec.x >> 16);
        const int r0 = wr * 64 + fr, col0 = u.q * 256 + wc * 32 + 8 * fq;
#pragma unroll
        for (int ai = 0; ai < 2; ++ai)
#pragma unroll
            for (int m = 0; m < 4; ++m) { const int rt = r0 + ai * 128 + m * 16;
                if (rt < nrows) {
                    bf16_t* rowp = Y + (size_t)(rec.y + rt - delta) * 2048 + col0;
#pragma unroll
                    for (int bj = 0; bj < 2; ++bj) { const f32x4 v0 = acc[ai][bj][m][0], v1 = acc[ai][bj][m][1];
                        u32x4 o; o.x = pk_bf16(v0[0], v0[1]); o.y = pk_bf16(v0[2], v0[3]); o.z = pk_bf16(v1[0], v1[1]); o.w = pk_bf16(v1[2], v1[3]); *(u32x4*)(rowp + bj * 128) = o; } } }
    }
};

template <class Prob, class Epi>
DI void gemm_phase(LAS unsigned char* lds, const Prob& P, const Epi& E) {
    const int tid = tid_opaque(), wid = __builtin_amdgcn_readfirstlane(tid >> 6), lane = tid & 63, wr = wid >> 2, wc = wid & 3, fr = lane & 15, fq = lane >> 4;
    const int K = P.K, nt = K / BK;
    int R0, C; stage_rc(tid * 16, R0, C);
    unsigned voffB[2];
#pragma unroll
    for (int i = 0; i < 2; ++i) { const int R = R0 + 64 * i;
        const int Rb = Epi::PERM ? ((R & ~31) + 8 * ((R & 15) >> 2) + 4 * ((R >> 4) & 1) + (R & 3)) : R;
        voffB[i] = ((unsigned)Rb * P.ldb + (unsigned)C) * 2u; }
    const size_t kstep = (size_t)(BK * 2);
    const unsigned ldsw = (unsigned)wid * 1024u;
    const int aoff = lds_byte(wr * 64 + fr, fq * 8), boff = lds_byte(wc * 32 + fr, fq * 8);
#define GM_SA(b, h) (((b) * 2 + (h)) * HTB)
#define GM_SB(b, h) ((4 + (b) * 2 + (h)) * HTB)
#define GM_STAGE_B(bufoff, gbase) do { _Pragma("unroll") for (int _i = 0; _i < 2; ++_i) \
        __builtin_amdgcn_global_load_lds((const unsigned*)((const char*)(gbase) + voffB[_i]), (LAS unsigned*)(lds + (bufoff) + ldsw + _i * 8192), 16, 0, 0); } while (0)
#define GM_STAGE_A(bufoff, st, h, koff) do { _Pragma("unroll") for (int _i = 0; _i < 2; ++_i) \
        __builtin_amdgcn_global_load_lds((const unsigned*)(P.a_addr(st, h, _i, R0, C, koff)), (LAS unsigned*)(lds + (bufoff) + ldsw + _i * 8192), 16, 0, 0); } while (0)
#define GM_LDA(dst, b, h) do { _Pragma("unroll") for (int m = 0; m < 4; ++m) _Pragma("unroll") for (int k = 0; k < 2; ++k) dst[m][k] = *(const LAS bf16x8*)(lds + GM_SA(b, h) + aoff + m * 2048 + k * 1024); } while (0)
#define GM_LDB(dst, b, h) do { _Pragma("unroll") for (int n = 0; n < 2; ++n) _Pragma("unroll") for (int k = 0; k < 2; ++k) dst[n][k] = *(const LAS bf16x8*)(lds + GM_SB(b, h) + boff + n * 2048 + k * 1024); } while (0)
#define GM_MMA(ai, bj, At, Bt) do { __builtin_amdgcn_s_setprio(1); _Pragma("unroll") for (int m = 0; m < 4; ++m) _Pragma("unroll") for (int n = 0; n < 2; ++n) _Pragma("unroll") for (int k = 0; k < 2; ++k) \
        acc[ai][bj][m][n] = __builtin_amdgcn_mfma_f32_16x16x32_bf16(Bt[n][k], At[m][k], acc[ai][bj][m][n], 0, 0, 0); __builtin_amdgcn_s_setprio(0); } while (0)
#define GM_WAIT_V(n) asm volatile("s_waitcnt vmcnt(" #n ")" ::: "memory")
#define GM_WAIT_L(n) asm volatile("s_waitcnt lgkmcnt(" #n ")" ::: "memory")
#define GM_BAR __builtin_amdgcn_s_barrier()
#define GM_SCHED __builtin_amdgcn_sched_barrier(0)
    Unit cur, nxt; int ui = 0;
    if (!P.next(0, cur)) return;
    f32x4 acc[2][2][4][2];
#pragma unroll
    for (int a = 0; a < 2; ++a)
#pragma unroll
        for (int b = 0; b < 2; ++b)
#pragma unroll
            for (int m = 0; m < 4; ++m)
#pragma unroll
                for (int n = 0; n < 2; ++n) acc[a][b][m][n] = (f32x4){0.f, 0.f, 0.f, 0.f};
    bf16x8 At[4][2], B0[2][2], B1[2][2];
    typename Prob::AState cs, ns; P.a_state(cur, R0, C, cs);
    const char* cB0 = P.b_ptr(cur, 0); const char* cB1 = P.b_ptr(cur, 1);
    GM_STAGE_B(GM_SB(0, 0), cB0); GM_STAGE_A(GM_SA(0, 0), cs, 0, 0); GM_STAGE_B(GM_SB(0, 1), cB1); GM_STAGE_A(GM_SA(0, 1), cs, 1, 0);
    if (wr == 1) GM_BAR;
    GM_WAIT_V(4); GM_BAR;
    GM_STAGE_B(GM_SB(1, 0), cB0 + kstep); GM_STAGE_A(GM_SA(1, 0), cs, 0, P.koff(1)); GM_STAGE_B(GM_SB(1, 1), cB1 + kstep);
    GM_WAIT_V(6); GM_BAR;
    for (;;) {
        const bool has_next = P.next(ui + 1, nxt);
        if (has_next) P.a_state(nxt, R0, C, ns); else ns = cs;
        const char* nB0 = has_next ? P.b_ptr(nxt, 0) : cB0; const char* nB1 = has_next ? P.b_ptr(nxt, 1) : cB1;
        for (int t = 0; t < nt; t += 2) {
            const bool last = (t == nt - 2);
            const size_t k1 = P.koff(t + 1);
            const size_t k2 = last ? (size_t)0 : P.koff(t + 2), k3 = last ? P.koff(1) : P.koff(t + 3);
            const typename Prob::AState s2 = Prob::sel(last, ns, cs);
            const char* b20 = last ? nB0 : cB0 + (size_t)(t + 2) * kstep; const char* b21 = last ? nB1 : cB1 + (size_t)(t + 2) * kstep;
            const char* b30 = b20 + kstep; const char* b31 = b21 + kstep;
            GM_LDB(B0, 0, 0); GM_SCHED; GM_LDA(At, 0, 0); GM_STAGE_A(GM_SA(1, 1), cs, 1, k1);
            GM_WAIT_L(8); GM_BAR; GM_WAIT_L(0); GM_MMA(0, 0, At, B0); GM_BAR; GM_SCHED;
            GM_LDB(B1, 0, 1); GM_STAGE_B(GM_SB(0, 0), b20);
            GM_BAR; GM_WAIT_L(0); GM_MMA(0, 1, At, B1); GM_BAR;
            GM_LDA(At, 0, 1); GM_STAGE_A(GM_SA(0, 0), s2, 0, k2);
            GM_BAR; GM_WAIT_L(0); GM_MMA(1, 0, At, B0); GM_BAR; GM_SCHED;
            GM_STAGE_B(GM_SB(0, 1), b21);
            GM_WAIT_V(6); GM_BAR; GM_MMA(1, 1, At, B1); GM_BAR;
            GM_LDB(B0, 1, 0); GM_SCHED; GM_LDA(At, 1, 0); GM_STAGE_A(GM_SA(0, 1), s2, 1, k2);
            GM_WAIT_L(8); GM_BAR; GM_WAIT_L(0); GM_MMA(0, 0, At, B0); GM_BAR; GM_SCHED;
            GM_LDB(B1, 1, 1); GM_STAGE_B(GM_SB(1, 0), b30);
            GM_BAR; GM_WAIT_L(0); GM_MMA(0, 1, At, B1); GM_BAR;
            GM_LDA(At, 1, 1); GM_STAGE_A(GM_SA(1, 0), s2, 0, k3);
            GM_BAR; GM_WAIT_L(0); GM_MMA(1, 0, At, B0); GM_BAR; GM_SCHED;
            GM_STAGE_B(GM_SB(1, 1), b31);
            GM_WAIT_V(6); GM_BAR; GM_MMA(1, 1, At, B1); GM_BAR;
        }
        E(acc, cur, wr, wc, fr, fq);
        if (!has_next) break;
#pragma unroll
        for (int a = 0; a < 2; ++a)
#pragma unroll
            for (int b = 0; b < 2; ++b)
#pragma unroll
                for (int m = 0; m < 4; ++m)
#pragma unroll
                    for (int n = 0; n < 2; ++n) acc[a][b][m][n] = (f32x4){0.f, 0.f, 0.f, 0.f};
        cur = nxt; cs = ns; cB0 = nB0; cB1 = nB1; ++ui;
    }
    GM_WAIT_V(0);
    if (wr == 0) GM_BAR;
    GM_BAR;
#undef GM_SA
#undef GM_SB
#undef GM_STAGE_A
#undef GM_STAGE_B
#undef GM_LDA
#undef GM_LDB
#undef GM_MMA
#undef GM_WAIT_V
#undef GM_WAIT_L
#undef GM_BAR
#undef GM_SCHED
}
}


#define XB_TMO      128
#define XB_XCNT(j)  (256  + 64 * (j))
#define XB_XSUB(j)  (1280 + 64 * (j))
#define XB_XGEN(j)  (2304 + 64 * (j))
#define XB_TOP      3328
#define XB_TOPGEN   3392
#define XCD_BAR_WORDS 3456
#define XB_SPIN_CAP (1u << 22)
#define LAS __attribute__((address_space(3)))

__device__ __forceinline__ unsigned xb_ld(unsigned* p)              { return __hip_atomic_load(p, __ATOMIC_RELAXED, __HIP_MEMORY_SCOPE_AGENT); }
__device__ __forceinline__ unsigned xb_add(unsigned* p, unsigned v) { return __hip_atomic_fetch_add(p, v, __ATOMIC_RELAXED, __HIP_MEMORY_SCOPE_AGENT); }
__device__ __forceinline__ unsigned xb_xcc_id() { return (unsigned)__builtin_amdgcn_s_getreg((3 << 11) | 20) & 0xFu; }
#define XB_SPIN(cond, bar) do { unsigned _sp = 0; while (cond) { __builtin_amdgcn_s_sleep(1); \
    if ((++_sp & 255u) == 0u) { if (xb_ld(&(bar)[XB_TMO])) break; if (_sp > XB_SPIN_CAP) { atomicAdd(&(bar)[XB_TMO], 1u); break; } } } } while (0)

struct XcdBarrier {
    unsigned* bar; unsigned x;
    volatile LAS unsigned* st;
};

__device__ __forceinline__ XcdBarrier xcd_barrier_post(unsigned* bar, volatile LAS unsigned* st) {
    XcdBarrier b; b.bar = bar; b.x = xb_xcc_id(); b.st = st;
    if (threadIdx.x == 0) (void)xb_add(&bar[XB_XCNT(b.x)], 1u);
    return b;
}
__device__ __forceinline__ void xcd_barrier_complete(unsigned* bar, unsigned x, unsigned& nloc, unsigned& nx) {
    const unsigned G = gridDim.x * gridDim.y * gridDim.z;
    unsigned sum, cnt, mine, sp = 0u;
    for (;;) {
        sum = 0u; cnt = 0u; mine = 0u;
#pragma unroll
        for (unsigned j = 0; j < 16; ++j) { const unsigned c = xb_ld(&bar[XB_XCNT(j)]); sum += c; cnt += (c > 0u) ? 1u : 0u; mine = (j == x) ? c : mine; }
        if (sum == G) break;
        __builtin_amdgcn_s_sleep(1);
        if ((++sp & 255u) == 0u) { if (xb_ld(&bar[XB_TMO])) break; if (sp > XB_SPIN_CAP) { atomicAdd(&bar[XB_TMO], 1u); break; } }
    }
    nloc = mine > 0u ? mine : 1u; nx = cnt > 0u ? cnt : 1u;
}

__device__ __forceinline__ void xcd_barrier(const XcdBarrier& b) {
    asm volatile("s_waitcnt vmcnt(0)" ::: "memory");
    __syncthreads();
    if (threadIdx.x == 0) {
        unsigned* bar = b.bar;
        __builtin_amdgcn_s_waitcnt(0);
        unsigned nloc = b.st[0], nx = b.st[1];
        if (nloc == 0u) { xcd_barrier_complete(bar, b.x, nloc, nx); b.st[0] = nloc; b.st[1] = nx; }
        const unsigned old = xb_add(&bar[XB_XSUB(b.x)], 1u);
        const unsigned gen = old / nloc;
        if (old + 1u == (gen + 1u) * nloc) {
            __builtin_amdgcn_fence(__ATOMIC_RELEASE, "agent");
            asm volatile("s_waitcnt vmcnt(0)" ::: "memory");
            const unsigned og = xb_add(&bar[XB_TOP], 1u);
            const unsigned tg = og / nx;
            if (og + 1u == (tg + 1u) * nx) xb_add(&bar[XB_TOPGEN], 1u);
            else XB_SPIN(xb_ld(&bar[XB_TOPGEN]) == tg, bar);
            __builtin_amdgcn_fence(__ATOMIC_ACQUIRE, "agent");
            xb_add(&bar[XB_XGEN(b.x)], 1u);
            asm volatile("s_waitcnt vmcnt(0)" ::: "memory");
        } else {
            XB_SPIN(xb_ld(&bar[XB_XGEN(b.x)]) == gen, bar);
            __builtin_amdgcn_fence(__ATOMIC_ACQUIRE, "agent");
            asm volatile("s_waitcnt vmcnt(0)" ::: "memory");
        }
    }
    __syncthreads();
}


struct MP {
    const float* x; const int* positions; const float* ab_w_in; const float* conv_w; const float* conv_b; const float* dt_bias; const float* a_log; const float* ssm_d;
    const float* ssm_norm_w; const float* cmp_pos; const float* cmp_w; const float* ab_w_out; const float* cd_w_in; const float* q_norm_w; const float* w_uq;
    const float* kv_norm_w; const float* w_ukv; const float* lb_logits; const float* hgrn_norm_w; const float* cd_w_out; const float* ln_g; const float* ln_b;
    const float* w_router; const float* router_bias; const float* w_gate; const float* w_up; const float* w_down; const float* sg; const float* su; const float* sd;
    float* out;
    bf16_t* WinABt; bf16_t* WoutABt; bf16_t* WinCDt; bf16_t* WoutCDt; bf16_t* Wuqt; bf16_t* Wukvt; bf16_t* WgT; bf16_t* WuT; bf16_t* WdT;
    bf16_t* hbuf; float* xbc; float* mix; bf16_t* H; bf16_t* Y; bf16_t* mixb; float* bufA; float* bufB; float* x3; bf16_t* xb; bf16_t* cqb; bf16_t* kr; float* kc; float* vc;
    float* rope_tab; bf16_t* kcb; bf16_t* vcT; bf16_t* vselT; bf16_t* vwinT; bf16_t* ksf; bf16_t* kwf; bf16_t* kvfrag; bf16_t* WcmpT; float* cpart; bf16_t* WrT3; int* top_e; float* top_w; int* lpos; int* cnt_tab; int* row_tok; float* row_w; int* row_slot; int* tiles; int* ntiles;
    unsigned* bar;
};

constexpr int NTHR = 512, NWAVE = 8;
constexpr int LDS_BAR_OFF = 135168;
constexpr int LDS_TAB_OFF = LDS_BAR_OFF + 64;
constexpr int LDS_TOTAL = LDS_TAB_OFF + 768 * 8;

DI float wave_sum(float v) {
#pragma unroll
    for (int o = 1; o < 64; o <<= 1) v += __shfl_xor(v, o);
    return v;
}

DI void cvt_wT_range(LAS unsigned char* lds, const float* __restrict__ W, bf16_t* __restrict__ Wt, int K, int N, int Npad, int bid, int nblk, int ntile) {
    const int tix = tid_opaque();
    LAS float* tile = (LAS float*)lds;
    const int tn = Npad / 64, tk = K / 64;
    const int tx = tix & 63, ty = tix >> 6;
    const int wn = tix >> 3, wk = (tix & 7) * 8;
    float cur[8];
    int tp = bid;
    if (tp < ntile) {
        int tq = tp; const int nx = tq % tn; tq /= tn; const int ky = tq % tk; const int bz = tq / tk;
        const float* Wb = W + (size_t)bz * K * N + (size_t)(ky * 64) * N + nx * 64 + tx;
        const bool nin = (nx * 64 + tx) < N;
#pragma unroll
        for (int i = 0; i < 8; ++i) cur[i] = nin ? Wb[(size_t)(ty + 8 * i) * N] : 0.f;
    }
    for (; tp < ntile; tp += nblk) {
        int tq = tp; const int nx = tq % tn; tq /= tn; const int ky = tq % tk; const int bz = tq / tk;
        const int n0 = nx * 64, k0 = ky * 64;
        bf16_t* Wtb = Wt + (size_t)bz * Npad * K;
#pragma unroll
        for (int i = 0; i < 8; ++i) tile[(ty + 8 * i) * 65 + tx] = cur[i];
        const int tp2 = tp + nblk;
        if (tp2 < ntile) {
            int tq2 = tp2; const int nx2 = tq2 % tn; tq2 /= tn; const int ky2 = tq2 % tk; const int bz2 = tq2 / tk;
            const float* Wb2 = W + (size_t)bz2 * K * N + (size_t)(ky2 * 64) * N + nx2 * 64 + tx;
            const bool nin2 = (nx2 * 64 + tx) < N;
#pragma unroll
            for (int i = 0; i < 8; ++i) cur[i] = nin2 ? Wb2[(size_t)(ty + 8 * i) * N] : 0.f;
        }
        __syncthreads();
        u32x4 o;
        o.x = pk_bf16(tile[(wk + 0) * 65 + wn], tile[(wk + 1) * 65 + wn]); o.y = pk_bf16(tile[(wk + 2) * 65 + wn], tile[(wk + 3) * 65 + wn]);
        o.z = pk_bf16(tile[(wk + 4) * 65 + wn], tile[(wk + 5) * 65 + wn]); o.w = pk_bf16(tile[(wk + 6) * 65 + wn], tile[(wk + 7) * 65 + wn]);
        *(u32x4*)(Wtb + (size_t)(n0 + wn) * K + k0 + wk) = o;
        __syncthreads();
    }
}
DI void ph_cvt_wT(LAS unsigned char* lds, const float* __restrict__ W, bf16_t* __restrict__ Wt, int K, int N, int Npad, int batch, int bid, int nblk) {
    cvt_wT_range(lds, W, Wt, K, N, Npad, bid, nblk, (Npad / 64) * (K / 64) * batch);
}
DI void ph_cvt_moe_weights(LAS unsigned char* lds, const MP& p, int layer, int bid, int nblk) {
    const size_t eo = (size_t)layer * 64 * DM * 512, so = (size_t)layer * DM * 512;
    ph_cvt_wT(lds, p.w_gate + eo, p.WgT, DM, 512, 512, 64, bid, nblk); ph_cvt_wT(lds, p.sg + so, p.WgT + (size_t)64 * 512 * DM, DM, 512, 512, 1, bid, nblk);
    ph_cvt_wT(lds, p.w_up + eo, p.WuT, DM, 512, 512, 64, bid, nblk);   ph_cvt_wT(lds, p.su + so, p.WuT + (size_t)64 * 512 * DM, DM, 512, 512, 1, bid, nblk);
    ph_cvt_wT(lds, p.w_down + eo, p.WdT, 512, DM, DM, 64, bid, nblk);  ph_cvt_wT(lds, p.sd + so, p.WdT + (size_t)64 * DM * 512, 512, DM, DM, 1, bid, nblk);
}

struct CvqPos { int nx, ky, bz; };
DI void cvq_adv4(CvqPos& s, int tn, int tk) { s.nx += 4; if (s.nx >= tn) { s.nx = 0; if (++s.ky == tk) { s.ky = 0; ++s.bz; } } }
DI void cvt_wT_quad(LAS unsigned char* lds, const float* __restrict__ W, bf16_t* __restrict__ Wt, int K, int N, int Npad, int t0, int t1) {
    const int tix = tid_opaque();
    const int tn = Npad / 64, tk = K / 64;
    const int tx = tix & 63, ty = tix >> 6;
    const int wn = tix >> 3, wq = tix & 7;
    float ca[4][8], cb[4][8];
#define CVQ_ISSUE(C_, S_) do { \
        _Pragma("unroll") for (int j = 0; j < 4; ++j) { \
            const int cn = (S_.nx + j) * 64 < N ? (S_.nx + j) * 64 : 0;        \
            const float* Wb = W + (size_t)S_.bz * K * N + (size_t)(S_.ky * 64 + 2 * ty) * N + cn + tx; \
            _Pragma("unroll") for (int i = 0; i < 4; ++i) { C_[j][2 * i] = Wb[(size_t)(16 * i) * N]; C_[j][2 * i + 1] = Wb[(size_t)(16 * i + 1) * N]; } } } while (0)
#define CVQ_STEP(C_, S_, BUF_, ISSUE_) do { \
        LAS unsigned* tile = (LAS unsigned*)lds + (BUF_) * (4 * 2080); \
        const CvqPos cur_ = S_; \
        _Pragma("unroll") for (int j = 0; j < 4; ++j) { \
            if ((cur_.nx + j) * 64 >= N) { _Pragma("unroll") for (int i = 0; i < 8; ++i) C_[j][i] = 0.f; } \
            _Pragma("unroll") for (int i = 0; i < 4; ++i) tile[j * 2080 + (ty + 8 * i) * 65 + tx] = pk_bf16(C_[j][2 * i], C_[j][2 * i + 1]); } \
        if (ISSUE_) { cvq_adv4(S_, tn, tk); cvq_adv4(S_, tn, tk); CVQ_ISSUE(C_, S_); } \
        __syncthreads(); \
        _Pragma("unroll") for (int j = 0; j < 4; ++j) { \
            const LAS unsigned* tl = tile + j * 2080 + (4 * wq) * 65 + wn; \
            u32x4 o; o.x = tl[0]; o.y = tl[65]; o.z = tl[130]; o.w = tl[195]; \
            __builtin_nontemporal_store(o, (u32x4*)(Wt + (size_t)cur_.bz * Npad * K + (size_t)((cur_.nx + j) * 64 + wn) * K + cur_.ky * 64 + 8 * wq));        \
        } } while (0)
    CvqPos sa, sb;
    { int tq = t0; sa.nx = tq % tn; tq /= tn; sa.ky = tq % tk; sa.bz = tq / tk; sb = sa; cvq_adv4(sb, tn, tk); }
    CVQ_ISSUE(ca, sa); CVQ_ISSUE(cb, sb);
    int tp = t0;
    for (; tp + 8 < t1; tp += 8) {
        CVQ_STEP(ca, sa, 0, true);
        CVQ_STEP(cb, sb, 1, true);
    }
    CVQ_STEP(ca, sa, 0, false);
    CVQ_STEP(cb, sb, 1, false);
    __syncthreads();
#undef CVQ_STEP
#undef CVQ_ISSUE
}
constexpr int CVQ_NG = 208;
constexpr int CVQ_SEG_E = 64 * 256, CVQ_SEG_S = 256, CVQ_BATCH = 32, CVQ_MOE_TILES = 3 * (CVQ_SEG_E + CVQ_SEG_S);
constexpr int CVQ_X0 = (9472 / 64) * (DM / 64), CVQ_X1 = (DM / 64) * (4096 / 64), CVQ_X2 = (3072 / 64) * (512 / 64), CVQ_X3 = (4096 / 64) * (512 / 64), CVQ_X4 = CVQ_X1, CVQ_X5 = 2 * (256 / 64) * (4096 / 64);
constexpr int CVQ_XTRA = CVQ_X0 + CVQ_X1 + CVQ_X2 + CVQ_X3 + CVQ_X4 + CVQ_X5;
static_assert(CVQ_X0 % CVQ_BATCH == 0 && CVQ_X1 % CVQ_BATCH == 0 && CVQ_X2 % CVQ_BATCH == 0 && CVQ_X3 % CVQ_BATCH == 0 && CVQ_X5 % CVQ_BATCH == 0 && CVQ_SEG_S % CVQ_BATCH == 0, "batches must not straddle matrices");
DI void moe_cvt_queue(LAS unsigned char* lds, const MP& p, int layer, unsigned* ctr) {
    const size_t eo = (size_t)layer * 64 * DM * 512, so = (size_t)layer * DM * 512;
    volatile LAS int* slot = (volatile LAS int*)(lds + LDS_BAR_OFF + 32);
    const int nbatch = (CVQ_MOE_TILES + (layer == 0 ? CVQ_XTRA : 0)) / CVQ_BATCH;
    asm volatile("s_waitcnt vmcnt(0)" ::: "memory");
    for (;;) {
        __syncthreads();
        if (threadIdx.x == 0) *slot = (int)__hip_atomic_fetch_add(ctr, 1u, __ATOMIC_RELAXED, __HIP_MEMORY_SCOPE_AGENT);
        __syncthreads();
        const int bt = __builtin_amdgcn_readfirstlane(*slot);
        if (bt >= nbatch) break;
        int g = bt * CVQ_BATCH;
        const float* W; bf16_t* Wt; int K, N, Npad;
        if (g < CVQ_MOE_TILES) {
            const int m = g / (CVQ_SEG_E + CVQ_SEG_S); g -= m * (CVQ_SEG_E + CVQ_SEG_S);
            const bool sh = g >= CVQ_SEG_E; if (sh) g -= CVQ_SEG_E;
            W = (m == 0) ? (sh ? p.sg + so : p.w_gate + eo) : (m == 1) ? (sh ? p.su + so : p.w_up + eo) : (sh ? p.sd + so : p.w_down + eo);
            Wt = ((m == 0) ? p.WgT : (m == 1) ? p.WuT : p.WdT) + (sh ? (size_t)64 * 512 * DM : (size_t)0);
            K = (m == 2) ? 512 : DM; N = (m == 2) ? DM : 512; Npad = N;
        } else {
            g -= CVQ_MOE_TILES;
            if (g < CVQ_X0) { W = p.cd_w_in; Wt = p.WinCDt; K = DM; N = CD_IN; Npad = 9472; }
            else if ((g -= CVQ_X0) < CVQ_X1) { W = p.cd_w_out; Wt = p.WoutCDt; K = 4096; N = DM; Npad = DM; }
            else if ((g -= CVQ_X1) < CVQ_X2) { W = p.w_uq; Wt = p.Wuqt; K = 512; N = 3072; Npad = 3072; }
            else if ((g -= CVQ_X2) < CVQ_X3) { W = p.w_ukv; Wt = p.Wukvt; K = 512; N = 4096; Npad = 4096; }
            else if ((g -= CVQ_X3) < CVQ_X4) { W = p.ab_w_out; Wt = p.WoutABt; K = 4096; N = DM; Npad = DM; }
            else { g -= CVQ_X4; W = p.cmp_w; Wt = p.WcmpT; K = 4096; N = 128; Npad = 256; }
        }
        cvt_wT_quad(lds, W, Wt, K, N, Npad, g, g + CVQ_BATCH);
    }
    __syncthreads();
}

DI void ph_cvt_x(const MP& p) {
    const int tix = tid_opaque();
    const long gt = (long)blockIdx.x * NTHR + tix, gs = (long)gridDim.x * NTHR;
    for (long i = gt; i < (long)T_TOK * DM / 4; i += gs) { const float4 v = ((const float4*)p.x)[i]; u32x2 o; o.x = pk_bf16(v.x, v.y); o.y = pk_bf16(v.z, v.w); ((u32x2*)p.xb)[i] = o; }
    for (long i = gt; i < DM / 2; i += gs) ((unsigned*)(p.xb + (size_t)T_TOK * DM))[i] = 0u;
}


DI void ph_ssd_norm(const MP& p) {
    const int tix = tid_opaque();
    const int lane = tix & 63, gw = blockIdx.x * NWAVE + (tix >> 6), nw = gridDim.x * NWAVE;
    const bf16_t* mixh = (const bf16_t*)p.mix;
    u32x2 nv[8];
    if (gw < T_TOK) {
#pragma unroll
        for (int j = 0; j < 8; ++j) nv[j] = *(const u32x2*)(mixh + (long)gw * 4096 + j * 256 + lane * 4);
    }
    for (int row = gw; row < T_TOK; row += nw) {
        float4 v[8]; float ss = 0.f;
#pragma unroll
        for (int j = 0; j < 8; ++j) { v[j].x = bflo(nv[j].x); v[j].y = bfhi(nv[j].x); v[j].z = bflo(nv[j].y); v[j].w = bfhi(nv[j].y); ss += v[j].x * v[j].x + v[j].y * v[j].y + v[j].z * v[j].z + v[j].w * v[j].w; }
        if (row + nw < T_TOK) {
#pragma unroll
            for (int j = 0; j < 8; ++j) nv[j] = *(const u32x2*)(mixh + (long)(row + nw) * 4096 + j * 256 + lane * 4);
        }
        const float r = rsqrtf(wave_sum(ss) / 2048.f + 1e-6f);
#pragma unroll
        for (int j = 0; j < 8; ++j) { const float4 w = *(const float4*)(p.ssm_norm_w + j * 256 + lane * 4);
            u32x2 o; o.x = pk_bf16(v[j].x * r * w.x, v[j].y * r * w.y); o.y = pk_bf16(v[j].z * r * w.z, v[j].w * r * w.w);
            *(u32x2*)(p.mixb + (long)row * 4096 + j * 256 + lane * 4) = o; }
    }
}

DI void ph_build_wr(const MP& p) {
    const int tix = tid_opaque();
    const long gt = (long)blockIdx.x * NTHR + tix, gs = (long)gridDim.x * NTHR;
    for (long idx = gt; idx < (long)2 * 256 * 4096; idx += gs) {
        const int k = (int)(idx & 4095), n = (int)((idx >> 12) & 255), layer = (int)(idx >> 20);
        float v = 0.f;
        if (n < 128) {
            const float wv = p.w_router[((size_t)layer * DM + (k & 2047)) * 64 + (n & 63)];
            const float hi = bf2f(f2bf(wv));
            if (n < 64) v = hi; else v = (k < 2048) ? (wv - hi) : 0.f;
        }
        p.WrT3[idx] = f2bf(v);
    }
}
template <bool XBF> DI void ph_ln(const MP& p, const void* xin_, const bf16_t* add, const float* gg, const float* bb, bf16_t* xob, bf16_t* xlo) {
    const int tix = tid_opaque();
    const int lane = tix & 63, gw = blockIdx.x * NWAVE + (tix >> 6), nw = gridDim.x * NWAVE;
    float4 na[8]; u32x2 nc[8];
    const float* xin = (const float*)xin_; const bf16_t* xinb = (const bf16_t*)xin_;
#define LN_LOADX(row_, j_) do { if constexpr (XBF) { const u32x2 h_ = *(const u32x2*)(xinb + (long)(row_) * DM + (j_) * 256 + lane * 4); na[j_] = make_float4(bflo(h_.x), bfhi(h_.x), bflo(h_.y), bfhi(h_.y)); } \
        else na[j_] = *(const float4*)(xin + (long)(row_) * DM + (j_) * 256 + lane * 4); } while (0)
    if (gw < T_TOK) {
#pragma unroll
        for (int j = 0; j < 8; ++j) { LN_LOADX(gw, j); nc[j] = *(const u32x2*)(add + (long)gw * DM + j * 256 + lane * 4); }
    }
    for (int t = gw; t < T_TOK; t += nw) {
        float4 v[8]; float s = 0.f;
#pragma unroll
        for (int j = 0; j < 8; ++j) { const float4 a = na[j]; const u32x2 c = nc[j];
            v[j].x = DN_ALPHA * a.x + bflo(c.x); v[j].y = DN_ALPHA * a.y + bfhi(c.x); v[j].z = DN_ALPHA * a.z + bflo(c.y); v[j].w = DN_ALPHA * a.w + bfhi(c.y); s += (v[j].x + v[j].y) + (v[j].z + v[j].w); }
        if (t + nw < T_TOK) {
#pragma unroll
            for (int j = 0; j < 8; ++j) { LN_LOADX(t + nw, j); nc[j] = *(const u32x2*)(add + (long)(t + nw) * DM + j * 256 + lane * 4); }
        }
        const float mu = wave_sum(s) / DM;
        float q = 0.f;
#pragma unroll
        for (int j = 0; j < 8; ++j) { v[j].x -= mu; v[j].y -= mu; v[j].z -= mu; v[j].w -= mu; q += v[j].x * v[j].x + v[j].y * v[j].y + v[j].z * v[j].z + v[j].w * v[j].w; }
        const float rs = rsqrtf(wave_sum(q) / DM + 1e-5f);
#pragma unroll
        for (int j = 0; j < 8; ++j) { const int c0 = j * 256 + lane * 4; const float4 g4 = *(const float4*)(gg + c0), b4 = *(const float4*)(bb + c0);
            float4 o; o.x = v[j].x * rs * g4.x + b4.x; o.y = v[j].y * rs * g4.y + b4.y; o.z = v[j].z * rs * g4.z + b4.z; o.w = v[j].w * rs * g4.w + b4.w;
            u32x2 hb; hb.x = pk_bf16(o.x, o.y); hb.y = pk_bf16(o.z, o.w); *(u32x2*)(xob + (long)t * DM + c0) = hb;
            u32x2 lb2; lb2.x = pk_bf16(o.x - bflo(hb.x), o.y - bfhi(hb.x)); lb2.y = pk_bf16(o.z - bflo(hb.y), o.w - bfhi(hb.y)); *(u32x2*)(xlo + (long)t * DM + c0) = lb2; }
    }
}
#undef LN_LOADX
DI void ph_route_select(const MP& p, const float* Cpart, const float* rbias) {
    const int tix = tid_opaque();
    const int lane = tix & 63, gw = blockIdx.x * NWAVE + (tix >> 6), nw = gridDim.x * NWAVE;
    const float bias = rbias[lane];
    const int grp = lane >> 3;
    for (int slot = gw; slot < MOE_NSLOT; slot += nw) {
        int cnt = 0;
        for (int i = 0; i < MOE_SLOT_TOK; ++i) {
            const int t = slot * MOE_SLOT_TOK + i;
            float logit = 0.f;
#pragma unroll
            for (int q = 0; q < 4; ++q) { const float* cp = Cpart + ((size_t)q * T_TOK + t) * 128; logit += cp[lane] + cp[64 + lane]; }
            if (!(logit == logit)) logit = 0.f;
            const float score = 1.f / (1.f + expf(-logit));
            const float biased = score + bias;
            float m1 = biased;
            m1 = fmaxf(m1, __shfl_xor(m1, 1)); m1 = fmaxf(m1, __shfl_xor(m1, 2)); m1 = fmaxf(m1, __shfl_xor(m1, 4));
            const unsigned long long bm = __ballot(biased == m1);
            const unsigned gb = (unsigned)((bm >> (8 * grp)) & 0xffull);
            const int first = __ffs(gb) - 1;
            float v2 = ((lane & 7) == first) ? -3.0e38f : biased;
            v2 = fmaxf(v2, __shfl_xor(v2, 1)); v2 = fmaxf(v2, __shfl_xor(v2, 2)); v2 = fmaxf(v2, __shfl_xor(v2, 4));
            const float gs = m1 + v2;
            int grank = 0;
#pragma unroll
            for (int g2 = 0; g2 < 8; ++g2) { const float o = __shfl(gs, g2 * 8); grank += (o > gs || (o == gs && g2 < grp)) ? 1 : 0; }
            const bool gsel = grank < 4;
            const float masked = gsel ? biased : -3.0e38f;
            int erank = 0;
            for (int e2 = 0; e2 < 64; ++e2) { const float o = __shfl(masked, e2); erank += (o > masked || (o == masked && e2 < lane)) ? 1 : 0; }
            const bool selected = gsel && erank < 8;
            const float ws = wave_sum(selected ? score : 0.f);
            if (selected) { p.top_e[t * 8 + erank] = lane; p.top_w[t * 8 + erank] = score / ws * 2.5f; p.lpos[t * 8 + erank] = cnt; ++cnt; }
        }
        p.cnt_tab[slot * 64 + lane] = cnt;
    }
}
DI void ph_router_gemm(LAS unsigned char* lds, const MP& p, int layer, float* Cpart, const bf16_t* xlo) {
    gm::RouterProb q; q.xhi = (const char*)p.xb; q.dlo = (long)((const char*)xlo - (const char*)p.xb); q.Bt = (const char*)(p.WrT3 + (size_t)layer * 256 * 4096); q.K = 1024; q.G = (int)gridDim.x; q.c = (int)blockIdx.x; q.ldb = 4096;
    gm::EpiRouter e; e.Cpart = Cpart;
    gm::gemm_phase(lds, q, e);
}

DI void ph_moe_scan(LAS unsigned char* lds, const MP& p) {
    const int tix = tid_opaque();
    LAS int* part_b = (LAS int*)lds;
    LAS int* part_a = part_b + 512;
    LAS int* total = part_a + 512; LAS int* base = total + 64; LAS int* pre = base + 64; LAS int* pc = pre + 64;
    const int tid = tix, e = tid & 63, part = tid >> 6;
    const int spb = (MOE_NSLOT + gridDim.x - 1) / gridDim.x;
    const int s0 = blockIdx.x * spb, s1 = min(MOE_NSLOT, s0 + spb);
    int sb = 0, sa = 0;
#pragma unroll 16
    for (int sl = part; sl < MOE_NSLOT; sl += NWAVE) { const int c = p.cnt_tab[sl * 64 + e]; sa += c; if (sl < s0) sb += c; }
    part_b[part * 64 + e] = sb; part_a[part * 64 + e] = sa;
    __syncthreads();
    if (tid < 64) {
        int ta = 0, tb = 0;
#pragma unroll
        for (int i = 0; i < NWAVE; ++i) { ta += part_a[i * 64 + tid]; tb += part_b[i * 64 + tid]; }
        total[tid] = ta; pre[tid] = tb; pc[tid] = (ta + MOE_TM - 1) / MOE_TM * MOE_TM;
    }
    __syncthreads();
    LAS int* ubase = pc + 64 + 512;
    if (tid == 0) { int a = 0, ua = 0; for (int i = 0; i < 64; ++i) { base[i] = a; a += pc[i]; ubase[i] = ua; ua += total[i]; } }
    __syncthreads();
    if (spb <= 8) {
        LAS int* cl = pc + 64;
        const int sll = tid >> 6;
        cl[tid] = (s0 + sll < s1) ? p.cnt_tab[(s0 + sll) * 64 + e] : 0;
        __syncthreads();
        if (tid < 64) { int run = pre[tid]; for (int i = 0; i < 8; ++i) { const int c = cl[i * 64 + tid]; cl[i * 64 + tid] = run; run += c; } }
        __syncthreads();
        if (s0 + sll < s1) {
            const int a = tid & 63; const int t = (s0 + sll) * MOE_SLOT_TOK + (a >> 3), k = a & 7;
            const int ex = p.top_e[t * 8 + k] & 63;
            const int pp = base[ex] + cl[sll * 64 + ex] + p.lpos[t * 8 + k];
            if (pp >= 0 && pp < MOE_PMAX) { p.row_tok[pp] = t; p.row_slot[t * 8 + k] = pp - (base[ex] - ubase[ex]); }
        }
    } else
    for (int sl = s0; sl < s1; ++sl) {
        if (tid < 64) {
            const int t = sl * MOE_SLOT_TOK + (tid >> 3), k = tid & 7;
            const int ex = p.top_e[t * 8 + k] & 63;
            const int pp = base[ex] + pre[ex] + p.lpos[t * 8 + k];
            if (pp >= 0 && pp < MOE_PMAX) { p.row_tok[pp] = t; p.row_slot[t * 8 + k] = pp - (base[ex] - ubase[ex]); }
        }
        __syncthreads();
        if (tid < 64) pre[tid] += p.cnt_tab[sl * 64 + tid];
        __syncthreads();
    }
    for (int ex = blockIdx.x; ex < 64; ex += gridDim.x)
        for (int pp = base[ex] + total[ex] + tid; pp < base[ex] + pc[ex]; pp += NTHR) p.row_tok[pp] = -1;
    for (int i = blockIdx.x * NTHR + tid; i < T_TOK; i += gridDim.x * NTHR) p.row_tok[MOE_PMAX + i] = i;
    if (blockIdx.x == 0 && tid < 64) {
        const int ex = tid, nt = pc[ex] / MOE_TM, t0 = base[ex] / MOE_TM;
        for (int j = 0; j < nt; ++j) { p.tiles[(t0 + j) * 4 + 0] = ex; p.tiles[(t0 + j) * 4 + 1] = base[ex] + j * MOE_TM; p.tiles[(t0 + j) * 4 + 2] = min(MOE_TM, total[ex] - j * MOE_TM); p.tiles[(t0 + j) * 4 + 3] = base[ex] - ubase[ex]; }
        const int nr = (base[63] + pc[63]) / MOE_TM;
        if (ex == 63) *p.ntiles = nr + T_TOK / MOE_TM;
        for (int j = ex; j < T_TOK / MOE_TM; j += 64) { p.tiles[(nr + j) * 4 + 0] = 64; p.tiles[(nr + j) * 4 + 1] = MOE_PMAX + j * MOE_TM; p.tiles[(nr + j) * 4 + 2] = MOE_TM; p.tiles[(nr + j) * 4 + 3] = MOE_PMAX - T_TOK * 8; }
    }
    __syncthreads();
}

DI void ph_moe_combine_ln(const MP& p, const bf16_t* xhi, const bf16_t* xlo, const float* gg, const float* bb, float* out, bf16_t* ob) {
    const int tix = tid_opaque();
    const int lane = tix & 63, gw = blockIdx.x * NWAVE + (tix >> 6), nw = gridDim.x * NWAVE;
    int myslot = 0; float myw = 0.f;
    { const long rr = (long)gw + (long)(lane >> 3) * nw; if (rr < T_TOK) { myslot = p.row_slot[rr * 8 + (lane & 7)]; myw = p.top_w[rr * 8 + (lane & 7)]; } }
    int ri = 0;
    for (int row = gw; row < T_TOK; row += nw, ++ri) {
        if (ri == 8) { ri = 0; const long rr = (long)row + (long)(lane >> 3) * nw; if (rr < T_TOK) { myslot = p.row_slot[rr * 8 + (lane & 7)]; myw = p.top_w[rr * 8 + (lane & 7)]; } }
        float v[32];
#pragma unroll
        for (int j = 0; j < 4; ++j) { const u32x4 a = *(const u32x4*)(xhi + (long)row * DM + j * 512 + lane * 8), b = *(const u32x4*)(xlo + (long)row * DM + j * 512 + lane * 8);
            v[j * 8 + 0] = DN_ALPHA * (bflo(a.x) + bflo(b.x)); v[j * 8 + 1] = DN_ALPHA * (bfhi(a.x) + bfhi(b.x)); v[j * 8 + 2] = DN_ALPHA * (bflo(a.y) + bflo(b.y)); v[j * 8 + 3] = DN_ALPHA * (bfhi(a.y) + bfhi(b.y));
            v[j * 8 + 4] = DN_ALPHA * (bflo(a.z) + bflo(b.z)); v[j * 8 + 5] = DN_ALPHA * (bfhi(a.z) + bfhi(b.z)); v[j * 8 + 6] = DN_ALPHA * (bflo(a.w) + bflo(b.w)); v[j * 8 + 7] = DN_ALPHA * (bfhi(a.w) + bfhi(b.w)); }
#pragma unroll 3
        for (int k = 0; k < 9; ++k) {
            const size_t yr = (k < 8) ? (size_t)__builtin_amdgcn_readfirstlane(__shfl(myslot, ri * 8 + (k & 7))) : (size_t)((long)T_TOK * 8 + row);
            const float wk = (k < 8) ? __shfl(myw, ri * 8 + (k & 7)) : 1.f;
#pragma unroll
            for (int j = 0; j < 4; ++j) { const u32x4 y = *(const u32x4*)(p.Y + yr * 2048 + j * 512 + lane * 8);
                v[j * 8 + 0] += wk * bflo(y.x); v[j * 8 + 1] += wk * bfhi(y.x); v[j * 8 + 2] += wk * bflo(y.y); v[j * 8 + 3] += wk * bfhi(y.y);
                v[j * 8 + 4] += wk * bflo(y.z); v[j * 8 + 5] += wk * bfhi(y.z); v[j * 8 + 6] += wk * bflo(y.w); v[j * 8 + 7] += wk * bfhi(y.w); }
        }
        float s = 0.f;
#pragma unroll
        for (int i = 0; i < 32; ++i) s += v[i];
        const float mu = wave_sum(s) / DM;
        float q = 0.f;
#pragma unroll
        for (int i = 0; i < 32; ++i) { v[i] -= mu; q += v[i] * v[i]; }
        const float rs = rsqrtf(wave_sum(q) / DM + 1e-5f);
#pragma unroll
        for (int j = 0; j < 4; ++j) { const int c0 = j * 512 + lane * 8;
            float o8[8];
#pragma unroll
            for (int i = 0; i < 8; ++i) o8[i] = v[j * 8 + i] * rs * gg[c0 + i] + bb[c0 + i];
            if (out) { *(float4*)(out + (long)row * DM + c0) = make_float4(o8[0], o8[1], o8[2], o8[3]);
                       *(float4*)(out + (long)row * DM + c0 + 4) = make_float4(o8[4], o8[5], o8[6], o8[7]); }
            if (ob) { u32x4 pk; pk.x = pk_bf16(o8[0], o8[1]); pk.y = pk_bf16(o8[2], o8[3]); pk.z = pk_bf16(o8[4], o8[5]); pk.w = pk_bf16(o8[6], o8[7]); *(u32x4*)(ob + (long)row * DM + c0) = pk; } }
    }
}

DI void ph_mla_rms(const MP& p) {
    const int tix = tid_opaque();
    const int lane = tix & 63, gw = blockIdx.x * NWAVE + (tix >> 6), nw = gridDim.x * NWAVE;
    for (int u = gw; u < T_TOK * 2; u += nw) {
        const int row = u >> 1, which = u & 1;
        const bf16_t* src = p.hbuf + (long)row * CD_IN + which * 512 + lane * 8;
        const u32x4 y = *(const u32x4*)src;
        float v[8] = {bflo(y.x), bfhi(y.x), bflo(y.y), bfhi(y.y), bflo(y.z), bfhi(y.z), bflo(y.w), bfhi(y.w)};
        float ss = 0.f;
#pragma unroll
        for (int i = 0; i < 8; ++i) ss += v[i] * v[i];
        const float r = rsqrtf(wave_sum(ss) / 512.f + 1e-6f);
        const float* w = (which ? p.kv_norm_w : p.q_norm_w) + lane * 8;
        u32x4 o; o.x = pk_bf16(v[0] * r * w[0], v[1] * r * w[1]); o.y = pk_bf16(v[2] * r * w[2], v[3] * r * w[3]); o.z = pk_bf16(v[4] * r * w[4], v[5] * r * w[5]); o.w = pk_bf16(v[6] * r * w[6], v[7] * r * w[7]);
        *(u32x4*)(p.cqb + (long)row * 1024 + which * 512 + lane * 8) = o;
    }
}
DI void ph_rope_k(const MP& p) {
    const int tix = tid_opaque();
    const long gt = (long)blockIdx.x * NTHR + tix, gs = (long)gridDim.x * NTHR;
    for (long idx = gt; idx < (long)T_TOK * 32; idx += gs) {
        const int j = (int)(idx & 31); const int t = (int)(idx >> 5);
        const float inv = powf(10000.f, -(float)(2 * j) / 64.f);
        const float ang = (float)p.positions[t] * inv;
        const float c = cosf(ang), sn = sinf(ang);
        const bf16_t* pp = p.hbuf + (long)t * CD_IN + CD_KR;
        const float t1 = ldh(pp, j), t2 = ldh(pp, j + 32);
        { const int b = t >> 11, sq = t & 2047; const size_t tb = ((size_t)b * 64 + (sq >> 5)) * 4; const int r = sq & 31;
          p.kr[(tb + (j >> 4)) * 512 + (((j >> 3) & 1) * 32 + r) * 8 + (j & 7)] = f2bf(t1 * c - t2 * sn);
          p.kr[(tb + ((j + 32) >> 4)) * 512 + ((((j + 32) >> 3) & 1) * 32 + r) * 8 + (j & 7)] = f2bf(t1 * sn + t2 * c); }
        *(float2*)(p.rope_tab + ((long)t * 32 + j) * 2) = make_float2(c, sn);
    }
}
DI void ph_hgrn_post(const MP& p) {
    const int tix = tid_opaque();
    const int lane = tix & 63, gw = blockIdx.x * NWAVE + (tix >> 6), nw = gridDim.x * NWAVE;
    for (int t = gw; t < T_TOK; t += nw) {
#pragma unroll
        for (int j = 0; j < 4; ++j) {
            const int col = j * 512 + lane * 8;
            const float4 a = *(const float4*)(p.x3 + (long)t * 2048 + col), c = *(const float4*)(p.x3 + (long)t * 2048 + col + 4);
            float ss = a.x * a.x + a.y * a.y + a.z * a.z + a.w * a.w + c.x * c.x + c.y * c.y + c.z * c.z + c.w * c.w;
            ss += __shfl_xor(ss, 1); ss += __shfl_xor(ss, 2); ss += __shfl_xor(ss, 4); ss += __shfl_xor(ss, 8);
            const float r = rsqrtf(ss / 128.f + 1e-6f);
            const u32x4 gv = *(const u32x4*)(p.hbuf + (long)t * CD_IN + CD_HG + col);
            const float4 w0 = *(const float4*)(p.hgrn_norm_w + (col & 127)), w1 = *(const float4*)(p.hgrn_norm_w + (col & 127) + 4);
            u32x4 o;
            o.x = pk_bf16(a.x * r * w0.x * siluf_(bflo(gv.x)), a.y * r * w0.y * siluf_(bfhi(gv.x)));
            o.y = pk_bf16(a.z * r * w0.z * siluf_(bflo(gv.y)), a.w * r * w0.w * siluf_(bfhi(gv.y)));
            o.z = pk_bf16(c.x * r * w1.x * siluf_(bflo(gv.z)), c.y * r * w1.y * siluf_(bfhi(gv.z)));
            o.w = pk_bf16(c.z * r * w1.z * siluf_(bflo(gv.w)), c.w * r * w1.w * siluf_(bfhi(gv.w)));
            *(u32x4*)(p.mixb + (long)t * 4096 + 2048 + col) = o;
        }
    }
}


typedef float f32x16 __attribute__((ext_vector_type(16)));
#define MFMA32(a, b, c) __builtin_amdgcn_mfma_f32_32x32x16_bf16((a), (b), (c), 0, 0, 0)
DI bf16x8 ld8(const bf16_t* q) { return *(const bf16x8*)q; }
DI size_t lnd(size_t v) { asm volatile("" : "+v"(v)); return v; }
DI const bf16_t* launder(const bf16_t* q) { asm volatile("" : "+v"(q)); return q; }
DI bf16x8 pack8(float a0, float a1, float a2, float a3, float a4, float a5, float a6, float a7) {
    u32x4 u; u.x = pk_bf16(a0, a1); u.y = pk_bf16(a2, a3); u.z = pk_bf16(a4, a5); u.w = pk_bf16(a6, a7); return __builtin_bit_cast(bf16x8, u);
}
DI void ph_mla_attn(LAS unsigned char* lds, const MP& p) {
    const int tix = tid_opaque();
    const int w = tix >> 6, lane = tix & 63, r = lane & 31, hh = lane >> 5;
    const bf16_t* qm = (const bf16_t*)p.xbc;
    const bf16_t* kfr = (const bf16_t*)p.kvfrag;
    const bf16_t* vfr = kfr + (size_t)T_TOK * 2048;
    const float sc2 = 0.07216878364870322f * 1.4426950408889634f;
    constexpr int SLOT = 20 * 1024;
    for (int unit = blockIdx.x; unit < NB * 16 * 4; unit += gridDim.x) {
        const int pair = unit & 3, head = (unit >> 2) & 15, b = unit >> 6;
        const bf16_t* g0 = kfr + (((size_t)(b * 16 + head) * 64) * 8 + w) * 512 + lane * 8;
        const bf16_t* g1 = (w < 4) ? p.kr + (((size_t)b * 64) * 4 + w) * 512 + lane * 8
                                   : vfr + (((size_t)(b * 16 + head) * 64) * 8 + (w - 4)) * 512 + lane * 8;
        const size_t g1step = (w < 4) ? 2048 : 4096;
        const bf16_t* g2 = vfr + (((size_t)(b * 16 + head) * 64) * 8 + 4 + (w & 3)) * 512 + lane * 8;
        const unsigned l0 = (unsigned)w * 1024u, l1 = (unsigned)(8 + w) * 1024u, l2 = (unsigned)(16 + (w & 3)) * 1024u;
#define MLA_DMA(kt_, slot_) do { LAS unsigned char* sb_ = lds + (slot_) * SLOT; \
        __builtin_amdgcn_global_load_lds((const unsigned*)(g0 + (size_t)(kt_) * 4096), (LAS unsigned*)(sb_ + l0), 16, 0, 0); \
        __builtin_amdgcn_global_load_lds((const unsigned*)(g1 + (size_t)(kt_) * g1step), (LAS unsigned*)(sb_ + l1), 16, 0, 0); \
        __builtin_amdgcn_global_load_lds((const unsigned*)(g2 + (size_t)(kt_) * 4096), (LAS unsigned*)(sb_ + l2), 16, 0, 0); } while (0)
        for (int half = 0; half < 2; ++half) {
            const int qb = half ? 7 - pair : pair;
            const int row0 = qb * 256 + 32 * w;
            const long tq = (long)b * SEQ + row0 + r;
            bf16x8 qf[12];
#pragma unroll
            for (int st = 0; st < 12; ++st) qf[st] = ld8(qm + tq * 3072 + head * 192 + 16 * st + 8 * hh);
#pragma unroll
            for (int g2i = 0; g2i < 2; ++g2i) {
                float o1[8], o2[8];
#pragma unroll
                for (int j = 0; j < 8; ++j) {
                    const float2 cs = *(const float2*)(p.rope_tab + (tq * 32 + 16 * g2i + 8 * hh + j) * 2);
                    const float t1 = bf2f((bf16_t)qf[8 + g2i][j]), t2 = bf2f((bf16_t)qf[10 + g2i][j]);
                    o1[j] = t1 * cs.x - t2 * cs.y; o2[j] = t1 * cs.y + t2 * cs.x;
                }
                qf[8 + g2i] = pack8(o1[0], o1[1], o1[2], o1[3], o1[4], o1[5], o1[6], o1[7]);
                qf[10 + g2i] = pack8(o2[0], o2[1], o2[2], o2[3], o2[4], o2[5], o2[6], o2[7]);
            }
            f32x16 O[4];
#pragma unroll
            for (int dt = 0; dt < 4; ++dt)
#pragma unroll
                for (int i = 0; i < 16; ++i) O[dt][i] = 0.f;
            float m = -INFINITY, l = 0.f;
            const int ktd = row0 >> 5;
            const int nt = qb * 8 + 8;
            asm volatile("s_waitcnt vmcnt(0)" ::: "memory");
            __syncthreads();
            MLA_DMA(0, 0); MLA_DMA(1, 1);
            for (int kt = 0; kt < nt; ++kt) {
                asm volatile("s_waitcnt vmcnt(3)" ::: "memory");
                __builtin_amdgcn_s_barrier();
                { const int kn2 = (kt + 2 < nt) ? kt + 2 : kt; MLA_DMA(kn2, (kt + 2) % 3); }
                if (kt <= ktd) {
                    const LAS unsigned char* sb = lds + (kt % 3) * SLOT + lane * 16;
                    bf16x8 kfr[12];
#pragma unroll
                    for (int st = 0; st < 12; ++st) kfr[st] = *(const LAS bf16x8*)(sb + st * 1024);
                    __builtin_amdgcn_sched_barrier(0);
                    f32x16 S, S2;
#pragma unroll
                    for (int i = 0; i < 16; ++i) { S[i] = 0.f; S2[i] = 0.f; }
#pragma unroll
                    for (int st = 0; st < 12; st += 2) { S = MFMA32(kfr[st], qf[st], S); S2 = MFMA32(kfr[st + 1], qf[st + 1], S2); }
                    bf16x8 vfr[8];
#pragma unroll
                    for (int f = 0; f < 8; ++f) vfr[f] = *(const LAS bf16x8*)(sb + (12 + f) * 1024);
                    __builtin_amdgcn_sched_barrier(0);
#pragma unroll
                    for (int i = 0; i < 16; ++i) S[i] += S2[i];
                    if (kt == ktd) {
#pragma unroll
                        for (int i = 0; i < 16; ++i) if (((i & 3) + 8 * (i >> 2) + 4 * hh) > r) S[i] = -INFINITY;
                    }
                    float mx = S[0];
#pragma unroll
                    for (int i = 1; i < 16; ++i) mx = fmaxf(mx, S[i]);
                    if (__any((mx - m) * sc2 > 24.f)) {
                        const float cm = fmaxf(mx, __shfl_xor(mx, 32));
                        const float mn = fmaxf(m, cm);
                        const float alpha = (m == -INFINITY) ? 0.f : __builtin_amdgcn_exp2f((m - mn) * sc2);
                        l *= alpha;
#pragma unroll
                        for (int dt = 0; dt < 4; ++dt)
#pragma unroll
                            for (int i = 0; i < 16; ++i) O[dt][i] *= alpha;
                        m = mn;
                    }
#pragma unroll
                    for (int i = 0; i < 16; ++i) { S[i] = __builtin_amdgcn_exp2f((S[i] - m) * sc2); l += S[i]; }
                    const bf16x8 pf0 = pack8(S[0], S[1], S[2], S[3], S[4], S[5], S[6], S[7]);
                    const bf16x8 pf1 = pack8(S[8], S[9], S[10], S[11], S[12], S[13], S[14], S[15]);
#pragma unroll
                    for (int dt = 0; dt < 4; ++dt) O[dt] = MFMA32(vfr[dt * 2], pf0, O[dt]);
#pragma unroll
                    for (int dt = 0; dt < 4; ++dt) O[dt] = MFMA32(vfr[dt * 2 + 1], pf1, O[dt]);
                }
            }
            asm volatile("s_waitcnt vmcnt(0)" ::: "memory");
            l += __shfl_xor(l, 32);
            const float il = 1.f / l;
            bf16_t* orow = p.mixb + tq * 4096 + head * 128;
#pragma unroll
            for (int dt = 0; dt < 4; ++dt)
#pragma unroll
                for (int i4 = 0; i4 < 4; ++i4) {
                    u32x2 o; o.x = pk_bf16(O[dt][i4 * 4 + 0] * il, O[dt][i4 * 4 + 1] * il); o.y = pk_bf16(O[dt][i4 * 4 + 2] * il, O[dt][i4 * 4 + 3] * il);
                    *(u32x2*)(orow + 32 * dt + 8 * i4 + 4 * hh) = o;
                }
        }
#undef MLA_DMA
    }
    __syncthreads();
}

DI void ph_cmp_bias(const MP& p) {
    const int tix = tid_opaque();
    const int e = tix & 127, sub = tix >> 7;
    for (int u = blockIdx.x; u < 64; u += gridDim.x) {
        const int which = u >> 5, l = u & 31;
        const float* pp = p.cmp_pos + ((size_t)which * 32 + l) * 128;
        const float* ww = p.cmp_w + ((size_t)which * 4096 + (size_t)l * 128) * 128;
        float a = 0.f;
        for (int d = sub * 32; d < sub * 32 + 32; ++d) a += pp[d] * ww[(size_t)d * 128 + e];
        p.cpart[(((size_t)which * 32 + l) * 4 + sub) * 128 + e] = a;
    }
}

#define MFMA16(a, b, c) __builtin_amdgcn_mfma_f32_16x16x32_bf16((a), (b), (c), 0, 0, 0)
constexpr int NSA_ACC_STRIDE = 132;
constexpr int NSA_ACC_WAVE = 32 * NSA_ACC_STRIDE;
template <int BR = 7> DI void ph_nsa_attn(LAS unsigned char* lds, const MP& p) {
    const int tix = tid_opaque();
    const int w = tix >> 6, lane = tix & 63, r = lane & 31, hh = lane >> 5, c16 = lane & 15, kg = lane >> 4;
    LAS float* acc = (LAS float*)lds + w * NSA_ACC_WAVE;
    const bf16_t* hb = p.hbuf;
    const float c2 = 0.08838834764831845f * 1.4426950408889634f;
    for (int unit = blockIdx.x; unit < NB * 2 * 32; unit += gridDim.x) {
        const int bg = unit & 15, qb = unit >> 4, b = bg >> 1, g = bg & 1;
        for (int sub = 0; sub < 2; ++sub) {
            const int s0 = qb * 64 + __builtin_amdgcn_readfirstlane(w) * 8 + sub * 4;
            unsigned selp0 = 0u, selp1 = 0u;
            if constexpr ((BR & 1) != 0) {
                const int lz = tid_opaque(); const int r = lz & 31, hh = (lz >> 5) & 1; LAS float* acc = (LAS float*)lds + (lz >> 6) * NSA_ACC_WAVE;
                const int sq = s0 + (r >> 3), head = r & 7;
                const long tq = (long)b * SEQ + sq;
                const float g0 = sigmoidf_(ldh(hb + tq * AB_IN + AB_G + (g * 8 + head) * 3, 0));
                bf16x8 qf[8];
#pragma unroll
                for (int st = 0; st < 8; ++st) qf[st] = ld8(hb + tq * AB_IN + AB_Q + (g * 8 + head) * 128 + 16 * st + 8 * hh);
                const int nv_lane = sq >= 31 ? (sq - 31) / 16 + 1 : 0;
                const int nv_max = (s0 + 3 >= 31) ? (s0 + 3 - 31) / 16 + 1 : 0;
                const int nkt = (nv_max + 31) >> 5;
                float m = -INFINITY, l = 0.f;
                for (int kt = 0; kt < nkt; ++kt) {
                    const bf16_t* kp = p.kcb + lnd(((size_t)(bg * 128 + 32 * kt + r)) * 128 + 8 * hh);
                    bf16x8 kf[8];
#pragma unroll
                    for (int st = 0; st < 8; ++st) kf[st] = ld8(kp + 16 * st);
                    __builtin_amdgcn_sched_barrier(0);
                    f32x16 S;
#pragma unroll
                    for (int i = 0; i < 16; ++i) S[i] = 0.f;
#pragma unroll
                    for (int st = 0; st < 8; ++st) S = MFMA32(kf[st], qf[st], S);
                    float mx = -INFINITY;
#pragma unroll
                    for (int i = 0; i < 16; ++i) { const int key = 32 * kt + (i & 3) + 8 * (i >> 2) + 4 * hh; if (key >= nv_lane) S[i] = -INFINITY; mx = fmaxf(mx, S[i]); }
                    mx = fmaxf(mx, __shfl_xor(mx, 32));
                    const float mn = fmaxf(m, mx);
                    const float mm = (mn == -INFINITY) ? 0.f : mn;
                    float rs = 0.f;
#pragma unroll
                    for (int i = 0; i < 16; ++i) rs += __builtin_amdgcn_exp2f((S[i] - mm) * c2);
                    rs += __shfl_xor(rs, 32);
                    l = l * __builtin_amdgcn_exp2f((m - mm) * c2) + rs;
                    m = mn;
                }
                const float mm = (m == -INFINITY) ? 0.f : m;
                const float il = l > 0.f ? 1.f / l : 0.f;
                float A[16];
                float prev_same = 0.f;
                f32x16 O[4];
#pragma unroll
                for (int dt = 0; dt < 4; ++dt)
#pragma unroll
                    for (int i = 0; i < 16; ++i) O[dt][i] = 0.f;
#pragma unroll
                for (int kt = 0; kt < 4; ++kt) {
                    if (kt < nkt) {
                        f32x16 S;
#pragma unroll
                        for (int i = 0; i < 16; ++i) S[i] = 0.f;
                        const bf16_t* kp = p.kcb + lnd(((size_t)(bg * 128 + 32 * kt + r)) * 128 + 8 * hh);
                        const bf16_t* vp = p.vcT + lnd(((size_t)(bg * 128 + r)) * 128 + 32 * kt + 8 * hh);
                        bf16x8 kf[8], vf[4];
#pragma unroll
                        for (int st = 0; st < 8; ++st) kf[st] = ld8(kp + 16 * st);
                        __builtin_amdgcn_sched_barrier(0);
#pragma unroll
                        for (int st = 0; st < 8; ++st) S = MFMA32(kf[st], qf[st], S);
                        __builtin_amdgcn_sched_barrier(0);
#pragma unroll
                        for (int dt = 0; dt < 2; ++dt) { vf[2 * dt] = ld8(vp + (size_t)(32 * dt) * 128); vf[2 * dt + 1] = ld8(vp + (size_t)(32 * dt) * 128 + 16); }
                        __builtin_amdgcn_sched_barrier(0);
#pragma unroll
                        for (int i = 0; i < 16; ++i) { const int key = 32 * kt + (i & 3) + 8 * (i >> 2) + 4 * hh; S[i] = (key < nv_lane) ? __builtin_amdgcn_exp2f((S[i] - mm) * c2) * il : 0.f; }
#pragma unroll
                        for (int c4 = 0; c4 < 4; ++c4) { const int i = 4 * c4;
                            const float part = S[i] + S[i + 1] + S[i + 2] + 0.5f * S[i + 3], car = 0.5f * S[i + 3];
                            const float same = __shfl_xor(car, 32);
                            float av = part + (hh ? same : prev_same); prev_same = same;
                            av += __shfl_xor(av, 1); av += __shfl_xor(av, 2); av += __shfl_xor(av, 4);
                            A[4 * kt + c4] = av; }
                        const bf16x8 pf0 = pack8(S[0], S[1], S[2], S[3], S[4], S[5], S[6], S[7]);
                        const bf16x8 pf1 = pack8(S[8], S[9], S[10], S[11], S[12], S[13], S[14], S[15]);
#pragma unroll
                        for (int dt = 0; dt < 2; ++dt) { O[dt] = MFMA32(vf[2 * dt], pf0, O[dt]); O[dt] = MFMA32(vf[2 * dt + 1], pf1, O[dt]); }
                        __builtin_amdgcn_sched_barrier(0);
#pragma unroll
                        for (int dt = 2; dt < 4; ++dt) { vf[2 * dt - 4] = ld8(vp + (size_t)(32 * dt) * 128); vf[2 * dt - 3] = ld8(vp + (size_t)(32 * dt) * 128 + 16); }
                        __builtin_amdgcn_sched_barrier(0);
#pragma unroll
                        for (int dt = 2; dt < 4; ++dt) { O[dt] = MFMA32(vf[2 * dt - 4], pf0, O[dt]); O[dt] = MFMA32(vf[2 * dt - 3], pf1, O[dt]); }
                    } else {
#pragma unroll
                        for (int c4 = 0; c4 < 4; ++c4) { float av = hh ? 0.f : prev_same; prev_same = 0.f; av += __shfl_xor(av, 1); av += __shfl_xor(av, 2); av += __shfl_xor(av, 4); A[4 * kt + c4] = av; }
                    }
                    __builtin_amdgcn_sched_barrier(0);
                }
#pragma unroll
                for (int dt = 0; dt < 4; ++dt)
#pragma unroll
                    for (int i4 = 0; i4 < 4; ++i4) { f32x4 o4; o4[0] = g0 * O[dt][4 * i4]; o4[1] = g0 * O[dt][4 * i4 + 1]; o4[2] = g0 * O[dt][4 * i4 + 2]; o4[3] = g0 * O[dt][4 * i4 + 3];
                        *(LAS f32x4*)(acc + r * NSA_ACC_STRIDE + 32 * dt + 8 * i4 + 4 * hh) = o4; }
                __builtin_amdgcn_sched_barrier(0);
                const int cur = sq >> 6;
#pragma unroll
                for (int q = 0; q < 16; ++q) { const int j = 2 * q + hh; const bool forced = (j == 0) || (j == cur) || (j == cur - 1); A[q] = forced ? 1.0e6f : (j <= cur ? A[q] : -1.0f); }
#pragma unroll
                for (int n = 0; n < 8; ++n) {
                    float bv = A[0]; int bj = hh;
#pragma unroll
                    for (int q = 1; q < 16; ++q) { if (A[q] > bv) { bv = A[q]; bj = 2 * q + hh; } }
                    const float ov = __shfl_xor(bv, 32); const int oj = __shfl_xor(bj, 32);
                    const bool take_other = (ov > bv) || (ov == bv && oj < bj);
                    const int wj = take_other ? oj : bj;
                    if (n < 4) selp0 |= (unsigned)wj << (8 * n); else selp1 |= (unsigned)wj << (8 * (n - 4));
#pragma unroll
                    for (int q = 0; q < 16; ++q) if (2 * q + hh == wj) A[q] = -INFINITY;
                }
            }
            __builtin_amdgcn_sched_barrier(0);
            if constexpr ((BR & 2) != 0) {
                const int lz = tid_opaque(); const int r = lz & 31, hh = (lz >> 5) & 1; LAS float* acc = (LAS float*)lds + (lz >> 6) * NSA_ACC_WAVE;
                const int sq = s0 + (r >> 3), head = r & 7;
                const long tq = (long)b * SEQ + sq;
                bf16x8 qw[8];
                { const bf16_t* qp = hb + lnd((size_t)tq * AB_IN + AB_Q + (g * 8 + head) * 128 + 8 * hh);
#pragma unroll
                  for (int st = 0; st < 8; ++st) qw[st] = ld8(qp + 16 * st); }
                f32x16 O[4];
#pragma unroll
                for (int dt = 0; dt < 4; ++dt)
#pragma unroll
                    for (int i = 0; i < 16; ++i) O[dt][i] = 0.f;
                float m = -INFINITY, l = 0.f;
                const int klo = s0 - 511 > 0 ? s0 - 511 : 0;
                const int kt_lo = klo >> 5, kt_hi = (s0 + 3) >> 5;
                for (int kt = kt_lo; kt <= kt_hi; ++kt) {
                    const size_t fo = lnd((((size_t)bg * 64 + kt) * 8 * 64 + (lz & 63)) * 8);
                    const bf16_t* kp = p.kwf + fo; const bf16_t* vb = p.vwinT + fo;
                    bf16x8 kf[8], vf[8];
#pragma unroll
                    for (int st = 0; st < 8; ++st) kf[st] = ld8(kp + st * 512);
                    __builtin_amdgcn_sched_barrier(0);
                    f32x16 S;
#pragma unroll
                    for (int i = 0; i < 16; ++i) S[i] = 0.f;
#pragma unroll
                    for (int st = 0; st < 8; ++st) S = MFMA32(kf[st], qw[st], S);
                    __builtin_amdgcn_sched_barrier(0);
#pragma unroll
                    for (int f = 0; f < 8; ++f) vf[f] = ld8(vb + f * 512);
                    __builtin_amdgcn_sched_barrier(0);
#pragma unroll
                    for (int i = 0; i < 16; ++i) { const int key = 32 * kt + (i & 3) + 8 * (i >> 2) + 4 * hh; if (key > sq || key <= sq - 512) S[i] = -INFINITY; }
                    float mx = S[0];
#pragma unroll
                    for (int i = 1; i < 16; ++i) mx = fmaxf(mx, S[i]);
                    if (__any((mx - m) * c2 > 24.f)) {
                        const float cm = fmaxf(mx, __shfl_xor(mx, 32));
                        const float mn = fmaxf(m, cm);
                        const float alpha = (m == -INFINITY) ? 0.f : __builtin_amdgcn_exp2f((m - mn) * c2);
                        l *= alpha;
#pragma unroll
                        for (int dt = 0; dt < 4; ++dt)
#pragma unroll
                            for (int i = 0; i < 16; ++i) O[dt][i] *= alpha;
                        m = mn;
                    }
                    const float mr = (m == -INFINITY) ? 0.f : m;
#pragma unroll
                    for (int i = 0; i < 16; ++i) { S[i] = __builtin_amdgcn_exp2f((S[i] - mr) * c2); l += S[i]; }
                    const bf16x8 pf0 = pack8(S[0], S[1], S[2], S[3], S[4], S[5], S[6], S[7]);
                    const bf16x8 pf1 = pack8(S[8], S[9], S[10], S[11], S[12], S[13], S[14], S[15]);
#pragma unroll
                    for (int dt = 0; dt < 4; ++dt) { O[dt] = MFMA32(vf[dt * 2], pf0, O[dt]); O[dt] = MFMA32(vf[dt * 2 + 1], pf1, O[dt]); }
                }
                l += __shfl_xor(l, 32);
                const float sc = sigmoidf_(ldh(hb + tq * AB_IN + AB_G + (g * 8 + head) * 3, 2)) / l;
#pragma unroll
                for (int dt = 0; dt < 4; ++dt)
#pragma unroll
                    for (int i4 = 0; i4 < 4; ++i4) { LAS f32x4* ap = (LAS f32x4*)(acc + r * NSA_ACC_STRIDE + 32 * dt + 8 * i4 + 4 * hh); f32x4 o4 = *ap;
                        o4[0] += sc * O[dt][4 * i4]; o4[1] += sc * O[dt][4 * i4 + 1]; o4[2] += sc * O[dt][4 * i4 + 2]; o4[3] += sc * O[dt][4 * i4 + 3]; *ap = o4; }
            }
            __builtin_amdgcn_sched_barrier(0); asm volatile("" ::: "memory");
            if constexpr ((BR & 4) != 0)
#pragma unroll 1
            for (int pr = 0; pr < 2; ++pr) {
                const int lz = tid_opaque(); const int c16 = lz & 15, kg = (lz >> 4) & 3; LAS float* acc = (LAS float*)lds + (lz >> 6) * NSA_ACC_WAVE;
                const bf16_t* kbase = p.ksf + (((size_t)bg * 128) * 4 * 64 + (lz & 63)) * 8;
                const bf16_t* vbase = p.vselT + (((size_t)bg * 64) * 8 * 64 + (lz & 63)) * 8;
                const int cur = qb;
#define NSA_KEY0(it_) ((int)((((it_) < 8 ? sp0 : sp1) >> (8 * (((it_) >> 1) & 3))) & 0xffu) * 64 + 32 * ((it_) & 1))
#define NSA_LOADK(it_) do { const int k0_ = NSA_KEY0(it_); const bf16_t* kp_ = kbase + (size_t)(k0_ >> 4) * 2048; \
        _Pragma("unroll") for (int st = 0; st < 4; ++st) { kR[st] = ld8(kp_ + st * 512); kR[4 + st] = ld8(kp_ + 2048 + st * 512); } } while (0)
#define NSA_LOADV(it_) do { const int k0_ = NSA_KEY0(it_); const bf16_t* vp_ = vbase + (size_t)(k0_ >> 5) * 4096; \
        _Pragma("unroll") for (int dt = 0; dt < 8; ++dt) vR[dt] = ld8(vp_ + dt * 512); } while (0)
#define NSA_SOFTMAX_PV(SQL_, SQMIN_, O_, M_, L_) do { \
                        if (key0 + 31 > (SQMIN_)) { \
                            _Pragma("unroll") for (int i = 0; i < 4; ++i) { if (key0 + 4 * kg + i > (SQL_)) Sa[i] = -INFINITY; if (key0 + 16 + 4 * kg + i > (SQL_)) Sb[i] = -INFINITY; } \
                        } \
                        const float mx = fmaxf(fmaxf(fmaxf(Sa[0], Sa[1]), fmaxf(Sa[2], Sa[3])), fmaxf(fmaxf(Sb[0], Sb[1]), fmaxf(Sb[2], Sb[3]))); \
                        if (__any((mx - M_) * c2 > 24.f)) { \
                            float cm = fmaxf(mx, __shfl_xor(mx, 16)); cm = fmaxf(cm, __shfl_xor(cm, 32)); \
                            const float mn = fmaxf(M_, cm); \
                            const float alpha = (M_ == -INFINITY) ? 0.f : __builtin_amdgcn_exp2f((M_ - mn) * c2); \
                            L_ *= alpha; \
                            _Pragma("unroll") for (int dt = 0; dt < 8; ++dt) O_[dt] *= alpha; \
                            M_ = mn; \
                        } \
                        const float mr_ = (M_ == -INFINITY) ? 0.f : -M_ * c2; \
                        float pa[4], pb[4]; \
                        _Pragma("unroll") for (int i = 0; i < 4; ++i) { pa[i] = __builtin_amdgcn_exp2f(__builtin_fmaf(Sa[i], c2, mr_)); pb[i] = __builtin_amdgcn_exp2f(__builtin_fmaf(Sb[i], c2, mr_)); L_ += pa[i] + pb[i]; } \
                        const bf16x8 pf = pack8(pa[0], pa[1], pa[2], pa[3], pb[0], pb[1], pb[2], pb[3]); \
                        _Pragma("unroll") for (int dt = 0; dt < 8; ++dt) O_[dt] = MFMA16(vR[dt], pf, O_[dt]); \
                    } while (0)
#define NSA_CHUNKS(SQL_, SQMIN_, Q_, O_, M_, L_) do { \
                    bf16x8 kR[8], vR[8]; \
                    int it = vmask ? (__builtin_ctz(vmask)) : 16; \
                    { const int i0_ = it < 16 ? it : 0; NSA_LOADK(i0_); NSA_LOADV(i0_); } \
                    if (it < 16) { \
                        f32x4 Sa, Sb; int key0; \
                        __builtin_amdgcn_s_waitcnt(0x0F70);      \
                        for (;;) { \
                            const unsigned rem = (it < 15) ? (vmask >> (it + 1)) : 0u; \
                            const int nx = rem ? it + 1 + __builtin_ctz(rem) : 16; \
                            key0 = NSA_KEY0(it); \
                            Sa = (f32x4){0.f, 0.f, 0.f, 0.f}; Sb = (f32x4){0.f, 0.f, 0.f, 0.f}; \
                            _Pragma("unroll") for (int st = 0; st < 4; ++st) { Sa = MFMA16(kR[st], Q_[st], Sa); Sb = MFMA16(kR[4 + st], Q_[st], Sb); } \
                            __builtin_amdgcn_sched_barrier(0); \
                            if (nx >= 16) break; \
                            NSA_LOADK(nx); \
                            __builtin_amdgcn_sched_barrier(0); \
                            NSA_SOFTMAX_PV(SQL_, SQMIN_, O_, M_, L_); \
                            __builtin_amdgcn_sched_barrier(0); \
                            NSA_LOADV(nx); \
                            it = nx; \
                        } \
                        NSA_SOFTMAX_PV(SQL_, SQMIN_, O_, M_, L_); \
                    } } while (0)
                f32x4 O1[8];
#pragma unroll
                for (int dt = 0; dt < 8; ++dt) O1[dt] = (f32x4){0.f, 0.f, 0.f, 0.f};
                float m1 = -INFINITY, l1 = 0.f;
                {
                    const int sqL = s0 + 2 * pr + (c16 >> 3);
                    const long tqL = (long)b * SEQ + sqL;
                    bf16x8 qP[4];
#pragma unroll
                    for (int st = 0; st < 4; ++st) qP[st] = ld8(hb + tqL * AB_IN + AB_Q + (g * 8 + (c16 & 7)) * 128 + 32 * st + 8 * kg);
                    const int sqmax = s0 + 2 * pr + 1;
                    const unsigned sp0 = cur >= 2 ? (((unsigned)(cur - 1) << 8) | ((unsigned)cur << 16)) : (cur == 1 ? (1u << 8) : 0u), sp1 = 0u;
                    const int nf = cur >= 2 ? 3 : cur + 1;
                    unsigned vmask = 0u;
#pragma unroll
                    for (int n = 0; n < 3; ++n) { const int jb = (int)((sp0 >> (8 * n)) & 0xffu); if (n < nf) { if (jb * 64 <= sqmax) vmask |= 1u << (2 * n); if (jb * 64 + 32 <= sqmax) vmask |= 2u << (2 * n); } }
                    NSA_CHUNKS(sqL, s0 + 2 * pr, qP, O1, m1, l1);
                }
                __builtin_amdgcn_sched_barrier(0);
#pragma unroll 1
                for (int qi = 0; qi < 2; ++qi) {
                    const int ql = 2 * pr + qi;
                    const int sq2 = s0 + ql; const long tq2 = (long)b * SEQ + sq2;
                    bf16x8 q16[4];
#pragma unroll
                    for (int st = 0; st < 4; ++st) q16[st] = ld8(hb + tq2 * AB_IN + AB_Q + (g * 8 + (c16 & 7)) * 128 + 32 * st + 8 * kg);
                    const float g1q = sigmoidf_(ldh(hb + tq2 * AB_IN + AB_G + (g * 8 + (c16 & 7)) * 3, 1));
                    f32x4 O16[8];
#pragma unroll
                    for (int dt = 0; dt < 8; ++dt) O16[dt] = (f32x4){0.f, 0.f, 0.f, 0.f};
                    const int src = (lz & 0x37) | (qi << 3);
                    const float m0 = __shfl(m1, src);
                    float m = m0, l = __shfl(l1, src);
                    const unsigned sp0 = (unsigned)__builtin_amdgcn_readfirstlane(__shfl((int)selp0, ql * 8)), sp1 = (unsigned)__builtin_amdgcn_readfirstlane(__shfl((int)selp1, ql * 8));
                    unsigned vmask = 0u;
#pragma unroll
                    for (int n = 0; n < 8; ++n) { const int jb = (int)(((n < 4 ? sp0 : sp1) >> (8 * (n & 3))) & 0xffu);
                        const bool forced = (jb == 0) || (jb == cur) || (jb == cur - 1);
                        if (!forced) { if (jb * 64 <= sq2) vmask |= 1u << (2 * n); if (jb * 64 + 32 <= sq2) vmask |= 2u << (2 * n); } }
                    NSA_CHUNKS(sq2, sq2, q16, O16, m, l);
                    l += __shfl_xor(l, 16); l += __shfl_xor(l, 32);
                    const float sc = g1q / l;
                    const float f1 = sc * __builtin_amdgcn_exp2f((m0 - m) * c2);
                    if ((c16 >> 3) == qi) {
#pragma unroll
                        for (int dt = 0; dt < 8; ++dt) { LAS f32x4* ap = (LAS f32x4*)(acc + (ql * 8 + (c16 & 7)) * NSA_ACC_STRIDE + 16 * dt + 4 * kg); f32x4 o4 = *ap;
                            o4[0] += sc * O16[dt][0] + f1 * O1[dt][0]; o4[1] += sc * O16[dt][1] + f1 * O1[dt][1]; o4[2] += sc * O16[dt][2] + f1 * O1[dt][2]; o4[3] += sc * O16[dt][3] + f1 * O1[dt][3]; *ap = o4; }
                    }
                }
#undef NSA_CHUNKS
#undef NSA_SOFTMAX_PV
#undef NSA_LOADK
#undef NSA_LOADV
#undef NSA_KEY0
            }
            asm volatile("s_waitcnt lgkmcnt(0)" ::: "memory");
            {
                const int lz = tid_opaque(); const int lane = lz & 63; LAS float* acc = (LAS float*)lds + (lz >> 6) * NSA_ACC_WAVE;
                const int row = lane >> 1, dh = (lane & 1) * 64;
                const long tt = (long)b * SEQ + s0 + (row >> 3);
                bf16_t* op = p.mixb + tt * 4096 + 2048 + (g * 8 + (row & 7)) * 128 + dh;
#pragma unroll
                for (int k8 = 0; k8 < 8; ++k8) {
                    const f32x4 a = *(const LAS f32x4*)(acc + row * NSA_ACC_STRIDE + dh + 8 * k8), c = *(const LAS f32x4*)(acc + row * NSA_ACC_STRIDE + dh + 8 * k8 + 4);
                    u32x4 o; o.x = pk_bf16(a[0], a[1]); o.y = pk_bf16(a[2], a[3]); o.z = pk_bf16(c[0], c[1]); o.w = pk_bf16(c[2], c[3]);
                    *(u32x4*)(op + 8 * k8) = o;
                }
            }
            asm volatile("s_waitcnt lgkmcnt(0)" ::: "memory");
        }
    }
}

DI void ph_conv_ssd(LAS unsigned char* lds, const MP& p) {
    const int tix = tid_opaque();
    LAS bf16_t* tile = (LAS bf16_t*)lds;
    const int tok = tix >> 3, c8 = (tix & 7) * 8;
    bf16_t* xT = (bf16_t*)p.xbc; bf16_t* BT = xT + (size_t)NB * 2048 * 2048; bf16_t* bcr = BT + (size_t)NB * 512 * 2048;
    const int cskip = (gridDim.x >= 64) ? 16 : 0;
    if ((int)blockIdx.x < cskip) return;
    for (int u = blockIdx.x - cskip; u < NB * 32 * 48; u += gridDim.x - cskip) {
        const int ct = u % 48, tt = (u / 48) & 31, b = u / (48 * 32);
        const int c0 = ct * 64, s = tt * 64 + tok; const long t = (long)b * SEQ + s;
        float a[8];
        { const float4 b0 = *(const float4*)(p.conv_b + c0 + c8), b1 = *(const float4*)(p.conv_b + c0 + c8 + 4); a[0] = b0.x; a[1] = b0.y; a[2] = b0.z; a[3] = b0.w; a[4] = b1.x; a[5] = b1.y; a[6] = b1.z; a[7] = b1.w; }
#pragma unroll
        for (int k = 0; k < 4; ++k) {
            if (s - 3 + k >= 0) {
                const u32x4 hv = *(const u32x4*)(p.hbuf + (t - 3 + k) * AB_IN + AB_XBC + c0 + c8);
                const float4 w0 = *(const float4*)(p.conv_w + k * 3072 + c0 + c8), w1 = *(const float4*)(p.conv_w + k * 3072 + c0 + c8 + 4);
                a[0] += w0.x * bflo(hv.x); a[1] += w0.y * bfhi(hv.x); a[2] += w0.z * bflo(hv.y); a[3] += w0.w * bfhi(hv.y);
                a[4] += w1.x * bflo(hv.z); a[5] += w1.y * bfhi(hv.z); a[6] += w1.z * bflo(hv.w); a[7] += w1.w * bfhi(hv.w);
            }
        }
#pragma unroll
        for (int e = 0; e < 8; ++e) a[e] = siluf_(a[e]);
        if (ct >= 32) { u32x4 o; o.x = pk_bf16(a[0], a[1]); o.y = pk_bf16(a[2], a[3]); o.z = pk_bf16(a[4], a[5]); o.w = pk_bf16(a[6], a[7]); *(u32x4*)(bcr + t * 1024 + (c0 - 2048) + c8) = o; }
        if (ct < 40) {
#pragma unroll
            for (int e = 0; e < 8; ++e) tile[(c8 + e) * 72 + tok] = f2bf(a[e]);
        }
        __syncthreads();
        if (ct < 40) {
            const int ch = tix >> 3, tg = tix & 7;
            const u32x4 v = *(const LAS u32x4*)(tile + ch * 72 + 8 * tg);
            const int c = c0 + ch;
            bf16_t* dst = (ct < 32) ? xT + ((size_t)b * 2048 + c) * 2048 : BT + ((size_t)b * 512 + (c - 2048)) * 2048;
            const int pos = tt * 64 + 16 * (tg >> 1) + 4 * (tg & 1);
            u32x2 lo; lo.x = v.x; lo.y = v.y; u32x2 hi; hi.x = v.z; hi.y = v.w;
            *(u32x2*)(dst + pos) = lo; *(u32x2*)(dst + pos + 8) = hi;
        }
        __syncthreads();
    }
}

DI void ph_ssd_chunk(LAS unsigned char* lds, const MP& p) {
    const int tix = tid_opaque();
    const int w = tix >> 6, lane = tix & 63, r = lane & 31, hh = lane >> 5, pt = w >> 2, lt = w & 3;
    LAS bf16_t* S_base = (LAS bf16_t*)lds;
    LAS float* acs_all = (LAS float*)(lds + 2 * 64 * 136 * 2);
    LAS float* dts_all = acs_all + 2048;
    LAS float* wl_all = dts_all + 2048;
    const bf16_t* xT = (const bf16_t*)p.xbc; const bf16_t* BT = xT + (size_t)NB * 2048 * 2048; const bf16_t* bcr = BT + (size_t)NB * 512 * 2048;
    const float L2E = 1.4426950408889634f;
    for (int unit = blockIdx.x; unit < NB * 32; unit += gridDim.x) {
        const int b = unit >> 5, h = unit & 31, g = h >> 3;
        const float a = -__expf(p.a_log[h]), dbias = p.dt_bias[h], dskip = p.ssm_d[h];
        f32x16 S;
#pragma unroll
        for (int i = 0; i < 16; ++i) S[i] = 0.f;
        __syncthreads();
#pragma unroll
        for (int cc = 0; cc < 2; ++cc) {
            const int c = 2 * w + cc; const long t0 = (long)b * SEQ + c * 128;
            const float d0 = softplusf_(ldh(p.hbuf, (t0 + 2 * lane) * AB_IN + AB_DT + h) + dbias), d1 = softplusf_(ldh(p.hbuf, (t0 + 2 * lane + 1) * AB_IN + AB_DT + h) + dbias);
            const float a0 = d0 * a, a1 = d1 * a;
            float run = a0 + a1;
#pragma unroll
            for (int o = 1; o < 64; o <<= 1) { const float v = __shfl_up(run, o); if (lane >= o) run += v; }
            const float tot = __shfl(run, 63);
            const float cs1 = run, cs0 = run - a1;
            acs_all[c * 128 + 2 * lane] = cs0; acs_all[c * 128 + 2 * lane + 1] = cs1; dts_all[c * 128 + 2 * lane] = d0; dts_all[c * 128 + 2 * lane + 1] = d1;
            wl_all[c * 128 + 2 * lane] = d0 * __expf(tot - cs0); wl_all[c * 128 + 2 * lane + 1] = d1 * __expf(tot - cs1);
        }
        for (int c = 0; c < 16; ++c) {
            const long t0 = (long)b * SEQ + c * 128;
            LAS bf16_t* S_lds = S_base + (c & 1) * (64 * 136);
            const LAS float* acs = acs_all + c * 128; const LAS float* dts = dts_all + c * 128; const LAS float* wl = wl_all + c * 128;
#pragma unroll
            for (int i = 0; i < 16; ++i) S_lds[(32 * pt + (i & 3) + 8 * (i >> 2) + 4 * hh) * 136 + 32 * lt + r] = f2bf(S[i]);
            __syncthreads();
            const float acl = acs[32 * lt + r];
            bf16x8 cf[8], xs[8], bs[8];
            u32x2 zv[4];
            {
                const bf16_t* cp = bcr + lnd((size_t)(t0 + 32 * lt + r) * 1024 + 512 + g * 128 + 8 * hh);
                const bf16_t* xsp = xT + lnd(((size_t)b * 2048 + h * 64 + 32 * pt + r) * 2048 + c * 128 + 8 * hh);
                const bf16_t* bsp = BT + lnd(((size_t)b * 512 + g * 128 + 32 * lt + r) * 2048 + c * 128 + 8 * hh);
                const bf16_t* zp = p.hbuf + lnd((size_t)(t0 + 32 * lt + r) * AB_IN + AB_Z + h * 64 + 32 * pt + 4 * hh);
#pragma unroll
                for (int st = 0; st < 8; ++st) cf[st] = ld8(cp + 16 * st);
#pragma unroll
                for (int st = 0; st < 8; ++st) { xs[st] = ld8(xsp + 16 * st); bs[st] = ld8(bsp + 16 * st); }
#pragma unroll
                for (int i4 = 0; i4 < 4; ++i4) zv[i4] = *(const u32x2*)(zp + 8 * i4);
            }
            bf16x8 sl[8];
#pragma unroll
            for (int st = 0; st < 8; ++st) sl[st] = *(const LAS bf16x8*)(S_lds + (32 * pt + r) * 136 + 16 * st + 8 * hh);
            __builtin_amdgcn_sched_barrier(0);
            f32x16 Y;
#pragma unroll
            for (int i = 0; i < 16; ++i) Y[i] = 0.f;
#pragma unroll
            for (int st = 0; st < 8; ++st) Y = MFMA32(sl[st], cf[st], Y);
            { const float ea = __expf(acl);
#pragma unroll
              for (int i = 0; i < 16; ++i) Y[i] *= ea; }
            for (int stile = 0; stile <= lt; ++stile) {
                const bf16_t* bp = bcr + lnd((size_t)(t0 + 32 * stile + r) * 1024 + g * 128 + 8 * hh);
                const bf16_t* xp = xT + lnd(((size_t)b * 2048 + h * 64 + 32 * pt + r) * 2048 + c * 128 + 32 * stile + 8 * hh);
                bf16x8 bf[8];
#pragma unroll
                for (int st = 0; st < 8; ++st) bf[st] = ld8(bp + 16 * st);
                const bf16x8 xa = ld8(xp), xb2 = ld8(xp + 16);
                __builtin_amdgcn_sched_barrier(0);
                f32x16 G;
#pragma unroll
                for (int i = 0; i < 16; ++i) G[i] = 0.f;
#pragma unroll
                for (int st = 0; st < 8; ++st) G = MFMA32(bf[st], cf[st], G);
#pragma unroll
                for (int i = 0; i < 16; ++i) {
                    const int sl2 = 32 * stile + (i & 3) + 8 * (i >> 2) + 4 * hh, ll = 32 * lt + r;
                    float v = G[i] * __builtin_amdgcn_exp2f((acl - acs[sl2]) * L2E) * dts[sl2];
                    v = (sl2 <= ll) ? v : 0.f;
                    if (sl2 == ll) v += dskip;
                    G[i] = v;
                }
                const bf16x8 pg0 = pack8(G[0], G[1], G[2], G[3], G[4], G[5], G[6], G[7]);
                const bf16x8 pg1 = pack8(G[8], G[9], G[10], G[11], G[12], G[13], G[14], G[15]);
                Y = MFMA32(xa, pg0, Y); Y = MFMA32(xb2, pg1, Y);
            }
            {
                bf16_t* op = (bf16_t*)p.mix + (t0 + 32 * lt + r) * 4096 + h * 64 + 32 * pt + 4 * hh;
#pragma unroll
                for (int i4 = 0; i4 < 4; ++i4) {
                    u32x2 o; o.x = pk_bf16(Y[4 * i4] * siluf_(bflo(zv[i4].x)), Y[4 * i4 + 1] * siluf_(bfhi(zv[i4].x))); o.y = pk_bf16(Y[4 * i4 + 2] * siluf_(bflo(zv[i4].y)), Y[4 * i4 + 3] * siluf_(bfhi(zv[i4].y)));
                    *(u32x2*)(op + 8 * i4) = o;
                }
            }
            {
                f32x16 Sn;
#pragma unroll
                for (int i = 0; i < 16; ++i) Sn[i] = 0.f;
#pragma unroll
                for (int st = 0; st < 8; ++st) {
                    const bf16x8 xf = xs[st];
                    const f32x4 w0 = *(const LAS f32x4*)(wl + 16 * st + 4 * hh), w1 = *(const LAS f32x4*)(wl + 16 * st + 8 + 4 * hh);
                    const bf16x8 xw = pack8(bf2f((bf16_t)xf[0]) * w0[0], bf2f((bf16_t)xf[1]) * w0[1], bf2f((bf16_t)xf[2]) * w0[2], bf2f((bf16_t)xf[3]) * w0[3],
                                            bf2f((bf16_t)xf[4]) * w1[0], bf2f((bf16_t)xf[5]) * w1[1], bf2f((bf16_t)xf[6]) * w1[2], bf2f((bf16_t)xf[7]) * w1[3]);
                    Sn = MFMA32(xw, bs[st], Sn);
                }
                const float ed = __expf(acs[127]);
#pragma unroll
                for (int i = 0; i < 16; ++i) S[i] = S[i] * ed + Sn[i];
            }
        }
    }
    __syncthreads();
}

DI void ph_hgrn_chunk(LAS unsigned char* lds, const MP& p) {
    if (blockIdx.x >= NB * 16) return;
    const int tix = tid_opaque();
    const int w = tix >> 6, lane = tix & 63, r = lane & 31, hh = lane >> 5;
    LAS bf16_t* qt_l = (LAS bf16_t*)lds;
    LAS bf16_t* kt_l = qt_l + 64 * 136;
    LAS bf16_t* kendT = kt_l + 64 * 136;
    LAS bf16_t* S_l = kendT + 128 * 72;
    LAS float* bl = (LAS float*)(S_l + 2 * 128 * 136);
    LAS float* tot = bl + 128;
    const int b = blockIdx.x >> 4, h = blockIdx.x & 15;
    const bf16_t* viT = (const bf16_t*)p.bufB;
    const int d = tix & 127, tq = tix >> 7;
    const float lb = 1.f / (1.f + expf(p.lb_logits[h * 128 + d] - p.lb_logits[2048 + h * 128 + d]));
    const int vt = w >> 1, tt = w & 1;
    f32x16 S0, S1;
#pragma unroll
    for (int i = 0; i < 16; ++i) { S0[i] = 0.f; S1[i] = 0.f; }
    for (int i = tix; i < 128 * 136 / 2; i += NTHR) ((LAS unsigned*)S_l)[i] = 0u;
    bf16_t rawq[16], rawf[16];
#pragma unroll
    for (int i = 0; i < 16; ++i) { const size_t t = (size_t)b * SEQ + 16 * tq + i; rawq[i] = p.hbuf[t * CD_IN + CD_HQ + h * 128 + d]; rawf[i] = p.hbuf[t * CD_IN + CD_HF + h * 128 + d]; }
    for (int c = 0; c < 32; ++c) {
        const long t0 = (long)b * SEQ + c * 64;
        bf16x8 vfr[4];
        { const bf16_t* vp = viT + lnd(((size_t)(b * 16 + h) * 128 + 32 * vt + r) * 2048 + c * 64 + 8 * hh);
#pragma unroll
          for (int ks = 0; ks < 4; ++ks) vfr[ks] = ld8(vp + 16 * ks); }
        {
            float qv[16], kv[16], bq[16]; float cum = 0.f;
#pragma unroll
            for (int i = 0; i < 16; ++i) {
                const float hq = bf2f(rawq[i]), hf = bf2f(rawf[i]);
                const float sg = sigmoidf_(hf);
                cum += __logf(lb + (1.f - lb) * sg);
                bq[i] = cum; kv[i] = (1.f - lb) * (1.f - sg); qv[i] = siluf_(hq);
            }
            tot[tq * 128 + d] = cum;
            if (c + 1 < 32) {
#pragma unroll
                for (int i = 0; i < 16; ++i) { const size_t t = (size_t)t0 + 64 + 16 * tq + i; rawq[i] = p.hbuf[t * CD_IN + CD_HQ + h * 128 + d]; rawf[i] = p.hbuf[t * CD_IN + CD_HF + h * 128 + d]; }
            }
            __syncthreads();
            float off = 0.f, blast = 0.f;
#pragma unroll
            for (int q2 = 0; q2 < 4; ++q2) { const float tv = tot[q2 * 128 + d]; blast += tv; if (q2 < tq) off += tv; }
#pragma unroll
            for (int i = 0; i < 16; ++i) {
                const int tl = 16 * tq + i;
                const float bb = off + bq[i];
                qt_l[tl * 136 + d] = f2bf(qv[i] * __expf(bb));
                kt_l[tl * 136 + d] = f2bf(kv[i] * __expf(-bb));
                kendT[d * 72 + ((tl & ~12) | ((tl & 4) << 1) | ((tl & 8) >> 1))] = f2bf(kv[i] * __expf(blast - bb));
            }
            if (tq == 0) bl[d] = __expf(blast);
        }
        __syncthreads();
        const LAS bf16_t* Scur = S_l + (c & 1) * (128 * 136);
        LAS bf16_t* Snxt = S_l + ((c + 1) & 1) * (128 * 136);
        {
            bf16x8 qf[8], sf[8];
#pragma unroll
            for (int st = 0; st < 8; ++st) { qf[st] = *(const LAS bf16x8*)(qt_l + (32 * tt + r) * 136 + 16 * st + 8 * hh); sf[st] = *(const LAS bf16x8*)(Scur + (32 * vt + r) * 136 + 16 * st + 8 * hh); }
            __builtin_amdgcn_sched_barrier(0);
            f32x16 O;
#pragma unroll
            for (int i = 0; i < 16; ++i) O[i] = 0.f;
#pragma unroll
            for (int st = 0; st < 8; ++st) O = MFMA32(sf[st], qf[st], O);
            for (int stile = 0; stile <= tt; ++stile) {
                bf16x8 kf[8];
#pragma unroll
                for (int st = 0; st < 8; ++st) kf[st] = *(const LAS bf16x8*)(kt_l + (32 * stile + r) * 136 + 16 * st + 8 * hh);
                __builtin_amdgcn_sched_barrier(0);
                f32x16 AT;
#pragma unroll
                for (int i = 0; i < 16; ++i) AT[i] = 0.f;
#pragma unroll
                for (int st = 0; st < 8; ++st) AT = MFMA32(kf[st], qf[st], AT);
                if (stile == tt) {
#pragma unroll
                    for (int i = 0; i < 16; ++i) if (((i & 3) + 8 * (i >> 2) + 4 * hh) > r) AT[i] = 0.f;
                }
                const bf16x8 pa0 = pack8(AT[0], AT[1], AT[2], AT[3], AT[4], AT[5], AT[6], AT[7]);
                const bf16x8 pa1 = pack8(AT[8], AT[9], AT[10], AT[11], AT[12], AT[13], AT[14], AT[15]);
                if (stile == 0) { O = MFMA32(vfr[0], pa0, O); O = MFMA32(vfr[1], pa1, O); }
                else            { O = MFMA32(vfr[2], pa0, O); O = MFMA32(vfr[3], pa1, O); }
            }
            float* op = p.x3 + (t0 + 32 * tt + r) * 2048 + h * 128 + 32 * vt + 4 * hh;
#pragma unroll
            for (int i4 = 0; i4 < 4; ++i4) { f32x4 o; o[0] = O[4 * i4]; o[1] = O[4 * i4 + 1]; o[2] = O[4 * i4 + 2]; o[3] = O[4 * i4 + 3]; *(f32x4*)(op + 8 * i4) = o; }
        }
        {
            bf16x8 ke0[4], ke1[4];
#pragma unroll
            for (int ks = 0; ks < 4; ++ks) { ke0[ks] = *(const LAS bf16x8*)(kendT + (64 * tt + r) * 72 + 16 * ks + 8 * hh); ke1[ks] = *(const LAS bf16x8*)(kendT + (64 * tt + 32 + r) * 72 + 16 * ks + 8 * hh); }
            __builtin_amdgcn_sched_barrier(0);
            f32x16 N0, N1;
#pragma unroll
            for (int i = 0; i < 16; ++i) { N0[i] = 0.f; N1[i] = 0.f; }
#pragma unroll
            for (int ks = 0; ks < 4; ++ks) { N0 = MFMA32(vfr[ks], ke0[ks], N0); N1 = MFMA32(vfr[ks], ke1[ks], N1); }
            const float e0 = bl[64 * tt + r], e1 = bl[64 * tt + 32 + r];
#pragma unroll
            for (int i = 0; i < 16; ++i) { S0[i] = S0[i] * e0 + N0[i]; S1[i] = S1[i] * e1 + N1[i]; }
#pragma unroll
            for (int i = 0; i < 16; ++i) { const int v = 32 * vt + (i & 3) + 8 * (i >> 2) + 4 * hh; Snxt[v * 136 + 64 * tt + r] = f2bf(S0[i]); Snxt[v * 136 + 64 * tt + 32 + r] = f2bf(S1[i]); }
        }
        __syncthreads();
    }
}

DI gm::DenseProb mk_dense(const bf16_t* A, unsigned lda, const bf16_t* Bt, unsigned ldb, int M, int Npad, int K) {
    gm::DenseProb d; d.A = (const char*)A; d.Bt = (const char*)Bt; d.lda = lda; d.ldb = ldb; d.K = K; d.nM = M / 256; d.nN = Npad / 256; d.G = (int)gridDim.x; d.c = (int)blockIdx.x; return d;
}
DI void ph_gemm_bf16(LAS unsigned char* lds, const bf16_t* A, unsigned lda, const bf16_t* Bt, int M, int N, int Npad, int K, bf16_t* C, long ldc) {
    gm::EpiBf16 e; e.C = C; e.ldc = ldc; e.N = N; gm::gemm_phase(lds, mk_dense(A, lda, Bt, (unsigned)K, M, Npad, K), e);
}
DI void ph_gemm_f32(LAS unsigned char* lds, const bf16_t* A, unsigned lda, const bf16_t* Bt, int M, int N, int Npad, int K, float* C, long ldc) {
    gm::EpiF32 e; e.C = C; e.ldc = ldc; e.N = N; gm::gemm_phase(lds, mk_dense(A, lda, Bt, (unsigned)K, M, Npad, K), e);
}
DI int moe_tile_table(LAS unsigned char* lds, const MP& p) {
    const int tix = tid_opaque();
    LAS i32x2* ttab = (LAS i32x2*)(lds + LDS_TAB_OFF);
    const int nt = *p.ntiles;
    for (int i = tix; i < nt && i < 768; i += NTHR) { const int4 t = *(const int4*)(p.tiles + i * 4); i32x2 r; r.x = (t.x & 0xff) | (((t.z - 1) & 0xff) << 8) | (t.w << 16); r.y = t.y; ttab[i] = r; }
    __syncthreads();
    return nt < 768 ? nt : 768;
}
DI void ph_moe_gemm1(LAS unsigned char* lds, const MP& p) {
    const int nt = moe_tile_table(lds, p);
    gm::MoeG1Prob q; q.A = (const char*)p.xb; q.WgT = (const char*)p.WgT; q.WuT = (const char*)p.WuT; q.lda = DM; q.ldb = DM; q.K = DM; q.G = (int)gridDim.x; q.c = (int)blockIdx.x;
    q.ttab = (const LAS i32x2*)(lds + LDS_TAB_OFF); q.ntl = nt; q.row_tok = p.row_tok;
    gm::EpiSwiglu e; e.H = p.H; e.ttab = q.ttab;
    gm::gemm_phase(lds, q, e);
}
DI void ph_moe_gemm2(LAS unsigned char* lds, const MP& p) {
    const int nt = moe_tile_table(lds, p);
    gm::MoeG2Prob q; q.A = (const char*)p.H; q.WdT = (const char*)p.WdT; q.lda = 512; q.ldb = 512; q.K = 512; q.G = (int)gridDim.x; q.c = (int)blockIdx.x; q.ttab = (const LAS i32x2*)(lds + LDS_TAB_OFF); q.ntl = nt;
    gm::EpiMoeDown e; e.Y = p.Y; e.ttab = q.ttab;
    gm::gemm_phase(lds, q, e);
}

#ifndef PROBE_SEL
#define PROBE_SEL 0
#endif
#define RG(...) { __VA_ARGS__; if (PROBE_SEL == 1) { __VA_ARGS__; } }
#define RA(...) { __VA_ARGS__; if (PROBE_SEL == 2) { __VA_ARGS__; } }
#define RM(...) { __VA_ARGS__; if (PROBE_SEL == 3) { __VA_ARGS__; } }
#define RC(...) { __VA_ARGS__; if (PROBE_SEL == 4) { __VA_ARGS__; } }
__global__ __launch_bounds__(512, 2) void mega_fwd(MP p) {
    extern __shared__ __attribute__((aligned(16))) unsigned char shm[];
    LAS unsigned char* lds = (LAS unsigned char*)shm;
    volatile LAS unsigned* xbw = (volatile LAS unsigned*)(lds + LDS_BAR_OFF);
    if (threadIdx.x == 0) { xbw[0] = 0u; xbw[1] = 0u; xbw[2] = 0u; xbw[3] = 0u; }
    __syncthreads();
    (void)xcd_barrier_post(p.bar, xbw);
#define SYNC() do { XcdBarrier b_; b_.bar = p.bar; b_.x = xb_xcc_id(); b_.st = (volatile LAS unsigned*)(lds + LDS_BAR_OFF); xcd_barrier(b_); } while (0)
    RC(ph_cvt_wT(lds, p.ab_w_in, p.WinABt, DM, AB_IN, 8960, 1, (int)blockIdx.x, (int)gridDim.x);)
    RC(ph_cvt_x(p);)
    RC(ph_cmp_bias(p);)
    RC(ph_build_wr(p);)
    SYNC();
    { const int NG = (int)gridDim.x >= 256 ? CVQ_NG : (int)gridDim.x;
      if ((int)blockIdx.x < NG) { gm::EpiAB e; e.C = p.hbuf; e.vselT = p.vselT; e.vwinT = p.vwinT; e.ksf = p.ksf; e.kwf = p.kwf; gm::DenseProb d = mk_dense(p.xb, DM, p.WinABt, DM, T_TOK, 8960, DM); d.G = NG; d.c = (int)blockIdx.x; gm::gemm_phase(lds, d, e); }
      moe_cvt_queue(lds, p, 0, p.bar + XCD_BAR_WORDS); }
    SYNC();
    RG({ gm::CmpProb q; q.hb = (const char*)p.hbuf; q.Wt = (const char*)p.WcmpT; q.ldb = 4096; q.K = 4096; q.G = (int)gridDim.x; q.c = (int)blockIdx.x; gm::EpiCmp e; e.kc = p.kcb; e.vcT = p.vcT; e.cpart = p.cpart; gm::gemm_phase(lds, q, e); })
    RM(ph_conv_ssd(lds, p);)
    SYNC();
    RA(ph_ssd_chunk(lds, p);)
    RA(ph_nsa_attn(lds, p);)
    SYNC();
    RM(ph_ssd_norm(p);)
    SYNC();
    RG(ph_gemm_bf16(lds, p.mixb, 4096, p.WoutABt, T_TOK, DM, DM, 4096, (bf16_t*)p.bufA, DM);)
    SYNC();
    RM(ph_ln<false>(p, p.x, (const bf16_t*)p.bufA, p.ln_g, p.ln_b, p.xb, p.mixb);)
    SYNC();
    RG(ph_router_gemm(lds, p, 0, (float*)(p.mixb + (size_t)T_TOK * DM), p.mixb);)
    SYNC();
    RM(ph_route_select(p, (const float*)(p.mixb + (size_t)T_TOK * DM), p.router_bias);)
    SYNC();
    RM(ph_moe_scan(lds, p);)
    SYNC();
    RG(ph_moe_gemm1(lds, p);)
    SYNC();
    RG(ph_moe_gemm2(lds, p);)
    SYNC();
    RM(ph_moe_combine_ln(p, p.xb, p.mixb, p.ln_g + DM, p.ln_b + DM, (float*)nullptr, p.xb);)
    SYNC();
    { const int NG = (int)gridDim.x >= 256 ? CVQ_NG : (int)gridDim.x;
      if ((int)blockIdx.x < NG) { gm::EpiCD e; e.C = p.hbuf; e.viT = (bf16_t*)p.bufB; gm::DenseProb d = mk_dense(p.xb, DM, p.WinCDt, DM, T_TOK, 9472, DM); d.G = NG; d.c = (int)blockIdx.x; gm::gemm_phase(lds, d, e); }
      moe_cvt_queue(lds, p, 1, p.bar + XCD_BAR_WORDS + 32); }
    SYNC();
    RM(ph_mla_rms(p);)
    RM(ph_rope_k(p);)
    SYNC();
    if (gridDim.x >= 256) {
        if (blockIdx.x < 128) { RA(ph_hgrn_chunk(lds, p);) }
        else {
            const int G2 = (int)gridDim.x - 128, c2 = (int)blockIdx.x - 128;
            { gm::DenseProb d = mk_dense(p.cqb, 1024, p.Wuqt, 512, T_TOK, 3072, 512); d.G = G2; d.c = c2; gm::EpiBf16 e; e.C = (bf16_t*)p.xbc; e.ldc = 3072; e.N = 3072; RG(gm::gemm_phase(lds, d, e);) }
            { gm::DenseProb d = mk_dense(p.cqb + 512, 1024, p.Wukvt, 512, T_TOK, 4096, 512); d.G = G2; d.c = c2; gm::EpiKV e; e.kf = (bf16_t*)p.kvfrag; e.vf = (bf16_t*)p.kvfrag + (size_t)T_TOK * 2048; RG(gm::gemm_phase(lds, d, e);) }
        }
    } else {
        RA(ph_hgrn_chunk(lds, p);)
        SYNC();
        RG(ph_gemm_bf16(lds, p.cqb, 1024, p.Wuqt, T_TOK, 3072, 3072, 512, (bf16_t*)p.xbc, 3072);)
        RG({ gm::EpiKV e; e.kf = (bf16_t*)p.kvfrag; e.vf = (bf16_t*)p.kvfrag + (size_t)T_TOK * 2048; gm::gemm_phase(lds, mk_dense(p.cqb + 512, 1024, p.Wukvt, 512, T_TOK, 4096, 512), e); })
    }
    SYNC();
    RA(ph_mla_attn(lds, p);)
    RM(ph_hgrn_post(p);)
    SYNC();
    RG(ph_gemm_bf16(lds, p.mixb, 4096, p.WoutCDt, T_TOK, DM, DM, 4096, (bf16_t*)p.bufB, DM);)
    SYNC();
    RM(ph_ln<true>(p, p.xb, (const bf16_t*)p.bufB, p.ln_g + 2 * DM, p.ln_b + 2 * DM, p.xb, p.mixb);)
    SYNC();
    RG(ph_router_gemm(lds, p, 1, (float*)(p.mixb + (size_t)T_TOK * DM), p.mixb);)
    SYNC();
    RM(ph_route_select(p, (const float*)(p.mixb + (size_t)T_TOK * DM), p.router_bias + 64);)
    SYNC();
    RM(ph_moe_scan(lds, p);)
    SYNC();
    RG(ph_moe_gemm1(lds, p);)
    SYNC();
    RG(ph_moe_gemm2(lds, p);)
    SYNC();
    RM(ph_moe_combine_ln(p, p.xb, p.mixb, p.ln_g + 3 * DM, p.ln_b + 3 * DM, p.out, (bf16_t*)nullptr);)
    if (xb_ld(&p.bar[XB_TMO]) != 0u) { SYNC(); for (long i = (long)blockIdx.x * NTHR + threadIdx.x; i < (long)T_TOK * DM; i += (long)gridDim.x * NTHR) p.out[i] = __uint_as_float(0x7fc00000u); }
#undef SYNC
}

extern "C" void kernel_launch(void* const* d_in, const int* in_sizes, int n_in, void* d_out, int out_size, void* d_ws, size_t ws_size, hipStream_t stream) {
    static int grid = 0;
    if (!grid) {
        int dev = 0, cus = 0; (void)hipGetDevice(&dev); (void)hipDeviceGetAttribute(&cus, hipDeviceAttributeMultiprocessorCount, dev);
        (void)hipFuncSetAttribute((const void*)mega_fwd, hipFuncAttributeMaxDynamicSharedMemorySize, LDS_TOTAL);
        grid = cus > 0 ? cus : 256;
    }
    (void)in_sizes; (void)n_in; (void)out_size; (void)ws_size;
    MP p{};
    p.x = (const float*)d_in[0]; p.positions = (const int*)d_in[1]; p.ab_w_in = (const float*)d_in[2]; p.conv_w = (const float*)d_in[3]; p.conv_b = (const float*)d_in[4];
    p.dt_bias = (const float*)d_in[5]; p.a_log = (const float*)d_in[6]; p.ssm_d = (const float*)d_in[7]; p.ssm_norm_w = (const float*)d_in[8]; p.cmp_pos = (const float*)d_in[9];
    p.cmp_w = (const float*)d_in[10]; p.ab_w_out = (const float*)d_in[11]; p.cd_w_in = (const float*)d_in[12]; p.q_norm_w = (const float*)d_in[13]; p.w_uq = (const float*)d_in[14];
    p.kv_norm_w = (const float*)d_in[15]; p.w_ukv = (const float*)d_in[16]; p.lb_logits = (const float*)d_in[17]; p.hgrn_norm_w = (const float*)d_in[18]; p.cd_w_out = (const float*)d_in[19];
    p.ln_g = (const float*)d_in[20]; p.ln_b = (const float*)d_in[21]; p.w_router = (const float*)d_in[22]; p.router_bias = (const float*)d_in[23]; p.w_gate = (const float*)d_in[24];
    p.w_up = (const float*)d_in[25]; p.w_down = (const float*)d_in[26]; p.sg = (const float*)d_in[27]; p.su = (const float*)d_in[28]; p.sd = (const float*)d_in[29];
    p.out = (float*)d_out;
    char* wp = (char*)d_ws;
    auto carve = [&](size_t bytes) { char* q = wp; wp += (bytes + 255) & ~(size_t)255; return q; };
    p.bar = (unsigned*)carve((size_t)(XCD_BAR_WORDS + 64) * 4);
    p.WinABt = (bf16_t*)carve((size_t)8960 * DM * 2);
    p.WoutABt = (bf16_t*)carve((size_t)DM * 4096 * 2);
    p.WinCDt = (bf16_t*)carve((size_t)9472 * DM * 2);
    p.WoutCDt = (bf16_t*)carve((size_t)DM * 4096 * 2);
    p.Wuqt = (bf16_t*)carve((size_t)3072 * 512 * 2);
    p.Wukvt = (bf16_t*)carve((size_t)4096 * 512 * 2);
    p.WgT = (bf16_t*)carve((size_t)65 * 512 * DM * 2); p.WuT = (bf16_t*)carve((size_t)65 * 512 * DM * 2); p.WdT = (bf16_t*)carve((size_t)65 * DM * 512 * 2);
    char* big = carve((size_t)T_TOK * CD_IN * 2 + (size_t)T_TOK * 3072 * 4 + (size_t)T_TOK * 4096 * 4 + 1024);
    p.hbuf = (bf16_t*)big;
    p.xbc = (float*)(big + (((size_t)T_TOK * CD_IN * 2 + 255) & ~(size_t)255));
    p.mix = (float*)((char*)p.xbc + (size_t)T_TOK * 3072 * 4);
    p.H = (bf16_t*)big;
    p.Y = (bf16_t*)(big + (((size_t)(MOE_PMAX + T_TOK) * 512 * 2 + 255) & ~(size_t)255));
    p.kvfrag = (bf16_t*)p.mix;
    p.mixb = (bf16_t*)carve((size_t)T_TOK * 4096 * 2);
    p.bufA = (float*)carve((size_t)T_TOK * DM * 4);
    p.bufB = (float*)carve((size_t)T_TOK * DM * 4);
    p.x3 = (float*)carve((size_t)T_TOK * DM * 4);
    p.xb = (bf16_t*)carve((size_t)(T_TOK + 1) * DM * 2);
    p.cqb = (bf16_t*)carve((size_t)T_TOK * 1024 * 2);
    p.kr = (bf16_t*)carve((size_t)T_TOK * 64 * 2);
    p.rope_tab = (float*)carve((size_t)T_TOK * 32 * 8);
    p.kcb = (bf16_t*)carve((size_t)16 * 128 * 128 * 2); p.vcT = (bf16_t*)carve((size_t)16 * 128 * 128 * 2);
    p.vselT = (bf16_t*)carve((size_t)16 * 128 * 2048 * 2); p.vwinT = (bf16_t*)carve((size_t)16 * 128 * 2048 * 2); p.ksf = (bf16_t*)carve((size_t)16 * 128 * 2048 * 2); p.kwf = (bf16_t*)carve((size_t)16 * 128 * 2048 * 2);
    p.WcmpT = (bf16_t*)carve((size_t)2 * 256 * 4096 * 2); p.WrT3 = (bf16_t*)carve((size_t)2 * 256 * 4096 * 2); p.cpart = (float*)carve((size_t)2 * 128 * 128 * 4);
    p.kc = (float*)carve((size_t)NB * NCMP * 2 * 128 * 4);
    p.vc = (float*)carve((size_t)NB * NCMP * 2 * 128 * 4);
    p.top_e = (int*)carve((size_t)T_TOK * 8 * 4); p.top_w = (float*)carve((size_t)T_TOK * 8 * 4); p.lpos = (int*)carve((size_t)T_TOK * 8 * 4);
    p.cnt_tab = (int*)carve((size_t)MOE_NSLOT * 64 * 4); p.row_tok = (int*)carve((size_t)(MOE_PMAX + T_TOK) * 4); p.row_w = (float*)carve((size_t)(MOE_PMAX + T_TOK) * 4);
    p.row_slot = (int*)carve((size_t)(MOE_PMAX + T_TOK) * 4); p.tiles = (int*)carve((size_t)MOE_MAXTILES * 16); p.ntiles = (int*)carve(256);
    (void)hipMemsetAsync(p.bar, 0, (size_t)(XCD_BAR_WORDS + 64) * 4, stream);
    hipLaunchKernelGGL(mega_fwd, dim3(grid), dim3(NTHR), LDS_TOTAL, stream, p);
}
```

```cpp
#include <hip/hip_runtime.h>
#include <stdint.h>

#define DI __device__ __forceinline__

constexpr int T_TOK = 16384, DM = 2048, SEQ = 2048, NB = 8;
constexpr int AB_IN = 8784, CD_IN = 9280;
constexpr int AB_Z = 0, AB_XBC = 2048, AB_DT = 5120, AB_Q = 5152, AB_KV = 7200, AB_G = 8736;
constexpr int CD_CQ = 0, CD_CKV = 512, CD_KR = 1024, CD_HQ = 1088, CD_HF = 3136, CD_HI = 5184, CD_HG = 7232;
constexpr float DN_ALPHA = 1.41421356237309515f;
constexpr int NCMP = 127;
constexpr int MOE_TM = 256;
constexpr int MOE_SLOT_TOK = 8;
constexpr int MOE_NSLOT = T_TOK / MOE_SLOT_TOK;
constexpr int MOE_PMAX = T_TOK * 8 + 64 * MOE_TM;
constexpr int MOE_MAXTILES = MOE_PMAX / MOE_TM + T_TOK / MOE_TM;
constexpr int LDH_AB = AB_IN, LDH_CD = CD_IN;

typedef unsigned short bf16_t;
DI float ldh(const bf16_t* p, long i) { return __uint_as_float(((unsigned)p[i]) << 16); }
DI bf16_t f2bf(float f) { unsigned u = __float_as_uint(f); u += 0x7fffu + ((u >> 16) & 1u); return (bf16_t)(u >> 16); }
DI int tid_opaque() { int t = (int)threadIdx.x; asm volatile("" : "+v"(t)); return t; }
DI float sigmoidf_(float x) { return 1.f / (1.f + __expf(-x)); }
DI float siluf_(float x) { return x / (1.f + __expf(-x)); }
DI float softplusf_(float x) { return x > 20.f ? x : log1pf(__expf(x)); }
#define LAS __attribute__((address_space(3)))
typedef unsigned short bf16_t;
typedef short bf16x8 __attribute__((ext_vector_type(8)));
typedef float f32x4 __attribute__((ext_vector_type(4)));
typedef unsigned u32x2 __attribute__((ext_vector_type(2)));
typedef unsigned u32x4 __attribute__((ext_vector_type(4)));
typedef int i32x2 __attribute__((ext_vector_type(2)));

typedef float f32x2_t __attribute__((ext_vector_type(2)));
typedef __bf16 bf16x2_t __attribute__((ext_vector_type(2)));
DI unsigned pk_bf16(float lo, float hi) { const f32x2_t v = {lo, hi}; const bf16x2_t r = __builtin_convertvector(v, bf16x2_t); return __builtin_bit_cast(unsigned, r); }
DI float bf2f(bf16_t b) { return __uint_as_float(((unsigned)b) << 16); }
DI float bflo(unsigned u) { return __uint_as_float(u << 16); }
DI float bfhi(unsigned u) { return __uint_as_float(u & 0xffff0000u); }

namespace gm {
constexpr int BM = 256, BK = 64, HALF = 128, HTB = HALF * BK * 2, STAGE_BYTES = 8 * HTB, NXCD = 8, WGM = 8;
DI int lds_byte(int r, int c) { const int st = (r >> 4) * 2 + (c >> 5), rr = r & 15, cc = c & 31, ob = rr * 64 + cc * 2; return st * 1024 + (ob ^ (((ob >> 9) & 1) << 5)); }
DI void stage_rc(int b, int& R, int& C) { const int st = b / 1024, sb = b % 1024, swz = sb ^ (((sb >> 9) & 1) << 5); R = (st >> 1) * 16 + swz / 64; C = (st & 1) * 32 + (swz % 64) / 2; }

struct Unit { int p, q; };

DI bool static_order(int i, int G, int c, int nM, int nN, Unit& u) {
    const int nwg = nM * nN;
    const long L = (long)i * G + c; if (L >= nwg) return false;
    int wgid = (int)L; { const int q = nwg / NXCD, r = nwg % NXCD, xcd = wgid % NXCD, off = wgid / NXCD; wgid = (xcd < r ? xcd * (q + 1) : r * (q + 1) + (xcd - r) * q) + off; }
    const int nig = WGM * nN, gid = wgid / nig, fm = gid * WGM, gsz = (nM - fm) < WGM ? (nM - fm) : WGM;
    u.p = fm + ((wgid % nig) % gsz); u.q = (wgid % nig) / gsz; return true;
}

struct DenseProb {
    const char* A; const char* Bt; unsigned lda, ldb;
    int K, nM, nN, G, c;
    struct AState { const char* base; };
    DI bool next(int i, Unit& u) const { return static_order(i, G, c, nM, nN, u); }
    DI void a_state(const Unit& u, int R0, int C, AState& s) const { s.base = A + (size_t)u.p * 256 * lda * 2; }
    DI const char* a_addr(const AState& s, int h, int i, int R0, int C, size_t koff) const { return s.base + koff + (size_t)h * 128 * lda * 2 + (size_t)((unsigned)(R0 + 64 * i) * lda + (unsigned)C) * 2u; }
    static DI AState sel(bool c, const AState& a, const AState& b) { AState r; r.base = c ? a.base : b.base; return r; }
    DI size_t koff(int kt) const { return (size_t)kt * 128; }
    DI const char* b_ptr(const Unit& u, int h) const { return Bt + ((size_t)u.q * 256 + (size_t)h * 128) * ldb * 2; }
};

DI i32x2 lds_tab_read(const LAS i32x2* q) { i32x2 r; const unsigned a = (unsigned)(size_t)q; asm volatile("ds_read_b64 %0, %1\n\ts_waitcnt lgkmcnt(0)" : "=v"(r) : "v"(a) : "memory"); return r; }
struct MoeG1Prob {
    const char* A; const char* WgT; const char* WuT; unsigned lda, ldb;
    int K, G, c;
    const LAS i32x2* ttab; int ntl; const int* row_tok;
    struct AState { unsigned off[2][2]; };
    DI bool next(int i, Unit& u) const {
        if ((G & 7) == 0) { const int x = c & 7, W = G >> 3, tpx = (ntl + 7) >> 3; const int m = i * W + (c >> 3); const int tl = m >> 2; const int tile = x * tpx + tl;
            if (tl >= tpx || tile >= ntl) return false; u.p = tile; u.q = m & 3; return true; }
        const long L = (long)i * G + c; if (L >= (long)ntl * 4) return false; u.p = (int)(L >> 2); u.q = (int)(L & 3); return true; }
    DI void a_state(const Unit& u, int R0, int C, AState& s) const {
        const int row0 = lds_tab_read(ttab + u.p).y;
#pragma unroll
        for (int h = 0; h < 2; ++h)
#pragma unroll
            for (int i = 0; i < 2; ++i) { int t = row_tok[row0 + h * 128 + R0 + 64 * i]; if (t < 0) t = T_TOK; s.off[h][i] = ((unsigned)t * lda + (unsigned)C) * 2u; }
    }
    DI const char* a_addr(const AState& s, int h, int i, int R0, int C, size_t koff) const { return A + koff + s.off[h][i]; }
    static DI AState sel(bool c, const AState& a, const AState& b) { AState r;
#pragma unroll
        for (int h = 0; h < 2; ++h)
#pragma unroll
            for (int i = 0; i < 2; ++i) r.off[h][i] = c ? a.off[h][i] : b.off[h][i];
        return r; }
    DI size_t koff(int kt) const { return (size_t)kt * 128; }
    DI const char* b_ptr(const Unit& u, int h) const { const int e = lds_tab_read(ttab + u.p).x & 0xff; return (h ? WuT : WgT) + ((size_t)e * 512 + (size_t)u.q * 128) * ldb * 2; }
};

struct MoeG2Prob {
    const char* A; const char* WdT; unsigned lda, ldb;
    int K, G, c;
    const LAS i32x2* ttab; int ntl;
    struct AState { const char* base; };
    DI bool next(int i, Unit& u) const {
        if ((G & 7) == 0) { const int x = c & 7, W = G >> 3, tpx = (ntl + 7) >> 3; const int m = i * W + (c >> 3); const int tl = m >> 3; const int tile = x * tpx + tl;
            if (tl >= tpx || tile >= ntl) return false; u.p = tile; u.q = m & 7; return true; }
        const long L = (long)i * G + c; if (L >= (long)ntl * 8) return false; u.p = (int)(L >> 3); u.q = (int)(L & 7); return true; }
    DI void a_state(const Unit& u, int R0, int C, AState& s) const { const int row0 = lds_tab_read(ttab + u.p).y; s.base = A + (size_t)row0 * lda * 2; }
    DI const char* a_addr(const AState& s, int h, int i, int R0, int C, size_t koff) const { return s.base + koff + (size_t)h * 128 * lda * 2 + (size_t)((unsigned)(R0 + 64 * i) * lda + (unsigned)C) * 2u; }
    static DI AState sel(bool c, const AState& a, const AState& b) { AState r; r.base = c ? a.base : b.base; return r; }
    DI size_t koff(int kt) const { return (size_t)kt * 128; }
    DI const char* b_ptr(const Unit& u, int h) const { const int e = lds_tab_read(ttab + u.p).x & 0xff; return WdT + ((size_t)e * 2048 + (size_t)u.q * 256 + (size_t)h * 128) * ldb * 2; }
};

struct EpiF32 {
    static constexpr bool PERM = false;
    float* C; long ldc; int N;
    DI void operator()(const f32x4 (&acc)[2][2][4][2], const Unit& u, int wr, int wc, int fr, int fq) const {
        const int row0 = u.p * 256 + wr * 64 + fr, col0 = u.q * 256 + wc * 32 + 4 * fq;
#pragma unroll
        for (int ai = 0; ai < 2; ++ai)
#pragma unroll
            for (int m = 0; m < 4; ++m) { float* rowp = C + (size_t)(row0 + ai * 128 + m * 16) * ldc;
#pragma unroll
                for (int bj = 0; bj < 2; ++bj)
#pragma unroll
                    for (int n = 0; n < 2; ++n) { const int col = col0 + bj * 128 + n * 16; if (col < N) *(f32x4*)(rowp + col) = acc[ai][bj][m][n]; } }
    }
};
struct EpiBf16 {
    static constexpr bool PERM = true;
    bf16_t* C; long ldc; int N;
    DI void operator()(const f32x4 (&acc)[2][2][4][2], const Unit& u, int wr, int wc, int fr, int fq) const {
        const int row0 = u.p * 256 + wr * 64 + fr, col0 = u.q * 256 + wc * 32 + 8 * fq;
#pragma unroll
        for (int ai = 0; ai < 2; ++ai)
#pragma unroll
            for (int m = 0; m < 4; ++m) { bf16_t* rowp = C + (size_t)(row0 + ai * 128 + m * 16) * ldc;
#pragma unroll
                for (int bj = 0; bj < 2; ++bj) { const int col = col0 + bj * 128; const f32x4 v0 = acc[ai][bj][m][0], v1 = acc[ai][bj][m][1];
                    if (col < N) { u32x4 o; o.x = pk_bf16(v0[0], v0[1]); o.y = pk_bf16(v0[2], v0[3]); o.z = pk_bf16(v1[0], v1[1]); o.w = pk_bf16(v1[2], v1[3]); *(u32x4*)(rowp + col) = o; } } }
    }
};
DI int perm16(int s) { return (s & ~12) | ((s & 4) << 1) | ((s & 8) >> 1); }
DI int perm32(int s) { return (s & ~28) | ((s & 12) << 1) | ((s & 16) >> 2); }
struct EpiKV {
    static constexpr bool PERM = true;
    bf16_t* kf; bf16_t* vf;
    DI void operator()(const f32x4 (&acc)[2][2][4][2], const Unit& u, int wr, int wc, int fr, int fq) const {
        const int row0 = u.p * 256 + wr * 64 + fr, head = u.q, c = wc * 32 + 8 * fq;
#pragma unroll
        for (int ai = 0; ai < 2; ++ai)
#pragma unroll
            for (int m = 0; m < 4; ++m) { const int t = row0 + ai * 128 + m * 16; const int b = t >> 11, s = t & 2047;
                const int kt = s >> 5, r = s & 31, s2 = (s >> 4) & 1;
                const int p16 = perm16(s & 15);
                const size_t tb = (size_t)(b * 16 + head) * 64 + kt;
                { const f32x4 v0 = acc[ai][0][m][0], v1 = acc[ai][0][m][1]; u32x4 o; o.x = pk_bf16(v0[0], v0[1]); o.y = pk_bf16(v0[2], v0[3]); o.z = pk_bf16(v1[0], v1[1]); o.w = pk_bf16(v1[2], v1[3]);
                  *(u32x4*)(kf + (tb * 8 + (c >> 4)) * 512 + (((c >> 3) & 1) * 32 + r) * 8) = o; }
                { bf16_t* vp = vf + ((tb * 4 + (c >> 5)) * 2 + s2) * 512 + ((p16 >> 3) * 32 + (c & 31)) * 8 + (p16 & 7);
#pragma unroll
                  for (int n = 0; n < 2; ++n) { const f32x4 vv = acc[ai][1][m][n];
#pragma unroll
                      for (int j = 0; j < 4; ++j) vp[(n * 4 + j) * 8] = f2bf(vv[j]); } } }
    }
};
struct CmpProb {
    const char* hb; const char* Wt;
    unsigned ldb; int K, G, c;
    struct AState { unsigned off[2][2]; };
    DI bool next(int i, Unit& u) const { const int L = i * G + c; if (L >= 16) return false; u.p = L & 7; u.q = L >> 3; return true; }
    DI void a_state(const Unit& u, int R0, int C, AState& s) const {
#pragma unroll
        for (int h = 0; h < 2; ++h)
#pragma unroll
            for (int i = 0; i < 2; ++i) { const int m = u.p * 256 + h * 128 + R0 + 64 * i; const int bg = m >> 7; int ci = m & 127; if (ci > 126) ci = 126;
                s.off[h][i] = (unsigned)(((size_t)((bg >> 1) * SEQ + 16 * ci) * AB_IN + AB_KV + u.q * 256 + (bg & 1) * 128 + C) * 2); }
    }
    DI const char* a_addr(const AState& s, int h, int i, int R0, int C, size_t koff) const { return hb + koff + s.off[h][i]; }
    static DI AState sel(bool c, const AState& a, const AState& b) { AState r;
#pragma unroll
        for (int h = 0; h < 2; ++h)
#pragma unroll
            for (int i = 0; i < 2; ++i) r.off[h][i] = c ? a.off[h][i] : b.off[h][i];
        return r; }
    DI size_t koff(int kt) const { return (size_t)(kt >> 1) * (AB_IN * 2) + (size_t)(kt & 1) * 128; }
    DI const char* b_ptr(const Unit& u, int h) const { return Wt + ((size_t)u.q * 256 + (size_t)h * 128) * ldb * 2; }
};
struct EpiCmp {
    static constexpr bool PERM = false;
    bf16_t* kc; bf16_t* vcT; const float* cpart;
    DI void operator()(const f32x4 (&acc)[2][2][4][2], const Unit& u, int wr, int wc, int fr, int fq) const {
        const int which = u.q, row0 = u.p * 256 + wr * 64 + fr, c0 = wc * 32 + 4 * fq;
        f32x4 bias[2];
#pragma unroll
        for (int n = 0; n < 2; ++n) { f32x4 a = {0.f, 0.f, 0.f, 0.f};
            for (int l = 0; l < 128; ++l) { const f32x4 v = *(const f32x4*)(cpart + ((size_t)which * 128 + l) * 128 + c0 + n * 16); a += v; }
            bias[n] = a; }
#pragma unroll
        for (int ai = 0; ai < 2; ++ai)
#pragma unroll
            for (int m = 0; m < 4; ++m) { const int mm = row0 + ai * 128 + m * 16; const int bg = mm >> 7, ci = mm & 127;
#pragma unroll
                for (int n = 0; n < 2; ++n) { const int c = c0 + n * 16; const f32x4 v = acc[ai][0][m][n] + bias[n];
                    if (which == 0) { u32x2 o; o.x = pk_bf16(v[0], v[1]); o.y = pk_bf16(v[2], v[3]); *(u32x2*)(kc + (size_t)mm * 128 + c) = o; }
                    else { bf16_t* vp = vcT + ((size_t)bg * 128 + c) * 128 + perm16(ci);
#pragma unroll
                        for (int j = 0; j < 4; ++j) vp[(size_t)j * 128] = f2bf(v[j]); } } }
    }
};
struct EpiAB {
    static constexpr bool PERM = true;
    bf16_t* C; bf16_t* vselT; bf16_t* vwinT; bf16_t* ksf; bf16_t* kwf;
    DI void operator()(const f32x4 (&acc)[2][2][4][2], const Unit& u, int wr, int wc, int fr, int fq) const {
        const int row0 = u.p * 256 + wr * 64 + fr, col0 = u.q * 256 + wc * 32 + 8 * fq;
        const bool special = (u.q >= 30);
#pragma unroll
        for (int ai = 0; ai < 2; ++ai)
#pragma unroll
            for (int m = 0; m < 4; ++m) { const int t = row0 + ai * 128 + m * 16; const int b = t >> 11, sp = t & 2047;
                bf16_t* rowp = C + (size_t)t * AB_IN;
#pragma unroll
                for (int bj = 0; bj < 2; ++bj) { const int col = col0 + bj * 128; const f32x4 v0 = acc[ai][bj][m][0], v1 = acc[ai][bj][m][1];
                    u32x4 o; o.x = pk_bf16(v0[0], v0[1]); o.y = pk_bf16(v0[2], v0[3]); o.z = pk_bf16(v1[0], v1[1]); o.w = pk_bf16(v1[2], v1[3]);
                    if (col < AB_IN) *(u32x4*)(rowp + col) = o;
                    if (special) {
                        if (col >= AB_KV + 512 && col < AB_KV + 768) { const int cc = col - (AB_KV + 512); const int bg = b * 2 + (cc >> 7), d = cc & 127;
                            *(u32x4*)(ksf + ((((size_t)bg * 128 + (sp >> 4)) * 4 + (d >> 5)) * 64 + ((d >> 3) & 3) * 16 + (sp & 15)) * 8) = o; }
                        if (col >= AB_KV + 768 && col < AB_KV + 1024) { const int cc = col - (AB_KV + 768); const int bg = b * 2 + (cc >> 7), d = cc & 127;
                            const int p32 = perm32(sp & 31);
                            bf16_t* vp = vselT + ((((size_t)bg * 64 + (sp >> 5)) * 8 + (d >> 4)) * 64 + (p32 >> 3) * 16 + (d & 15)) * 8 + (p32 & 7);
#pragma unroll
                            for (int j = 0; j < 4; ++j) { vp[j * 8] = f2bf(v0[j]); vp[(4 + j) * 8] = f2bf(v1[j]); } }
                        if (col >= AB_KV + 1024 && col < AB_KV + 1280) { const int cc = col - (AB_KV + 1024); const int bg = b * 2 + (cc >> 7), d = cc & 127;
                            *(u32x4*)(kwf + ((((size_t)bg * 64 + (sp >> 5)) * 8 + (d >> 4)) * 64 + ((d >> 3) & 1) * 32 + (sp & 31)) * 8) = o; }
                        if (col >= AB_KV + 1280 && col < AB_KV + 1536) { const int cc = col - (AB_KV + 1280); const int bg = b * 2 + (cc >> 7), d = cc & 127;
                            const int p16 = perm16(sp & 15);
                            bf16_t* vp = vwinT + (((((size_t)bg * 64 + (sp >> 5)) * 4 + (d >> 5)) * 2 + ((sp >> 4) & 1)) * 64 + (p16 >> 3) * 32 + (d & 31)) * 8 + (p16 & 7);
#pragma unroll
                            for (int j = 0; j < 4; ++j) { vp[j * 8] = f2bf(v0[j]); vp[(4 + j) * 8] = f2bf(v1[j]); } }
                    } } }
    }
};
struct EpiCD {
    static constexpr bool PERM = true;
    bf16_t* C; bf16_t* viT;
    DI void operator()(const f32x4 (&acc)[2][2][4][2], const Unit& u, int wr, int wc, int fr, int fq) const {
        const int row0 = u.p * 256 + wr * 64 + fr, col0 = u.q * 256 + wc * 32 + 8 * fq;
        const bool special = (u.q >= 20 && u.q <= 28);
#pragma unroll
        for (int ai = 0; ai < 2; ++ai)
#pragma unroll
            for (int m = 0; m < 4; ++m) { const int t = row0 + ai * 128 + m * 16; const int b = t >> 11, sp = t & 2047;
                bf16_t* rowp = C + (size_t)t * CD_IN;
#pragma unroll
                for (int bj = 0; bj < 2; ++bj) { const int col = col0 + bj * 128; const f32x4 v0 = acc[ai][bj][m][0], v1 = acc[ai][bj][m][1];
                    if (col < CD_IN) { u32x4 o; o.x = pk_bf16(v0[0], v0[1]); o.y = pk_bf16(v0[2], v0[3]); o.z = pk_bf16(v1[0], v1[1]); o.w = pk_bf16(v1[2], v1[3]); *(u32x4*)(rowp + col) = o; }
                    if (special && col >= CD_HI && col < CD_HI + 2048) { const int cc = col - CD_HI;
                        bf16_t* vp = viT + ((size_t)(b * 16 + (cc >> 7)) * 128 + (cc & 127)) * 2048 + perm16(sp);
#pragma unroll
                        for (int j = 0; j < 4; ++j) { vp[(size_t)j * 2048] = f2bf(v0[j]); vp[(size_t)(4 + j) * 2048] = f2bf(v1[j]); } } } }
    }
};
struct RouterProb {
    const char* xhi; long dlo; const char* Bt;
    int K, G, c;
    struct AState { const char* base; };
    DI bool next(int i, Unit& u) const { const int L = i * G + c; if (L >= 256) return false; u.p = L >> 2; u.q = L & 3; return true; }
    DI void a_state(const Unit& u, int R0, int C, AState& s) const { s.base = xhi + (long)((u.q >> 1) & 1) * dlo + (size_t)u.p * 256 * 4096 + (size_t)(u.q & 1) * 2048; }
    DI const char* a_addr(const AState& s, int h, int i, int R0, int C, size_t koff) const { return s.base + koff + (size_t)h * 128 * 4096 + (size_t)((unsigned)(R0 + 64 * i) * 2048u + (unsigned)C) * 2u; }
    static DI AState sel(bool c, const AState& a, const AState& b) { AState r; r.base = c ? a.base : b.base; return r; }
    DI size_t koff(int kt) const { return (size_t)kt * 128; }
    DI const char* b_ptr(const Unit& u, int h) const { return Bt + ((size_t)h * 128 * 4096 + (size_t)u.q * 1024) * 2; }
    unsigned ldb;
};
struct EpiRouter {
    static constexpr bool PERM = false;
    float* Cpart;
    DI void operator()(const f32x4 (&acc)[2][2][4][2], const Unit& u, int wr, int wc, int fr, int fq) const {
        const int row0 = u.p * 256 + wr * 64 + fr, col0 = wc * 32 + 4 * fq;
#pragma unroll
        for (int ai = 0; ai < 2; ++ai)
#pragma unroll
            for (int m = 0; m < 4; ++m) { float* rowp = Cpart + ((size_t)u.q * T_TOK + (size_t)(row0 + ai * 128 + m * 16)) * 128 + col0;
#pragma unroll
                for (int n = 0; n < 2; ++n) *(f32x4*)(rowp + n * 16) = acc[ai][0][m][n]; }
    }
};
struct EpiSwiglu {
    static constexpr bool PERM = true;
    bf16_t* H; const LAS i32x2* ttab;
    DI void operator()(const f32x4 (&acc)[2][2][4][2], const Unit& u, int wr, int wc, int fr, int fq) const {
        const int row0 = lds_tab_read(ttab + u.p).y + wr * 64 + fr, col0 = u.q * 128 + wc * 32 + 8 * fq;
#pragma unroll
        for (int ai = 0; ai < 2; ++ai)
#pragma unroll
            for (int m = 0; m < 4; ++m) { bf16_t* rowp = H + (size_t)(row0 + ai * 128 + m * 16) * 512 + col0;
                float hv[8];
#pragma unroll
                for (int n = 0; n < 2; ++n) { const f32x4 g = acc[ai][0][m][n], up = acc[ai][1][m][n];
#pragma unroll
                    for (int j = 0; j < 4; ++j) hv[n * 4 + j] = g[j] / (1.f + __expf(-g[j])) * up[j]; }
                u32x4 o; o.x = pk_bf16(hv[0], hv[1]); o.y = pk_bf16(hv[2], hv[3]); o.z = pk_bf16(hv[4], hv[5]); o.w = pk_bf16(hv[6], hv[7]); *(u32x4*)rowp = o; }
    }
};
struct EpiMoeDown {
    static constexpr bool PERM = true;
    bf16_t* Y; const LAS i32x2* ttab;
    DI void operator()(const f32x4 (&acc)[2][2][4][2], const Unit& u, int wr, int wc, int fr, int fq) const {
        const i32x2 rec = lds_tab_read(ttab + u.p);
        const int nrows = ((rec.x >> 8) & 0xff) + 1, delta = (int)((unsigned)rec.x >> 16);
        const int r0 = wr * 64 + fr, col0 = u.q * 256 + wc * 32 + 8 * fq;
#pragma unroll
        for (int ai = 0; ai < 2; ++ai)
#pragma unroll
            for (int m = 0; m < 4; ++m) { const int rt = r0 + ai * 128 + m * 16;
                if (rt < nrows) {
                    bf16_t* rowp = Y + (size_t)(rec.y + rt - delta) * 2048 + col0;
#pragma unroll
                    for (int bj = 0; bj < 2; ++bj) { const f32x4 v0 = acc[ai][bj][m][0], v1 = acc[ai][bj][m][1];
                        u32x4 o; o.x = pk_bf16(v0[0], v0[1]); o.y = pk_bf16(v0[2], v0[3]); o.z = pk_bf16(v1[0], v1[1]); o.w = pk_bf16(v1[2], v1[3]); *(u32x4*)(rowp + bj * 128) = o; } } }
    }
};

template <class Prob, class Epi>
DI void gemm_phase(LAS unsigned char* lds, const Prob& P, const Epi& E) {
    const int tid = tid_opaque(), wid = __builtin_amdgcn_readfirstlane(tid >> 6), lane = tid & 63, wr = wid >> 2, wc = wid & 3, fr = lane & 15, fq = lane >> 4;
    const int K = P.K, nt = K / BK;
    int R0, C; stage_rc(tid * 16, R0, C);
    unsigned voffB[2];
#pragma unroll
    for (int i = 0; i < 2; ++i) { const int R = R0 + 64 * i;
        const int Rb = Epi::PERM ? ((R & ~31) + 8 * ((R & 15) >> 2) + 4 * ((R >> 4) & 1) + (R & 3)) : R;
        voffB[i] = ((unsigned)Rb * P.ldb + (unsigned)C) * 2u; }
    const size_t kstep = (size_t)(BK * 2);
    const unsigned ldsw = (unsigned)wid * 1024u;
    const int aoff = lds_byte(wr * 64 + fr, fq * 8), boff = lds_byte(wc * 32 + fr, fq * 8);
#define GM_SA(b, h) (((b) * 2 + (h)) * HTB)
#define GM_SB(b, h) ((4 + (b) * 2 + (h)) * HTB)
#define GM_STAGE_B(bufoff, gbase) do { _Pragma("unroll") for (int _i = 0; _i < 2; ++_i) \
        __builtin_amdgcn_global_load_lds((const unsigned*)((const char*)(gbase) + voffB[_i]), (LAS unsigned*)(lds + (bufoff) + ldsw + _i * 8192), 16, 0, 0); } while (0)
#define GM_STAGE_A(bufoff, st, h, koff) do { _Pragma("unroll") for (int _i = 0; _i < 2; ++_i) \
        __builtin_amdgcn_global_load_lds((const unsigned*)(P.a_addr(st, h, _i, R0, C, koff)), (LAS unsigned*)(lds + (bufoff) + ldsw + _i * 8192), 16, 0, 0); } while (0)
#define GM_LDA(dst, b, h) do { _Pragma("unroll") for (int m = 0; m < 4; ++m) _Pragma("unroll") for (int k = 0; k < 2; ++k) dst[m][k] = *(const LAS bf16x8*)(lds + GM_SA(b, h) + aoff + m * 2048 + k * 1024); } while (0)
#define GM_LDB(dst, b, h) do { _Pragma("unroll") for (int n = 0; n < 2; ++n) _Pragma("unroll") for (int k = 0; k < 2; ++k) dst[n][k] = *(const LAS bf16x8*)(lds + GM_SB(b, h) + boff + n * 2048 + k * 1024); } while (0)
#define GM_MMA(ai, bj, At, Bt) do { __builtin_amdgcn_s_setprio(1); _Pragma("unroll") for (int m = 0; m < 4; ++m) _Pragma("unroll") for (int n = 0; n < 2; ++n) _Pragma("unroll") for (int k = 0; k < 2; ++k) \
        acc[ai][bj][m][n] = __builtin_amdgcn_mfma_f32_16x16x32_bf16(Bt[n][k], At[m][k], acc[ai][bj][m][n], 0, 0, 0); __builtin_amdgcn_s_setprio(0); } while (0)
#define GM_WAIT_V(n) asm volatile("s_waitcnt vmcnt(" #n ")" ::: "memory")
#define GM_WAIT_L(n) asm volatile("s_waitcnt lgkmcnt(" #n ")" ::: "memory")
#define GM_BAR __builtin_amdgcn_s_barrier()
#define GM_SCHED __builtin_amdgcn_sched_barrier(0)
    Unit cur, nxt; int ui = 0;
    if (!P.next(0, cur)) return;
    f32x4 acc[2][2][4][2];
#pragma unroll
    for (int a = 0; a < 2; ++a)
#pragma unroll
        for (int b = 0; b < 2; ++b)
#pragma unroll
            for (int m = 0; m < 4; ++m)
#pragma unroll
                for (int n = 0; n < 2; ++n) acc[a][b][m][n] = (f32x4){0.f, 0.f, 0.f, 0.f};
    bf16x8 At[4][2], B0[2][2], B1[2][2];
    typename Prob::AState cs, ns; P.a_state(cur, R0, C, cs);
    const char* cB0 = P.b_ptr(cur, 0); const char* cB1 = P.b_ptr(cur, 1);
    GM_STAGE_B(GM_SB(0, 0), cB0); GM_STAGE_A(GM_SA(0, 0), cs, 0, 0); GM_STAGE_B(GM_SB(0, 1), cB1); GM_STAGE_A(GM_SA(0, 1), cs, 1, 0);
    if (wr == 1) GM_BAR;
    GM_WAIT_V(4); GM_BAR;
    GM_STAGE_B(GM_SB(1, 0), cB0 + kstep); GM_STAGE_A(GM_SA(1, 0), cs, 0, P.koff(1)); GM_STAGE_B(GM_SB(1, 1), cB1 + kstep);
    GM_WAIT_V(6); GM_BAR;
    for (;;) {
        const bool has_next = P.next(ui + 1, nxt);
        if (has_next) P.a_state(nxt, R0, C, ns); else ns = cs;
        const char* nB0 = has_next ? P.b_ptr(nxt, 0) : cB0; const char* nB1 = has_next ? P.b_ptr(nxt, 1) : cB1;
        for (int t = 0; t < nt; t += 2) {
            const bool last = (t == nt - 2);
            const size_t k1 = P.koff(t + 1);
            const size_t k2 = last ? (size_t)0 : P.koff(t + 2), k3 = last ? P.koff(1) : P.koff(t + 3);
            const typename Prob::AState s2 = Prob::sel(last, ns, cs);
            const char* b20 = last ? nB0 : cB0 + (size_t)(t + 2) * kstep; const char* b21 = last ? nB1 : cB1 + (size_t)(t + 2) * kstep;
            const char* b30 = b20 + kstep; const char* b31 = b21 + kstep;
            GM_LDB(B0, 0, 0); GM_SCHED; GM_LDA(At, 0, 0); GM_STAGE_A(GM_SA(1, 1), cs, 1, k1);
            GM_WAIT_L(8); GM_BAR; GM_WAIT_L(0); GM_MMA(0, 0, At, B0); GM_BAR; GM_SCHED;
            GM_LDB(B1, 0, 1); GM_STAGE_B(GM_SB(0, 0), b20);
            GM_BAR; GM_WAIT_L(0); GM_MMA(0, 1, At, B1); GM_BAR;
            GM_LDA(At, 0, 1); GM_STAGE_A(GM_SA(0, 0), s2, 0, k2);
            GM_BAR; GM_WAIT_L(0); GM_MMA(1, 0, At, B0); GM_BAR; GM_SCHED;
            GM_STAGE_B(GM_SB(0, 1), b21);
            GM_WAIT_V(6); GM_BAR; GM_MMA(1, 1, At, B1); GM_BAR;
            GM_LDB(B0, 1, 0); GM_SCHED; GM_LDA(At, 1, 0); GM_STAGE_A(GM_SA(0, 1), s2, 1, k2);
            GM_WAIT_L(8); GM_BAR; GM_WAIT_L(0); GM_MMA(0, 0, At, B0); GM_BAR; GM_SCHED;
            GM_LDB(B1, 1, 1); GM_STAGE_B(GM_SB(1, 0), b30);
            GM_BAR; GM_WAIT_L(0); GM_MMA(0, 1, At, B1); GM_BAR;
            GM_LDA(At, 1, 1); GM_STAGE_A(GM_SA(1, 0), s2, 0, k3);
            GM_BAR; GM_WAIT_L(0); GM_MMA(1, 0, At, B0); GM_BAR; GM_SCHED;
            GM_STAGE_B(GM_SB(1, 1), b31);
            GM_WAIT_V(6); GM_BAR; GM_MMA(1, 1, At, B1); GM_BAR;
        }
        E(acc, cur, wr, wc, fr, fq);
        if (!has_next) break;
#pragma unroll
        for (int a = 0; a < 2; ++a)
#pragma unroll
            for (int b = 0; b < 2; ++b)
#pragma unroll
                for (int m = 0; m < 4; ++m)
#pragma unroll
                    for (int n = 0; n < 2; ++n) acc[a][b][m][n] = (f32x4){0.f, 0.f, 0.f, 0.f};
        cur = nxt; cs = ns; cB0 = nB0; cB1 = nB1; ++ui;
    }
    GM_WAIT_V(0);
    if (wr == 0) GM_BAR;
    GM_BAR;
#undef GM_SA
#undef GM_SB
#undef GM_STAGE_A
#undef GM_STAGE_B
#undef GM_LDA
#undef GM_LDB
#undef GM_MMA
#undef GM_WAIT_V
#undef GM_WAIT_L
#undef GM_BAR
#undef GM_SCHED
}
}


#define XB_TMO      128
#define XB_XCNT(j)  (256  + 64 * (j))
#define XB_XSUB(j)  (1280 + 64 * (j))
#define XB_XGEN(j)  (2304 + 64 * (j))
#define XB_TOP      3328
#define XB_TOPGEN   3392
#define XCD_BAR_WORDS 3456
#define XB_SPIN_CAP (1u << 22)
#define LAS __attribute__((address_space(3)))

__device__ __forceinline__ unsigned xb_ld(unsigned* p)              { return __hip_atomic_load(p, __ATOMIC_RELAXED, __HIP_MEMORY_SCOPE_AGENT); }
__device__ __forceinline__ unsigned xb_add(unsigned* p, unsigned v) { return __hip_atomic_fetch_add(p, v, __ATOMIC_RELAXED, __HIP_MEMORY_SCOPE_AGENT); }
__device__ __forceinline__ unsigned xb_xcc_id() { return (unsigned)__builtin_amdgcn_s_getreg((3 << 11) | 20) & 0xFu; }
#define XB_SPIN(cond, bar) do { unsigned _sp = 0; while (cond) { __builtin_amdgcn_s_sleep(1); \
    if ((++_sp & 255u) == 0u) { if (xb_ld(&(bar)[XB_TMO])) break; if (_sp > XB_SPIN_CAP) { atomicAdd(&(bar)[XB_TMO], 1u); break; } } } } while (0)

struct XcdBarrier {
    unsigned* bar; unsigned x;
    volatile LAS unsigned* st;
};

__device__ __forceinline__ XcdBarrier xcd_barrier_post(unsigned* bar, volatile LAS unsigned* st) {
    XcdBarrier b; b.bar = bar; b.x = xb_xcc_id(); b.st = st;
    if (threadIdx.x == 0) (void)xb_add(&bar[XB_XCNT(b.x)], 1u);
    return b;
}
__device__ __forceinline__ void xcd_barrier_complete(unsigned* bar, unsigned x, unsigned& nloc, unsigned& nx) {
    const unsigned G = gridDim.x * gridDim.y * gridDim.z;
    unsigned sum, cnt, mine, sp = 0u;
    for (;;) {
        sum = 0u; cnt = 0u; mine = 0u;
#pragma unroll
        for (unsigned j = 0; j < 16; ++j) { const unsigned c = xb_ld(&bar[XB_XCNT(j)]); sum += c; cnt += (c > 0u) ? 1u : 0u; mine = (j == x) ? c : mine; }
        if (sum == G) break;
        __builtin_amdgcn_s_sleep(1);
        if ((++sp & 255u) == 0u) { if (xb_ld(&bar[XB_TMO])) break; if (sp > XB_SPIN_CAP) { atomicAdd(&bar[XB_TMO], 1u); break; } }
    }
    nloc = mine > 0u ? mine : 1u; nx = cnt > 0u ? cnt : 1u;
}

__device__ __forceinline__ void xcd_barrier(const XcdBarrier& b) {
    asm volatile("s_waitcnt vmcnt(0)" ::: "memory");
    __syncthreads();
    if (threadIdx.x == 0) {
        unsigned* bar = b.bar;
        __builtin_amdgcn_s_waitcnt(0);
        unsigned nloc = b.st[0], nx = b.st[1];
        if (nloc == 0u) { xcd_barrier_complete(bar, b.x, nloc, nx); b.st[0] = nloc; b.st[1] = nx; }
        const unsigned old = xb_add(&bar[XB_XSUB(b.x)], 1u);
        const unsigned gen = old / nloc;
        if (old + 1u == (gen + 1u) * nloc) {
            __builtin_amdgcn_fence(__ATOMIC_RELEASE, "agent");
            asm volatile("s_waitcnt vmcnt(0)" ::: "memory");
            const unsigned og = xb_add(&bar[XB_TOP], 1u);
            const unsigned tg = og / nx;
            if (og + 1u == (tg + 1u) * nx) xb_add(&bar[XB_TOPGEN], 1u);
            else XB_SPIN(xb_ld(&bar[XB_TOPGEN]) == tg, bar);
            __builtin_amdgcn_fence(__ATOMIC_ACQUIRE, "agent");
            xb_add(&bar[XB_XGEN(b.x)], 1u);
            asm volatile("s_waitcnt vmcnt(0)" ::: "memory");
        } else {
            XB_SPIN(xb_ld(&bar[XB_XGEN(b.x)]) == gen, bar);
            __builtin_amdgcn_fence(__ATOMIC_ACQUIRE, "agent");
            asm volatile("s_waitcnt vmcnt(0)" ::: "memory");
        }
    }
    __syncthreads();
}


struct MP {
    const float* x; const int* positions; const float* ab_w_in; const float* conv_w; const float* conv_b; const float* dt_bias; const float* a_log; const float* ssm_d;
    const float* ssm_norm_w; const float* cmp_pos; const float* cmp_w; const float* ab_w_out; const float* cd_w_in; const float* q_norm_w; const float* w_uq;
    const float* kv_norm_w; const float* w_ukv; const float* lb_logits; const float* hgrn_norm_w; const float* cd_w_out; const float* ln_g; const float* ln_b;
    const float* w_router; const float* router_bias; const float* w_gate; const float* w_up; const float* w_down; const float* sg; const float* su; const float* sd;
    float* out;
    bf16_t* WinABt; bf16_t* WoutABt; bf16_t* WinCDt; bf16_t* WoutCDt; bf16_t* Wuqt; bf16_t* Wukvt; bf16_t* WgT; bf16_t* WuT; bf16_t* WdT;
    bf16_t* hbuf; float* xbc; float* mix; bf16_t* H; bf16_t* Y; bf16_t* mixb; float* bufA; float* bufB; float* x3; bf16_t* xb; bf16_t* cqb; bf16_t* kr; float* kc; float* vc;
    float* rope_tab; bf16_t* kcb; bf16_t* vcT; bf16_t* vselT; bf16_t* vwinT; bf16_t* ksf; bf16_t* kwf; bf16_t* kvfrag; bf16_t* WcmpT; float* cpart; bf16_t* WrT3; int* top_e; float* top_w; int* lpos; int* cnt_tab; int* row_tok; float* row_w; int* row_slot; int* tiles; int* ntiles;
    unsigned* bar;
};

constexpr int NTHR = 512, NWAVE = 8;
constexpr int LDS_BAR_OFF = 135168;
constexpr int LDS_TAB_OFF = LDS_BAR_OFF + 64;
constexpr int LDS_TOTAL = LDS_TAB_OFF + 768 * 8;

DI float wave_sum(float v) {
#pragma unroll
    for (int o = 1; o < 64; o <<= 1) v += __shfl_xor(v, o);
    return v;
}

DI void cvt_wT_range(LAS unsigned char* lds, const float* __restrict__ W, bf16_t* __restrict__ Wt, int K, int N, int Npad, int bid, int nblk, int ntile) {
    const int tix = tid_opaque();
    LAS float* tile = (LAS float*)lds;
    const int tn = Npad / 64, tk = K / 64;
    const int tx = tix & 63, ty = tix >> 6;
    const int wn = tix >> 3, wk = (tix & 7) * 8;
    float cur[8];
    int tp = bid;
    if (tp < ntile) {
        int tq = tp; const int nx = tq % tn; tq /= tn; const int ky = tq % tk; const int bz = tq / tk;
        const float* Wb = W + (size_t)bz * K * N + (size_t)(ky * 64) * N + nx * 64 + tx;
        const bool nin = (nx * 64 + tx) < N;
#pragma unroll
        for (int i = 0; i < 8; ++i) cur[i] = nin ? Wb[(size_t)(ty + 8 * i) * N] : 0.f;
    }
    for (; tp < ntile; tp += nblk) {
        int tq = tp; const int nx = tq % tn; tq /= tn; const int ky = tq % tk; const int bz = tq / tk;
        const int n0 = nx * 64, k0 = ky * 64;
        bf16_t* Wtb = Wt + (size_t)bz * Npad * K;
#pragma unroll
        for (int i = 0; i < 8; ++i) tile[(ty + 8 * i) * 65 + tx] = cur[i];
        const int tp2 = tp + nblk;
        if (tp2 < ntile) {
            int tq2 = tp2; const int nx2 = tq2 % tn; tq2 /= tn; const int ky2 = tq2 % tk; const int bz2 = tq2 / tk;
            const float* Wb2 = W + (size_t)bz2 * K * N + (size_t)(ky2 * 64) * N + nx2 * 64 + tx;
            const bool nin2 = (nx2 * 64 + tx) < N;
#pragma unroll
            for (int i = 0; i < 8; ++i) cur[i] = nin2 ? Wb2[(size_t)(ty + 8 * i) * N] : 0.f;
        }
        __syncthreads();
        u32x4 o;
        o.x = pk_bf16(tile[(wk + 0) * 65 + wn], tile[(wk + 1) * 65 + wn]); o.y = pk_bf16(tile[(wk + 2) * 65 + wn], tile[(wk + 3) * 65 + wn]);
        o.z = pk_bf16(tile[(wk + 4) * 65 + wn], tile[(wk + 5) * 65 + wn]); o.w = pk_bf16(tile[(wk + 6) * 65 + wn], tile[(wk + 7) * 65 + wn]);
        *(u32x4*)(Wtb + (size_t)(n0 + wn) * K + k0 + wk) = o;
        __syncthreads();
    }
}
DI void ph_cvt_wT(LAS unsigned char* lds, const float* __restrict__ W, bf16_t* __restrict__ Wt, int K, int N, int Npad, int batch, int bid, int nblk) {
    cvt_wT_range(lds, W, Wt, K, N, Npad, bid, nblk, (Npad / 64) * (K / 64) * batch);
}
DI void ph_cvt_moe_weights(LAS unsigned char* lds, const MP& p, int layer, int bid, int nblk) {
    const size_t eo = (size_t)layer * 64 * DM * 512, so = (size_t)layer * DM * 512;
    ph_cvt_wT(lds, p.w_gate + eo, p.WgT, DM, 512, 512, 64, bid, nblk); ph_cvt_wT(lds, p.sg + so, p.WgT + (size_t)64 * 512 * DM, DM, 512, 512, 1, bid, nblk);
    ph_cvt_wT(lds, p.w_up + eo, p.WuT, DM, 512, 512, 64, bid, nblk);   ph_cvt_wT(lds, p.su + so, p.WuT + (size_t)64 * 512 * DM, DM, 512, 512, 1, bid, nblk);
    ph_cvt_wT(lds, p.w_down + eo, p.WdT, 512, DM, DM, 64, bid, nblk);  ph_cvt_wT(lds, p.sd + so, p.WdT + (size_t)64 * DM * 512, 512, DM, DM, 1, bid, nblk);
}

struct CvqPos { int nx, ky, bz; };
DI void cvq_adv4(CvqPos& s, int tn, int tk) { s.nx += 4; if (s.nx >= tn) { s.nx = 0; if (++s.ky == tk) { s.ky = 0; ++s.bz; } } }
DI void cvt_wT_quad(LAS unsigned char* lds, const float* __restrict__ W, bf16_t* __restrict__ Wt, int K, int N, int Npad, int t0, int t1) {
    const int tix = tid_opaque();
    const int tn = Npad / 64, tk = K / 64;
    const int tx = tix & 63, ty = tix >> 6;
    const int wn = tix >> 3, wq = tix & 7;
    float ca[4][8], cb[4][8];
#define CVQ_ISSUE(C_, S_) do { \
        _Pragma("unroll") for (int j = 0; j < 4; ++j) { \
            const int cn = (S_.nx + j) * 64 < N ? (S_.nx + j) * 64 : 0;        \
            const float* Wb = W + (size_t)S_.bz * K * N + (size_t)(S_.ky * 64 + 2 * ty) * N + cn + tx; \
            _Pragma("unroll") for (int i = 0; i < 4; ++i) { C_[j][2 * i] = __builtin_nontemporal_load(Wb + (size_t)(16 * i) * N); C_[j][2 * i + 1] = __builtin_nontemporal_load(Wb + (size_t)(16 * i + 1) * N); } } } while (0)
#define CVQ_STEP(C_, S_, BUF_, ISSUE_) do { \
        LAS unsigned* tile = (LAS unsigned*)lds + (BUF_) * (4 * 2080); \
        const CvqPos cur_ = S_; \
        _Pragma("unroll") for (int j = 0; j < 4; ++j) { \
            if ((cur_.nx + j) * 64 >= N) { _Pragma("unroll") for (int i = 0; i < 8; ++i) C_[j][i] = 0.f; } \
            _Pragma("unroll") for (int i = 0; i < 4; ++i) tile[j * 2080 + (ty + 8 * i) * 65 + tx] = pk_bf16(C_[j][2 * i], C_[j][2 * i + 1]); } \
        if (ISSUE_) { cvq_adv4(S_, tn, tk); cvq_adv4(S_, tn, tk); CVQ_ISSUE(C_, S_); } \
        __syncthreads(); \
        _Pragma("unroll") for (int j = 0; j < 4; ++j) { \
            const LAS unsigned* tl = tile + j * 2080 + (4 * wq) * 65 + wn; \
            u32x4 o; o.x = tl[0]; o.y = tl[65]; o.z = tl[130]; o.w = tl[195]; \
            __builtin_nontemporal_store(o, (u32x4*)(Wt + (size_t)cur_.bz * Npad * K + (size_t)((cur_.nx + j) * 64 + wn) * K + cur_.ky * 64 + 8 * wq));        \
        } } while (0)
    CvqPos sa, sb;
    { int tq = t0; sa.nx = tq % tn; tq /= tn; sa.ky = tq % tk; sa.bz = tq / tk; sb = sa; cvq_adv4(sb, tn, tk); }
    CVQ_ISSUE(ca, sa); CVQ_ISSUE(cb, sb);
    int tp = t0;
    for (; tp + 8 < t1; tp += 8) {
        CVQ_STEP(ca, sa, 0, true);
        CVQ_STEP(cb, sb, 1, true);
    }
    CVQ_STEP(ca, sa, 0, false);
    CVQ_STEP(cb, sb, 1, false);
    __syncthreads();
#undef CVQ_STEP
#undef CVQ_ISSUE
}
constexpr int CVQ_NG = 208;
constexpr int CVQ_SEG_E = 64 * 256, CVQ_SEG_S = 256, CVQ_BATCH = 32, CVQ_MOE_TILES = 3 * (CVQ_SEG_E + CVQ_SEG_S);
constexpr int CVQ_X0 = (9472 / 64) * (DM / 64), CVQ_X1 = (DM / 64) * (4096 / 64), CVQ_X2 = (3072 / 64) * (512 / 64), CVQ_X3 = (4096 / 64) * (512 / 64), CVQ_X4 = CVQ_X1, CVQ_X5 = 2 * (256 / 64) * (4096 / 64);
constexpr int CVQ_XTRA = CVQ_X0 + CVQ_X1 + CVQ_X2 + CVQ_X3 + CVQ_X4 + CVQ_X5;
static_assert(CVQ_X0 % CVQ_BATCH == 0 && CVQ_X1 % CVQ_BATCH == 0 && CVQ_X2 % CVQ_BATCH == 0 && CVQ_X3 % CVQ_BATCH == 0 && CVQ_X5 % CVQ_BATCH == 0 && CVQ_SEG_S % CVQ_BATCH == 0, "batches must not straddle matrices");
DI void moe_cvt_queue(LAS unsigned char* lds, const MP& p, int layer, unsigned* ctr) {
    const size_t eo = (size_t)layer * 64 * DM * 512, so = (size_t)layer * DM * 512;
    volatile LAS int* slot = (volatile LAS int*)(lds + LDS_BAR_OFF + 32);
    const int nbatch = (CVQ_MOE_TILES + (layer == 0 ? CVQ_XTRA : 0)) / CVQ_BATCH;
    asm volatile("s_waitcnt vmcnt(0)" ::: "memory");
    for (;;) {
        __syncthreads();
        if (threadIdx.x == 0) *slot = (int)__hip_atomic_fetch_add(ctr, 1u, __ATOMIC_RELAXED, __HIP_MEMORY_SCOPE_AGENT);
        __syncthreads();
        const int bt = __builtin_amdgcn_readfirstlane(*slot);
        if (bt >= nbatch) break;
        int g = bt * CVQ_BATCH;
        const float* W; bf16_t* Wt; int K, N, Npad;
        if (g < CVQ_MOE_TILES) {
            const int m = g / (CVQ_SEG_E + CVQ_SEG_S); g -= m * (CVQ_SEG_E + CVQ_SEG_S);
            const bool sh = g >= CVQ_SEG_E; if (sh) g -= CVQ_SEG_E;
            W = (m == 0) ? (sh ? p.sg + so : p.w_gate + eo) : (m == 1) ? (sh ? p.su + so : p.w_up + eo) : (sh ? p.sd + so : p.w_down + eo);
            Wt = ((m == 0) ? p.WgT : (m == 1) ? p.WuT : p.WdT) + (sh ? (size_t)64 * 512 * DM : (size_t)0);
            K = (m == 2) ? 512 : DM; N = (m == 2) ? DM : 512; Npad = N;
        } else {
            g -= CVQ_MOE_TILES;
            if (g < CVQ_X0) { W = p.cd_w_in; Wt = p.WinCDt; K = DM; N = CD_IN; Npad = 9472; }
            else if ((g -= CVQ_X0) < CVQ_X1) { W = p.cd_w_out; Wt = p.WoutCDt; K = 4096; N = DM; Npad = DM; }
            else if ((g -= CVQ_X1) < CVQ_X2) { W = p.w_uq; Wt = p.Wuqt; K = 512; N = 3072; Npad = 3072; }
            else if ((g -= CVQ_X2) < CVQ_X3) { W = p.w_ukv; Wt = p.Wukvt; K = 512; N = 4096; Npad = 4096; }
            else if ((g -= CVQ_X3) < CVQ_X4) { W = p.ab_w_out; Wt = p.WoutABt; K = 4096; N = DM; Npad = DM; }
            else { g -= CVQ_X4; W = p.cmp_w; Wt = p.WcmpT; K = 4096; N = 128; Npad = 256; }
        }
        cvt_wT_quad(lds, W, Wt, K, N, Npad, g, g + CVQ_BATCH);
    }
    __syncthreads();
}

DI void ph_cvt_x(const MP& p) {
    const int tix = tid_opaque();
    const long gt = (long)blockIdx.x * NTHR + tix, gs = (long)gridDim.x * NTHR;
    for (long i = gt; i < (long)T_TOK * DM / 4; i += gs) { const float4 v = ((const float4*)p.x)[i]; u32x2 o; o.x = pk_bf16(v.x, v.y); o.y = pk_bf16(v.z, v.w); ((u32x2*)p.xb)[i] = o; }
    for (long i = gt; i < DM / 2; i += gs) ((unsigned*)(p.xb + (size_t)T_TOK * DM))[i] = 0u;
}


DI void ph_ssd_norm(const MP& p) {
    const int tix = tid_opaque();
    const int lane = tix & 63, gw = blockIdx.x * NWAVE + (tix >> 6), nw = gridDim.x * NWAVE;
    const bf16_t* mixh = (const bf16_t*)p.mix;
    u32x2 nv[8];
    if (gw < T_TOK) {
#pragma unroll
        for (int j = 0; j < 8; ++j) nv[j] = *(const u32x2*)(mixh + (long)gw * 4096 + j * 256 + lane * 4);
    }
    for (int row = gw; row < T_TOK; row += nw) {
        float4 v[8]; float ss = 0.f;
#pragma unroll
        for (int j = 0; j < 8; ++j) { v[j].x = bflo(nv[j].x); v[j].y = bfhi(nv[j].x); v[j].z = bflo(nv[j].y); v[j].w = bfhi(nv[j].y); ss += v[j].x * v[j].x + v[j].y * v[j].y + v[j].z * v[j].z + v[j].w * v[j].w; }
        if (row + nw < T_TOK) {
#pragma unroll
            for (int j = 0; j < 8; ++j) nv[j] = *(const u32x2*)(mixh + (long)(row + nw) * 4096 + j * 256 + lane * 4);
        }
        const float r = rsqrtf(wave_sum(ss) / 2048.f + 1e-6f);
#pragma unroll
        for (int j = 0; j < 8; ++j) { const float4 w = *(const float4*)(p.ssm_norm_w + j * 256 + lane * 4);
            u32x2 o; o.x = pk_bf16(v[j].x * r * w.x, v[j].y * r * w.y); o.y = pk_bf16(v[j].z * r * w.z, v[j].w * r * w.w);
            *(u32x2*)(p.mixb + (long)row * 4096 + j * 256 + lane * 4) = o; }
    }
}

DI void ph_build_wr(const MP& p) {
    const int tix = tid_opaque();
    const long gt = (long)blockIdx.x * NTHR + tix, gs = (long)gridDim.x * NTHR;
    for (long idx = gt; idx < (long)2 * 256 * 4096; idx += gs) {
        const int k = (int)(idx & 4095), n = (int)((idx >> 12) & 255), layer = (int)(idx >> 20);
        float v = 0.f;
        if (n < 128) {
            const float wv = p.w_router[((size_t)layer * DM + (k & 2047)) * 64 + (n & 63)];
            const float hi = bf2f(f2bf(wv));
            if (n < 64) v = hi; else v = (k < 2048) ? (wv - hi) : 0.f;
        }
        p.WrT3[idx] = f2bf(v);
    }
}
template <bool XBF> DI void ph_ln(const MP& p, const void* xin_, const bf16_t* add, const float* gg, const float* bb, bf16_t* xob, bf16_t* xlo) {
    const int tix = tid_opaque();
    const int lane = tix & 63, gw = blockIdx.x * NWAVE + (tix >> 6), nw = gridDim.x * NWAVE;
    float4 na[8]; u32x2 nc[8];
    const float* xin = (const float*)xin_; const bf16_t* xinb = (const bf16_t*)xin_;
#define LN_LOADX(row_, j_) do { if constexpr (XBF) { const u32x2 h_ = *(const u32x2*)(xinb + (long)(row_) * DM + (j_) * 256 + lane * 4); na[j_] = make_float4(bflo(h_.x), bfhi(h_.x), bflo(h_.y), bfhi(h_.y)); } \
        else na[j_] = *(const float4*)(xin + (long)(row_) * DM + (j_) * 256 + lane * 4); } while (0)
    if (gw < T_TOK) {
#pragma unroll
        for (int j = 0; j < 8; ++j) { LN_LOADX(gw, j); nc[j] = *(const u32x2*)(add + (long)gw * DM + j * 256 + lane * 4); }
    }
    for (int t = gw; t < T_TOK; t += nw) {
        float4 v[8]; float s = 0.f;
#pragma unroll
        for (int j = 0; j < 8; ++j) { const float4 a = na[j]; const u32x2 c = nc[j];
            v[j].x = DN_ALPHA * a.x + bflo(c.x); v[j].y = DN_ALPHA * a.y + bfhi(c.x); v[j].z = DN_ALPHA * a.z + bflo(c.y); v[j].w = DN_ALPHA * a.w + bfhi(c.y); s += (v[j].x + v[j].y) + (v[j].z + v[j].w); }
        if (t + nw < T_TOK) {
#pragma unroll
            for (int j = 0; j < 8; ++j) { LN_LOADX(t + nw, j); nc[j] = *(const u32x2*)(add + (long)(t + nw) * DM + j * 256 + lane * 4); }
        }
        const float mu = wave_sum(s) / DM;
        float q = 0.f;
#pragma unroll
        for (int j = 0; j < 8; ++j) { v[j].x -= mu; v[j].y -= mu; v[j].z -= mu; v[j].w -= mu; q += v[j].x * v[j].x + v[j].y * v[j].y + v[j].z * v[j].z + v[j].w * v[j].w; }
        const float rs = rsqrtf(wave_sum(q) / DM + 1e-5f);
#pragma unroll
        for (int j = 0; j < 8; ++j) { const int c0 = j * 256 + lane * 4; const float4 g4 = *(const float4*)(gg + c0), b4 = *(const float4*)(bb + c0);
            float4 o; o.x = v[j].x * rs * g4.x + b4.x; o.y = v[j].y * rs * g4.y + b4.y; o.z = v[j].z * rs * g4.z + b4.z; o.w = v[j].w * rs * g4.w + b4.w;
            u32x2 hb; hb.x = pk_bf16(o.x, o.y); hb.y = pk_bf16(o.z, o.w); *(u32x2*)(xob + (long)t * DM + c0) = hb;
            u32x2 lb2; lb2.x = pk_bf16(o.x - bflo(hb.x), o.y - bfhi(hb.x)); lb2.y = pk_bf16(o.z - bflo(hb.y), o.w - bfhi(hb.y)); *(u32x2*)(xlo + (long)t * DM + c0) = lb2; }
    }
}
#undef LN_LOADX
DI void ph_route_select(const MP& p, const float* Cpart, const float* rbias) {
    const int tix = tid_opaque();
    const int lane = tix & 63, gw = blockIdx.x * NWAVE + (tix >> 6), nw = gridDim.x * NWAVE;
    const float bias = rbias[lane];
    const int grp = lane >> 3;
    for (int slot = gw; slot < MOE_NSLOT; slot += nw) {
        int cnt = 0;
        for (int i = 0; i < MOE_SLOT_TOK; ++i) {
            const int t = slot * MOE_SLOT_TOK + i;
            float logit = 0.f;
#pragma unroll
            for (int q = 0; q < 4; ++q) { const float* cp = Cpart + ((size_t)q * T_TOK + t) * 128; logit += cp[lane] + cp[64 + lane]; }
            if (!(logit == logit)) logit = 0.f;
            const float score = 1.f / (1.f + expf(-logit));
            const float biased = score + bias;
            float m1 = biased;
            m1 = fmaxf(m1, __shfl_xor(m1, 1)); m1 = fmaxf(m1, __shfl_xor(m1, 2)); m1 = fmaxf(m1, __shfl_xor(m1, 4));
            const unsigned long long bm = __ballot(biased == m1);
            const unsigned gb = (unsigned)((bm >> (8 * grp)) & 0xffull);
            const int first = __ffs(gb) - 1;
            float v2 = ((lane & 7) == first) ? -3.0e38f : biased;
            v2 = fmaxf(v2, __shfl_xor(v2, 1)); v2 = fmaxf(v2, __shfl_xor(v2, 2)); v2 = fmaxf(v2, __shfl_xor(v2, 4));
            const float gs = m1 + v2;
            int grank = 0;
#pragma unroll
            for (int g2 = 0; g2 < 8; ++g2) { const float o = __shfl(gs, g2 * 8); grank += (o > gs || (o == gs && g2 < grp)) ? 1 : 0; }
            const bool gsel = grank < 4;
            const float masked = gsel ? biased : -3.0e38f;
            int erank = 0;
            for (int e2 = 0; e2 < 64; ++e2) { const float o = __shfl(masked, e2); erank += (o > masked || (o == masked && e2 < lane)) ? 1 : 0; }
            const bool selected = gsel && erank < 8;
            const float ws = wave_sum(selected ? score : 0.f);
            if (selected) { p.top_e[t * 8 + erank] = lane; p.top_w[t * 8 + erank] = score / ws * 2.5f; p.lpos[t * 8 + erank] = cnt; ++cnt; }
        }
        p.cnt_tab[slot * 64 + lane] = cnt;
    }
}
DI void ph_router_gemm(LAS unsigned char* lds, const MP& p, int layer, float* Cpart, const bf16_t* xlo) {
    gm::RouterProb q; q.xhi = (const char*)p.xb; q.dlo = (long)((const char*)xlo - (const char*)p.xb); q.Bt = (const char*)(p.WrT3 + (size_t)layer * 256 * 4096); q.K = 1024; q.G = (int)gridDim.x; q.c = (int)blockIdx.x; q.ldb = 4096;
    gm::EpiRouter e; e.Cpart = Cpart;
    gm::gemm_phase(lds, q, e);
}

DI void ph_moe_scan(LAS unsigned char* lds, const MP& p) {
    const int tix = tid_opaque();
    LAS int* part_b = (LAS int*)lds;
    LAS int* part_a = part_b + 512;
    LAS int* total = part_a + 512; LAS int* base = total + 64; LAS int* pre = base + 64; LAS int* pc = pre + 64;
    const int tid = tix, e = tid & 63, part = tid >> 6;
    const int spb = (MOE_NSLOT + gridDim.x - 1) / gridDim.x;
    const int s0 = blockIdx.x * spb, s1 = min(MOE_NSLOT, s0 + spb);
    int sb = 0, sa = 0;
#pragma unroll 16
    for (int sl = part; sl < MOE_NSLOT; sl += NWAVE) { const int c = p.cnt_tab[sl * 64 + e]; sa += c; if (sl < s0) sb += c; }
    part_b[part * 64 + e] = sb; part_a[part * 64 + e] = sa;
    __syncthreads();
    if (tid < 64) {
        int ta = 0, tb = 0;
#pragma unroll
        for (int i = 0; i < NWAVE; ++i) { ta += part_a[i * 64 + tid]; tb += part_b[i * 64 + tid]; }
        total[tid] = ta; pre[tid] = tb; pc[tid] = (ta + MOE_TM - 1) / MOE_TM * MOE_TM;
    }
    __syncthreads();
    LAS int* ubase = pc + 64 + 512;
    if (tid == 0) { int a = 0, ua = 0; for (int i = 0; i < 64; ++i) { base[i] = a; a += pc[i]; ubase[i] = ua; ua += total[i]; } }
    __syncthreads();
    if (spb <= 8) {
        LAS int* cl = pc + 64;
        const int sll = tid >> 6;
        cl[tid] = (s0 + sll < s1) ? p.cnt_tab[(s0 + sll) * 64 + e] : 0;
        __syncthreads();
        if (tid < 64) { int run = pre[tid]; for (int i = 0; i < 8; ++i) { const int c = cl[i * 64 + tid]; cl[i * 64 + tid] = run; run += c; } }
        __syncthreads();
        if (s0 + sll < s1) {
            const int a = tid & 63; const int t = (s0 + sll) * MOE_SLOT_TOK + (a >> 3), k = a & 7;
            const int ex = p.top_e[t * 8 + k] & 63;
            const int pp = base[ex] + cl[sll * 64 + ex] + p.lpos[t * 8 + k];
            if (pp >= 0 && pp < MOE_PMAX) { p.row_tok[pp] = t; p.row_slot[t * 8 + k] = pp - (base[ex] - ubase[ex]); }
        }
    } else
    for (int sl = s0; sl < s1; ++sl) {
        if (tid < 64) {
            const int t = sl * MOE_SLOT_TOK + (tid >> 3), k = tid & 7;
            const int ex = p.top_e[t * 8 + k] & 63;
            const int pp = base[ex] + pre[ex] + p.lpos[t * 8 + k];
            if (pp >= 0 && pp < MOE_PMAX) { p.row_tok[pp] = t; p.row_slot[t * 8 + k] = pp - (base[ex] - ubase[ex]); }
        }
        __syncthreads();
        if (tid < 64) pre[tid] += p.cnt_tab[sl * 64 + tid];
        __syncthreads();
    }
    for (int ex = blockIdx.x; ex < 64; ex += gridDim.x)
        for (int pp = base[ex] + total[ex] + tid; pp < base[ex] + pc[ex]; pp += NTHR) p.row_tok[pp] = -1;
    for (int i = blockIdx.x * NTHR + tid; i < T_TOK; i += gridDim.x * NTHR) p.row_tok[MOE_PMAX + i] = i;
    if (blockIdx.x == 0 && tid < 64) {
        const int ex = tid, nt = pc[ex] / MOE_TM, t0 = base[ex] / MOE_TM;
        for (int j = 0; j < nt; ++j) { p.tiles[(t0 + j) * 4 + 0] = ex; p.tiles[(t0 + j) * 4 + 1] = base[ex] + j * MOE_TM; p.tiles[(t0 + j) * 4 + 2] = min(MOE_TM, total[ex] - j * MOE_TM); p.tiles[(t0 + j) * 4 + 3] = base[ex] - ubase[ex]; }
        const int nr = (base[63] + pc[63]) / MOE_TM;
        if (ex == 63) *p.ntiles = nr + T_TOK / MOE_TM;
        for (int j = ex; j < T_TOK / MOE_TM; j += 64) { p.tiles[(nr + j) * 4 + 0] = 64; p.tiles[(nr + j) * 4 + 1] = MOE_PMAX + j * MOE_TM; p.tiles[(nr + j) * 4 + 2] = MOE_TM; p.tiles[(nr + j) * 4 + 3] = MOE_PMAX - T_TOK * 8; }
    }
    __syncthreads();
}

DI void ph_moe_combine_ln(const MP& p, const bf16_t* xhi, const bf16_t* xlo, const float* gg, const float* bb, float* out, bf16_t* ob) {
    const int tix = tid_opaque();
    const int lane = tix & 63, gw = blockIdx.x * NWAVE + (tix >> 6), nw = gridDim.x * NWAVE;
    int myslot = 0; float myw = 0.f;
    { const long rr = (long)gw + (long)(lane >> 3) * nw; if (rr < T_TOK) { myslot = p.row_slot[rr * 8 + (lane & 7)]; myw = p.top_w[rr * 8 + (lane & 7)]; } }
    int ri = 0;
    for (int row = gw; row < T_TOK; row += nw, ++ri) {
        if (ri == 8) { ri = 0; const long rr = (long)row + (long)(lane >> 3) * nw; if (rr < T_TOK) { myslot = p.row_slot[rr * 8 + (lane & 7)]; myw = p.top_w[rr * 8 + (lane & 7)]; } }
        float v[32];
#pragma unroll
        for (int j = 0; j < 4; ++j) { const u32x4 a = *(const u32x4*)(xhi + (long)row * DM + j * 512 + lane * 8), b = *(const u32x4*)(xlo + (long)row * DM + j * 512 + lane * 8);
            v[j * 8 + 0] = DN_ALPHA * (bflo(a.x) + bflo(b.x)); v[j * 8 + 1] = DN_ALPHA * (bfhi(a.x) + bfhi(b.x)); v[j * 8 + 2] = DN_ALPHA * (bflo(a.y) + bflo(b.y)); v[j * 8 + 3] = DN_ALPHA * (bfhi(a.y) + bfhi(b.y));
            v[j * 8 + 4] = DN_ALPHA * (bflo(a.z) + bflo(b.z)); v[j * 8 + 5] = DN_ALPHA * (bfhi(a.z) + bfhi(b.z)); v[j * 8 + 6] = DN_ALPHA * (bflo(a.w) + bflo(b.w)); v[j * 8 + 7] = DN_ALPHA * (bfhi(a.w) + bfhi(b.w)); }
#pragma unroll 3
        for (int k = 0; k < 9; ++k) {
            const size_t yr = (k < 8) ? (size_t)__builtin_amdgcn_readfirstlane(__shfl(myslot, ri * 8 + (k & 7))) : (size_t)((long)T_TOK * 8 + row);
            const float wk = (k < 8) ? __shfl(myw, ri * 8 + (k & 7)) : 1.f;
#pragma unroll
            for (int j = 0; j < 4; ++j) { const u32x4 y = __builtin_nontemporal_load((const u32x4*)(p.Y + yr * 2048 + j * 512 + lane * 8));
                v[j * 8 + 0] += wk * bflo(y.x); v[j * 8 + 1] += wk * bfhi(y.x); v[j * 8 + 2] += wk * bflo(y.y); v[j * 8 + 3] += wk * bfhi(y.y);
                v[j * 8 + 4] += wk * bflo(y.z); v[j * 8 + 5] += wk * bfhi(y.z); v[j * 8 + 6] += wk * bflo(y.w); v[j * 8 + 7] += wk * bfhi(y.w); }
        }
        float s = 0.f;
#pragma unroll
        for (int i = 0; i < 32; ++i) s += v[i];
        const float mu = wave_sum(s) / DM;
        float q = 0.f;
#pragma unroll
        for (int i = 0; i < 32; ++i) { v[i] -= mu; q += v[i] * v[i]; }
        const float rs = rsqrtf(wave_sum(q) / DM + 1e-5f);
#pragma unroll
        for (int j = 0; j < 4; ++j) { const int c0 = j * 512 + lane * 8;
            float o8[8];
#pragma unroll
            for (int i = 0; i < 8; ++i) o8[i] = v[j * 8 + i] * rs * gg[c0 + i] + bb[c0 + i];
            if (out) { *(float4*)(out + (long)row * DM + c0) = make_float4(o8[0], o8[1], o8[2], o8[3]);
                       *(float4*)(out + (long)row * DM + c0 + 4) = make_float4(o8[4], o8[5], o8[6], o8[7]); }
            if (ob) { u32x4 pk; pk.x = pk_bf16(o8[0], o8[1]); pk.y = pk_bf16(o8[2], o8[3]); pk.z = pk_bf16(o8[4], o8[5]); pk.w = pk_bf16(o8[6], o8[7]); *(u32x4*)(ob + (long)row * DM + c0) = pk; } }
    }
}

DI void ph_mla_rms(const MP& p) {
    const int tix = tid_opaque();
    const int lane = tix & 63, gw = blockIdx.x * NWAVE + (tix >> 6), nw = gridDim.x * NWAVE;
    for (int u = gw; u < T_TOK * 2; u += nw) {
        const int row = u >> 1, which = u & 1;
        const bf16_t* src = p.hbuf + (long)row * CD_IN + which * 512 + lane * 8;
        const u32x4 y = *(const u32x4*)src;
        float v[8] = {bflo(y.x), bfhi(y.x), bflo(y.y), bfhi(y.y), bflo(y.z), bfhi(y.z), bflo(y.w), bfhi(y.w)};
        float ss = 0.f;
#pragma unroll
        for (int i = 0; i < 8; ++i) ss += v[i] * v[i];
        const float r = rsqrtf(wave_sum(ss) / 512.f + 1e-6f);
        const float* w = (which ? p.kv_norm_w : p.q_norm_w) + lane * 8;
        u32x4 o; o.x = pk_bf16(v[0] * r * w[0], v[1] * r * w[1]); o.y = pk_bf16(v[2] * r * w[2], v[3] * r * w[3]); o.z = pk_bf16(v[4] * r * w[4], v[5] * r * w[5]); o.w = pk_bf16(v[6] * r * w[6], v[7] * r * w[7]);
        *(u32x4*)(p.cqb + (long)row * 1024 + which * 512 + lane * 8) = o;
    }
}
DI void ph_rope_k(const MP& p) {
    const int tix = tid_opaque();
    const long gt = (long)blockIdx.x * NTHR + tix, gs = (long)gridDim.x * NTHR;
    for (long idx = gt; idx < (long)T_TOK * 32; idx += gs) {
        const int j = (int)(idx & 31); const int t = (int)(idx >> 5);
        const float inv = powf(10000.f, -(float)(2 * j) / 64.f);
        const float ang = (float)p.positions[t] * inv;
        const float c = cosf(ang), sn = sinf(ang);
        const bf16_t* pp = p.hbuf + (long)t * CD_IN + CD_KR;
        const float t1 = ldh(pp, j), t2 = ldh(pp, j + 32);
        { const int b = t >> 11, sq = t & 2047; const size_t tb = ((size_t)b * 64 + (sq >> 5)) * 4; const int r = sq & 31;
          p.kr[(tb + (j >> 4)) * 512 + (((j >> 3) & 1) * 32 + r) * 8 + (j & 7)] = f2bf(t1 * c - t2 * sn);
          p.kr[(tb + ((j + 32) >> 4)) * 512 + ((((j + 32) >> 3) & 1) * 32 + r) * 8 + (j & 7)] = f2bf(t1 * sn + t2 * c); }
        *(float2*)(p.rope_tab + ((long)t * 32 + j) * 2) = make_float2(c, sn);
    }
}
DI void ph_hgrn_post(const MP& p) {
    const int tix = tid_opaque();
    const int lane = tix & 63, gw = blockIdx.x * NWAVE + (tix >> 6), nw = gridDim.x * NWAVE;
    for (int t = gw; t < T_TOK; t += nw) {
#pragma unroll
        for (int j = 0; j < 4; ++j) {
            const int col = j * 512 + lane * 8;
            const float4 a = *(const float4*)(p.x3 + (long)t * 2048 + col), c = *(const float4*)(p.x3 + (long)t * 2048 + col + 4);
            float ss = a.x * a.x + a.y * a.y + a.z * a.z + a.w * a.w + c.x * c.x + c.y * c.y + c.z * c.z + c.w * c.w;
            ss += __shfl_xor(ss, 1); ss += __shfl_xor(ss, 2); ss += __shfl_xor(ss, 4); ss += __shfl_xor(ss, 8);
            const float r = rsqrtf(ss / 128.f + 1e-6f);
            const u32x4 gv = *(const u32x4*)(p.hbuf + (long)t * CD_IN + CD_HG + col);
            const float4 w0 = *(const float4*)(p.hgrn_norm_w + (col & 127)), w1 = *(const float4*)(p.hgrn_norm_w + (col & 127) + 4);
            u32x4 o;
            o.x = pk_bf16(a.x * r * w0.x * siluf_(bflo(gv.x)), a.y * r * w0.y * siluf_(bfhi(gv.x)));
            o.y = pk_bf16(a.z * r * w0.z * siluf_(bflo(gv.y)), a.w * r * w0.w * siluf_(bfhi(gv.y)));
            o.z = pk_bf16(c.x * r * w1.x * siluf_(bflo(gv.z)), c.y * r * w1.y * siluf_(bfhi(gv.z)));
            o.w = pk_bf16(c.z * r * w1.z * siluf_(bflo(gv.w)), c.w * r * w1.w * siluf_(bfhi(gv.w)));
            *(u32x4*)(p.mixb + (long)t * 4096 + 2048 + col) = o;
        }
    }
}


typedef float f32x16 __attribute__((ext_vector_type(16)));
#define MFMA32(a, b, c) __builtin_amdgcn_mfma_f32_32x32x16_bf16((a), (b), (c), 0, 0, 0)
DI bf16x8 ld8(const bf16_t* q) { return *(const bf16x8*)q; }
DI size_t lnd(size_t v) { asm volatile("" : "+v"(v)); return v; }
DI const bf16_t* launder(const bf16_t* q) { asm volatile("" : "+v"(q)); return q; }
DI bf16x8 pack8(float a0, float a1, float a2, float a3, float a4, float a5, float a6, float a7) {
    u32x4 u; u.x = pk_bf16(a0, a1); u.y = pk_bf16(a2, a3); u.z = pk_bf16(a4, a5); u.w = pk_bf16(a6, a7); return __builtin_bit_cast(bf16x8, u);
}
DI void ph_mla_attn(LAS unsigned char* lds, const MP& p) {
    const int tix = tid_opaque();
    const int w = tix >> 6, lane = tix & 63, r = lane & 31, hh = lane >> 5;
    const bf16_t* qm = (const bf16_t*)p.xbc;
    const bf16_t* kfr = (const bf16_t*)p.kvfrag;
    const bf16_t* vfr = kfr + (size_t)T_TOK * 2048;
    const float sc2 = 0.07216878364870322f * 1.4426950408889634f;
    constexpr int SLOT = 20 * 1024;
    for (int unit = blockIdx.x; unit < NB * 16 * 4; unit += gridDim.x) {
        const int pair = unit & 3, head = (unit >> 2) & 15, b = unit >> 6;
        const bf16_t* g0 = kfr + (((size_t)(b * 16 + head) * 64) * 8 + w) * 512 + lane * 8;
        const bf16_t* g1 = (w < 4) ? p.kr + (((size_t)b * 64) * 4 + w) * 512 + lane * 8
                                   : vfr + (((size_t)(b * 16 + head) * 64) * 8 + (w - 4)) * 512 + lane * 8;
        const size_t g1step = (w < 4) ? 2048 : 4096;
        const bf16_t* g2 = vfr + (((size_t)(b * 16 + head) * 64) * 8 + 4 + (w & 3)) * 512 + lane * 8;
        const unsigned l0 = (unsigned)w * 1024u, l1 = (unsigned)(8 + w) * 1024u, l2 = (unsigned)(16 + (w & 3)) * 1024u;
#define MLA_DMA(kt_, slot_) do { LAS unsigned char* sb_ = lds + (slot_) * SLOT; \
        __builtin_amdgcn_global_load_lds((const unsigned*)(g0 + (size_t)(kt_) * 4096), (LAS unsigned*)(sb_ + l0), 16, 0, 0); \
        __builtin_amdgcn_global_load_lds((const unsigned*)(g1 + (size_t)(kt_) * g1step), (LAS unsigned*)(sb_ + l1), 16, 0, 0); \
        __builtin_amdgcn_global_load_lds((const unsigned*)(g2 + (size_t)(kt_) * 4096), (LAS unsigned*)(sb_ + l2), 16, 0, 0); } while (0)
        for (int half = 0; half < 2; ++half) {
            const int qb = half ? 7 - pair : pair;
            const int row0 = qb * 256 + 32 * w;
            const long tq = (long)b * SEQ + row0 + r;
            bf16x8 qf[12];
#pragma unroll
            for (int st = 0; st < 12; ++st) qf[st] = ld8(qm + tq * 3072 + head * 192 + 16 * st + 8 * hh);
#pragma unroll
            for (int g2i = 0; g2i < 2; ++g2i) {
                float o1[8], o2[8];
#pragma unroll
                for (int j = 0; j < 8; ++j) {
                    const float2 cs = *(const float2*)(p.rope_tab + (tq * 32 + 16 * g2i + 8 * hh + j) * 2);
                    const float t1 = bf2f((bf16_t)qf[8 + g2i][j]), t2 = bf2f((bf16_t)qf[10 + g2i][j]);
                    o1[j] = t1 * cs.x - t2 * cs.y; o2[j] = t1 * cs.y + t2 * cs.x;
                }
                qf[8 + g2i] = pack8(o1[0], o1[1], o1[2], o1[3], o1[4], o1[5], o1[6], o1[7]);
                qf[10 + g2i] = pack8(o2[0], o2[1], o2[2], o2[3], o2[4], o2[5], o2[6], o2[7]);
            }
            f32x16 O[4];
#pragma unroll
            for (int dt = 0; dt < 4; ++dt)
#pragma unroll
                for (int i = 0; i < 16; ++i) O[dt][i] = 0.f;
            float m = -INFINITY, l = 0.f;
            const int ktd = row0 >> 5;
            const int nt = qb * 8 + 8;
            asm volatile("s_waitcnt vmcnt(0)" ::: "memory");
            __syncthreads();
            MLA_DMA(0, 0); MLA_DMA(1, 1);
            for (int kt = 0; kt < nt; ++kt) {
                asm volatile("s_waitcnt vmcnt(3)" ::: "memory");
                __builtin_amdgcn_s_barrier();
                { const int kn2 = (kt + 2 < nt) ? kt + 2 : kt; MLA_DMA(kn2, (kt + 2) % 3); }
                if (kt <= ktd) {
                    const LAS unsigned char* sb = lds + (kt % 3) * SLOT + lane * 16;
                    bf16x8 kfr[12];
#pragma unroll
                    for (int st = 0; st < 12; ++st) kfr[st] = *(const LAS bf16x8*)(sb + st * 1024);
                    __builtin_amdgcn_sched_barrier(0);
                    f32x16 S, S2;
#pragma unroll
                    for (int i = 0; i < 16; ++i) { S[i] = 0.f; S2[i] = 0.f; }
#pragma unroll
                    for (int st = 0; st < 12; st += 2) { S = MFMA32(kfr[st], qf[st], S); S2 = MFMA32(kfr[st + 1], qf[st + 1], S2); }
                    bf16x8 vfr[8];
#pragma unroll
                    for (int f = 0; f < 8; ++f) vfr[f] = *(const LAS bf16x8*)(sb + (12 + f) * 1024);
                    __builtin_amdgcn_sched_barrier(0);
#pragma unroll
                    for (int i = 0; i < 16; ++i) S[i] += S2[i];
                    if (kt == ktd) {
#pragma unroll
                        for (int i = 0; i < 16; ++i) if (((i & 3) + 8 * (i >> 2) + 4 * hh) > r) S[i] = -INFINITY;
                    }
                    float mx = S[0];
#pragma unroll
                    for (int i = 1; i < 16; ++i) mx = fmaxf(mx, S[i]);
                    if (__any((mx - m) * sc2 > 24.f)) {
                        const float cm = fmaxf(mx, __shfl_xor(mx, 32));
                        const float mn = fmaxf(m, cm);
                        const float alpha = (m == -INFINITY) ? 0.f : __builtin_amdgcn_exp2f((m - mn) * sc2);
                        l *= alpha;
#pragma unroll
                        for (int dt = 0; dt < 4; ++dt)
#pragma unroll
                            for (int i = 0; i < 16; ++i) O[dt][i] *= alpha;
                        m = mn;
                    }
#pragma unroll
                    for (int i = 0; i < 16; ++i) { S[i] = __builtin_amdgcn_exp2f((S[i] - m) * sc2); l += S[i]; }
                    const bf16x8 pf0 = pack8(S[0], S[1], S[2], S[3], S[4], S[5], S[6], S[7]);
                    const bf16x8 pf1 = pack8(S[8], S[9], S[10], S[11], S[12], S[13], S[14], S[15]);
#pragma unroll
                    for (int dt = 0; dt < 4; ++dt) O[dt] = MFMA32(vfr[dt * 2], pf0, O[dt]);
#pragma unroll
                    for (int dt = 0; dt < 4; ++dt) O[dt] = MFMA32(vfr[dt * 2 + 1], pf1, O[dt]);
                }
            }
            asm volatile("s_waitcnt vmcnt(0)" ::: "memory");
            l += __shfl_xor(l, 32);
            const float il = 1.f / l;
            bf16_t* orow = p.mixb + tq * 4096 + head * 128;
#pragma unroll
            for (int dt = 0; dt < 4; ++dt)
#pragma unroll
                for (int i4 = 0; i4 < 4; ++i4) {
                    u32x2 o; o.x = pk_bf16(O[dt][i4 * 4 + 0] * il, O[dt][i4 * 4 + 1] * il); o.y = pk_bf16(O[dt][i4 * 4 + 2] * il, O[dt][i4 * 4 + 3] * il);
                    *(u32x2*)(orow + 32 * dt + 8 * i4 + 4 * hh) = o;
                }
        }
#undef MLA_DMA
    }
    __syncthreads();
}

DI void ph_cmp_bias(const MP& p) {
    const int tix = tid_opaque();
    const int e = tix & 127, sub = tix >> 7;
    for (int u = blockIdx.x; u < 64; u += gridDim.x) {
        const int which = u >> 5, l = u & 31;
        const float* pp = p.cmp_pos + ((size_t)which * 32 + l) * 128;
        const float* ww = p.cmp_w + ((size_t)which * 4096 + (size_t)l * 128) * 128;
        float a = 0.f;
        for (int d = sub * 32; d < sub * 32 + 32; ++d) a += pp[d] * ww[(size_t)d * 128 + e];
        p.cpart[(((size_t)which * 32 + l) * 4 + sub) * 128 + e] = a;
    }
}

#define MFMA16(a, b, c) __builtin_amdgcn_mfma_f32_16x16x32_bf16((a), (b), (c), 0, 0, 0)
constexpr int NSA_ACC_STRIDE = 132;
constexpr int NSA_ACC_WAVE = 32 * NSA_ACC_STRIDE;
template <int BR = 7> DI void ph_nsa_attn(LAS unsigned char* lds, const MP& p) {
    const int tix = tid_opaque();
    const int w = tix >> 6, lane = tix & 63, r = lane & 31, hh = lane >> 5, c16 = lane & 15, kg = lane >> 4;
    LAS float* acc = (LAS float*)lds + w * NSA_ACC_WAVE;
    const bf16_t* hb = p.hbuf;
    const float c2 = 0.08838834764831845f * 1.4426950408889634f;
    for (int unit = blockIdx.x; unit < NB * 2 * 32; unit += gridDim.x) {
        const int bg = unit & 15, qb = unit >> 4, b = bg >> 1, g = bg & 1;
        for (int sub = 0; sub < 2; ++sub) {
            const int s0 = qb * 64 + __builtin_amdgcn_readfirstlane(w) * 8 + sub * 4;
            unsigned selp0 = 0u, selp1 = 0u;
            if constexpr ((BR & 1) != 0) {
                const int lz = tid_opaque(); const int r = lz & 31, hh = (lz >> 5) & 1; LAS float* acc = (LAS float*)lds + (lz >> 6) * NSA_ACC_WAVE;
                const int sq = s0 + (r >> 3), head = r & 7;
                const long tq = (long)b * SEQ + sq;
                const float g0 = sigmoidf_(ldh(hb + tq * AB_IN + AB_G + (g * 8 + head) * 3, 0));
                bf16x8 qf[8];
#pragma unroll
                for (int st = 0; st < 8; ++st) qf[st] = ld8(hb + tq * AB_IN + AB_Q + (g * 8 + head) * 128 + 16 * st + 8 * hh);
                const int nv_lane = sq >= 31 ? (sq - 31) / 16 + 1 : 0;
                const int nv_max = (s0 + 3 >= 31) ? (s0 + 3 - 31) / 16 + 1 : 0;
                const int nkt = (nv_max + 31) >> 5;
                float m = -INFINITY, l = 0.f;
                for (int kt = 0; kt < nkt; ++kt) {
                    const bf16_t* kp = p.kcb + lnd(((size_t)(bg * 128 + 32 * kt + r)) * 128 + 8 * hh);
                    bf16x8 kf[8];
#pragma unroll
                    for (int st = 0; st < 8; ++st) kf[st] = ld8(kp + 16 * st);
                    __builtin_amdgcn_sched_barrier(0);
                    f32x16 S;
#pragma unroll
                    for (int i = 0; i < 16; ++i) S[i] = 0.f;
#pragma unroll
                    for (int st = 0; st < 8; ++st) S = MFMA32(kf[st], qf[st], S);
                    float mx = -INFINITY;
#pragma unroll
                    for (int i = 0; i < 16; ++i) { const int key = 32 * kt + (i & 3) + 8 * (i >> 2) + 4 * hh; if (key >= nv_lane) S[i] = -INFINITY; mx = fmaxf(mx, S[i]); }
                    mx = fmaxf(mx, __shfl_xor(mx, 32));
                    const float mn = fmaxf(m, mx);
                    const float mm = (mn == -INFINITY) ? 0.f : mn;
                    float rs = 0.f;
#pragma unroll
                    for (int i = 0; i < 16; ++i) rs += __builtin_amdgcn_exp2f((S[i] - mm) * c2);
                    rs += __shfl_xor(rs, 32);
                    l = l * __builtin_amdgcn_exp2f((m - mm) * c2) + rs;
                    m = mn;
                }
                const float mm = (m == -INFINITY) ? 0.f : m;
                const float il = l > 0.f ? 1.f / l : 0.f;
                float A[16];
                float prev_same = 0.f;
                f32x16 O[4];
#pragma unroll
                for (int dt = 0; dt < 4; ++dt)
#pragma unroll
                    for (int i = 0; i < 16; ++i) O[dt][i] = 0.f;
#pragma unroll
                for (int kt = 0; kt < 4; ++kt) {
                    if (kt < nkt) {
                        f32x16 S;
#pragma unroll
                        for (int i = 0; i < 16; ++i) S[i] = 0.f;
                        const bf16_t* kp = p.kcb + lnd(((size_t)(bg * 128 + 32 * kt + r)) * 128 + 8 * hh);
                        const bf16_t* vp = p.vcT + lnd(((size_t)(bg * 128 + r)) * 128 + 32 * kt + 8 * hh);
                        bf16x8 kf[8], vf[4];
#pragma unroll
                        for (int st = 0; st < 8; ++st) kf[st] = ld8(kp + 16 * st);
                        __builtin_amdgcn_sched_barrier(0);
#pragma unroll
                        for (int st = 0; st < 8; ++st) S = MFMA32(kf[st], qf[st], S);
                        __builtin_amdgcn_sched_barrier(0);
#pragma unroll
                        for (int dt = 0; dt < 2; ++dt) { vf[2 * dt] = ld8(vp + (size_t)(32 * dt) * 128); vf[2 * dt + 1] = ld8(vp + (size_t)(32 * dt) * 128 + 16); }
                        __builtin_amdgcn_sched_barrier(0);
#pragma unroll
                        for (int i = 0; i < 16; ++i) { const int key = 32 * kt + (i & 3) + 8 * (i >> 2) + 4 * hh; S[i] = (key < nv_lane) ? __builtin_amdgcn_exp2f((S[i] - mm) * c2) * il : 0.f; }
#pragma unroll
                        for (int c4 = 0; c4 < 4; ++c4) { const int i = 4 * c4;
                            const float part = S[i] + S[i + 1] + S[i + 2] + 0.5f * S[i + 3], car = 0.5f * S[i + 3];
                            const float same = __shfl_xor(car, 32);
                            float av = part + (hh ? same : prev_same); prev_same = same;
                            av += __shfl_xor(av, 1); av += __shfl_xor(av, 2); av += __shfl_xor(av, 4);
                            A[4 * kt + c4] = av; }
                        const bf16x8 pf0 = pack8(S[0], S[1], S[2], S[3], S[4], S[5], S[6], S[7]);
                        const bf16x8 pf1 = pack8(S[8], S[9], S[10], S[11], S[12], S[13], S[14], S[15]);
#pragma unroll
                        for (int dt = 0; dt < 2; ++dt) { O[dt] = MFMA32(vf[2 * dt], pf0, O[dt]); O[dt] = MFMA32(vf[2 * dt + 1], pf1, O[dt]); }
                        __builtin_amdgcn_sched_barrier(0);
#pragma unroll
                        for (int dt = 2; dt < 4; ++dt) { vf[2 * dt - 4] = ld8(vp + (size_t)(32 * dt) * 128); vf[2 * dt - 3] = ld8(vp + (size_t)(32 * dt) * 128 + 16); }
                        __builtin_amdgcn_sched_barrier(0);
#pragma unroll
                        for (int dt = 2; dt < 4; ++dt) { O[dt] = MFMA32(vf[2 * dt - 4], pf0, O[dt]); O[dt] = MFMA32(vf[2 * dt - 3], pf1, O[dt]); }
                    } else {
#pragma unroll
                        for (int c4 = 0; c4 < 4; ++c4) { float av = hh ? 0.f : prev_same; prev_same = 0.f; av += __shfl_xor(av, 1); av += __shfl_xor(av, 2); av += __shfl_xor(av, 4); A[4 * kt + c4] = av; }
                    }
                    __builtin_amdgcn_sched_barrier(0);
                }
#pragma unroll
                for (int dt = 0; dt < 4; ++dt)
#pragma unroll
                    for (int i4 = 0; i4 < 4; ++i4) { f32x4 o4; o4[0] = g0 * O[dt][4 * i4]; o4[1] = g0 * O[dt][4 * i4 + 1]; o4[2] = g0 * O[dt][4 * i4 + 2]; o4[3] = g0 * O[dt][4 * i4 + 3];
                        *(LAS f32x4*)(acc + r * NSA_ACC_STRIDE + 32 * dt + 8 * i4 + 4 * hh) = o4; }
                __builtin_amdgcn_sched_barrier(0);
                const int cur = sq >> 6;
#pragma unroll
                for (int q = 0; q < 16; ++q) { const int j = 2 * q + hh; const bool forced = (j == 0) || (j == cur) || (j == cur - 1); A[q] = forced ? 1.0e6f : (j <= cur ? A[q] : -1.0f); }
#pragma unroll
                for (int n = 0; n < 8; ++n) {
                    float bv = A[0]; int bj = hh;
#pragma unroll
                    for (int q = 1; q < 16; ++q) { if (A[q] > bv) { bv = A[q]; bj = 2 * q + hh; } }
                    const float ov = __shfl_xor(bv, 32); const int oj = __shfl_xor(bj, 32);
                    const bool take_other = (ov > bv) || (ov == bv && oj < bj);
                    const int wj = take_other ? oj : bj;
                    if (n < 4) selp0 |= (unsigned)wj << (8 * n); else selp1 |= (unsigned)wj << (8 * (n - 4));
#pragma unroll
                    for (int q = 0; q < 16; ++q) if (2 * q + hh == wj) A[q] = -INFINITY;
                }
            }
            __builtin_amdgcn_sched_barrier(0);
            if constexpr ((BR & 2) != 0) {
                const int lz = tid_opaque(); const int r = lz & 31, hh = (lz >> 5) & 1; LAS float* acc = (LAS float*)lds + (lz >> 6) * NSA_ACC_WAVE;
                const int sq = s0 + (r >> 3), head = r & 7;
                const long tq = (long)b * SEQ + sq;
                bf16x8 qw[8];
                { const bf16_t* qp = hb + lnd((size_t)tq * AB_IN + AB_Q + (g * 8 + head) * 128 + 8 * hh);
#pragma unroll
                  for (int st = 0; st < 8; ++st) qw[st] = ld8(qp + 16 * st); }
                f32x16 O[4];
#pragma unroll
                for (int dt = 0; dt < 4; ++dt)
#pragma unroll
                    for (int i = 0; i < 16; ++i) O[dt][i] = 0.f;
                float m = -INFINITY, l = 0.f;
                const int klo = s0 - 511 > 0 ? s0 - 511 : 0;
                const int kt_lo = klo >> 5, kt_hi = (s0 + 3) >> 5;
                for (int kt = kt_lo; kt <= kt_hi; ++kt) {
                    const size_t fo = lnd((((size_t)bg * 64 + kt) * 8 * 64 + (lz & 63)) * 8);
                    const bf16_t* kp = p.kwf + fo; const bf16_t* vb = p.vwinT + fo;
                    bf16x8 kf[8], vf[8];
#pragma unroll
                    for (int st = 0; st < 8; ++st) kf[st] = ld8(kp + st * 512);
                    __builtin_amdgcn_sched_barrier(0);
                    f32x16 S;
#pragma unroll
                    for (int i = 0; i < 16; ++i) S[i] = 0.f;
#pragma unroll
                    for (int st = 0; st < 8; ++st) S = MFMA32(kf[st], qw[st], S);
                    __builtin_amdgcn_sched_barrier(0);
#pragma unroll
                    for (int f = 0; f < 8; ++f) vf[f] = ld8(vb + f * 512);
                    __builtin_amdgcn_sched_barrier(0);
#pragma unroll
                    for (int i = 0; i < 16; ++i) { const int key = 32 * kt + (i & 3) + 8 * (i >> 2) + 4 * hh; if (key > sq || key <= sq - 512) S[i] = -INFINITY; }
                    float mx = S[0];
#pragma unroll
                    for (int i = 1; i < 16; ++i) mx = fmaxf(mx, S[i]);
                    if (__any((mx - m) * c2 > 24.f)) {
                        const float cm = fmaxf(mx, __shfl_xor(mx, 32));
                        const float mn = fmaxf(m, cm);
                        const float alpha = (m == -INFINITY) ? 0.f : __builtin_amdgcn_exp2f((m - mn) * c2);
                        l *= alpha;
#pragma unroll
                        for (int dt = 0; dt < 4; ++dt)
#pragma unroll
                            for (int i = 0; i < 16; ++i) O[dt][i] *= alpha;
                        m = mn;
                    }
                    const float mr = (m == -INFINITY) ? 0.f : m;
#pragma unroll
                    for (int i = 0; i < 16; ++i) { S[i] = __builtin_amdgcn_exp2f((S[i] - mr) * c2); l += S[i]; }
                    const bf16x8 pf0 = pack8(S[0], S[1], S[2], S[3], S[4], S[5], S[6], S[7]);
                    const bf16x8 pf1 = pack8(S[8], S[9], S[10], S[11], S[12], S[13], S[14], S[15]);
#pragma unroll
                    for (int dt = 0; dt < 4; ++dt) { O[dt] = MFMA32(vf[dt * 2], pf0, O[dt]); O[dt] = MFMA32(vf[dt * 2 + 1], pf1, O[dt]); }
                }
                l += __shfl_xor(l, 32);
                const float sc = sigmoidf_(ldh(hb + tq * AB_IN + AB_G + (g * 8 + head) * 3, 2)) / l;
#pragma unroll
                for (int dt = 0; dt < 4; ++dt)
#pragma unroll
                    for (int i4 = 0; i4 < 4; ++i4) { LAS f32x4* ap = (LAS f32x4*)(acc + r * NSA_ACC_STRIDE + 32 * dt + 8 * i4 + 4 * hh); f32x4 o4 = *ap;
                        o4[0] += sc * O[dt][4 * i4]; o4[1] += sc * O[dt][4 * i4 + 1]; o4[2] += sc * O[dt][4 * i4 + 2]; o4[3] += sc * O[dt][4 * i4 + 3]; *ap = o4; }
            }
            __builtin_amdgcn_sched_barrier(0); asm volatile("" ::: "memory");
            if constexpr ((BR & 4) != 0)
#pragma unroll 1
            for (int pr = 0; pr < 2; ++pr) {
                const int lz = tid_opaque(); const int c16 = lz & 15, kg = (lz >> 4) & 3; LAS float* acc = (LAS float*)lds + (lz >> 6) * NSA_ACC_WAVE;
                const bf16_t* kbase = p.ksf + (((size_t)bg * 128) * 4 * 64 + (lz & 63)) * 8;
                const bf16_t* vbase = p.vselT + (((size_t)bg * 64) * 8 * 64 + (lz & 63)) * 8;
                const int cur = qb;
#define NSA_KEY0(it_) ((int)((((it_) < 8 ? sp0 : sp1) >> (8 * (((it_) >> 1) & 3))) & 0xffu) * 64 + 32 * ((it_) & 1))
#define NSA_LOADK(it_) do { const int k0_ = NSA_KEY0(it_); const bf16_t* kp_ = kbase + (size_t)(k0_ >> 4) * 2048; \
        _Pragma("unroll") for (int st = 0; st < 4; ++st) { kR[st] = ld8(kp_ + st * 512); kR[4 + st] = ld8(kp_ + 2048 + st * 512); } } while (0)
#define NSA_LOADV(it_) do { const int k0_ = NSA_KEY0(it_); const bf16_t* vp_ = vbase + (size_t)(k0_ >> 5) * 4096; \
        _Pragma("unroll") for (int dt = 0; dt < 8; ++dt) vR[dt] = ld8(vp_ + dt * 512); } while (0)
#define NSA_SOFTMAX_PV(SQL_, SQMIN_, O_, M_, L_) do { \
                        if (key0 + 31 > (SQMIN_)) { \
                            _Pragma("unroll") for (int i = 0; i < 4; ++i) { if (key0 + 4 * kg + i > (SQL_)) Sa[i] = -INFINITY; if (key0 + 16 + 4 * kg + i > (SQL_)) Sb[i] = -INFINITY; } \
                        } \
                        const float mx = fmaxf(fmaxf(fmaxf(Sa[0], Sa[1]), fmaxf(Sa[2], Sa[3])), fmaxf(fmaxf(Sb[0], Sb[1]), fmaxf(Sb[2], Sb[3]))); \
                        if (__any((mx - M_) * c2 > 24.f)) { \
                            float cm = fmaxf(mx, __shfl_xor(mx, 16)); cm = fmaxf(cm, __shfl_xor(cm, 32)); \
                            const float mn = fmaxf(M_, cm); \
                            const float alpha = (M_ == -INFINITY) ? 0.f : __builtin_amdgcn_exp2f((M_ - mn) * c2); \
                            L_ *= alpha; \
                            _Pragma("unroll") for (int dt = 0; dt < 8; ++dt) O_[dt] *= alpha; \
                            M_ = mn; \
                        } \
                        const float mr_ = (M_ == -INFINITY) ? 0.f : -M_ * c2; \
                        float pa[4], pb[4]; \
                        _Pragma("unroll") for (int i = 0; i < 4; ++i) { pa[i] = __builtin_amdgcn_exp2f(__builtin_fmaf(Sa[i], c2, mr_)); pb[i] = __builtin_amdgcn_exp2f(__builtin_fmaf(Sb[i], c2, mr_)); L_ += pa[i] + pb[i]; } \
                        const bf16x8 pf = pack8(pa[0], pa[1], pa[2], pa[3], pb[0], pb[1], pb[2], pb[3]); \
                        _Pragma("unroll") for (int dt = 0; dt < 8; ++dt) O_[dt] = MFMA16(vR[dt], pf, O_[dt]); \
                    } while (0)
#define NSA_CHUNKS(SQL_, SQMIN_, Q_, O_, M_, L_) do { \
                    bf16x8 kR[8], vR[8]; \
                    int it = vmask ? (__builtin_ctz(vmask)) : 16; \
                    { const int i0_ = it < 16 ? it : 0; NSA_LOADK(i0_); NSA_LOADV(i0_); } \
                    if (it < 16) { \
                        f32x4 Sa, Sb; int key0; \
                        __builtin_amdgcn_s_waitcnt(0x0F70);      \
                        for (;;) { \
                            const unsigned rem = (it < 15) ? (vmask >> (it + 1)) : 0u; \
                            const int nx = rem ? it + 1 + __builtin_ctz(rem) : 16; \
                            key0 = NSA_KEY0(it); \
                            Sa = (f32x4){0.f, 0.f, 0.f, 0.f}; Sb = (f32x4){0.f, 0.f, 0.f, 0.f}; \
                            _Pragma("unroll") for (int st = 0; st < 4; ++st) { Sa = MFMA16(kR[st], Q_[st], Sa); Sb = MFMA16(kR[4 + st], Q_[st], Sb); } \
                            __builtin_amdgcn_sched_barrier(0); \
                            if (nx >= 16) break; \
                            NSA_LOADK(nx); \
                            __builtin_amdgcn_sched_barrier(0); \
                            NSA_SOFTMAX_PV(SQL_, SQMIN_, O_, M_, L_); \
                            __builtin_amdgcn_sched_barrier(0); \
                            NSA_LOADV(nx); \
                            it = nx; \
                        } \
                        NSA_SOFTMAX_PV(SQL_, SQMIN_, O_, M_, L_); \
                    } } while (0)
                f32x4 O1[8];
#pragma unroll
                for (int dt = 0; dt < 8; ++dt) O1[dt] = (f32x4){0.f, 0.f, 0.f, 0.f};
                float m1 = -INFINITY, l1 = 0.f;
                {
                    const int sqL = s0 + 2 * pr + (c16 >> 3);
                    const long tqL = (long)b * SEQ + sqL;
                    bf16x8 qP[4];
#pragma unroll
                    for (int st = 0; st < 4; ++st) qP[st] = ld8(hb + tqL * AB_IN + AB_Q + (g * 8 + (c16 & 7)) * 128 + 32 * st + 8 * kg);
                    const int sqmax = s0 + 2 * pr + 1;
                    const unsigned sp0 = cur >= 2 ? (((unsigned)(cur - 1) << 8) | ((unsigned)cur << 16)) : (cur == 1 ? (1u << 8) : 0u), sp1 = 0u;
                    const int nf = cur >= 2 ? 3 : cur + 1;
                    unsigned vmask = 0u;
#pragma unroll
                    for (int n = 0; n < 3; ++n) { const int jb = (int)((sp0 >> (8 * n)) & 0xffu); if (n < nf) { if (jb * 64 <= sqmax) vmask |= 1u << (2 * n); if (jb * 64 + 32 <= sqmax) vmask |= 2u << (2 * n); } }
                    NSA_CHUNKS(sqL, s0 + 2 * pr, qP, O1, m1, l1);
                }
                __builtin_amdgcn_sched_barrier(0);
#pragma unroll 1
                for (int qi = 0; qi < 2; ++qi) {
                    const int ql = 2 * pr + qi;
                    const int sq2 = s0 + ql; const long tq2 = (long)b * SEQ + sq2;
                    bf16x8 q16[4];
#pragma unroll
                    for (int st = 0; st < 4; ++st) q16[st] = ld8(hb + tq2 * AB_IN + AB_Q + (g * 8 + (c16 & 7)) * 128 + 32 * st + 8 * kg);
                    const float g1q = sigmoidf_(ldh(hb + tq2 * AB_IN + AB_G + (g * 8 + (c16 & 7)) * 3, 1));
                    f32x4 O16[8];
#pragma unroll
                    for (int dt = 0; dt < 8; ++dt) O16[dt] = (f32x4){0.f, 0.f, 0.f, 0.f};
                    const int src = (lz & 0x37) | (qi << 3);
                    const float m0 = __shfl(m1, src);
                    float m = m0, l = __shfl(l1, src);
                    const unsigned sp0 = (unsigned)__builtin_amdgcn_readfirstlane(__shfl((int)selp0, ql * 8)), sp1 = (unsigned)__builtin_amdgcn_readfirstlane(__shfl((int)selp1, ql * 8));
                    unsigned vmask = 0u;
#pragma unroll
                    for (int n = 0; n < 8; ++n) { const int jb = (int)(((n < 4 ? sp0 : sp1) >> (8 * (n & 3))) & 0xffu);
                        const bool forced = (jb == 0) || (jb == cur) || (jb == cur - 1);
                        if (!forced) { if (jb * 64 <= sq2) vmask |= 1u << (2 * n); if (jb * 64 + 32 <= sq2) vmask |= 2u << (2 * n); } }
                    NSA_CHUNKS(sq2, sq2, q16, O16, m, l);
                    l += __shfl_xor(l, 16); l += __shfl_xor(l, 32);
                    const float sc = g1q / l;
                    const float f1 = sc * __builtin_amdgcn_exp2f((m0 - m) * c2);
                    if ((c16 >> 3) == qi) {
#pragma unroll
                        for (int dt = 0; dt < 8; ++dt) { LAS f32x4* ap = (LAS f32x4*)(acc + (ql * 8 + (c16 & 7)) * NSA_ACC_STRIDE + 16 * dt + 4 * kg); f32x4 o4 = *ap;
                            o4[0] += sc * O16[dt][0] + f1 * O1[dt][0]; o4[1] += sc * O16[dt][1] + f1 * O1[dt][1]; o4[2] += sc * O16[dt][2] + f1 * O1[dt][2]; o4[3] += sc * O16[dt][3] + f1 * O1[dt][3]; *ap = o4; }
                    }
                }
#undef NSA_CHUNKS
#undef NSA_SOFTMAX_PV
#undef NSA_LOADK
#undef NSA_LOADV
#undef NSA_KEY0
            }
            asm volatile("s_waitcnt lgkmcnt(0)" ::: "memory");
            {
                const int lz = tid_opaque(); const int lane = lz & 63; LAS float* acc = (LAS float*)lds + (lz >> 6) * NSA_ACC_WAVE;
                const int row = lane >> 1, dh = (lane & 1) * 64;
                const long tt = (long)b * SEQ + s0 + (row >> 3);
                bf16_t* op = p.mixb + tt * 4096 + 2048 + (g * 8 + (row & 7)) * 128 + dh;
#pragma unroll
                for (int k8 = 0; k8 < 8; ++k8) {
                    const f32x4 a = *(const LAS f32x4*)(acc + row * NSA_ACC_STRIDE + dh + 8 * k8), c = *(const LAS f32x4*)(acc + row * NSA_ACC_STRIDE + dh + 8 * k8 + 4);
                    u32x4 o; o.x = pk_bf16(a[0], a[1]); o.y = pk_bf16(a[2], a[3]); o.z = pk_bf16(c[0], c[1]); o.w = pk_bf16(c[2], c[3]);
                    *(u32x4*)(op + 8 * k8) = o;
                }
            }
            asm volatile("s_waitcnt lgkmcnt(0)" ::: "memory");
        }
    }
}

DI void ph_conv_ssd(LAS unsigned char* lds, const MP& p) {
    const int tix = tid_opaque();
    LAS bf16_t* tile = (LAS bf16_t*)lds;
    const int tok = tix >> 3, c8 = (tix & 7) * 8;
    bf16_t* xT = (bf16_t*)p.xbc; bf16_t* BT = xT + (size_t)NB * 2048 * 2048; bf16_t* bcr = BT + (size_t)NB * 512 * 2048;
    const int cskip = (gridDim.x >= 64) ? 16 : 0;
    if ((int)blockIdx.x < cskip) return;
    for (int u = blockIdx.x - cskip; u < NB * 32 * 48; u += gridDim.x - cskip) {
        const int ct = u % 48, tt = (u / 48) & 31, b = u / (48 * 32);
        const int c0 = ct * 64, s = tt * 64 + tok; const long t = (long)b * SEQ + s;
        float a[8];
        { const float4 b0 = *(const float4*)(p.conv_b + c0 + c8), b1 = *(const float4*)(p.conv_b + c0 + c8 + 4); a[0] = b0.x; a[1] = b0.y; a[2] = b0.z; a[3] = b0.w; a[4] = b1.x; a[5] = b1.y; a[6] = b1.z; a[7] = b1.w; }
#pragma unroll
        for (int k = 0; k < 4; ++k) {
            if (s - 3 + k >= 0) {
                const u32x4 hv = *(const u32x4*)(p.hbuf + (t - 3 + k) * AB_IN + AB_XBC + c0 + c8);
                const float4 w0 = *(const float4*)(p.conv_w + k * 3072 + c0 + c8), w1 = *(const float4*)(p.conv_w + k * 3072 + c0 + c8 + 4);
                a[0] += w0.x * bflo(hv.x); a[1] += w0.y * bfhi(hv.x); a[2] += w0.z * bflo(hv.y); a[3] += w0.w * bfhi(hv.y);
                a[4] += w1.x * bflo(hv.z); a[5] += w1.y * bfhi(hv.z); a[6] += w1.z * bflo(hv.w); a[7] += w1.w * bfhi(hv.w);
            }
        }
#pragma unroll
        for (int e = 0; e < 8; ++e) a[e] = siluf_(a[e]);
        if (ct >= 32) { u32x4 o; o.x = pk_bf16(a[0], a[1]); o.y = pk_bf16(a[2], a[3]); o.z = pk_bf16(a[4], a[5]); o.w = pk_bf16(a[6], a[7]); *(u32x4*)(bcr + t * 1024 + (c0 - 2048) + c8) = o; }
        if (ct < 40) {
#pragma unroll
            for (int e = 0; e < 8; ++e) tile[(c8 + e) * 72 + tok] = f2bf(a[e]);
        }
        __syncthreads();
        if (ct < 40) {
            const int ch = tix >> 3, tg = tix & 7;
            const u32x4 v = *(const LAS u32x4*)(tile + ch * 72 + 8 * tg);
            const int c = c0 + ch;
            bf16_t* dst = (ct < 32) ? xT + ((size_t)b * 2048 + c) * 2048 : BT + ((size_t)b * 512 + (c - 2048)) * 2048;
            const int pos = tt * 64 + 16 * (tg >> 1) + 4 * (tg & 1);
            u32x2 lo; lo.x = v.x; lo.y = v.y; u32x2 hi; hi.x = v.z; hi.y = v.w;
            *(u32x2*)(dst + pos) = lo; *(u32x2*)(dst + pos + 8) = hi;
        }
        __syncthreads();
    }
}

DI void ph_ssd_chunk(LAS unsigned char* lds, const MP& p) {
    const int tix = tid_opaque();
    const int w = tix >> 6, lane = tix & 63, r = lane & 31, hh = lane >> 5, pt = w >> 2, lt = w & 3;
    LAS bf16_t* S_base = (LAS bf16_t*)lds;
    LAS float* acs_all = (LAS float*)(lds + 2 * 64 * 136 * 2);
    LAS float* dts_all = acs_all + 2048;
    LAS float* wl_all = dts_all + 2048;
    const bf16_t* xT = (const bf16_t*)p.xbc; const bf16_t* BT = xT + (size_t)NB * 2048 * 2048; const bf16_t* bcr = BT + (size_t)NB * 512 * 2048;
    const float L2E = 1.4426950408889634f;
    for (int unit = blockIdx.x; unit < NB * 32; unit += gridDim.x) {
        const int b = unit >> 5, h = unit & 31, g = h >> 3;
        const float a = -__expf(p.a_log[h]), dbias = p.dt_bias[h], dskip = p.ssm_d[h];
        f32x16 S;
#pragma unroll
        for (int i = 0; i < 16; ++i) S[i] = 0.f;
        __syncthreads();
#pragma unroll
        for (int cc = 0; cc < 2; ++cc) {
            const int c = 2 * w + cc; const long t0 = (long)b * SEQ + c * 128;
            const float d0 = softplusf_(ldh(p.hbuf, (t0 + 2 * lane) * AB_IN + AB_DT + h) + dbias), d1 = softplusf_(ldh(p.hbuf, (t0 + 2 * lane + 1) * AB_IN + AB_DT + h) + dbias);
            const float a0 = d0 * a, a1 = d1 * a;
            float run = a0 + a1;
#pragma unroll
            for (int o = 1; o < 64; o <<= 1) { const float v = __shfl_up(run, o); if (lane >= o) run += v; }
            const float tot = __shfl(run, 63);
            const float cs1 = run, cs0 = run - a1;
            acs_all[c * 128 + 2 * lane] = cs0; acs_all[c * 128 + 2 * lane + 1] = cs1; dts_all[c * 128 + 2 * lane] = d0; dts_all[c * 128 + 2 * lane + 1] = d1;
            wl_all[c * 128 + 2 * lane] = d0 * __expf(tot - cs0); wl_all[c * 128 + 2 * lane + 1] = d1 * __expf(tot - cs1);
        }
        for (int c = 0; c < 16; ++c) {
            const long t0 = (long)b * SEQ + c * 128;
            LAS bf16_t* S_lds = S_base + (c & 1) * (64 * 136);
            const LAS float* acs = acs_all + c * 128; const LAS float* dts = dts_all + c * 128; const LAS float* wl = wl_all + c * 128;
#pragma unroll
            for (int i = 0; i < 16; ++i) S_lds[(32 * pt + (i & 3) + 8 * (i >> 2) + 4 * hh) * 136 + 32 * lt + r] = f2bf(S[i]);
            __syncthreads();
            const float acl = acs[32 * lt + r];
            bf16x8 cf[8], xs[8], bs[8];
            u32x2 zv[4];
            {
                const bf16_t* cp = bcr + lnd((size_t)(t0 + 32 * lt + r) * 1024 + 512 + g * 128 + 8 * hh);
                const bf16_t* xsp = xT + lnd(((size_t)b * 2048 + h * 64 + 32 * pt + r) * 2048 + c * 128 + 8 * hh);
                const bf16_t* bsp = BT + lnd(((size_t)b * 512 + g * 128 + 32 * lt + r) * 2048 + c * 128 + 8 * hh);
                const bf16_t* zp = p.hbuf + lnd((size_t)(t0 + 32 * lt + r) * AB_IN + AB_Z + h * 64 + 32 * pt + 4 * hh);
#pragma unroll
                for (int st = 0; st < 8; ++st) cf[st] = ld8(cp + 16 * st);
#pragma unroll
                for (int st = 0; st < 8; ++st) { xs[st] = ld8(xsp + 16 * st); bs[st] = ld8(bsp + 16 * st); }
#pragma unroll
                for (int i4 = 0; i4 < 4; ++i4) zv[i4] = *(const u32x2*)(zp + 8 * i4);
            }
            bf16x8 sl[8];
#pragma unroll
            for (int st = 0; st < 8; ++st) sl[st] = *(const LAS bf16x8*)(S_lds + (32 * pt + r) * 136 + 16 * st + 8 * hh);
            __builtin_amdgcn_sched_barrier(0);
            f32x16 Y;
#pragma unroll
            for (int i = 0; i < 16; ++i) Y[i] = 0.f;
#pragma unroll
            for (int st = 0; st < 8; ++st) Y = MFMA32(sl[st], cf[st], Y);
            { const float ea = __expf(acl);
#pragma unroll
              for (int i = 0; i < 16; ++i) Y[i] *= ea; }
            for (int stile = 0; stile <= lt; ++stile) {
                const bf16_t* bp = bcr + lnd((size_t)(t0 + 32 * stile + r) * 1024 + g * 128 + 8 * hh);
                const bf16_t* xp = xT + lnd(((size_t)b * 2048 + h * 64 + 32 * pt + r) * 2048 + c * 128 + 32 * stile + 8 * hh);
                bf16x8 bf[8];
#pragma unroll
                for (int st = 0; st < 8; ++st) bf[st] = ld8(bp + 16 * st);
                const bf16x8 xa = ld8(xp), xb2 = ld8(xp + 16);
                __builtin_amdgcn_sched_barrier(0);
                f32x16 G;
#pragma unroll
                for (int i = 0; i < 16; ++i) G[i] = 0.f;
#pragma unroll
                for (int st = 0; st < 8; ++st) G = MFMA32(bf[st], cf[st], G);
#pragma unroll
                for (int i = 0; i < 16; ++i) {
                    const int sl2 = 32 * stile + (i & 3) + 8 * (i >> 2) + 4 * hh, ll = 32 * lt + r;
                    float v = G[i] * __builtin_amdgcn_exp2f((acl - acs[sl2]) * L2E) * dts[sl2];
                    v = (sl2 <= ll) ? v : 0.f;
                    if (sl2 == ll) v += dskip;
                    G[i] = v;
                }
                const bf16x8 pg0 = pack8(G[0], G[1], G[2], G[3], G[4], G[5], G[6], G[7]);
                const bf16x8 pg1 = pack8(G[8], G[9], G[10], G[11], G[12], G[13], G[14], G[15]);
                Y = MFMA32(xa, pg0, Y); Y = MFMA32(xb2, pg1, Y);
            }
            {
                bf16_t* op = (bf16_t*)p.mix + (t0 + 32 * lt + r) * 4096 + h * 64 + 32 * pt + 4 * hh;
#pragma unroll
                for (int i4 = 0; i4 < 4; ++i4) {
                    u32x2 o; o.x = pk_bf16(Y[4 * i4] * siluf_(bflo(zv[i4].x)), Y[4 * i4 + 1] * siluf_(bfhi(zv[i4].x))); o.y = pk_bf16(Y[4 * i4 + 2] * siluf_(bflo(zv[i4].y)), Y[4 * i4 + 3] * siluf_(bfhi(zv[i4].y)));
                    *(u32x2*)(op + 8 * i4) = o;
                }
            }
            {
                f32x16 Sn;
#pragma unroll
                for (int i = 0; i < 16; ++i) Sn[i] = 0.f;
#pragma unroll
                for (int st = 0; st < 8; ++st) {
                    const bf16x8 xf = xs[st];
                    const f32x4 w0 = *(const LAS f32x4*)(wl + 16 * st + 4 * hh), w1 = *(const LAS f32x4*)(wl + 16 * st + 8 + 4 * hh);
                    const bf16x8 xw = pack8(bf2f((bf16_t)xf[0]) * w0[0], bf2f((bf16_t)xf[1]) * w0[1], bf2f((bf16_t)xf[2]) * w0[2], bf2f((bf16_t)xf[3]) * w0[3],
                                            bf2f((bf16_t)xf[4]) * w1[0], bf2f((bf16_t)xf[5]) * w1[1], bf2f((bf16_t)xf[6]) * w1[2], bf2f((bf16_t)xf[7]) * w1[3]);
                    Sn = MFMA32(xw, bs[st], Sn);
                }
                const float ed = __expf(acs[127]);
#pragma unroll
                for (int i = 0; i < 16; ++i) S[i] = S[i] * ed + Sn[i];
            }
        }
    }
    __syncthreads();
}

DI void ph_hgrn_chunk(LAS unsigned char* lds, const MP& p) {
    if (blockIdx.x >= NB * 16) return;
    const int tix = tid_opaque();
    const int w = tix >> 6, lane = tix & 63, r = lane & 31, hh = lane >> 5;
    LAS bf16_t* qt_l = (LAS bf16_t*)lds;
    LAS bf16_t* kt_l = qt_l + 64 * 136;
    LAS bf16_t* kendT = kt_l + 64 * 136;
    LAS bf16_t* S_l = kendT + 128 * 72;
    LAS float* bl = (LAS float*)(S_l + 2 * 128 * 136);
    LAS float* tot = bl + 128;
    const int b = blockIdx.x >> 4, h = blockIdx.x & 15;
    const bf16_t* viT = (const bf16_t*)p.bufB;
    const int d = tix & 127, tq = tix >> 7;
    const float lb = 1.f / (1.f + expf(p.lb_logits[h * 128 + d] - p.lb_logits[2048 + h * 128 + d]));
    const int vt = w >> 1, tt = w & 1;
    f32x16 S0, S1;
#pragma unroll
    for (int i = 0; i < 16; ++i) { S0[i] = 0.f; S1[i] = 0.f; }
    for (int i = tix; i < 128 * 136 / 2; i += NTHR) ((LAS unsigned*)S_l)[i] = 0u;
    bf16_t rawq[16], rawf[16];
#pragma unroll
    for (int i = 0; i < 16; ++i) { const size_t t = (size_t)b * SEQ + 16 * tq + i; rawq[i] = p.hbuf[t * CD_IN + CD_HQ + h * 128 + d]; rawf[i] = p.hbuf[t * CD_IN + CD_HF + h * 128 + d]; }
    for (int c = 0; c < 32; ++c) {
        const long t0 = (long)b * SEQ + c * 64;
        bf16x8 vfr[4];
        { const bf16_t* vp = viT + lnd(((size_t)(b * 16 + h) * 128 + 32 * vt + r) * 2048 + c * 64 + 8 * hh);
#pragma unroll
          for (int ks = 0; ks < 4; ++ks) vfr[ks] = ld8(vp + 16 * ks); }
        {
            float qv[16], kv[16], bq[16]; float cum = 0.f;
#pragma unroll
            for (int i = 0; i < 16; ++i) {
                const float hq = bf2f(rawq[i]), hf = bf2f(rawf[i]);
                const float sg = sigmoidf_(hf);
                cum += __logf(lb + (1.f - lb) * sg);
                bq[i] = cum; kv[i] = (1.f - lb) * (1.f - sg); qv[i] = siluf_(hq);
            }
            tot[tq * 128 + d] = cum;
            if (c + 1 < 32) {
#pragma unroll
                for (int i = 0; i < 16; ++i) { const size_t t = (size_t)t0 + 64 + 16 * tq + i; rawq[i] = p.hbuf[t * CD_IN + CD_HQ + h * 128 + d]; rawf[i] = p.hbuf[t * CD_IN + CD_HF + h * 128 + d]; }
            }
            __syncthreads();
            float off = 0.f, blast = 0.f;
#pragma unroll
            for (int q2 = 0; q2 < 4; ++q2) { const float tv = tot[q2 * 128 + d]; blast += tv; if (q2 < tq) off += tv; }
#pragma unroll
            for (int i = 0; i < 16; ++i) {
                const int tl = 16 * tq + i;
                const float bb = off + bq[i];
                qt_l[tl * 136 + d] = f2bf(qv[i] * __expf(bb));
                kt_l[tl * 136 + d] = f2bf(kv[i] * __expf(-bb));
                kendT[d * 72 + ((tl & ~12) | ((tl & 4) << 1) | ((tl & 8) >> 1))] = f2bf(kv[i] * __expf(blast - bb));
            }
            if (tq == 0) bl[d] = __expf(blast);
        }
        __syncthreads();
        const LAS bf16_t* Scur = S_l + (c & 1) * (128 * 136);
        LAS bf16_t* Snxt = S_l + ((c + 1) & 1) * (128 * 136);
        {
            bf16x8 qf[8], sf[8];
#pragma unroll
            for (int st = 0; st < 8; ++st) { qf[st] = *(const LAS bf16x8*)(qt_l + (32 * tt + r) * 136 + 16 * st + 8 * hh); sf[st] = *(const LAS bf16x8*)(Scur + (32 * vt + r) * 136 + 16 * st + 8 * hh); }
            __builtin_amdgcn_sched_barrier(0);
            f32x16 O;
#pragma unroll
            for (int i = 0; i < 16; ++i) O[i] = 0.f;
#pragma unroll
            for (int st = 0; st < 8; ++st) O = MFMA32(sf[st], qf[st], O);
            for (int stile = 0; stile <= tt; ++stile) {
                bf16x8 kf[8];
#pragma unroll
                for (int st = 0; st < 8; ++st) kf[st] = *(const LAS bf16x8*)(kt_l + (32 * stile + r) * 136 + 16 * st + 8 * hh);
                __builtin_amdgcn_sched_barrier(0);
                f32x16 AT;
#pragma unroll
                for (int i = 0; i < 16; ++i) AT[i] = 0.f;
#pragma unroll
                for (int st = 0; st < 8; ++st) AT = MFMA32(kf[st], qf[st], AT);
                if (stile == tt) {
#pragma unroll
                    for (int i = 0; i < 16; ++i) if (((i & 3) + 8 * (i >> 2) + 4 * hh) > r) AT[i] = 0.f;
                }
                const bf16x8 pa0 = pack8(AT[0], AT[1], AT[2], AT[3], AT[4], AT[5], AT[6], AT[7]);
                const bf16x8 pa1 = pack8(AT[8], AT[9], AT[10], AT[11], AT[12], AT[13], AT[14], AT[15]);
                if (stile == 0) { O = MFMA32(vfr[0], pa0, O); O = MFMA32(vfr[1], pa1, O); }
                else            { O = MFMA32(vfr[2], pa0, O); O = MFMA32(vfr[3], pa1, O); }
            }
            float* op = p.x3 + (t0 + 32 * tt + r) * 2048 + h * 128 + 32 * vt + 4 * hh;
#pragma unroll
            for (int i4 = 0; i4 < 4; ++i4) { f32x4 o; o[0] = O[4 * i4]; o[1] = O[4 * i4 + 1]; o[2] = O[4 * i4 + 2]; o[3] = O[4 * i4 + 3]; *(f32x4*)(op + 8 * i4) = o; }
        }
        {
            bf16x8 ke0[4], ke1[4];
#pragma unroll
            for (int ks = 0; ks < 4; ++ks) { ke0[ks] = *(const LAS bf16x8*)(kendT + (64 * tt + r) * 72 + 16 * ks + 8 * hh); ke1[ks] = *(const LAS bf16x8*)(kendT + (64 * tt + 32 + r) * 72 + 16 * ks + 8 * hh); }
            __builtin_amdgcn_sched_barrier(0);
            f32x16 N0, N1;
#pragma unroll
            for (int i = 0; i < 16; ++i) { N0[i] = 0.f; N1[i] = 0.f; }
#pragma unroll
            for (int ks = 0; ks < 4; ++ks) { N0 = MFMA32(vfr[ks], ke0[ks], N0); N1 = MFMA32(vfr[ks], ke1[ks], N1); }
            const float e0 = bl[64 * tt + r], e1 = bl[64 * tt + 32 + r];
#pragma unroll
            for (int i = 0; i < 16; ++i) { S0[i] = S0[i] * e0 + N0[i]; S1[i] = S1[i] * e1 + N1[i]; }
#pragma unroll
            for (int i = 0; i < 16; ++i) { const int v = 32 * vt + (i & 3) + 8 * (i >> 2) + 4 * hh; Snxt[v * 136 + 64 * tt + r] = f2bf(S0[i]); Snxt[v * 136 + 64 * tt + 32 + r] = f2bf(S1[i]); }
        }
        __syncthreads();
    }
}

DI gm::DenseProb mk_dense(const bf16_t* A, unsigned lda, const bf16_t* Bt, unsigned ldb, int M, int Npad, int K) {
    gm::DenseProb d; d.A = (const char*)A; d.Bt = (const char*)Bt; d.lda = lda; d.ldb = ldb; d.K = K; d.nM = M / 256; d.nN = Npad / 256; d.G = (int)gridDim.x; d.c = (int)blockIdx.x; return d;
}
DI void ph_gemm_bf16(LAS unsigned char* lds, const bf16_t* A, unsigned lda, const bf16_t* Bt, int M, int N, int Npad, int K, bf16_t* C, long ldc) {
    gm::EpiBf16 e; e.C = C; e.ldc = ldc; e.N = N; gm::gemm_phase(lds, mk_dense(A, lda, Bt, (unsigned)K, M, Npad, K), e);
}
DI void ph_gemm_f32(LAS unsigned char* lds, const bf16_t* A, unsigned lda, const bf16_t* Bt, int M, int N, int Npad, int K, float* C, long ldc) {
    gm::EpiF32 e; e.C = C; e.ldc = ldc; e.N = N; gm::gemm_phase(lds, mk_dense(A, lda, Bt, (unsigned)K, M, Npad, K), e);
}
DI int moe_tile_table(LAS unsigned char* lds, const MP& p) {
    const int tix = tid_opaque();
    LAS i32x2* ttab = (LAS i32x2*)(lds + LDS_TAB_OFF);
    const int nt = *p.ntiles;
    for (int i = tix; i < nt && i < 768; i += NTHR) { const int4 t = *(const int4*)(p.tiles + i * 4); i32x2 r; r.x = (t.x & 0xff) | (((t.z - 1) & 0xff) << 8) | (t.w << 16); r.y = t.y; ttab[i] = r; }
    __syncthreads();
    return nt < 768 ? nt : 768;
}
DI void ph_moe_gemm1(LAS unsigned char* lds, const MP& p) {
    const int nt = moe_tile_table(lds, p);
    gm::MoeG1Prob q; q.A = (const char*)p.xb; q.WgT = (const char*)p.WgT; q.WuT = (const char*)p.WuT; q.lda = DM; q.ldb = DM; q.K = DM; q.G = (int)gridDim.x; q.c = (int)blockIdx.x;
    q.ttab = (const LAS i32x2*)(lds + LDS_TAB_OFF); q.ntl = nt; q.row_tok = p.row_tok;
    gm::EpiSwiglu e; e.H = p.H; e.ttab = q.ttab;
    gm::gemm_phase(lds, q, e);
}
DI void ph_moe_gemm2(LAS unsigned char* lds, const MP& p) {
    const int nt = moe_tile_table(lds, p);
    gm::MoeG2Prob q; q.A = (const char*)p.H; q.WdT = (const char*)p.WdT; q.lda = 512; q.ldb = 512; q.K = 512; q.G = (int)gridDim.x; q.c = (int)blockIdx.x; q.ttab = (const LAS i32x2*)(lds + LDS_TAB_OFF); q.ntl = nt;
    gm::EpiMoeDown e; e.Y = p.Y; e.ttab = q.ttab;
    gm::gemm_phase(lds, q, e);
}

#ifndef PROBE_SEL
#define PROBE_SEL 0
#endif
#define RG(...) { __VA_ARGS__; if (PROBE_SEL == 1) { __VA_ARGS__; } }
#define RA(...) { __VA_ARGS__; if (PROBE_SEL == 2) { __VA_ARGS__; } }
#define RM(...) { __VA_ARGS__; if (PROBE_SEL == 3) { __VA_ARGS__; } }
#define RC(...) { __VA_ARGS__; if (PROBE_SEL == 4) { __VA_ARGS__; } }
__global__ __launch_bounds__(512, 2) void mega_fwd(MP p) {
    extern __shared__ __attribute__((aligned(16))) unsigned char shm[];
    LAS unsigned char* lds = (LAS unsigned char*)shm;
    volatile LAS unsigned* xbw = (volatile LAS unsigned*)(lds + LDS_BAR_OFF);
    if (threadIdx.x == 0) { xbw[0] = 0u; xbw[1] = 0u; xbw[2] = 0u; xbw[3] = 0u; }
    __syncthreads();
    (void)xcd_barrier_post(p.bar, xbw);
#define SYNC() do { XcdBarrier b_; b_.bar = p.bar; b_.x = xb_xcc_id(); b_.st = (volatile LAS unsigned*)(lds + LDS_BAR_OFF); xcd_barrier(b_); } while (0)
    RC(ph_cvt_wT(lds, p.ab_w_in, p.WinABt, DM, AB_IN, 8960, 1, (int)blockIdx.x, (int)gridDim.x);)
    RC(ph_cvt_x(p);)
    RC(ph_cmp_bias(p);)
    RC(ph_build_wr(p);)
    SYNC();
    { const int NG = (int)gridDim.x >= 256 ? CVQ_NG : (int)gridDim.x;
      if ((int)blockIdx.x < NG) { gm::EpiAB e; e.C = p.hbuf; e.vselT = p.vselT; e.vwinT = p.vwinT; e.ksf = p.ksf; e.kwf = p.kwf; gm::DenseProb d = mk_dense(p.xb, DM, p.WinABt, DM, T_TOK, 8960, DM); d.G = NG; d.c = (int)blockIdx.x; gm::gemm_phase(lds, d, e); }
      moe_cvt_queue(lds, p, 0, p.bar + XCD_BAR_WORDS); }
    SYNC();
    RG({ gm::CmpProb q; q.hb = (const char*)p.hbuf; q.Wt = (const char*)p.WcmpT; q.ldb = 4096; q.K = 4096; q.G = (int)gridDim.x; q.c = (int)blockIdx.x; gm::EpiCmp e; e.kc = p.kcb; e.vcT = p.vcT; e.cpart = p.cpart; gm::gemm_phase(lds, q, e); })
    RM(ph_conv_ssd(lds, p);)
    SYNC();
    RA(ph_ssd_chunk(lds, p);)
    RA(ph_nsa_attn(lds, p);)
    SYNC();
    RM(ph_ssd_norm(p);)
    SYNC();
    RG(ph_gemm_bf16(lds, p.mixb, 4096, p.WoutABt, T_TOK, DM, DM, 4096, (bf16_t*)p.bufA, DM);)
    SYNC();
    RM(ph_ln<false>(p, p.x, (const bf16_t*)p.bufA, p.ln_g, p.ln_b, p.xb, p.mixb);)
    SYNC();
    RG(ph_router_gemm(lds, p, 0, (float*)(p.mixb + (size_t)T_TOK * DM), p.mixb);)
    SYNC();
    RM(ph_route_select(p, (const float*)(p.mixb + (size_t)T_TOK * DM), p.router_bias);)
    SYNC();
    RM(ph_moe_scan(lds, p);)
    SYNC();
    RG(ph_moe_gemm1(lds, p);)
    SYNC();
    RG(ph_moe_gemm2(lds, p);)
    SYNC();
    RM(ph_moe_combine_ln(p, p.xb, p.mixb, p.ln_g + DM, p.ln_b + DM, (float*)nullptr, p.xb);)
    SYNC();
    { const int NG = (int)gridDim.x >= 256 ? CVQ_NG : (int)gridDim.x;
      if ((int)blockIdx.x < NG) { gm::EpiCD e; e.C = p.hbuf; e.viT = (bf16_t*)p.bufB; gm::DenseProb d = mk_dense(p.xb, DM, p.WinCDt, DM, T_TOK, 9472, DM); d.G = NG; d.c = (int)blockIdx.x; gm::gemm_phase(lds, d, e); }
      moe_cvt_queue(lds, p, 1, p.bar + XCD_BAR_WORDS + 32); }
    SYNC();
    RM(ph_mla_rms(p);)
    RM(ph_rope_k(p);)
    SYNC();
    if (gridDim.x >= 256) {
        if (blockIdx.x < 128) { RA(ph_hgrn_chunk(lds, p);) }
        else {
            const int G2 = (int)gridDim.x - 128, c2 = (int)blockIdx.x - 128;
            { gm::DenseProb d = mk_dense(p.cqb, 1024, p.Wuqt, 512, T_TOK, 3072, 512); d.G = G2; d.c = c2; gm::EpiBf16 e; e.C = (bf16_t*)p.xbc; e.ldc = 3072; e.N = 3072; RG(gm::gemm_phase(lds, d, e);) }
            { gm::DenseProb d = mk_dense(p.cqb + 512, 1024, p.Wukvt, 512, T_TOK, 4096, 512); d.G = G2; d.c = c2; gm::EpiKV e; e.kf = (bf16_t*)p.kvfrag; e.vf = (bf16_t*)p.kvfrag + (size_t)T_TOK * 2048; RG(gm::gemm_phase(lds, d, e);) }
        }
    } else {
        RA(ph_hgrn_chunk(lds, p);)
        SYNC();
        RG(ph_gemm_bf16(lds, p.cqb, 1024, p.Wuqt, T_TOK, 3072, 3072, 512, (bf16_t*)p.xbc, 3072);)
        RG({ gm::EpiKV e; e.kf = (bf16_t*)p.kvfrag; e.vf = (bf16_t*)p.kvfrag + (size_t)T_TOK * 2048; gm::gemm_phase(lds, mk_dense(p.cqb + 512, 1024, p.Wukvt, 512, T_TOK, 4096, 512), e); })
    }
    SYNC();
    RA(ph_mla_attn(lds, p);)
    RM(ph_hgrn_post(p);)
    SYNC();
    RG(ph_gemm_bf16(lds, p.mixb, 4096, p.WoutCDt, T_TOK, DM, DM, 4096, (bf16_t*)p.bufB, DM);)
    SYNC();
    RM(ph_ln<true>(p, p.xb, (const bf16_t*)p.bufB, p.ln_g + 2 * DM, p.ln_b + 2 * DM, p.xb, p.mixb);)
    SYNC();
    RG(ph_router_gemm(lds, p, 1, (float*)(p.mixb + (size_t)T_TOK * DM), p.mixb);)
    SYNC();
    RM(ph_route_select(p, (const float*)(p.mixb + (size_t)T_TOK * DM), p.router_bias + 64);)
    SYNC();
    RM(ph_moe_scan(lds, p);)
    SYNC();
    RG(ph_moe_gemm1(lds, p);)
    SYNC();
    RG(ph_moe_gemm2(lds, p);)
    SYNC();
    RM(ph_moe_combine_ln(p, p.xb, p.mixb, p.ln_g + 3 * DM, p.ln_b + 3 * DM, p.out, (bf16_t*)nullptr);)
    if (xb_ld(&p.bar[XB_TMO]) != 0u) { SYNC(); for (long i = (long)blockIdx.x * NTHR + threadIdx.x; i < (long)T_TOK * DM; i += (long)gridDim.x * NTHR) p.out[i] = __uint_as_float(0x7fc00000u); }
#undef SYNC
}

extern "C" void kernel_launch(void* const* d_in, const int* in_sizes, int n_in, void* d_out, int out_size, void* d_ws, size_t ws_size, hipStream_t stream) {
    static int grid = 0;
    if (!grid) {
        int dev = 0, cus = 0; (void)hipGetDevice(&dev); (void)hipDeviceGetAttribute(&cus, hipDeviceAttributeMultiprocessorCount, dev);
        (void)hipFuncSetAttribute((const void*)mega_fwd, hipFuncAttributeMaxDynamicSharedMemorySize, LDS_TOTAL);
        grid = cus > 0 ? cus : 256;
    }
    (void)in_sizes; (void)n_in; (void)out_size; (void)ws_size;
    MP p{};
    p.x = (const float*)d_in[0]; p.positions = (const int*)d_in[1]; p.ab_w_in = (const float*)d_in[2]; p.conv_w = (const float*)d_in[3]; p.conv_b = (const float*)d_in[4];
    p.dt_bias = (const float*)d_in[5]; p.a_log = (const float*)d_in[6]; p.ssm_d = (const float*)d_in[7]; p.ssm_norm_w = (const float*)d_in[8]; p.cmp_pos = (const float*)d_in[9];
    p.cmp_w = (const float*)d_in[10]; p.ab_w_out = (const float*)d_in[11]; p.cd_w_in = (const float*)d_in[12]; p.q_norm_w = (const float*)d_in[13]; p.w_uq = (const float*)d_in[14];
    p.kv_norm_w = (const float*)d_in[15]; p.w_ukv = (const float*)d_in[16]; p.lb_logits = (const float*)d_in[17]; p.hgrn_norm_w = (const float*)d_in[18]; p.cd_w_out = (const float*)d_in[19];
    p.ln_g = (const float*)d_in[20]; p.ln_b = (const float*)d_in[21]; p.w_router = (const float*)d_in[22]; p.router_bias = (const float*)d_in[23]; p.w_gate = (const float*)d_in[24];
    p.w_up = (const float*)d_in[25]; p.w_down = (const float*)d_in[26]; p.sg = (const float*)d_in[27]; p.su = (const float*)d_in[28]; p.sd = (const float*)d_in[29];
    p.out = (float*)d_out;
    char* wp = (char*)d_ws;
    auto carve = [&](size_t bytes) { char* q = wp; wp += (bytes + 255) & ~(size_t)255; return q; };
    p.bar = (unsigned*)carve((size_t)(XCD_BAR_WORDS + 64) * 4);
    p.WinABt = (bf16_t*)carve((size_t)8960 * DM * 2);
    p.WoutABt = (bf16_t*)carve((size_t)DM * 4096 * 2);
    p.WinCDt = (bf16_t*)carve((size_t)9472 * DM * 2);
    p.WoutCDt = (bf16_t*)carve((size_t)DM * 4096 * 2);
    p.Wuqt = (bf16_t*)carve((size_t)3072 * 512 * 2);
    p.Wukvt = (bf16_t*)carve((size_t)4096 * 512 * 2);
    p.WgT = (bf16_t*)carve((size_t)65 * 512 * DM * 2); p.WuT = (bf16_t*)carve((size_t)65 * 512 * DM * 2); p.WdT = (bf16_t*)carve((size_t)65 * DM * 512 * 2);
    char* big = carve((size_t)T_TOK * CD_IN * 2 + (size_t)T_TOK * 3072 * 4 + (size_t)T_TOK * 4096 * 4 + 1024);
    p.hbuf = (bf16_t*)big;
    p.xbc = (float*)(big + (((size_t)T_TOK * CD_IN * 2 + 255) & ~(size_t)255));
    p.mix = (float*)((char*)p.xbc + (size_t)T_TOK * 3072 * 4);
    p.H = (bf16_t*)big;
    p.Y = (bf16_t*)(big + (((size_t)(MOE_PMAX + T_TOK) * 512 * 2 + 255) & ~(size_t)255));
    p.kvfrag = (bf16_t*)p.mix;
    p.mixb = (bf16_t*)carve((size_t)T_TOK * 4096 * 2);
    p.bufA = (float*)carve((size_t)T_TOK * DM * 4);
    p.bufB = (float*)carve((size_t)T_TOK * DM * 4);
    p.x3 = (float*)carve((size_t)T_TOK * DM * 4);
    p.xb = (bf16_t*)carve((size_t)(T_TOK + 1) * DM * 2);
    p.cqb = (bf16_t*)carve((size_t)T_TOK * 1024 * 2);
    p.kr = (bf16_t*)carve((size_t)T_TOK * 64 * 2);
    p.rope_tab = (float*)carve((size_t)T_TOK * 32 * 8);
    p.kcb = (bf16_t*)carve((size_t)16 * 128 * 128 * 2); p.vcT = (bf16_t*)carve((size_t)16 * 128 * 128 * 2);
    p.vselT = (bf16_t*)carve((size_t)16 * 128 * 2048 * 2); p.vwinT = (bf16_t*)carve((size_t)16 * 128 * 2048 * 2); p.ksf = (bf16_t*)carve((size_t)16 * 128 * 2048 * 2); p.kwf = (bf16_t*)carve((size_t)16 * 128 * 2048 * 2);
    p.WcmpT = (bf16_t*)carve((size_t)2 * 256 * 4096 * 2); p.WrT3 = (bf16_t*)carve((size_t)2 * 256 * 4096 * 2); p.cpart = (float*)carve((size_t)2 * 128 * 128 * 4);
    p.kc = (float*)carve((size_t)NB * NCMP * 2 * 128 * 4);
    p.vc = (float*)carve((size_t)NB * NCMP * 2 * 128 * 4);
    p.top_e = (int*)carve((size_t)T_TOK * 8 * 4); p.top_w = (float*)carve((size_t)T_TOK * 8 * 4); p.lpos = (int*)carve((size_t)T_TOK * 8 * 4);
    p.cnt_tab = (int*)carve((size_t)MOE_NSLOT * 64 * 4); p.row_tok = (int*)carve((size_t)(MOE_PMAX + T_TOK) * 4); p.row_w = (float*)carve((size_t)(MOE_PMAX + T_TOK) * 4);
    p.row_slot = (int*)carve((size_t)(MOE_PMAX + T_TOK) * 4); p.tiles = (int*)carve((size_t)MOE_MAXTILES * 16); p.ntiles = (int*)carve(256);
    (void)hipMemsetAsync(p.bar, 0, (size_t)(XCD_BAR_WORDS + 64) * 4, stream);
    hipLaunchKernelGGL(mega_fwd, dim3(grid), dim3(NTHR), LDS_TOTAL, stream, p);
}
```

```cpp
#include <hip/hip_runtime.h>
#include <stdint.h>

#define DI __device__ __forceinline__

constexpr int T_TOK = 16384, DM = 2048, SEQ = 2048, NB = 8;
constexpr int AB_IN = 8784, CD_IN = 9280;
constexpr int AB_Z = 0, AB_XBC = 2048, AB_DT = 5120, AB_Q = 5152, AB_KV = 7200, AB_G = 8736;
constexpr int CD_CQ = 0, CD_CKV = 512, CD_KR = 1024, CD_HQ = 1088, CD_HF = 3136, CD_HI = 5184, CD_HG = 7232;
constexpr float DN_ALPHA = 1.41421356237309515f;
constexpr int NCMP = 127;
constexpr int MOE_TM = 256;
constexpr int MOE_SLOT_TOK = 8;
constexpr int MOE_NSLOT = T_TOK / MOE_SLOT_TOK;
constexpr int MOE_PMAX = T_TOK * 8 + 64 * MOE_TM;
constexpr int MOE_MAXTILES = MOE_PMAX / MOE_TM + T_TOK / MOE_TM;
constexpr int LDH_AB = AB_IN, LDH_CD = CD_IN;

typedef unsigned short bf16_t;
DI float ldh(const bf16_t* p, long i) { return __uint_as_float(((unsigned)p[i]) << 16); }
DI bf16_t f2bf(float f) { unsigned u = __float_as_uint(f); u += 0x7fffu + ((u >> 16) & 1u); return (bf16_t)(u >> 16); }
DI int tid_opaque() { int t = (int)threadIdx.x; asm volatile("" : "+v"(t)); return t; }
DI float sigmoidf_(float x) { return 1.f / (1.f + __expf(-x)); }
DI float siluf_(float x) { return x / (1.f + __expf(-x)); }
DI float softplusf_(float x) { return x > 20.f ? x : log1pf(__expf(x)); }
#define LAS __attribute__((address_space(3)))
typedef unsigned short bf16_t;
typedef short bf16x8 __attribute__((ext_vector_type(8)));
typedef float f32x4 __attribute__((ext_vector_type(4)));
typedef unsigned u32x2 __attribute__((ext_vector_type(2)));
typedef unsigned u32x4 __attribute__((ext_vector_type(4)));
typedef int i32x2 __attribute__((ext_vector_type(2)));

typedef float f32x2_t __attribute__((ext_vector_type(2)));
typedef __bf16 bf16x2_t __attribute__((ext_vector_type(2)));
DI unsigned pk_bf16(float lo, float hi) { const f32x2_t v = {lo, hi}; const bf16x2_t r = __builtin_convertvector(v, bf16x2_t); return __builtin_bit_cast(unsigned, r); }
DI float bf2f(bf16_t b) { return __uint_as_float(((unsigned)b) << 16); }
DI float bflo(unsigned u) { return __uint_as_float(u << 16); }
DI float bfhi(unsigned u) { return __uint_as_float(u & 0xffff0000u); }

namespace gm {
constexpr int BM = 256, BK = 64, HALF = 128, HTB = HALF * BK * 2, STAGE_BYTES = 8 * HTB, NXCD = 8, WGM = 8;
DI int lds_byte(int r, int c) { const int st = (r >> 4) * 2 + (c >> 5), rr = r & 15, cc = c & 31, ob = rr * 64 + cc * 2; return st * 1024 + (ob ^ (((ob >> 9) & 1) << 5)); }
DI void stage_rc(int b, int& R, int& C) { const int st = b / 1024, sb = b % 1024, swz = sb ^ (((sb >> 9) & 1) << 5); R = (st >> 1) * 16 + swz / 64; C = (st & 1) * 32 + (swz % 64) / 2; }

struct Unit { int p, q; };

DI bool static_order(int i, int G, int c, int nM, int nN, Unit& u) {
    const int nwg = nM * nN;
    const long L = (long)i * G + c; if (L >= nwg) return false;
    int wgid = (int)L; { const int q = nwg / NXCD, r = nwg % NXCD, xcd = wgid % NXCD, off = wgid / NXCD; wgid = (xcd < r ? xcd * (q + 1) : r * (q + 1) + (xcd - r) * q) + off; }
    const int nig = WGM * nN, gid = wgid / nig, fm = gid * WGM, gsz = (nM - fm) < WGM ? (nM - fm) : WGM;
    u.p = fm + ((wgid % nig) % gsz); u.q = (wgid % nig) / gsz; return true;
}

struct DenseProb {
    const char* A; const char* Bt; unsigned lda, ldb;
    int K, nM, nN, G, c;
    struct AState { const char* base; };
    DI bool next(int i, Unit& u) const { return static_order(i, G, c, nM, nN, u); }
    DI void a_state(const Unit& u, int R0, int C, AState& s) const { s.base = A + (size_t)u.p * 256 * lda * 2; }
    DI const char* a_addr(const AState& s, int h, int i, int R0, int C, size_t koff) const { return s.base + koff + (size_t)h * 128 * lda * 2 + (size_t)((unsigned)(R0 + 64 * i) * lda + (unsigned)C) * 2u; }
    static DI AState sel(bool c, const AState& a, const AState& b) { AState r; r.base = c ? a.base : b.base; return r; }
    DI size_t koff(int kt) const { return (size_t)kt * 128; }
    DI const char* b_ptr(const Unit& u, int h) const { return Bt + ((size_t)u.q * 256 + (size_t)h * 128) * ldb * 2; }
};

DI i32x2 lds_tab_read(const LAS i32x2* q) { i32x2 r; const unsigned a = (unsigned)(size_t)q; asm volatile("ds_read_b64 %0, %1\n\ts_waitcnt lgkmcnt(0)" : "=v"(r) : "v"(a) : "memory"); return r; }
struct MoeG1Prob {
    const char* A; const char* WgT; const char* WuT; unsigned lda, ldb;
    int K, G, c;
    const LAS i32x2* ttab; int ntl; const int* row_tok;
    struct AState { unsigned off[2][2]; };
    DI bool next(int i, Unit& u) const {
        if ((G & 7) == 0) { const int x = c & 7, W = G >> 3, tpx = (ntl + 7) >> 3; const int m = i * W + (c >> 3); const int tl = m >> 2; const int tile = x * tpx + tl;
            if (tl >= tpx || tile >= ntl) return false; u.p = tile; u.q = m & 3; return true; }
        const long L = (long)i * G + c; if (L >= (long)ntl * 4) return false; u.p = (int)(L >> 2); u.q = (int)(L & 3); return true; }
    DI void a_state(const Unit& u, int R0, int C, AState& s) const {
        const int row0 = lds_tab_read(ttab + u.p).y;
#pragma unroll
        for (int h = 0; h < 2; ++h)
#pragma unroll
            for (int i = 0; i < 2; ++i) { int t = row_tok[row0 + h * 128 + R0 + 64 * i]; if (t < 0) t = T_TOK; s.off[h][i] = ((unsigned)t * lda + (unsigned)C) * 2u; }
    }
    DI const char* a_addr(const AState& s, int h, int i, int R0, int C, size_t koff) const { return A + koff + s.off[h][i]; }
    static DI AState sel(bool c, const AState& a, const AState& b) { AState r;
#pragma unroll
        for (int h = 0; h < 2; ++h)
#pragma unroll
            for (int i = 0; i < 2; ++i) r.off[h][i] = c ? a.off[h][i] : b.off[h][i];
        return r; }
    DI size_t koff(int kt) const { return (size_t)kt * 128; }
    DI const char* b_ptr(const Unit& u, int h) const { const int e = lds_tab_read(ttab + u.p).x & 0xff; return (h ? WuT : WgT) + ((size_t)e * 512 + (size_t)u.q * 128) * ldb * 2; }
};

struct MoeG2Prob {
    const char* A; const char* WdT; unsigned lda, ldb;
    int K, G, c;
    const LAS i32x2* ttab; int ntl;
    struct AState { const char* base; };
    DI bool next(int i, Unit& u) const {
        if ((G & 7) == 0) { const int x = c & 7, W = G >> 3, tpx = (ntl + 7) >> 3; const int m = i * W + (c >> 3); const int tl = m >> 3; const int tile = x * tpx + tl;
            if (tl >= tpx || tile >= ntl) return false; u.p = tile; u.q = m & 7; return true; }
        const long L = (long)i * G + c; if (L >= (long)ntl * 8) return false; u.p = (int)(L >> 3); u.q = (int)(L & 7); return true; }
    DI void a_state(const Unit& u, int R0, int C, AState& s) const { const int row0 = lds_tab_read(ttab + u.p).y; s.base = A + (size_t)row0 * lda * 2; }
    DI const char* a_addr(const AState& s, int h, int i, int R0, int C, size_t koff) const { return s.base + koff + (size_t)h * 128 * lda * 2 + (size_t)((unsigned)(R0 + 64 * i) * lda + (unsigned)C) * 2u; }
    static DI AState sel(bool c, const AState& a, const AState& b) { AState r; r.base = c ? a.base : b.base; return r; }
    DI size_t koff(int kt) const { return (size_t)kt * 128; }
    DI const char* b_ptr(const Unit& u, int h) const { const int e = lds_tab_read(ttab + u.p).x & 0xff; return WdT + ((size_t)e * 2048 + (size_t)u.q * 256 + (size_t)h * 128) * ldb * 2; }
};

struct EpiF32 {
    static constexpr bool PERM = false;
    float* C; long ldc; int N;
    DI void operator()(const f32x4 (&acc)[2][2][4][2], const Unit& u, int wr, int wc, int fr, int fq) const {
        const int row0 = u.p * 256 + wr * 64 + fr, col0 = u.q * 256 + wc * 32 + 4 * fq;
#pragma unroll
        for (int ai = 0; ai < 2; ++ai)
#pragma unroll
            for (int m = 0; m < 4; ++m) { float* rowp = C + (size_t)(row0 + ai * 128 + m * 16) * ldc;
#pragma unroll
                for (int bj = 0; bj < 2; ++bj)
#pragma unroll
                    for (int n = 0; n < 2; ++n) { const int col = col0 + bj * 128 + n * 16; if (col < N) *(f32x4*)(rowp + col) = acc[ai][bj][m][n]; } }
    }
};
struct EpiBf16 {
    static constexpr bool PERM = true;
    bf16_t* C; long ldc; int N;
    DI void operator()(const f32x4 (&acc)[2][2][4][2], const Unit& u, int wr, int wc, int fr, int fq) const {
        const int row0 = u.p * 256 + wr * 64 + fr, col0 = u.q * 256 + wc * 32 + 8 * fq;
#pragma unroll
        for (int ai = 0; ai < 2; ++ai)
#pragma unroll
            for (int m = 0; m < 4; ++m) { bf16_t* rowp = C + (size_t)(row0 + ai * 128 + m * 16) * ldc;
#pragma unroll
                for (int bj = 0; bj < 2; ++bj) { const int col = col0 + bj * 128; const f32x4 v0 = acc[ai][bj][m][0], v1 = acc[ai][bj][m][1];
                    if (col < N) { u32x4 o; o.x = pk_bf16(v0[0], v0[1]); o.y = pk_bf16(v0[2], v0[3]); o.z = pk_bf16(v1[0], v1[1]); o.w = pk_bf16(v1[2], v1[3]); *(u32x4*)(rowp + col) = o; } } }
    }
};
DI int perm16(int s) { return (s & ~12) | ((s & 4) << 1) | ((s & 8) >> 1); }
DI int perm32(int s) { return (s & ~28) | ((s & 12) << 1) | ((s & 16) >> 2); }
struct EpiKV {
    static constexpr bool PERM = true;
    bf16_t* kf; bf16_t* vf;
    DI void operator()(const f32x4 (&acc)[2][2][4][2], const Unit& u, int wr, int wc, int fr, int fq) const {
        const int row0 = u.p * 256 + wr * 64 + fr, head = u.q, c = wc * 32 + 8 * fq;
#pragma unroll
        for (int ai = 0; ai < 2; ++ai)
#pragma unroll
            for (int m = 0; m < 4; ++m) { const int t = row0 + ai * 128 + m * 16; const int b = t >> 11, s = t & 2047;
                const int kt = s >> 5, r = s & 31, s2 = (s >> 4) & 1;
                const int p16 = perm16(s & 15);
                const size_t tb = (size_t)(b * 16 + head) * 64 + kt;
                { const f32x4 v0 = acc[ai][0][m][0], v1 = acc[ai][0][m][1]; u32x4 o; o.x = pk_bf16(v0[0], v0[1]); o.y = pk_bf16(v0[2], v0[3]); o.z = pk_bf16(v1[0], v1[1]); o.w = pk_bf16(v1[2], v1[3]);
                  *(u32x4*)(kf + (tb * 8 + (c >> 4)) * 512 + (((c >> 3) & 1) * 32 + r) * 8) = o; }
                { bf16_t* vp = vf + ((tb * 4 + (c >> 5)) * 2 + s2) * 512 + ((p16 >> 3) * 32 + (c & 31)) * 8 + (p16 & 7);
#pragma unroll
                  for (int n = 0; n < 2; ++n) { const f32x4 vv = acc[ai][1][m][n];
#pragma unroll
                      for (int j = 0; j < 4; ++j) vp[(n * 4 + j) * 8] = f2bf(vv[j]); } } }
    }
};
struct CmpProb {
    const char* hb; const char* Wt;
    unsigned ldb; int K, G, c;
    struct AState { unsigned off[2][2]; };
    DI bool next(int i, Unit& u) const { const int L = i * G + c; if (L >= 16) return false; u.p = L & 7; u.q = L >> 3; return true; }
    DI void a_state(const Unit& u, int R0, int C, AState& s) const {
#pragma unroll
        for (int h = 0; h < 2; ++h)
#pragma unroll
            for (int i = 0; i < 2; ++i) { const int m = u.p * 256 + h * 128 + R0 + 64 * i; const int bg = m >> 7; int ci = m & 127; if (ci > 126) ci = 126;
                s.off[h][i] = (unsigned)(((size_t)((bg >> 1) * SEQ + 16 * ci) * AB_IN + AB_KV + u.q * 256 + (bg & 1) * 128 + C) * 2); }
    }
    DI const char* a_addr(const AState& s, int h, int i, int R0, int C, size_t koff) const { return hb + koff + s.off[h][i]; }
    static DI AState sel(bool c, const AState& a, const AState& b) { AState r;
#pragma unroll
        for (int h = 0; h < 2; ++h)
#pragma unroll
            for (int i = 0; i < 2; ++i) r.off[h][i] = c ? a.off[h][i] : b.off[h][i];
        return r; }
    DI size_t koff(int kt) const { return (size_t)(kt >> 1) * (AB_IN * 2) + (size_t)(kt & 1) * 128; }
    DI const char* b_ptr(const Unit& u, int h) const { return Wt + ((size_t)u.q * 256 + (size_t)h * 128) * ldb * 2; }
};
struct EpiCmp {
    static constexpr bool PERM = false;
    bf16_t* kc; bf16_t* vcT; const float* cpart;
    DI void operator()(const f32x4 (&acc)[2][2][4][2], const Unit& u, int wr, int wc, int fr, int fq) const {
        const int which = u.q, row0 = u.p * 256 + wr * 64 + fr, c0 = wc * 32 + 4 * fq;
        f32x4 bias[2];
#pragma unroll
        for (int n = 0; n < 2; ++n) { f32x4 a = {0.f, 0.f, 0.f, 0.f};
            for (int l = 0; l < 128; ++l) { const f32x4 v = *(const f32x4*)(cpart + ((size_t)which * 128 + l) * 128 + c0 + n * 16); a += v; }
            bias[n] = a; }
#pragma unroll
        for (int ai = 0; ai < 2; ++ai)
#pragma unroll
            for (int m = 0; m < 4; ++m) { const int mm = row0 + ai * 128 + m * 16; const int bg = mm >> 7, ci = mm & 127;
#pragma unroll
                for (int n = 0; n < 2; ++n) { const int c = c0 + n * 16; const f32x4 v = acc[ai][0][m][n] + bias[n];
                    if (which == 0) { u32x2 o; o.x = pk_bf16(v[0], v[1]); o.y = pk_bf16(v[2], v[3]); *(u32x2*)(kc + (size_t)mm * 128 + c) = o; }
                    else { bf16_t* vp = vcT + ((size_t)bg * 128 + c) * 128 + perm16(ci);
#pragma unroll
                        for (int j = 0; j < 4; ++j) vp[(size_t)j * 128] = f2bf(v[j]); } } }
    }
};
struct EpiAB {
    static constexpr bool PERM = true;
    bf16_t* C; bf16_t* vselT; bf16_t* vwinT; bf16_t* ksf; bf16_t* kwf;
    DI void operator()(const f32x4 (&acc)[2][2][4][2], const Unit& u, int wr, int wc, int fr, int fq) const {
        const int row0 = u.p * 256 + wr * 64 + fr, col0 = u.q * 256 + wc * 32 + 8 * fq;
        const bool special = (u.q >= 30);
#pragma unroll
        for (int ai = 0; ai < 2; ++ai)
#pragma unroll
            for (int m = 0; m < 4; ++m) { const int t = row0 + ai * 128 + m * 16; const int b = t >> 11, sp = t & 2047;
                bf16_t* rowp = C + (size_t)t * AB_IN;
#pragma unroll
                for (int bj = 0; bj < 2; ++bj) { const int col = col0 + bj * 128; const f32x4 v0 = acc[ai][bj][m][0], v1 = acc[ai][bj][m][1];
                    u32x4 o; o.x = pk_bf16(v0[0], v0[1]); o.y = pk_bf16(v0[2], v0[3]); o.z = pk_bf16(v1[0], v1[1]); o.w = pk_bf16(v1[2], v1[3]);
                    if (col < AB_IN) *(u32x4*)(rowp + col) = o;
                    if (special) {
                        if (col >= AB_KV + 512 && col < AB_KV + 768) { const int cc = col - (AB_KV + 512); const int bg = b * 2 + (cc >> 7), d = cc & 127;
                            *(u32x4*)(ksf + ((((size_t)bg * 128 + (sp >> 4)) * 4 + (d >> 5)) * 64 + ((d >> 3) & 3) * 16 + (sp & 15)) * 8) = o; }
                        if (col >= AB_KV + 768 && col < AB_KV + 1024) { const int cc = col - (AB_KV + 768); const int bg = b * 2 + (cc >> 7), d = cc & 127;
                            const int p32 = perm32(sp & 31);
                            bf16_t* vp = vselT + ((((size_t)bg * 64 + (sp >> 5)) * 8 + (d >> 4)) * 64 + (p32 >> 3) * 16 + (d & 15)) * 8 + (p32 & 7);
#pragma unroll
                            for (int j = 0; j < 4; ++j) { vp[j * 8] = f2bf(v0[j]); vp[(4 + j) * 8] = f2bf(v1[j]); } }
                        if (col >= AB_KV + 1024 && col < AB_KV + 1280) { const int cc = col - (AB_KV + 1024); const int bg = b * 2 + (cc >> 7), d = cc & 127;
                            *(u32x4*)(kwf + ((((size_t)bg * 64 + (sp >> 5)) * 8 + (d >> 4)) * 64 + ((d >> 3) & 1) * 32 + (sp & 31)) * 8) = o; }
                        if (col >= AB_KV + 1280 && col < AB_KV + 1536) { const int cc = col - (AB_KV + 1280); const int bg = b * 2 + (cc >> 7), d = cc & 127;
                            const int p16 = perm16(sp & 15);
                            bf16_t* vp = vwinT + (((((size_t)bg * 64 + (sp >> 5)) * 4 + (d >> 5)) * 2 + ((sp >> 4) & 1)) * 64 + (p16 >> 3) * 32 + (d & 31)) * 8 + (p16 & 7);
#pragma unroll
                            for (int j = 0; j < 4; ++j) { vp[j * 8] = f2bf(v0[j]); vp[(4 + j) * 8] = f2bf(v1[j]); } }
                    } } }
    }
};
struct EpiCD {
    static constexpr bool PERM = true;
    bf16_t* C; bf16_t* viT;
    DI void operator()(const f32x4 (&acc)[2][2][4][2], const Unit& u, int wr, int wc, int fr, int fq) const {
        const int row0 = u.p * 256 + wr * 64 + fr, col0 = u.q * 256 + wc * 32 + 8 * fq;
        const bool special = (u.q >= 20 && u.q <= 28);
#pragma unroll
        for (int ai = 0; ai < 2; ++ai)
#pragma unroll
            for (int m = 0; m < 4; ++m) { const int t = row0 + ai * 128 + m * 16; const int b = t >> 11, sp = t & 2047;
                bf16_t* rowp = C + (size_t)t * CD_IN;
#pragma unroll
                for (int bj = 0; bj < 2; ++bj) { const int col = col0 + bj * 128; const f32x4 v0 = acc[ai][bj][m][0], v1 = acc[ai][bj][m][1];
                    if (col < CD_IN) { u32x4 o; o.x = pk_bf16(v0[0], v0[1]); o.y = pk_bf16(v0[2], v0[3]); o.z = pk_bf16(v1[0], v1[1]); o.w = pk_bf16(v1[2], v1[3]); *(u32x4*)(rowp + col) = o; }
                    if (special && col >= CD_HI && col < CD_HI + 2048) { const int cc = col - CD_HI;
                        bf16_t* vp = viT + ((size_t)(b * 16 + (cc >> 7)) * 128 + (cc & 127)) * 2048 + perm16(sp);
#pragma unroll
                        for (int j = 0; j < 4; ++j) { vp[(size_t)j * 2048] = f2bf(v0[j]); vp[(size_t)(4 + j) * 2048] = f2bf(v1[j]); } } } }
    }
};
struct RouterProb {
    const char* xhi; long dlo; const char* Bt;
    int K, G, c;
    struct AState { const char* base; };
    DI bool next(int i, Unit& u) const { const int L = i * G + c; if (L >= 256) return false; u.p = L >> 2; u.q = L & 3; return true; }
    DI void a_state(const Unit& u, int R0, int C, AState& s) const { s.base = xhi + (long)((u.q >> 1) & 1) * dlo + (size_t)u.p * 256 * 4096 + (size_t)(u.q & 1) * 2048; }
    DI const char* a_addr(const AState& s, int h, int i, int R0, int C, size_t koff) const { return s.base + koff + (size_t)h * 128 * 4096 + (size_t)((unsigned)(R0 + 64 * i) * 2048u + (unsigned)C) * 2u; }
    static DI AState sel(bool c, const AState& a, const AState& b) { AState r; r.base = c ? a.base : b.base; return r; }
    DI size_t koff(int kt) const { return (size_t)kt * 128; }
    DI const char* b_ptr(const Unit& u, int h) const { return Bt + ((size_t)h * 128 * 4096 + (size_t)u.q * 1024) * 2; }
    unsigned ldb;
};
struct EpiRouter {
    static constexpr bool PERM = false;
    float* Cpart;
    DI void operator()(const f32x4 (&acc)[2][2][4][2], const Unit& u, int wr, int wc, int fr, int fq) const {
        const int row0 = u.p * 256 + wr * 64 + fr, col0 = wc * 32 + 4 * fq;
#pragma unroll
        for (int ai = 0; ai < 2; ++ai)
#pragma unroll
            for (int m = 0; m < 4; ++m) { float* rowp = Cpart + ((size_t)u.q * T_TOK + (size_t)(row0 + ai * 128 + m * 16)) * 128 + col0;
#pragma unroll
                for (int n = 0; n < 2; ++n) *(f32x4*)(rowp + n * 16) = acc[ai][0][m][n]; }
    }
};
struct EpiSwiglu {
    static constexpr bool PERM = true;
    bf16_t* H; const LAS i32x2* ttab;
    DI void operator()(const f32x4 (&acc)[2][2][4][2], const Unit& u, int wr, int wc, int fr, int fq) const {
        const int row0 = lds_tab_read(ttab + u.p).y + wr * 64 + fr, col0 = u.q * 128 + wc * 32 + 8 * fq;
#pragma unroll
        for (int ai = 0; ai < 2; ++ai)
#pragma unroll
            for (int m = 0; m < 4; ++m) { bf16_t* rowp = H + (size_t)(row0 + ai * 128 + m * 16) * 512 + col0;
                float hv[8];
#pragma unroll
                for (int n = 0; n < 2; ++n) { const f32x4 g = acc[ai][0][m][n], up = acc[ai][1][m][n];
#pragma unroll
                    for (int j = 0; j < 4; ++j) hv[n * 4 + j] = g[j] / (1.f + __expf(-g[j])) * up[j]; }
                u32x4 o; o.x = pk_bf16(hv[0], hv[1]); o.y = pk_bf16(hv[2], hv[3]); o.z = pk_bf16(hv[4], hv[5]); o.w = pk_bf16(hv[6], hv[7]); *(u32x4*)rowp = o; }
    }
};
struct EpiMoeDown {
    static constexpr bool PERM = true;
    bf16_t* Y; const LAS i32x2* ttab;
    DI void operator()(const f32x4 (&acc)[2][2][4][2], const Unit& u, int wr, int wc, int fr, int fq) const {
        const i32x2 rec = lds_tab_read(ttab + u.p);
        const int nrows = ((rec.x >> 8) & 0xff) + 1, delta = (int)((unsigned)rec.x >> 16);
        const int r0 = wr * 64 + fr, col0 = u.q * 256 + wc * 32 + 8 * fq;
#pragma unroll
        for (int ai = 0; ai < 2; ++ai)
#pragma unroll
            for (int m = 0; m < 4; ++m) { const int rt = r0 + ai * 128 + m * 16;
                if (rt < nrows) {
                    bf16_t* rowp = Y + (size_t)(rec.y + rt - delta) * 2048 + col0;
#pragma unroll
                    for (int bj = 0; bj < 2; ++bj) { const f32x4 v0 = acc[ai][bj][m][0], v1 = acc[ai][bj][m][1];
                        u32x4 o; o.x = pk_bf16(v0[0], v0[1]); o.y = pk_bf16(v0[2], v0[3]); o.z = pk_bf16(v1[0], v1[1]); o.w = pk_bf16(v1[2], v1[3]); *(u32x4*)(rowp + bj * 128) = o; } } }
    }
};

template <class Prob, class Epi>
DI void gemm_phase(LAS unsigned char* lds, const Prob& P, const Epi& E) {
    const int tid = tid_opaque(), wid = __builtin_amdgcn_readfirstlane(tid >> 6), lane = tid & 63, wr = wid >> 2, wc = wid & 3, fr = lane & 15, fq = lane >> 4;
    const int K = P.K, nt = K / BK;
    int R0, C; stage_rc(tid * 16, R0, C);
    unsigned voffB[2];
#pragma unroll
    for (int i = 0; i < 2; ++i) { const int R = R0 + 64 * i;
        const int Rb = Epi::PERM ? ((R & ~31) + 8 * ((R & 15) >> 2) + 4 * ((R >> 4) & 1) + (R & 3)) : R;
        voffB[i] = ((unsigned)Rb * P.ldb + (unsigned)C) * 2u; }
    const size_t kstep = (size_t)(BK * 2);
    const unsigned ldsw = (unsigned)wid * 1024u;
    const int aoff = lds_byte(wr * 64 + fr, fq * 8), boff = lds_byte(wc * 32 + fr, fq * 8);
#define GM_SA(b, h) (((b) * 2 + (h)) * HTB)
#define GM_SB(b, h) ((4 + (b) * 2 + (h)) * HTB)
#define GM_STAGE_B(bufoff, gbase) do { _Pragma("unroll") for (int _i = 0; _i < 2; ++_i) \
        __builtin_amdgcn_global_load_lds((const unsigned*)((const char*)(gbase) + voffB[_i]), (LAS unsigned*)(lds + (bufoff) + ldsw + _i * 8192), 16, 0, 0); } while (0)
#define GM_STAGE_A(bufoff, st, h, koff) do { _Pragma("unroll") for (int _i = 0; _i < 2; ++_i) \
        __builtin_amdgcn_global_load_lds((const unsigned*)(P.a_addr(st, h, _i, R0, C, koff)), (LAS unsigned*)(lds + (bufoff) + ldsw + _i * 8192), 16, 0, 0); } while (0)
#define GM_LDA(dst, b, h) do { _Pragma("unroll") for (int m = 0; m < 4; ++m) _Pragma("unroll") for (int k = 0; k < 2; ++k) dst[m][k] = *(const LAS bf16x8*)(lds + GM_SA(b, h) + aoff + m * 2048 + k * 1024); } while (0)
#define GM_LDB(dst, b, h) do { _Pragma("unroll") for (int n = 0; n < 2; ++n) _Pragma("unroll") for (int k = 0; k < 2; ++k) dst[n][k] = *(const LAS bf16x8*)(lds + GM_SB(b, h) + boff + n * 2048 + k * 1024); } while (0)
#define GM_MMA(ai, bj, At, Bt) do { __builtin_amdgcn_s_setprio(1); _Pragma("unroll") for (int m = 0; m < 4; ++m) _Pragma("unroll") for (int n = 0; n < 2; ++n) _Pragma("unroll") for (int k = 0; k < 2; ++k) \
        acc[ai][bj][m][n] = __builtin_amdgcn_mfma_f32_16x16x32_bf16(Bt[n][k], At[m][k], acc[ai][bj][m][n], 0, 0, 0); __builtin_amdgcn_s_setprio(0); } while (0)
#define GM_WAIT_V(n) asm volatile("s_waitcnt vmcnt(" #n ")" ::: "memory")
#define GM_WAIT_L(n) asm volatile("s_waitcnt lgkmcnt(" #n ")" ::: "memory")
#define GM_BAR __builtin_amdgcn_s_barrier()
#define GM_SCHED __builtin_amdgcn_sched_barrier(0)
    Unit cur, nxt; int ui = 0;
    if (!P.next(0, cur)) return;
    f32x4 acc[2][2][4][2];
#pragma unroll
    for (int a = 0; a < 2; ++a)
#pragma unroll
        for (int b = 0; b < 2; ++b)
#pragma unroll
            for (int m = 0; m < 4; ++m)
#pragma unroll
                for (int n = 0; n < 2; ++n) acc[a][b][m][n] = (f32x4){0.f, 0.f, 0.f, 0.f};
    bf16x8 At[4][2], B0[2][2], B1[2][2];
    typename Prob::AState cs, ns; P.a_state(cur, R0, C, cs);
    const char* cB0 = P.b_ptr(cur, 0); const char* cB1 = P.b_ptr(cur, 1);
    GM_STAGE_B(GM_SB(0, 0), cB0); GM_STAGE_A(GM_SA(0, 0), cs, 0, 0); GM_STAGE_B(GM_SB(0, 1), cB1); GM_STAGE_A(GM_SA(0, 1), cs, 1, 0);
    if (wr == 1) GM_BAR;
    GM_WAIT_V(4); GM_BAR;
    GM_STAGE_B(GM_SB(1, 0), cB0 + kstep); GM_STAGE_A(GM_SA(1, 0), cs, 0, P.koff(1)); GM_STAGE_B(GM_SB(1, 1), cB1 + kstep);
    GM_WAIT_V(6); GM_BAR;
    for (;;) {
        const bool has_next = P.next(ui + 1, nxt);
        if (has_next) P.a_state(nxt, R0, C, ns); else ns = cs;
        const char* nB0 = has_next ? P.b_ptr(nxt, 0) : cB0; const char* nB1 = has_next ? P.b_ptr(nxt, 1) : cB1;
        for (int t = 0; t < nt; t += 2) {
            const bool last = (t == nt - 2);
            const size_t k1 = P.koff(t + 1);
            const size_t k2 = last ? (size_t)0 : P.koff(t + 2), k3 = last ? P.koff(1) : P.koff(t + 3);
            const typename Prob::AState s2 = Prob::sel(last, ns, cs);
            const char* b20 = last ? nB0 : cB0 + (size_t)(t + 2) * kstep; const char* b21 = last ? nB1 : cB1 + (size_t)(t + 2) * kstep;
            const char* b30 = b20 + kstep; const char* b31 = b21 + kstep;
            GM_LDB(B0, 0, 0); GM_SCHED; GM_LDA(At, 0, 0); GM_STAGE_A(GM_SA(1, 1), cs, 1, k1);
            GM_WAIT_L(8); GM_BAR; GM_WAIT_L(0); GM_MMA(0, 0, At, B0); GM_BAR; GM_SCHED;
            GM_LDB(B1, 0, 1); GM_STAGE_B(GM_SB(0, 0), b20);
            GM_BAR; GM_WAIT_L(0); GM_MMA(0, 1, At, B1); GM_BAR;
            GM_LDA(At, 0, 1); GM_STAGE_A(GM_SA(0, 0), s2, 0, k2);
            GM_BAR; GM_WAIT_L(0); GM_MMA(1, 0, At, B0); GM_BAR; GM_SCHED;
            GM_STAGE_B(GM_SB(0, 1), b21);
            GM_WAIT_V(6); GM_BAR; GM_MMA(1, 1, At, B1); GM_BAR;
            GM_LDB(B0, 1, 0); GM_SCHED; GM_LDA(At, 1, 0); GM_STAGE_A(GM_SA(0, 1), s2, 1, k2);
            GM_WAIT_L(8); GM_BAR; GM_WAIT_L(0); GM_MMA(0, 0, At, B0); GM_BAR; GM_SCHED;
            GM_LDB(B1, 1, 1); GM_STAGE_B(GM_SB(1, 0), b30);
            GM_BAR; GM_WAIT_L(0); GM_MMA(0, 1, At, B1); GM_BAR;
            GM_LDA(At, 1, 1); GM_STAGE_A(GM_SA(1, 0), s2, 0, k3);
            GM_BAR; GM_WAIT_L(0); GM_MMA(1, 0, At, B0); GM_BAR; GM_SCHED;
            GM_STAGE_B(GM_SB(1, 1), b31);
            GM_WAIT_V(6); GM_BAR; GM_MMA(1, 1, At, B1); GM_BAR;
        }
        E(acc, cur, wr, wc, fr, fq);
        if (!has_next) break;
#pragma unroll
        for (int a = 0; a < 2; ++a)
#pragma unroll
            for (int b = 0; b < 2; ++b)
#pragma unroll
                for (int m = 0; m < 4; ++m)
#pragma unroll
                    for (int n = 0; n < 2; ++n) acc[a][b][m][n] = (f32x4){0.f, 0.f, 0.f, 0.f};
        cur = nxt; cs = ns; cB0 = nB0; cB1 = nB1; ++ui;
    }
    GM_WAIT_V(0);
    if (wr == 0) GM_BAR;
    GM_BAR;
#undef GM_SA
#undef GM_SB
#undef GM_STAGE_A
#undef GM_STAGE_B
#undef GM_LDA
#undef GM_LDB
#undef GM_MMA
#undef GM_WAIT_V
#undef GM_WAIT_L
#undef GM_BAR
#undef GM_SCHED
}
}


#define XB_TMO      128
#define XB_XCNT(j)  (256  + 64 * (j))
#define XB_XSUB(j)  (1280 + 64 * (j))
#define XB_XGEN(j)  (2304 + 64 * (j))
#define XB_TOP      3328
#define XB_TOPGEN   3392
#define XCD_BAR_WORDS 3456
#define XB_SPIN_CAP (1u << 22)
#define LAS __attribute__((address_space(3)))

__device__ __forceinline__ unsigned xb_ld(unsigned* p)              { return __hip_atomic_load(p, __ATOMIC_RELAXED, __HIP_MEMORY_SCOPE_AGENT); }
__device__ __forceinline__ unsigned xb_add(unsigned* p, unsigned v) { return __hip_atomic_fetch_add(p, v, __ATOMIC_RELAXED, __HIP_MEMORY_SCOPE_AGENT); }
__device__ __forceinline__ unsigned xb_xcc_id() { return (unsigned)__builtin_amdgcn_s_getreg((3 << 11) | 20) & 0xFu; }
#define XB_SPIN(cond, bar) do { unsigned _sp = 0; while (cond) { __builtin_amdgcn_s_sleep(1); \
    if ((++_sp & 255u) == 0u) { if (xb_ld(&(bar)[XB_TMO])) break; if (_sp > XB_SPIN_CAP) { atomicAdd(&(bar)[XB_TMO], 1u); break; } } } } while (0)

struct XcdBarrier {
    unsigned* bar; unsigned x;
    volatile LAS unsigned* st;
};

__device__ __forceinline__ XcdBarrier xcd_barrier_post(unsigned* bar, volatile LAS unsigned* st) {
    XcdBarrier b; b.bar = bar; b.x = xb_xcc_id(); b.st = st;
    if (threadIdx.x == 0) (void)xb_add(&bar[XB_XCNT(b.x)], 1u);
    return b;
}
__device__ __forceinline__ void xcd_barrier_complete(unsigned* bar, unsigned x, unsigned& nloc, unsigned& nx) {
    const unsigned G = gridDim.x * gridDim.y * gridDim.z;
    unsigned sum, cnt, mine, sp = 0u;
    for (;;) {
        sum = 0u; cnt = 0u; mine = 0u;
#pragma unroll
        for (unsigned j = 0; j < 16; ++j) { const unsigned c = xb_ld(&bar[XB_XCNT(j)]); sum += c; cnt += (c > 0u) ? 1u : 0u; mine = (j == x) ? c : mine; }
        if (sum == G) break;
        __builtin_amdgcn_s_sleep(1);
        if ((++sp & 255u) == 0u) { if (xb_ld(&bar[XB_TMO])) break; if (sp > XB_SPIN_CAP) { atomicAdd(&bar[XB_TMO], 1u); break; } }
    }
    nloc = mine > 0u ? mine : 1u; nx = cnt > 0u ? cnt : 1u;
}

__device__ __forceinline__ void xcd_barrier(const XcdBarrier& b) {
    asm volatile("s_waitcnt vmcnt(0)" ::: "memory");
    __syncthreads();
    if (threadIdx.x == 0) {
        unsigned* bar = b.bar;
        __builtin_amdgcn_s_waitcnt(0);
        unsigned nloc = b.st[0], nx = b.st[1];
        if (nloc == 0u) { xcd_barrier_complete(bar, b.x, nloc, nx); b.st[0] = nloc; b.st[1] = nx; }
        const unsigned old = xb_add(&bar[XB_XSUB(b.x)], 1u);
        const unsigned gen = old / nloc;
        if (old + 1u == (gen + 1u) * nloc) {
            __builtin_amdgcn_fence(__ATOMIC_RELEASE, "agent");
            asm volatile("s_waitcnt vmcnt(0)" ::: "memory");
            const unsigned og = xb_add(&bar[XB_TOP], 1u);
            const unsigned tg = og / nx;
            if (og + 1u == (tg + 1u) * nx) xb_add(&bar[XB_TOPGEN], 1u);
            else XB_SPIN(xb_ld(&bar[XB_TOPGEN]) == tg, bar);
            __builtin_amdgcn_fence(__ATOMIC_ACQUIRE, "agent");
            xb_add(&bar[XB_XGEN(b.x)], 1u);
            asm volatile("s_waitcnt vmcnt(0)" ::: "memory");
        } else {
            XB_SPIN(xb_ld(&bar[XB_XGEN(b.x)]) == gen, bar);
            __builtin_amdgcn_fence(__ATOMIC_ACQUIRE, "agent");
            asm volatile("s_waitcnt vmcnt(0)" ::: "memory");
        }
    }
    __syncthreads();
}


struct MP {
    const float* x; const int* positions; const float* ab_w_in; const float* conv_w; const float* conv_b; const float* dt_bias; const float* a_log; const float* ssm_d;
    const float* ssm_norm_w; const float* cmp_pos; const float* cmp_w; const float* ab_w_out; const float* cd_w_in; const float* q_norm_w; const float* w_uq;
    const float* kv_norm_w; const float* w_ukv; const float* lb_logits; const float* hgrn_norm_w; const float* cd_w_out; const float* ln_g; const float* ln_b;
    const float* w_router; const float* router_bias; const float* w_gate; const float* w_up; const float* w_down; const float* sg; const float* su; const float* sd;
    float* out;
    bf16_t* WinABt; bf16_t* WoutABt; bf16_t* WinCDt; bf16_t* WoutCDt; bf16_t* Wuqt; bf16_t* Wukvt; bf16_t* WgT; bf16_t* WuT; bf16_t* WdT;
    bf16_t* hbuf; float* xbc; float* mix; bf16_t* H; bf16_t* Y; bf16_t* mixb; float* bufA; float* bufB; float* x3; bf16_t* xb; bf16_t* cqb; bf16_t* kr; float* kc; float* vc;
    float* rope_tab; bf16_t* kcb; bf16_t* vcT; bf16_t* vselT; bf16_t* vwinT; bf16_t* ksf; bf16_t* kwf; bf16_t* kvfrag; bf16_t* WcmpT; float* cpart; bf16_t* WrT3; int* top_e; float* top_w; int* lpos; int* cnt_tab; int* row_tok; float* row_w; int* row_slot; int* tiles; int* ntiles;
    unsigned* bar;
};

constexpr int NTHR = 512, NWAVE = 8;
constexpr int LDS_BAR_OFF = 135168;
constexpr int LDS_TAB_OFF = LDS_BAR_OFF + 64;
constexpr int LDS_TOTAL = LDS_TAB_OFF + 768 * 8;

DI float wave_sum(float v) {
#pragma unroll
    for (int o = 1; o < 64; o <<= 1) v += __shfl_xor(v, o);
    return v;
}

DI void cvt_wT_range(LAS unsigned char* lds, const float* __restrict__ W, bf16_t* __restrict__ Wt, int K, int N, int Npad, int bid, int nblk, int ntile) {
    const int tix = tid_opaque();
    LAS float* tile = (LAS float*)lds;
    const int tn = Npad / 64, tk = K / 64;
    const int tx = tix & 63, ty = tix >> 6;
    const int wn = tix >> 3, wk = (tix & 7) * 8;
    float cur[8];
    int tp = bid;
    if (tp < ntile) {
        int tq = tp; const int nx = tq % tn; tq /= tn; const int ky = tq % tk; const int bz = tq / tk;
        const float* Wb = W + (size_t)bz * K * N + (size_t)(ky * 64) * N + nx * 64 + tx;
        const bool nin = (nx * 64 + tx) < N;
#pragma unroll
        for (int i = 0; i < 8; ++i) cur[i] = nin ? __builtin_nontemporal_load(Wb + (size_t)(ty + 8 * i) * N) : 0.f;
    }
    for (; tp < ntile; tp += nblk) {
        int tq = tp; const int nx = tq % tn; tq /= tn; const int ky = tq % tk; const int bz = tq / tk;
        const int n0 = nx * 64, k0 = ky * 64;
        bf16_t* Wtb = Wt + (size_t)bz * Npad * K;
#pragma unroll
        for (int i = 0; i < 8; ++i) tile[(ty + 8 * i) * 65 + tx] = cur[i];
        const int tp2 = tp + nblk;
        if (tp2 < ntile) {
            int tq2 = tp2; const int nx2 = tq2 % tn; tq2 /= tn; const int ky2 = tq2 % tk; const int bz2 = tq2 / tk;
            const float* Wb2 = W + (size_t)bz2 * K * N + (size_t)(ky2 * 64) * N + nx2 * 64 + tx;
            const bool nin2 = (nx2 * 64 + tx) < N;
#pragma unroll
            for (int i = 0; i < 8; ++i) cur[i] = nin2 ? __builtin_nontemporal_load(Wb2 + (size_t)(ty + 8 * i) * N) : 0.f;
        }
        __syncthreads();
        u32x4 o;
        o.x = pk_bf16(tile[(wk + 0) * 65 + wn], tile[(wk + 1) * 65 + wn]); o.y = pk_bf16(tile[(wk + 2) * 65 + wn], tile[(wk + 3) * 65 + wn]);
        o.z = pk_bf16(tile[(wk + 4) * 65 + wn], tile[(wk + 5) * 65 + wn]); o.w = pk_bf16(tile[(wk + 6) * 65 + wn], tile[(wk + 7) * 65 + wn]);
        *(u32x4*)(Wtb + (size_t)(n0 + wn) * K + k0 + wk) = o;
        __syncthreads();
    }
}
DI void ph_cvt_wT(LAS unsigned char* lds, const float* __restrict__ W, bf16_t* __restrict__ Wt, int K, int N, int Npad, int batch, int bid, int nblk) {
    cvt_wT_range(lds, W, Wt, K, N, Npad, bid, nblk, (Npad / 64) * (K / 64) * batch);
}
DI void ph_cvt_moe_weights(LAS unsigned char* lds, const MP& p, int layer, int bid, int nblk) {
    const size_t eo = (size_t)layer * 64 * DM * 512, so = (size_t)layer * DM * 512;
    ph_cvt_wT(lds, p.w_gate + eo, p.WgT, DM, 512, 512, 64, bid, nblk); ph_cvt_wT(lds, p.sg + so, p.WgT + (size_t)64 * 512 * DM, DM, 512, 512, 1, bid, nblk);
    ph_cvt_wT(lds, p.w_up + eo, p.WuT, DM, 512, 512, 64, bid, nblk);   ph_cvt_wT(lds, p.su + so, p.WuT + (size_t)64 * 512 * DM, DM, 512, 512, 1, bid, nblk);
    ph_cvt_wT(lds, p.w_down + eo, p.WdT, 512, DM, DM, 64, bid, nblk);  ph_cvt_wT(lds, p.sd + so, p.WdT + (size_t)64 * DM * 512, 512, DM, DM, 1, bid, nblk);
}

struct CvqPos { int nx, ky, bz; };
DI void cvq_adv4(CvqPos& s, int tn, int tk) { s.nx += 4; if (s.nx >= tn) { s.nx = 0; if (++s.ky == tk) { s.ky = 0; ++s.bz; } } }
DI void cvt_wT_quad(LAS unsigned char* lds, const float* __restrict__ W, bf16_t* __restrict__ Wt, int K, int N, int Npad, int t0, int t1) {
    const int tix = tid_opaque();
    const int tn = Npad / 64, tk = K / 64;
    const int tx = tix & 63, ty = tix >> 6;
    const int wn = tix >> 3, wq = tix & 7;
    float ca[4][8], cb[4][8];
#define CVQ_ISSUE(C_, S_) do { \
        _Pragma("unroll") for (int j = 0; j < 4; ++j) { \
            const int cn = (S_.nx + j) * 64 < N ? (S_.nx + j) * 64 : 0;        \
            const float* Wb = W + (size_t)S_.bz * K * N + (size_t)(S_.ky * 64 + 2 * ty) * N + cn + tx; \
            _Pragma("unroll") for (int i = 0; i < 4; ++i) { C_[j][2 * i] = __builtin_nontemporal_load(Wb + (size_t)(16 * i) * N); C_[j][2 * i + 1] = __builtin_nontemporal_load(Wb + (size_t)(16 * i + 1) * N); } } } while (0)
#define CVQ_STEP(C_, S_, BUF_, ISSUE_) do { \
        LAS unsigned* tile = (LAS unsigned*)lds + (BUF_) * (4 * 2080); \
        const CvqPos cur_ = S_; \
        _Pragma("unroll") for (int j = 0; j < 4; ++j) { \
            if ((cur_.nx + j) * 64 >= N) { _Pragma("unroll") for (int i = 0; i < 8; ++i) C_[j][i] = 0.f; } \
            _Pragma("unroll") for (int i = 0; i < 4; ++i) tile[j * 2080 + (ty + 8 * i) * 65 + tx] = pk_bf16(C_[j][2 * i], C_[j][2 * i + 1]); } \
        if (ISSUE_) { cvq_adv4(S_, tn, tk); cvq_adv4(S_, tn, tk); CVQ_ISSUE(C_, S_); } \
        __syncthreads(); \
        _Pragma("unroll") for (int j = 0; j < 4; ++j) { \
            const LAS unsigned* tl = tile + j * 2080 + (4 * wq) * 65 + wn; \
            u32x4 o; o.x = tl[0]; o.y = tl[65]; o.z = tl[130]; o.w = tl[195]; \
            __builtin_nontemporal_store(o, (u32x4*)(Wt + (size_t)cur_.bz * Npad * K + (size_t)((cur_.nx + j) * 64 + wn) * K + cur_.ky * 64 + 8 * wq));        \
        } } while (0)
    CvqPos sa, sb;
    { int tq = t0; sa.nx = tq % tn; tq /= tn; sa.ky = tq % tk; sa.bz = tq / tk; sb = sa; cvq_adv4(sb, tn, tk); }
    CVQ_ISSUE(ca, sa); CVQ_ISSUE(cb, sb);
    int tp = t0;
    for (; tp + 8 < t1; tp += 8) {
        CVQ_STEP(ca, sa, 0, true);
        CVQ_STEP(cb, sb, 1, true);
    }
    CVQ_STEP(ca, sa, 0, false);
    CVQ_STEP(cb, sb, 1, false);
    __syncthreads();
#undef CVQ_STEP
#undef CVQ_ISSUE
}
constexpr int CVQ_NG = 208;
constexpr int CVQ_SEG_E = 64 * 256, CVQ_SEG_S = 256, CVQ_BATCH = 32, CVQ_MOE_TILES = 3 * (CVQ_SEG_E + CVQ_SEG_S);
constexpr int CVQ_X0 = (9472 / 64) * (DM / 64), CVQ_X1 = (DM / 64) * (4096 / 64), CVQ_X2 = (3072 / 64) * (512 / 64), CVQ_X3 = (4096 / 64) * (512 / 64), CVQ_X4 = CVQ_X1, CVQ_X5 = 2 * (256 / 64) * (4096 / 64);
constexpr int CVQ_XTRA = CVQ_X0 + CVQ_X1 + CVQ_X2 + CVQ_X3 + CVQ_X4 + CVQ_X5;
static_assert(CVQ_X0 % CVQ_BATCH == 0 && CVQ_X1 % CVQ_BATCH == 0 && CVQ_X2 % CVQ_BATCH == 0 && CVQ_X3 % CVQ_BATCH == 0 && CVQ_X5 % CVQ_BATCH == 0 && CVQ_SEG_S % CVQ_BATCH == 0, "batches must not straddle matrices");
DI void moe_cvt_queue(LAS unsigned char* lds, const MP& p, int layer, unsigned* ctr) {
    const size_t eo = (size_t)layer * 64 * DM * 512, so = (size_t)layer * DM * 512;
    volatile LAS int* slot = (volatile LAS int*)(lds + LDS_BAR_OFF + 32);
    const int nbatch = (CVQ_MOE_TILES + (layer == 0 ? CVQ_XTRA : 0)) / CVQ_BATCH;
    asm volatile("s_waitcnt vmcnt(0)" ::: "memory");
    for (;;) {
        __syncthreads();
        if (threadIdx.x == 0) *slot = (int)__hip_atomic_fetch_add(ctr, 1u, __ATOMIC_RELAXED, __HIP_MEMORY_SCOPE_AGENT);
        __syncthreads();
        const int bt = __builtin_amdgcn_readfirstlane(*slot);
        if (bt >= nbatch) break;
        int g = bt * CVQ_BATCH;
        const float* W; bf16_t* Wt; int K, N, Npad;
        if (g < CVQ_MOE_TILES) {
            const int m = g / (CVQ_SEG_E + CVQ_SEG_S); g -= m * (CVQ_SEG_E + CVQ_SEG_S);
            const bool sh = g >= CVQ_SEG_E; if (sh) g -= CVQ_SEG_E;
            W = (m == 0) ? (sh ? p.sg + so : p.w_gate + eo) : (m == 1) ? (sh ? p.su + so : p.w_up + eo) : (sh ? p.sd + so : p.w_down + eo);
            Wt = ((m == 0) ? p.WgT : (m == 1) ? p.WuT : p.WdT) + (sh ? (size_t)64 * 512 * DM : (size_t)0);
            K = (m == 2) ? 512 : DM; N = (m == 2) ? DM : 512; Npad = N;
        } else {
            g -= CVQ_MOE_TILES;
            if (g < CVQ_X0) { W = p.cd_w_in; Wt = p.WinCDt; K = DM; N = CD_IN; Npad = 9472; }
            else if ((g -= CVQ_X0) < CVQ_X1) { W = p.cd_w_out; Wt = p.WoutCDt; K = 4096; N = DM; Npad = DM; }
            else if ((g -= CVQ_X1) < CVQ_X2) { W = p.w_uq; Wt = p.Wuqt; K = 512; N = 3072; Npad = 3072; }
            else if ((g -= CVQ_X2) < CVQ_X3) { W = p.w_ukv; Wt = p.Wukvt; K = 512; N = 4096; Npad = 4096; }
            else if ((g -= CVQ_X3) < CVQ_X4) { W = p.ab_w_out; Wt = p.WoutABt; K = 4096; N = DM; Npad = DM; }
            else { g -= CVQ_X4; W = p.cmp_w; Wt = p.WcmpT; K = 4096; N = 128; Npad = 256; }
        }
        cvt_wT_quad(lds, W, Wt, K, N, Npad, g, g + CVQ_BATCH);
    }
    __syncthreads();
}

DI void ph_cvt_x(const MP& p) {
    const int tix = tid_opaque();
    const long gt = (long)blockIdx.x * NTHR + tix, gs = (long)gridDim.x * NTHR;
    for (long i = gt; i < (long)T_TOK * DM / 4; i += gs) { const float4 v = ((const float4*)p.x)[i]; u32x2 o; o.x = pk_bf16(v.x, v.y); o.y = pk_bf16(v.z, v.w); ((u32x2*)p.xb)[i] = o; }
    for (long i = gt; i < DM / 2; i += gs) ((unsigned*)(p.xb + (size_t)T_TOK * DM))[i] = 0u;
}


DI void ph_ssd_norm(const MP& p) {
    const int tix = tid_opaque();
    const int lane = tix & 63, gw = blockIdx.x * NWAVE + (tix >> 6), nw = gridDim.x * NWAVE;
    const bf16_t* mixh = (const bf16_t*)p.mix;
    u32x2 nv[8];
    if (gw < T_TOK) {
#pragma unroll
        for (int j = 0; j < 8; ++j) nv[j] = __builtin_nontemporal_load((const u32x2*)(mixh + (long)gw * 4096 + j * 256 + lane * 4));
    }
    for (int row = gw; row < T_TOK; row += nw) {
        float4 v[8]; float ss = 0.f;
#pragma unroll
        for (int j = 0; j < 8; ++j) { v[j].x = bflo(nv[j].x); v[j].y = bfhi(nv[j].x); v[j].z = bflo(nv[j].y); v[j].w = bfhi(nv[j].y); ss += v[j].x * v[j].x + v[j].y * v[j].y + v[j].z * v[j].z + v[j].w * v[j].w; }
        if (row + nw < T_TOK) {
#pragma unroll
            for (int j = 0; j < 8; ++j) nv[j] = __builtin_nontemporal_load((const u32x2*)(mixh + (long)(row + nw) * 4096 + j * 256 + lane * 4));
        }
        const float r = rsqrtf(wave_sum(ss) / 2048.f + 1e-6f);
#pragma unroll
        for (int j = 0; j < 8; ++j) { const float4 w = *(const float4*)(p.ssm_norm_w + j * 256 + lane * 4);
            u32x2 o; o.x = pk_bf16(v[j].x * r * w.x, v[j].y * r * w.y); o.y = pk_bf16(v[j].z * r * w.z, v[j].w * r * w.w);
            *(u32x2*)(p.mixb + (long)row * 4096 + j * 256 + lane * 4) = o; }
    }
}

DI void ph_build_wr(const MP& p) {
    const int tix = tid_opaque();
    const long gt = (long)blockIdx.x * NTHR + tix, gs = (long)gridDim.x * NTHR;
    for (long idx = gt; idx < (long)2 * 256 * 4096; idx += gs) {
        const int k = (int)(idx & 4095), n = (int)((idx >> 12) & 255), layer = (int)(idx >> 20);
        float v = 0.f;
        if (n < 128) {
            const float wv = p.w_router[((size_t)layer * DM + (k & 2047)) * 64 + (n & 63)];
            const float hi = bf2f(f2bf(wv));
            if (n < 64) v = hi; else v = (k < 2048) ? (wv - hi) : 0.f;
        }
        p.WrT3[idx] = f2bf(v);
    }
}
template <bool XBF> DI void ph_ln(const MP& p, const void* xin_, const bf16_t* add, const float* gg, const float* bb, bf16_t* xob, bf16_t* xlo) {
    const int tix = tid_opaque();
    const int lane = tix & 63, gw = blockIdx.x * NWAVE + (tix >> 6), nw = gridDim.x * NWAVE;
    float4 na[8]; u32x2 nc[8];
    const float* xin = (const float*)xin_; const bf16_t* xinb = (const bf16_t*)xin_;
#define LN_LOADX(row_, j_) do { if constexpr (XBF) { const u32x2 h_ = __builtin_nontemporal_load((const u32x2*)(xinb + (long)(row_) * DM + (j_) * 256 + lane * 4)); na[j_] = make_float4(bflo(h_.x), bfhi(h_.x), bflo(h_.y), bfhi(h_.y)); } \
        else { const f32x4 f_ = __builtin_nontemporal_load((const f32x4*)(xin + (long)(row_) * DM + (j_) * 256 + lane * 4)); na[j_] = make_float4(f_[0], f_[1], f_[2], f_[3]); } } while (0)
    if (gw < T_TOK) {
#pragma unroll
        for (int j = 0; j < 8; ++j) { LN_LOADX(gw, j); nc[j] = __builtin_nontemporal_load((const u32x2*)(add + (long)gw * DM + j * 256 + lane * 4)); }
    }
    for (int t = gw; t < T_TOK; t += nw) {
        float4 v[8]; float s = 0.f;
#pragma unroll
        for (int j = 0; j < 8; ++j) { const float4 a = na[j]; const u32x2 c = nc[j];
            v[j].x = DN_ALPHA * a.x + bflo(c.x); v[j].y = DN_ALPHA * a.y + bfhi(c.x); v[j].z = DN_ALPHA * a.z + bflo(c.y); v[j].w = DN_ALPHA * a.w + bfhi(c.y); s += (v[j].x + v[j].y) + (v[j].z + v[j].w); }
        if (t + nw < T_TOK) {
#pragma unroll
            for (int j = 0; j < 8; ++j) { LN_LOADX(t + nw, j); nc[j] = __builtin_nontemporal_load((const u32x2*)(add + (long)(t + nw) * DM + j * 256 + lane * 4)); }
        }
        const float mu = wave_sum(s) / DM;
        float q = 0.f;
#pragma unroll
        for (int j = 0; j < 8; ++j) { v[j].x -= mu; v[j].y -= mu; v[j].z -= mu; v[j].w -= mu; q += v[j].x * v[j].x + v[j].y * v[j].y + v[j].z * v[j].z + v[j].w * v[j].w; }
        const float rs = rsqrtf(wave_sum(q) / DM + 1e-5f);
#pragma unroll
        for (int j = 0; j < 8; ++j) { const int c0 = j * 256 + lane * 4; const float4 g4 = *(const float4*)(gg + c0), b4 = *(const float4*)(bb + c0);
            float4 o; o.x = v[j].x * rs * g4.x + b4.x; o.y = v[j].y * rs * g4.y + b4.y; o.z = v[j].z * rs * g4.z + b4.z; o.w = v[j].w * rs * g4.w + b4.w;
            u32x2 hb; hb.x = pk_bf16(o.x, o.y); hb.y = pk_bf16(o.z, o.w); *(u32x2*)(xob + (long)t * DM + c0) = hb;
            u32x2 lb2; lb2.x = pk_bf16(o.x - bflo(hb.x), o.y - bfhi(hb.x)); lb2.y = pk_bf16(o.z - bflo(hb.y), o.w - bfhi(hb.y)); *(u32x2*)(xlo + (long)t * DM + c0) = lb2; }
    }
}
#undef LN_LOADX
DI void ph_route_select(const MP& p, const float* Cpart, const float* rbias) {
    const int tix = tid_opaque();
    const int lane = tix & 63, gw = blockIdx.x * NWAVE + (tix >> 6), nw = gridDim.x * NWAVE;
    const float bias = rbias[lane];
    const int grp = lane >> 3;
    for (int slot = gw; slot < MOE_NSLOT; slot += nw) {
        int cnt = 0;
        for (int i = 0; i < MOE_SLOT_TOK; ++i) {
            const int t = slot * MOE_SLOT_TOK + i;
            float logit = 0.f;
#pragma unroll
            for (int q = 0; q < 4; ++q) { const float* cp = Cpart + ((size_t)q * T_TOK + t) * 128; logit += cp[lane] + cp[64 + lane]; }
            if (!(logit == logit)) logit = 0.f;
            const float score = 1.f / (1.f + expf(-logit));
            const float biased = score + bias;
            float m1 = biased;
            m1 = fmaxf(m1, __shfl_xor(m1, 1)); m1 = fmaxf(m1, __shfl_xor(m1, 2)); m1 = fmaxf(m1, __shfl_xor(m1, 4));
            const unsigned long long bm = __ballot(biased == m1);
            const unsigned gb = (unsigned)((bm >> (8 * grp)) & 0xffull);
            const int first = __ffs(gb) - 1;
            float v2 = ((lane & 7) == first) ? -3.0e38f : biased;
            v2 = fmaxf(v2, __shfl_xor(v2, 1)); v2 = fmaxf(v2, __shfl_xor(v2, 2)); v2 = fmaxf(v2, __shfl_xor(v2, 4));
            const float gs = m1 + v2;
            int grank = 0;
#pragma unroll
            for (int g2 = 0; g2 < 8; ++g2) { const float o = __shfl(gs, g2 * 8); grank += (o > gs || (o == gs && g2 < grp)) ? 1 : 0; }
            const bool gsel = grank < 4;
            const float masked = gsel ? biased : -3.0e38f;
            int erank = 0;
            for (int e2 = 0; e2 < 64; ++e2) { const float o = __shfl(masked, e2); erank += (o > masked || (o == masked && e2 < lane)) ? 1 : 0; }
            const bool selected = gsel && erank < 8;
            const float ws = wave_sum(selected ? score : 0.f);
            if (selected) { p.top_e[t * 8 + erank] = lane; p.top_w[t * 8 + erank] = score / ws * 2.5f; p.lpos[t * 8 + erank] = cnt; ++cnt; }
        }
        p.cnt_tab[slot * 64 + lane] = cnt;
    }
}
DI void ph_router_gemm(LAS unsigned char* lds, const MP& p, int layer, float* Cpart, const bf16_t* xlo) {
    gm::RouterProb q; q.xhi = (const char*)p.xb; q.dlo = (long)((const char*)xlo - (const char*)p.xb); q.Bt = (const char*)(p.WrT3 + (size_t)layer * 256 * 4096); q.K = 1024; q.G = (int)gridDim.x; q.c = (int)blockIdx.x; q.ldb = 4096;
    gm::EpiRouter e; e.Cpart = Cpart;
    gm::gemm_phase(lds, q, e);
}

DI void ph_moe_scan(LAS unsigned char* lds, const MP& p) {
    const int tix = tid_opaque();
    LAS int* part_b = (LAS int*)lds;
    LAS int* part_a = part_b + 512;
    LAS int* total = part_a + 512; LAS int* base = total + 64; LAS int* pre = base + 64; LAS int* pc = pre + 64;
    const int tid = tix, e = tid & 63, part = tid >> 6;
    const int spb = (MOE_NSLOT + gridDim.x - 1) / gridDim.x;
    const int s0 = blockIdx.x * spb, s1 = min(MOE_NSLOT, s0 + spb);
    int sb = 0, sa = 0;
#pragma unroll 16
    for (int sl = part; sl < MOE_NSLOT; sl += NWAVE) { const int c = p.cnt_tab[sl * 64 + e]; sa += c; if (sl < s0) sb += c; }
    part_b[part * 64 + e] = sb; part_a[part * 64 + e] = sa;
    __syncthreads();
    if (tid < 64) {
        int ta = 0, tb = 0;
#pragma unroll
        for (int i = 0; i < NWAVE; ++i) { ta += part_a[i * 64 + tid]; tb += part_b[i * 64 + tid]; }
        total[tid] = ta; pre[tid] = tb; pc[tid] = (ta + MOE_TM - 1) / MOE_TM * MOE_TM;
    }
    __syncthreads();
    LAS int* ubase = pc + 64 + 512;
    if (tid == 0) { int a = 0, ua = 0; for (int i = 0; i < 64; ++i) { base[i] = a; a += pc[i]; ubase[i] = ua; ua += total[i]; } }
    __syncthreads();
    if (spb <= 8) {
        LAS int* cl = pc + 64;
        const int sll = tid >> 6;
        cl[tid] = (s0 + sll < s1) ? p.cnt_tab[(s0 + sll) * 64 + e] : 0;
        __syncthreads();
        if (tid < 64) { int run = pre[tid]; for (int i = 0; i < 8; ++i) { const int c = cl[i * 64 + tid]; cl[i * 64 + tid] = run; run += c; } }
        __syncthreads();
        if (s0 + sll < s1) {
            const int a = tid & 63; const int t = (s0 + sll) * MOE_SLOT_TOK + (a >> 3), k = a & 7;
            const int ex = p.top_e[t * 8 + k] & 63;
            const int pp = base[ex] + cl[sll * 64 + ex] + p.lpos[t * 8 + k];
            if (pp >= 0 && pp < MOE_PMAX) { p.row_tok[pp] = t; p.row_slot[t * 8 + k] = pp - (base[ex] - ubase[ex]); }
        }
    } else
    for (int sl = s0; sl < s1; ++sl) {
        if (tid < 64) {
            const int t = sl * MOE_SLOT_TOK + (tid >> 3), k = tid & 7;
            const int ex = p.top_e[t * 8 + k] & 63;
            const int pp = base[ex] + pre[ex] + p.lpos[t * 8 + k];
            if (pp >= 0 && pp < MOE_PMAX) { p.row_tok[pp] = t; p.row_slot[t * 8 + k] = pp - (base[ex] - ubase[ex]); }
        }
        __syncthreads();
        if (tid < 64) pre[tid] += p.cnt_tab[sl * 64 + tid];
        __syncthreads();
    }
    for (int ex = blockIdx.x; ex < 64; ex += gridDim.x)
        for (int pp = base[ex] + total[ex] + tid; pp < base[ex] + pc[ex]; pp += NTHR) p.row_tok[pp] = -1;
    for (int i = blockIdx.x * NTHR + tid; i < T_TOK; i += gridDim.x * NTHR) p.row_tok[MOE_PMAX + i] = i;
    if (blockIdx.x == 0 && tid < 64) {
        const int ex = tid, nt = pc[ex] / MOE_TM, t0 = base[ex] / MOE_TM;
        for (int j = 0; j < nt; ++j) { p.tiles[(t0 + j) * 4 + 0] = ex; p.tiles[(t0 + j) * 4 + 1] = base[ex] + j * MOE_TM; p.tiles[(t0 + j) * 4 + 2] = min(MOE_TM, total[ex] - j * MOE_TM); p.tiles[(t0 + j) * 4 + 3] = base[ex] - ubase[ex]; }
        const int nr = (base[63] + pc[63]) / MOE_TM;
        if (ex == 63) *p.ntiles = nr + T_TOK / MOE_TM;
        for (int j = ex; j < T_TOK / MOE_TM; j += 64) { p.tiles[(nr + j) * 4 + 0] = 64; p.tiles[(nr + j) * 4 + 1] = MOE_PMAX + j * MOE_TM; p.tiles[(nr + j) * 4 + 2] = MOE_TM; p.tiles[(nr + j) * 4 + 3] = MOE_PMAX - T_TOK * 8; }
    }
    __syncthreads();
}

DI void ph_moe_combine_ln(const MP& p, const bf16_t* xhi, const bf16_t* xlo, const float* gg, const float* bb, float* out, bf16_t* ob) {
    const int tix = tid_opaque();
    const int lane = tix & 63, gw = blockIdx.x * NWAVE + (tix >> 6), nw = gridDim.x * NWAVE;
    int myslot = 0; float myw = 0.f;
    { const long rr = (long)gw + (long)(lane >> 3) * nw; if (rr < T_TOK) { myslot = p.row_slot[rr * 8 + (lane & 7)]; myw = p.top_w[rr * 8 + (lane & 7)]; } }
    int ri = 0;
    for (int row = gw; row < T_TOK; row += nw, ++ri) {
        if (ri == 8) { ri = 0; const long rr = (long)row + (long)(lane >> 3) * nw; if (rr < T_TOK) { myslot = p.row_slot[rr * 8 + (lane & 7)]; myw = p.top_w[rr * 8 + (lane & 7)]; } }
        float v[32];
#pragma unroll
        for (int j = 0; j < 4; ++j) { const u32x4 a = *(const u32x4*)(xhi + (long)row * DM + j * 512 + lane * 8), b = *(const u32x4*)(xlo + (long)row * DM + j * 512 + lane * 8);
            v[j * 8 + 0] = DN_ALPHA * (bflo(a.x) + bflo(b.x)); v[j * 8 + 1] = DN_ALPHA * (bfhi(a.x) + bfhi(b.x)); v[j * 8 + 2] = DN_ALPHA * (bflo(a.y) + bflo(b.y)); v[j * 8 + 3] = DN_ALPHA * (bfhi(a.y) + bfhi(b.y));
            v[j * 8 + 4] = DN_ALPHA * (bflo(a.z) + bflo(b.z)); v[j * 8 + 5] = DN_ALPHA * (bfhi(a.z) + bfhi(b.z)); v[j * 8 + 6] = DN_ALPHA * (bflo(a.w) + bflo(b.w)); v[j * 8 + 7] = DN_ALPHA * (bfhi(a.w) + bfhi(b.w)); }
#pragma unroll 3
        for (int k = 0; k < 9; ++k) {
            const size_t yr = (k < 8) ? (size_t)__builtin_amdgcn_readfirstlane(__shfl(myslot, ri * 8 + (k & 7))) : (size_t)((long)T_TOK * 8 + row);
            const float wk = (k < 8) ? __shfl(myw, ri * 8 + (k & 7)) : 1.f;
#pragma unroll
            for (int j = 0; j < 4; ++j) { const u32x4 y = __builtin_nontemporal_load((const u32x4*)(p.Y + yr * 2048 + j * 512 + lane * 8));
                v[j * 8 + 0] += wk * bflo(y.x); v[j * 8 + 1] += wk * bfhi(y.x); v[j * 8 + 2] += wk * bflo(y.y); v[j * 8 + 3] += wk * bfhi(y.y);
                v[j * 8 + 4] += wk * bflo(y.z); v[j * 8 + 5] += wk * bfhi(y.z); v[j * 8 + 6] += wk * bflo(y.w); v[j * 8 + 7] += wk * bfhi(y.w); }
        }
        float s = 0.f;
#pragma unroll
        for (int i = 0; i < 32; ++i) s += v[i];
        const float mu = wave_sum(s) / DM;
        float q = 0.f;
#pragma unroll
        for (int i = 0; i < 32; ++i) { v[i] -= mu; q += v[i] * v[i]; }
        const float rs = rsqrtf(wave_sum(q) / DM + 1e-5f);
#pragma unroll
        for (int j = 0; j < 4; ++j) { const int c0 = j * 512 + lane * 8;
            float o8[8];
#pragma unroll
            for (int i = 0; i < 8; ++i) o8[i] = v[j * 8 + i] * rs * gg[c0 + i] + bb[c0 + i];
            if (out) { *(float4*)(out + (long)row * DM + c0) = make_float4(o8[0], o8[1], o8[2], o8[3]);
                       *(float4*)(out + (long)row * DM + c0 + 4) = make_float4(o8[4], o8[5], o8[6], o8[7]); }
            if (ob) { u32x4 pk; pk.x = pk_bf16(o8[0], o8[1]); pk.y = pk_bf16(o8[2], o8[3]); pk.z = pk_bf16(o8[4], o8[5]); pk.w = pk_bf16(o8[6], o8[7]); *(u32x4*)(ob + (long)row * DM + c0) = pk; } }
    }
}

DI void ph_mla_rms(const MP& p) {
    const int tix = tid_opaque();
    const int lane = tix & 63, gw = blockIdx.x * NWAVE + (tix >> 6), nw = gridDim.x * NWAVE;
    for (int u = gw; u < T_TOK * 2; u += nw) {
        const int row = u >> 1, which = u & 1;
        const bf16_t* src = p.hbuf + (long)row * CD_IN + which * 512 + lane * 8;
        const u32x4 y = *(const u32x4*)src;
        float v[8] = {bflo(y.x), bfhi(y.x), bflo(y.y), bfhi(y.y), bflo(y.z), bfhi(y.z), bflo(y.w), bfhi(y.w)};
        float ss = 0.f;
#pragma unroll
        for (int i = 0; i < 8; ++i) ss += v[i] * v[i];
        const float r = rsqrtf(wave_sum(ss) / 512.f + 1e-6f);
        const float* w = (which ? p.kv_norm_w : p.q_norm_w) + lane * 8;
        u32x4 o; o.x = pk_bf16(v[0] * r * w[0], v[1] * r * w[1]); o.y = pk_bf16(v[2] * r * w[2], v[3] * r * w[3]); o.z = pk_bf16(v[4] * r * w[4], v[5] * r * w[5]); o.w = pk_bf16(v[6] * r * w[6], v[7] * r * w[7]);
        *(u32x4*)(p.cqb + (long)row * 1024 + which * 512 + lane * 8) = o;
    }
}
DI void ph_rope_k(const MP& p) {
    const int tix = tid_opaque();
    const long gt = (long)blockIdx.x * NTHR + tix, gs = (long)gridDim.x * NTHR;
    for (long idx = gt; idx < (long)T_TOK * 32; idx += gs) {
        const int j = (int)(idx & 31); const int t = (int)(idx >> 5);
        const float inv = powf(10000.f, -(float)(2 * j) / 64.f);
        const float ang = (float)p.positions[t] * inv;
        const float c = cosf(ang), sn = sinf(ang);
        const bf16_t* pp = p.hbuf + (long)t * CD_IN + CD_KR;
        const float t1 = ldh(pp, j), t2 = ldh(pp, j + 32);
        { const int b = t >> 11, sq = t & 2047; const size_t tb = ((size_t)b * 64 + (sq >> 5)) * 4; const int r = sq & 31;
          p.kr[(tb + (j >> 4)) * 512 + (((j >> 3) & 1) * 32 + r) * 8 + (j & 7)] = f2bf(t1 * c - t2 * sn);
          p.kr[(tb + ((j + 32) >> 4)) * 512 + ((((j + 32) >> 3) & 1) * 32 + r) * 8 + (j & 7)] = f2bf(t1 * sn + t2 * c); }
        *(float2*)(p.rope_tab + ((long)t * 32 + j) * 2) = make_float2(c, sn);
    }
}
DI void ph_hgrn_post(const MP& p) {
    const int tix = tid_opaque();
    const int lane = tix & 63, gw = blockIdx.x * NWAVE + (tix >> 6), nw = gridDim.x * NWAVE;
    for (int t = gw; t < T_TOK; t += nw) {
#pragma unroll
        for (int j = 0; j < 4; ++j) {
            const int col = j * 512 + lane * 8;
            const float4 a = *(const float4*)(p.x3 + (long)t * 2048 + col), c = *(const float4*)(p.x3 + (long)t * 2048 + col + 4);
            float ss = a.x * a.x + a.y * a.y + a.z * a.z + a.w * a.w + c.x * c.x + c.y * c.y + c.z * c.z + c.w * c.w;
            ss += __shfl_xor(ss, 1); ss += __shfl_xor(ss, 2); ss += __shfl_xor(ss, 4); ss += __shfl_xor(ss, 8);
            const float r = rsqrtf(ss / 128.f + 1e-6f);
            const u32x4 gv = *(const u32x4*)(p.hbuf + (long)t * CD_IN + CD_HG + col);
            const float4 w0 = *(const float4*)(p.hgrn_norm_w + (col & 127)), w1 = *(const float4*)(p.hgrn_norm_w + (col & 127) + 4);
            u32x4 o;
            o.x = pk_bf16(a.x * r * w0.x * siluf_(bflo(gv.x)), a.y * r * w0.y * siluf_(bfhi(gv.x)));
            o.y = pk_bf16(a.z * r * w0.z * siluf_(bflo(gv.y)), a.w * r * w0.w * siluf_(bfhi(gv.y)));
            o.z = pk_bf16(c.x * r * w1.x * siluf_(bflo(gv.z)), c.y * r * w1.y * siluf_(bfhi(gv.z)));
            o.w = pk_bf16(c.z * r * w1.z * siluf_(bflo(gv.w)), c.w * r * w1.w * siluf_(bfhi(gv.w)));
            *(u32x4*)(p.mixb + (long)t * 4096 + 2048 + col) = o;
        }
    }
}


typedef float f32x16 __attribute__((ext_vector_type(16)));
#define MFMA32(a, b, c) __builtin_amdgcn_mfma_f32_32x32x16_bf16((a), (b), (c), 0, 0, 0)
DI bf16x8 ld8(const bf16_t* q) { return *(const bf16x8*)q; }
DI size_t lnd(size_t v) { asm volatile("" : "+v"(v)); return v; }
DI const bf16_t* launder(const bf16_t* q) { asm volatile("" : "+v"(q)); return q; }
DI bf16x8 pack8(float a0, float a1, float a2, float a3, float a4, float a5, float a6, float a7) {
    u32x4 u; u.x = pk_bf16(a0, a1); u.y = pk_bf16(a2, a3); u.z = pk_bf16(a4, a5); u.w = pk_bf16(a6, a7); return __builtin_bit_cast(bf16x8, u);
}
DI void ph_mla_attn(LAS unsigned char* lds, const MP& p) {
    const int tix = tid_opaque();
    const int w = tix >> 6, lane = tix & 63, r = lane & 31, hh = lane >> 5;
    const bf16_t* qm = (const bf16_t*)p.xbc;
    const bf16_t* kfr = (const bf16_t*)p.kvfrag;
    const bf16_t* vfr = kfr + (size_t)T_TOK * 2048;
    const float sc2 = 0.07216878364870322f * 1.4426950408889634f;
    constexpr int SLOT = 20 * 1024;
    for (int unit = blockIdx.x; unit < NB * 16 * 4; unit += gridDim.x) {
        const int pair = unit & 3, head = (unit >> 2) & 15, b = unit >> 6;
        const bf16_t* g0 = kfr + (((size_t)(b * 16 + head) * 64) * 8 + w) * 512 + lane * 8;
        const bf16_t* g1 = (w < 4) ? p.kr + (((size_t)b * 64) * 4 + w) * 512 + lane * 8
                                   : vfr + (((size_t)(b * 16 + head) * 64) * 8 + (w - 4)) * 512 + lane * 8;
        const size_t g1step = (w < 4) ? 2048 : 4096;
        const bf16_t* g2 = vfr + (((size_t)(b * 16 + head) * 64) * 8 + 4 + (w & 3)) * 512 + lane * 8;
        const unsigned l0 = (unsigned)w * 1024u, l1 = (unsigned)(8 + w) * 1024u, l2 = (unsigned)(16 + (w & 3)) * 1024u;
#define MLA_DMA(kt_, slot_) do { LAS unsigned char* sb_ = lds + (slot_) * SLOT; \
        __builtin_amdgcn_global_load_lds((const unsigned*)(g0 + (size_t)(kt_) * 4096), (LAS unsigned*)(sb_ + l0), 16, 0, 0); \
        __builtin_amdgcn_global_load_lds((const unsigned*)(g1 + (size_t)(kt_) * g1step), (LAS unsigned*)(sb_ + l1), 16, 0, 0); \
        __builtin_amdgcn_global_load_lds((const unsigned*)(g2 + (size_t)(kt_) * 4096), (LAS unsigned*)(sb_ + l2), 16, 0, 0); } while (0)
        for (int half = 0; half < 2; ++half) {
            const int qb = half ? 7 - pair : pair;
            const int row0 = qb * 256 + 32 * w;
            const long tq = (long)b * SEQ + row0 + r;
            bf16x8 qf[12];
#pragma unroll
            for (int st = 0; st < 12; ++st) qf[st] = ld8(qm + tq * 3072 + head * 192 + 16 * st + 8 * hh);
#pragma unroll
            for (int g2i = 0; g2i < 2; ++g2i) {
                float o1[8], o2[8];
#pragma unroll
                for (int j = 0; j < 8; ++j) {
                    const float2 cs = *(const float2*)(p.rope_tab + (tq * 32 + 16 * g2i + 8 * hh + j) * 2);
                    const float t1 = bf2f((bf16_t)qf[8 + g2i][j]), t2 = bf2f((bf16_t)qf[10 + g2i][j]);
                    o1[j] = t1 * cs.x - t2 * cs.y; o2[j] = t1 * cs.y + t2 * cs.x;
                }
                qf[8 + g2i] = pack8(o1[0], o1[1], o1[2], o1[3], o1[4], o1[5], o1[6], o1[7]);
                qf[10 + g2i] = pack8(o2[0], o2[1], o2[2], o2[3], o2[4], o2[5], o2[6], o2[7]);
            }
            f32x16 O[4];
#pragma unroll
            for (int dt = 0; dt < 4; ++dt)
#pragma unroll
                for (int i = 0; i < 16; ++i) O[dt][i] = 0.f;
            float m = -INFINITY, l = 0.f;
            const int ktd = row0 >> 5;
            const int nt = qb * 8 + 8;
            asm volatile("s_waitcnt vmcnt(0)" ::: "memory");
            __syncthreads();
            MLA_DMA(0, 0); MLA_DMA(1, 1);
            for (int kt = 0; kt < nt; ++kt) {
                asm volatile("s_waitcnt vmcnt(3)" ::: "memory");
                __builtin_amdgcn_s_barrier();
                { const int kn2 = (kt + 2 < nt) ? kt + 2 : kt; MLA_DMA(kn2, (kt + 2) % 3); }
                if (kt <= ktd) {
                    const LAS unsigned char* sb = lds + (kt % 3) * SLOT + lane * 16;
                    bf16x8 kfr[12];
#pragma unroll
                    for (int st = 0; st < 12; ++st) kfr[st] = *(const LAS bf16x8*)(sb + st * 1024);
                    __builtin_amdgcn_sched_barrier(0);
                    f32x16 S, S2;
#pragma unroll
                    for (int i = 0; i < 16; ++i) { S[i] = 0.f; S2[i] = 0.f; }
#pragma unroll
                    for (int st = 0; st < 12; st += 2) { S = MFMA32(kfr[st], qf[st], S); S2 = MFMA32(kfr[st + 1], qf[st + 1], S2); }
                    bf16x8 vfr[8];
#pragma unroll
                    for (int f = 0; f < 8; ++f) vfr[f] = *(const LAS bf16x8*)(sb + (12 + f) * 1024);
                    __builtin_amdgcn_sched_barrier(0);
#pragma unroll
                    for (int i = 0; i < 16; ++i) S[i] += S2[i];
                    if (kt == ktd) {
#pragma unroll
                        for (int i = 0; i < 16; ++i) if (((i & 3) + 8 * (i >> 2) + 4 * hh) > r) S[i] = -INFINITY;
                    }
                    float mx = S[0];
#pragma unroll
                    for (int i = 1; i < 16; ++i) mx = fmaxf(mx, S[i]);
                    if (__any((mx - m) * sc2 > 24.f)) {
                        const float cm = fmaxf(mx, __shfl_xor(mx, 32));
                        const float mn = fmaxf(m, cm);
                        const float alpha = (m == -INFINITY) ? 0.f : __builtin_amdgcn_exp2f((m - mn) * sc2);
                        l *= alpha;
#pragma unroll
                        for (int dt = 0; dt < 4; ++dt)
#pragma unroll
                            for (int i = 0; i < 16; ++i) O[dt][i] *= alpha;
                        m = mn;
                    }
#pragma unroll
                    for (int i = 0; i < 16; ++i) { S[i] = __builtin_amdgcn_exp2f((S[i] - m) * sc2); l += S[i]; }
                    const bf16x8 pf0 = pack8(S[0], S[1], S[2], S[3], S[4], S[5], S[6], S[7]);
                    const bf16x8 pf1 = pack8(S[8], S[9], S[10], S[11], S[12], S[13], S[14], S[15]);
#pragma unroll
                    for (int dt = 0; dt < 4; ++dt) O[dt] = MFMA32(vfr[dt * 2], pf0, O[dt]);
#pragma unroll
                    for (int dt = 0; dt < 4; ++dt) O[dt] = MFMA32(vfr[dt * 2 + 1], pf1, O[dt]);
                }
            }
            asm volatile("s_waitcnt vmcnt(0)" ::: "memory");
            l += __shfl_xor(l, 32);
            const float il = 1.f / l;
            bf16_t* orow = p.mixb + tq * 4096 + head * 128;
#pragma unroll
            for (int dt = 0; dt < 4; ++dt)
#pragma unroll
                for (int i4 = 0; i4 < 4; ++i4) {
                    u32x2 o; o.x = pk_bf16(O[dt][i4 * 4 + 0] * il, O[dt][i4 * 4 + 1] * il); o.y = pk_bf16(O[dt][i4 * 4 + 2] * il, O[dt][i4 * 4 + 3] * il);
                    *(u32x2*)(orow + 32 * dt + 8 * i4 + 4 * hh) = o;
                }
        }
#undef MLA_DMA
    }
    __syncthreads();
}

DI void ph_cmp_bias(const MP& p) {
    const int tix = tid_opaque();
    const int e = tix & 127, sub = tix >> 7;
    for (int u = blockIdx.x; u < 64; u += gridDim.x) {
        const int which = u >> 5, l = u & 31;
        const float* pp = p.cmp_pos + ((size_t)which * 32 + l) * 128;
        const float* ww = p.cmp_w + ((size_t)which * 4096 + (size_t)l * 128) * 128;
        float a = 0.f;
        for (int d = sub * 32; d < sub * 32 + 32; ++d) a += pp[d] * ww[(size_t)d * 128 + e];
        p.cpart[(((size_t)which * 32 + l) * 4 + sub) * 128 + e] = a;
    }
}

#define MFMA16(a, b, c) __builtin_amdgcn_mfma_f32_16x16x32_bf16((a), (b), (c), 0, 0, 0)
constexpr int NSA_ACC_STRIDE = 132;
constexpr int NSA_ACC_WAVE = 32 * NSA_ACC_STRIDE;
template <int BR = 7> DI void ph_nsa_attn(LAS unsigned char* lds, const MP& p) {
    const int tix = tid_opaque();
    const int w = tix >> 6, lane = tix & 63, r = lane & 31, hh = lane >> 5, c16 = lane & 15, kg = lane >> 4;
    LAS float* acc = (LAS float*)lds + w * NSA_ACC_WAVE;
    const bf16_t* hb = p.hbuf;
    const float c2 = 0.08838834764831845f * 1.4426950408889634f;
    for (int unit = blockIdx.x; unit < NB * 2 * 32; unit += gridDim.x) {
        const int bg = unit & 15, qb = unit >> 4, b = bg >> 1, g = bg & 1;
        for (int sub = 0; sub < 2; ++sub) {
            const int s0 = qb * 64 + __builtin_amdgcn_readfirstlane(w) * 8 + sub * 4;
            unsigned selp0 = 0u, selp1 = 0u;
            if constexpr ((BR & 1) != 0) {
                const int lz = tid_opaque(); const int r = lz & 31, hh = (lz >> 5) & 1; LAS float* acc = (LAS float*)lds + (lz >> 6) * NSA_ACC_WAVE;
                const int sq = s0 + (r >> 3), head = r & 7;
                const long tq = (long)b * SEQ + sq;
                const float g0 = sigmoidf_(ldh(hb + tq * AB_IN + AB_G + (g * 8 + head) * 3, 0));
                bf16x8 qf[8];
#pragma unroll
                for (int st = 0; st < 8; ++st) qf[st] = ld8(hb + tq * AB_IN + AB_Q + (g * 8 + head) * 128 + 16 * st + 8 * hh);
                const int nv_lane = sq >= 31 ? (sq - 31) / 16 + 1 : 0;
                const int nv_max = (s0 + 3 >= 31) ? (s0 + 3 - 31) / 16 + 1 : 0;
                const int nkt = (nv_max + 31) >> 5;
                float m = -INFINITY, l = 0.f;
                for (int kt = 0; kt < nkt; ++kt) {
                    const bf16_t* kp = p.kcb + lnd(((size_t)(bg * 128 + 32 * kt + r)) * 128 + 8 * hh);
                    bf16x8 kf[8];
#pragma unroll
                    for (int st = 0; st < 8; ++st) kf[st] = ld8(kp + 16 * st);
                    __builtin_amdgcn_sched_barrier(0);
                    f32x16 S;
#pragma unroll
                    for (int i = 0; i < 16; ++i) S[i] = 0.f;
#pragma unroll
                    for (int st = 0; st < 8; ++st) S = MFMA32(kf[st], qf[st], S);
                    float mx = -INFINITY;
#pragma unroll
                    for (int i = 0; i < 16; ++i) { const int key = 32 * kt + (i & 3) + 8 * (i >> 2) + 4 * hh; if (key >= nv_lane) S[i] = -INFINITY; mx = fmaxf(mx, S[i]); }
                    mx = fmaxf(mx, __shfl_xor(mx, 32));
                    const float mn = fmaxf(m, mx);
                    const float mm = (mn == -INFINITY) ? 0.f : mn;
                    float rs = 0.f;
#pragma unroll
                    for (int i = 0; i < 16; ++i) rs += __builtin_amdgcn_exp2f((S[i] - mm) * c2);
                    rs += __shfl_xor(rs, 32);
                    l = l * __builtin_amdgcn_exp2f((m - mm) * c2) + rs;
                    m = mn;
                }
                const float mm = (m == -INFINITY) ? 0.f : m;
                const float il = l > 0.f ? 1.f / l : 0.f;
                float A[16];
                float prev_same = 0.f;
                f32x16 O[4];
#pragma unroll
                for (int dt = 0; dt < 4; ++dt)
#pragma unroll
                    for (int i = 0; i < 16; ++i) O[dt][i] = 0.f;
#pragma unroll
                for (int kt = 0; kt < 4; ++kt) {
                    if (kt < nkt) {
                        f32x16 S;
#pragma unroll
                        for (int i = 0; i < 16; ++i) S[i] = 0.f;
                        const bf16_t* kp = p.kcb + lnd(((size_t)(bg * 128 + 32 * kt + r)) * 128 + 8 * hh);
                        const bf16_t* vp = p.vcT + lnd(((size_t)(bg * 128 + r)) * 128 + 32 * kt + 8 * hh);
                        bf16x8 kf[8], vf[4];
#pragma unroll
                        for (int st = 0; st < 8; ++st) kf[st] = ld8(kp + 16 * st);
                        __builtin_amdgcn_sched_barrier(0);
#pragma unroll
                        for (int st = 0; st < 8; ++st) S = MFMA32(kf[st], qf[st], S);
                        __builtin_amdgcn_sched_barrier(0);
#pragma unroll
                        for (int dt = 0; dt < 2; ++dt) { vf[2 * dt] = ld8(vp + (size_t)(32 * dt) * 128); vf[2 * dt + 1] = ld8(vp + (size_t)(32 * dt) * 128 + 16); }
                        __builtin_amdgcn_sched_barrier(0);
#pragma unroll
                        for (int i = 0; i < 16; ++i) { const int key = 32 * kt + (i & 3) + 8 * (i >> 2) + 4 * hh; S[i] = (key < nv_lane) ? __builtin_amdgcn_exp2f((S[i] - mm) * c2) * il : 0.f; }
#pragma unroll
                        for (int c4 = 0; c4 < 4; ++c4) { const int i = 4 * c4;
                            const float part = S[i] + S[i + 1] + S[i + 2] + 0.5f * S[i + 3], car = 0.5f * S[i + 3];
                            const float same = __shfl_xor(car, 32);
                            float av = part + (hh ? same : prev_same); prev_same = same;
                            av += __shfl_xor(av, 1); av += __shfl_xor(av, 2); av += __shfl_xor(av, 4);
                            A[4 * kt + c4] = av; }
                        const bf16x8 pf0 = pack8(S[0], S[1], S[2], S[3], S[4], S[5], S[6], S[7]);
                        const bf16x8 pf1 = pack8(S[8], S[9], S[10], S[11], S[12], S[13], S[14], S[15]);
#pragma unroll
                        for (int dt = 0; dt < 2; ++dt) { O[dt] = MFMA32(vf[2 * dt], pf0, O[dt]); O[dt] = MFMA32(vf[2 * dt + 1], pf1, O[dt]); }
                        __builtin_amdgcn_sched_barrier(0);
#pragma unroll
                        for (int dt = 2; dt < 4; ++dt) { vf[2 * dt - 4] = ld8(vp + (size_t)(32 * dt) * 128); vf[2 * dt - 3] = ld8(vp + (size_t)(32 * dt) * 128 + 16); }
                        __builtin_amdgcn_sched_barrier(0);
#pragma unroll
                        for (int dt = 2; dt < 4; ++dt) { O[dt] = MFMA32(vf[2 * dt - 4], pf0, O[dt]); O[dt] = MFMA32(vf[2 * dt - 3], pf1, O[dt]); }
                    } else {
#pragma unroll
                        for (int c4 = 0; c4 < 4; ++c4) { float av = hh ? 0.f : prev_same; prev_same = 0.f; av += __shfl_xor(av, 1); av += __shfl_xor(av, 2); av += __shfl_xor(av, 4); A[4 * kt + c4] = av; }
                    }
                    __builtin_amdgcn_sched_barrier(0);
                }
#pragma unroll
                for (int dt = 0; dt < 4; ++dt)
#pragma unroll
                    for (int i4 = 0; i4 < 4; ++i4) { f32x4 o4; o4[0] = g0 * O[dt][4 * i4]; o4[1] = g0 * O[dt][4 * i4 + 1]; o4[2] = g0 * O[dt][4 * i4 + 2]; o4[3] = g0 * O[dt][4 * i4 + 3];
                        *(LAS f32x4*)(acc + r * NSA_ACC_STRIDE + 32 * dt + 8 * i4 + 4 * hh) = o4; }
                __builtin_amdgcn_sched_barrier(0);
                const int cur = sq >> 6;
#pragma unroll
                for (int q = 0; q < 16; ++q) { const int j = 2 * q + hh; const bool forced = (j == 0) || (j == cur) || (j == cur - 1); A[q] = forced ? 1.0e6f : (j <= cur ? A[q] : -1.0f); }
#pragma unroll
                for (int n = 0; n < 8; ++n) {
                    float bv = A[0]; int bj = hh;
#pragma unroll
                    for (int q = 1; q < 16; ++q) { if (A[q] > bv) { bv = A[q]; bj = 2 * q + hh; } }
                    const float ov = __shfl_xor(bv, 32); const int oj = __shfl_xor(bj, 32);
                    const bool take_other = (ov > bv) || (ov == bv && oj < bj);
                    const int wj = take_other ? oj : bj;
                    if (n < 4) selp0 |= (unsigned)wj << (8 * n); else selp1 |= (unsigned)wj << (8 * (n - 4));
#pragma unroll
                    for (int q = 0; q < 16; ++q) if (2 * q + hh == wj) A[q] = -INFINITY;
                }
            }
            __builtin_amdgcn_sched_barrier(0);
            if constexpr ((BR & 2) != 0) {
                const int lz = tid_opaque(); const int r = lz & 31, hh = (lz >> 5) & 1; LAS float* acc = (LAS float*)lds + (lz >> 6) * NSA_ACC_WAVE;
                const int sq = s0 + (r >> 3), head = r & 7;
                const long tq = (long)b * SEQ + sq;
                bf16x8 qw[8];
                { const bf16_t* qp = hb + lnd((size_t)tq * AB_IN + AB_Q + (g * 8 + head) * 128 + 8 * hh);
#pragma unroll
                  for (int st = 0; st < 8; ++st) qw[st] = ld8(qp + 16 * st); }
                f32x16 O[4];
#pragma unroll
                for (int dt = 0; dt < 4; ++dt)
#pragma unroll
                    for (int i = 0; i < 16; ++i) O[dt][i] = 0.f;
                float m = -INFINITY, l = 0.f;
                const int klo = s0 - 511 > 0 ? s0 - 511 : 0;
                const int kt_lo = klo >> 5, kt_hi = (s0 + 3) >> 5;
                for (int kt = kt_lo; kt <= kt_hi; ++kt) {
                    const size_t fo = lnd((((size_t)bg * 64 + kt) * 8 * 64 + (lz & 63)) * 8);
                    const bf16_t* kp = p.kwf + fo; const bf16_t* vb = p.vwinT + fo;
                    bf16x8 kf[8], vf[8];
#pragma unroll
                    for (int st = 0; st < 8; ++st) kf[st] = ld8(kp + st * 512);
                    __builtin_amdgcn_sched_barrier(0);
                    f32x16 S;
#pragma unroll
                    for (int i = 0; i < 16; ++i) S[i] = 0.f;
#pragma unroll
                    for (int st = 0; st < 8; ++st) S = MFMA32(kf[st], qw[st], S);
                    __builtin_amdgcn_sched_barrier(0);
#pragma unroll
                    for (int f = 0; f < 8; ++f) vf[f] = ld8(vb + f * 512);
                    __builtin_amdgcn_sched_barrier(0);
#pragma unroll
                    for (int i = 0; i < 16; ++i) { const int key = 32 * kt + (i & 3) + 8 * (i >> 2) + 4 * hh; if (key > sq || key <= sq - 512) S[i] = -INFINITY; }
                    float mx = S[0];
#pragma unroll
                    for (int i = 1; i < 16; ++i) mx = fmaxf(mx, S[i]);
                    if (__any((mx - m) * c2 > 24.f)) {
                        const float cm = fmaxf(mx, __shfl_xor(mx, 32));
                        const float mn = fmaxf(m, cm);
                        const float alpha = (m == -INFINITY) ? 0.f : __builtin_amdgcn_exp2f((m - mn) * c2);
                        l *= alpha;
#pragma unroll
                        for (int dt = 0; dt < 4; ++dt)
#pragma unroll
                            for (int i = 0; i < 16; ++i) O[dt][i] *= alpha;
                        m = mn;
                    }
                    const float mr = (m == -INFINITY) ? 0.f : m;
#pragma unroll
                    for (int i = 0; i < 16; ++i) { S[i] = __builtin_amdgcn_exp2f((S[i] - mr) * c2); l += S[i]; }
                    const bf16x8 pf0 = pack8(S[0], S[1], S[2], S[3], S[4], S[5], S[6], S[7]);
                    const bf16x8 pf1 = pack8(S[8], S[9], S[10], S[11], S[12], S[13], S[14], S[15]);
#pragma unroll
                    for (int dt = 0; dt < 4; ++dt) { O[dt] = MFMA32(vf[dt * 2], pf0, O[dt]); O[dt] = MFMA32(vf[dt * 2 + 1], pf1, O[dt]); }
                }
                l += __shfl_xor(l, 32);
                const float sc = sigmoidf_(ldh(hb + tq * AB_IN + AB_G + (g * 8 + head) * 3, 2)) / l;
#pragma unroll
                for (int dt = 0; dt < 4; ++dt)
#pragma unroll
                    for (int i4 = 0; i4 < 4; ++i4) { LAS f32x4* ap = (LAS f32x4*)(acc + r * NSA_ACC_STRIDE + 32 * dt + 8 * i4 + 4 * hh); f32x4 o4 = *ap;
                        o4[0] += sc * O[dt][4 * i4]; o4[1] += sc * O[dt][4 * i4 + 1]; o4[2] += sc * O[dt][4 * i4 + 2]; o4[3] += sc * O[dt][4 * i4 + 3]; *ap = o4; }
            }
            __builtin_amdgcn_sched_barrier(0); asm volatile("" ::: "memory");
            if constexpr ((BR & 4) != 0)
#pragma unroll 1
            for (int pr = 0; pr < 2; ++pr) {
                const int lz = tid_opaque(); const int c16 = lz & 15, kg = (lz >> 4) & 3; LAS float* acc = (LAS float*)lds + (lz >> 6) * NSA_ACC_WAVE;
                const bf16_t* kbase = p.ksf + (((size_t)bg * 128) * 4 * 64 + (lz & 63)) * 8;
                const bf16_t* vbase = p.vselT + (((size_t)bg * 64) * 8 * 64 + (lz & 63)) * 8;
                const int cur = qb;
#define NSA_KEY0(it_) ((int)((((it_) < 8 ? sp0 : sp1) >> (8 * (((it_) >> 1) & 3))) & 0xffu) * 64 + 32 * ((it_) & 1))
#define NSA_LOADK(it_) do { const int k0_ = NSA_KEY0(it_); const bf16_t* kp_ = kbase + (size_t)(k0_ >> 4) * 2048; \
        _Pragma("unroll") for (int st = 0; st < 4; ++st) { kR[st] = ld8(kp_ + st * 512); kR[4 + st] = ld8(kp_ + 2048 + st * 512); } } while (0)
#define NSA_LOADV(it_) do { const int k0_ = NSA_KEY0(it_); const bf16_t* vp_ = vbase + (size_t)(k0_ >> 5) * 4096; \
        _Pragma("unroll") for (int dt = 0; dt < 8; ++dt) vR[dt] = ld8(vp_ + dt * 512); } while (0)
#define NSA_SOFTMAX_PV(SQL_, SQMIN_, O_, M_, L_) do { \
                        if (key0 + 31 > (SQMIN_)) { \
                            _Pragma("unroll") for (int i = 0; i < 4; ++i) { if (key0 + 4 * kg + i > (SQL_)) Sa[i] = -INFINITY; if (key0 + 16 + 4 * kg + i > (SQL_)) Sb[i] = -INFINITY; } \
                        } \
                        const float mx = fmaxf(fmaxf(fmaxf(Sa[0], Sa[1]), fmaxf(Sa[2], Sa[3])), fmaxf(fmaxf(Sb[0], Sb[1]), fmaxf(Sb[2], Sb[3]))); \
                        if (__any((mx - M_) * c2 > 24.f)) { \
                            float cm = fmaxf(mx, __shfl_xor(mx, 16)); cm = fmaxf(cm, __shfl_xor(cm, 32)); \
                            const float mn = fmaxf(M_, cm); \
                            const float alpha = (M_ == -INFINITY) ? 0.f : __builtin_amdgcn_exp2f((M_ - mn) * c2); \
                            L_ *= alpha; \
                            _Pragma("unroll") for (int dt = 0; dt < 8; ++dt) O_[dt] *= alpha; \
                            M_ = mn; \
                        } \
                        const float mr_ = (M_ == -INFINITY) ? 0.f : -M_ * c2; \
                        float pa[4], pb[4]; \
                        _Pragma("unroll") for (int i = 0; i < 4; ++i) { pa[i] = __builtin_amdgcn_exp2f(__builtin_fmaf(Sa[i], c2, mr_)); pb[i] = __builtin_amdgcn_exp2f(__builtin_fmaf(Sb[i], c2, mr_)); L_ += pa[i] + pb[i]; } \
                        const bf16x8 pf = pack8(pa[0], pa[1], pa[2], pa[3], pb[0], pb[1], pb[2], pb[3]); \
                        _Pragma("unroll") for (int dt = 0; dt < 8; ++dt) O_[dt] = MFMA16(vR[dt], pf, O_[dt]); \
                    } while (0)
#define NSA_CHUNKS(SQL_, SQMIN_, Q_, O_, M_, L_) do { \
                    bf16x8 kR[8], vR[8]; \
                    int it = vmask ? (__builtin_ctz(vmask)) : 16; \
                    { const int i0_ = it < 16 ? it : 0; NSA_LOADK(i0_); NSA_LOADV(i0_); } \
                    if (it < 16) { \
                        f32x4 Sa, Sb; int key0; \
                        __builtin_amdgcn_s_waitcnt(0x0F70);      \
                        for (;;) { \
                            const unsigned rem = (it < 15) ? (vmask >> (it + 1)) : 0u; \
                            const int nx = rem ? it + 1 + __builtin_ctz(rem) : 16; \
                            key0 = NSA_KEY0(it); \
                            Sa = (f32x4){0.f, 0.f, 0.f, 0.f}; Sb = (f32x4){0.f, 0.f, 0.f, 0.f}; \
                            _Pragma("unroll") for (int st = 0; st < 4; ++st) { Sa = MFMA16(kR[st], Q_[st], Sa); Sb = MFMA16(kR[4 + st], Q_[st], Sb); } \
                            __builtin_amdgcn_sched_barrier(0); \
                            if (nx >= 16) break; \
                            NSA_LOADK(nx); \
                            __builtin_amdgcn_sched_barrier(0); \
                            NSA_SOFTMAX_PV(SQL_, SQMIN_, O_, M_, L_); \
                            __builtin_amdgcn_sched_barrier(0); \
                            NSA_LOADV(nx); \
                            it = nx; \
                        } \
                        NSA_SOFTMAX_PV(SQL_, SQMIN_, O_, M_, L_); \
                    } } while (0)
                f32x4 O1[8];
#pragma unroll
                for (int dt = 0; dt < 8; ++dt) O1[dt] = (f32x4){0.f, 0.f, 0.f, 0.f};
                float m1 = -INFINITY, l1 = 0.f;
                {
                    const int sqL = s0 + 2 * pr + (c16 >> 3);
                    const long tqL = (long)b * SEQ + sqL;
                    bf16x8 qP[4];
#pragma unroll
                    for (int st = 0; st < 4; ++st) qP[st] = ld8(hb + tqL * AB_IN + AB_Q + (g * 8 + (c16 & 7)) * 128 + 32 * st + 8 * kg);
                    const int sqmax = s0 + 2 * pr + 1;
                    const unsigned sp0 = cur >= 2 ? (((unsigned)(cur - 1) << 8) | ((unsigned)cur << 16)) : (cur == 1 ? (1u << 8) : 0u), sp1 = 0u;
                    const int nf = cur >= 2 ? 3 : cur + 1;
                    unsigned vmask = 0u;
#pragma unroll
                    for (int n = 0; n < 3; ++n) { const int jb = (int)((sp0 >> (8 * n)) & 0xffu); if (n < nf) { if (jb * 64 <= sqmax) vmask |= 1u << (2 * n); if (jb * 64 + 32 <= sqmax) vmask |= 2u << (2 * n); } }
                    NSA_CHUNKS(sqL, s0 + 2 * pr, qP, O1, m1, l1);
                }
                __builtin_amdgcn_sched_barrier(0);
#pragma unroll 1
                for (int qi = 0; qi < 2; ++qi) {
                    const int ql = 2 * pr + qi;
                    const int sq2 = s0 + ql; const long tq2 = (long)b * SEQ + sq2;
                    bf16x8 q16[4];
#pragma unroll
                    for (int st = 0; st < 4; ++st) q16[st] = ld8(hb + tq2 * AB_IN + AB_Q + (g * 8 + (c16 & 7)) * 128 + 32 * st + 8 * kg);
                    const float g1q = sigmoidf_(ldh(hb + tq2 * AB_IN + AB_G + (g * 8 + (c16 & 7)) * 3, 1));
                    f32x4 O16[8];
#pragma unroll
                    for (int dt = 0; dt < 8; ++dt) O16[dt] = (f32x4){0.f, 0.f, 0.f, 0.f};
                    const int src = (lz & 0x37) | (qi << 3);
                    const float m0 = __shfl(m1, src);
                    float m = m0, l = __shfl(l1, src);
                    const unsigned sp0 = (unsigned)__builtin_amdgcn_readfirstlane(__shfl((int)selp0, ql * 8)), sp1 = (unsigned)__builtin_amdgcn_readfirstlane(__shfl((int)selp1, ql * 8));
                    unsigned vmask = 0u;
#pragma unroll
                    for (int n = 0; n < 8; ++n) { const int jb = (int)(((n < 4 ? sp0 : sp1) >> (8 * (n & 3))) & 0xffu);
                        const bool forced = (jb == 0) || (jb == cur) || (jb == cur - 1);
                        if (!forced) { if (jb * 64 <= sq2) vmask |= 1u << (2 * n); if (jb * 64 + 32 <= sq2) vmask |= 2u << (2 * n); } }
                    NSA_CHUNKS(sq2, sq2, q16, O16, m, l);
                    l += __shfl_xor(l, 16); l += __shfl_xor(l, 32);
                    const float sc = g1q / l;
                    const float f1 = sc * __builtin_amdgcn_exp2f((m0 - m) * c2);
                    if ((c16 >> 3) == qi) {
#pragma unroll
                        for (int dt = 0; dt < 8; ++dt) { LAS f32x4* ap = (LAS f32x4*)(acc + (ql * 8 + (c16 & 7)) * NSA_ACC_STRIDE + 16 * dt + 4 * kg); f32x4 o4 = *ap;
                            o4[0] += sc * O16[dt][0] + f1 * O1[dt][0]; o4[1] += sc * O16[dt][1] + f1 * O1[dt][1]; o4[2] += sc * O16[dt][2] + f1 * O1[dt][2]; o4[3] += sc * O16[dt][3] + f1 * O1[dt][3]; *ap = o4; }
                    }
                }
#undef NSA_CHUNKS
#undef NSA_SOFTMAX_PV
#undef NSA_LOADK
#undef NSA_LOADV
#undef NSA_KEY0
            }
            asm volatile("s_waitcnt lgkmcnt(0)" ::: "memory");
            {
                const int lz = tid_opaque(); const int lane = lz & 63; LAS float* acc = (LAS float*)lds + (lz >> 6) * NSA_ACC_WAVE;
                const int row = lane >> 1, dh = (lane & 1) * 64;
                const long tt = (long)b * SEQ + s0 + (row >> 3);
                bf16_t* op = p.mixb + tt * 4096 + 2048 + (g * 8 + (row & 7)) * 128 + dh;
#pragma unroll
                for (int k8 = 0; k8 < 8; ++k8) {
                    const f32x4 a = *(const LAS f32x4*)(acc + row * NSA_ACC_STRIDE + dh + 8 * k8), c = *(const LAS f32x4*)(acc + row * NSA_ACC_STRIDE + dh + 8 * k8 + 4);
                    u32x4 o; o.x = pk_bf16(a[0], a[1]); o.y = pk_bf16(a[2], a[3]); o.z = pk_bf16(c[0], c[1]); o.w = pk_bf16(c[2], c[3]);
                    *(u32x4*)(op + 8 * k8) = o;
                }
            }
            asm volatile("s_waitcnt lgkmcnt(0)" ::: "memory");
        }
    }
}

DI void ph_conv_ssd(LAS unsigned char* lds, const MP& p) {
    const int tix = tid_opaque();
    LAS bf16_t* tile = (LAS bf16_t*)lds;
    const int tok = tix >> 3, c8 = (tix & 7) * 8;
    bf16_t* xT = (bf16_t*)p.xbc; bf16_t* BT = xT + (size_t)NB * 2048 * 2048; bf16_t* bcr = BT + (size_t)NB * 512 * 2048;
    const int cskip = (gridDim.x >= 64) ? 16 : 0;
    if ((int)blockIdx.x < cskip) return;
    for (int u = blockIdx.x - cskip; u < NB * 32 * 48; u += gridDim.x - cskip) {
        const int ct = u % 48, tt = (u / 48) & 31, b = u / (48 * 32);
        const int c0 = ct * 64, s = tt * 64 + tok; const long t = (long)b * SEQ + s;
        float a[8];
        { const float4 b0 = *(const float4*)(p.conv_b + c0 + c8), b1 = *(const float4*)(p.conv_b + c0 + c8 + 4); a[0] = b0.x; a[1] = b0.y; a[2] = b0.z; a[3] = b0.w; a[4] = b1.x; a[5] = b1.y; a[6] = b1.z; a[7] = b1.w; }
#pragma unroll
        for (int k = 0; k < 4; ++k) {
            if (s - 3 + k >= 0) {
                const u32x4 hv = *(const u32x4*)(p.hbuf + (t - 3 + k) * AB_IN + AB_XBC + c0 + c8);
                const float4 w0 = *(const float4*)(p.conv_w + k * 3072 + c0 + c8), w1 = *(const float4*)(p.conv_w + k * 3072 + c0 + c8 + 4);
                a[0] += w0.x * bflo(hv.x); a[1] += w0.y * bfhi(hv.x); a[2] += w0.z * bflo(hv.y); a[3] += w0.w * bfhi(hv.y);
                a[4] += w1.x * bflo(hv.z); a[5] += w1.y * bfhi(hv.z); a[6] += w1.z * bflo(hv.w); a[7] += w1.w * bfhi(hv.w);
            }
        }
#pragma unroll
        for (int e = 0; e < 8; ++e) a[e] = siluf_(a[e]);
        if (ct >= 32) { u32x4 o; o.x = pk_bf16(a[0], a[1]); o.y = pk_bf16(a[2], a[3]); o.z = pk_bf16(a[4], a[5]); o.w = pk_bf16(a[6], a[7]); *(u32x4*)(bcr + t * 1024 + (c0 - 2048) + c8) = o; }
        if (ct < 40) {
#pragma unroll
            for (int e = 0; e < 8; ++e) tile[(c8 + e) * 72 + tok] = f2bf(a[e]);
        }
        __syncthreads();
        if (ct < 40) {
            const int ch = tix >> 3, tg = tix & 7;
            const u32x4 v = *(const LAS u32x4*)(tile + ch * 72 + 8 * tg);
            const int c = c0 + ch;
            bf16_t* dst = (ct < 32) ? xT + ((size_t)b * 2048 + c) * 2048 : BT + ((size_t)b * 512 + (c - 2048)) * 2048;
            const int pos = tt * 64 + 16 * (tg >> 1) + 4 * (tg & 1);
            u32x2 lo; lo.x = v.x; lo.y = v.y; u32x2 hi; hi.x = v.z; hi.y = v.w;
            *(u32x2*)(dst + pos) = lo; *(u32x2*)(dst + pos + 8) = hi;
        }
        __syncthreads();
    }
}

DI void ph_ssd_chunk(LAS unsigned char* lds, const MP& p) {
    const int tix = tid_opaque();
    const int w = tix >> 6, lane = tix & 63, r = lane & 31, hh = lane >> 5, pt = w >> 2, lt = w & 3;
    LAS bf16_t* S_base = (LAS bf16_t*)lds;
    LAS float* acs_all = (LAS float*)(lds + 2 * 64 * 136 * 2);
    LAS float* dts_all = acs_all + 2048;
    LAS float* wl_all = dts_all + 2048;
    const bf16_t* xT = (const bf16_t*)p.xbc; const bf16_t* BT = xT + (size_t)NB * 2048 * 2048; const bf16_t* bcr = BT + (size_t)NB * 512 * 2048;
    const float L2E = 1.4426950408889634f;
    for (int unit = blockIdx.x; unit < NB * 32; unit += gridDim.x) {
        const int b = unit >> 5, h = unit & 31, g = h >> 3;
        const float a = -__expf(p.a_log[h]), dbias = p.dt_bias[h], dskip = p.ssm_d[h];
        f32x16 S;
#pragma unroll
        for (int i = 0; i < 16; ++i) S[i] = 0.f;
        __syncthreads();
#pragma unroll
        for (int cc = 0; cc < 2; ++cc) {
            const int c = 2 * w + cc; const long t0 = (long)b * SEQ + c * 128;
            const float d0 = softplusf_(ldh(p.hbuf, (t0 + 2 * lane) * AB_IN + AB_DT + h) + dbias), d1 = softplusf_(ldh(p.hbuf, (t0 + 2 * lane + 1) * AB_IN + AB_DT + h) + dbias);
            const float a0 = d0 * a, a1 = d1 * a;
            float run = a0 + a1;
#pragma unroll
            for (int o = 1; o < 64; o <<= 1) { const float v = __shfl_up(run, o); if (lane >= o) run += v; }
            const float tot = __shfl(run, 63);
            const float cs1 = run, cs0 = run - a1;
            acs_all[c * 128 + 2 * lane] = cs0; acs_all[c * 128 + 2 * lane + 1] = cs1; dts_all[c * 128 + 2 * lane] = d0; dts_all[c * 128 + 2 * lane + 1] = d1;
            wl_all[c * 128 + 2 * lane] = d0 * __expf(tot - cs0); wl_all[c * 128 + 2 * lane + 1] = d1 * __expf(tot - cs1);
        }
        for (int c = 0; c < 16; ++c) {
            const long t0 = (long)b * SEQ + c * 128;
            LAS bf16_t* S_lds = S_base + (c & 1) * (64 * 136);
            const LAS float* acs = acs_all + c * 128; const LAS float* dts = dts_all + c * 128; const LAS float* wl = wl_all + c * 128;
#pragma unroll
            for (int i = 0; i < 16; ++i) S_lds[(32 * pt + (i & 3) + 8 * (i >> 2) + 4 * hh) * 136 + 32 * lt + r] = f2bf(S[i]);
            __syncthreads();
            const float acl = acs[32 * lt + r];
            bf16x8 cf[8], xs[8], bs[8];
            u32x2 zv[4];
            {
                const bf16_t* cp = bcr + lnd((size_t)(t0 + 32 * lt + r) * 1024 + 512 + g * 128 + 8 * hh);
                const bf16_t* xsp = xT + lnd(((size_t)b * 2048 + h * 64 + 32 * pt + r) * 2048 + c * 128 + 8 * hh);
                const bf16_t* bsp = BT + lnd(((size_t)b * 512 + g * 128 + 32 * lt + r) * 2048 + c * 128 + 8 * hh);
                const bf16_t* zp = p.hbuf + lnd((size_t)(t0 + 32 * lt + r) * AB_IN + AB_Z + h * 64 + 32 * pt + 4 * hh);
#pragma unroll
                for (int st = 0; st < 8; ++st) cf[st] = ld8(cp + 16 * st);
#pragma unroll
                for (int st = 0; st < 8; ++st) { xs[st] = ld8(xsp + 16 * st); bs[st] = ld8(bsp + 16 * st); }
#pragma unroll
                for (int i4 = 0; i4 < 4; ++i4) zv[i4] = *(const u32x2*)(zp + 8 * i4);
            }
            bf16x8 sl[8];
#pragma unroll
            for (int st = 0; st < 8; ++st) sl[st] = *(const LAS bf16x8*)(S_lds + (32 * pt + r) * 136 + 16 * st + 8 * hh);
            __builtin_amdgcn_sched_barrier(0);
            f32x16 Y;
#pragma unroll
            for (int i = 0; i < 16; ++i) Y[i] = 0.f;
#pragma unroll
            for (int st = 0; st < 8; ++st) Y = MFMA32(sl[st], cf[st], Y);
            { const float ea = __expf(acl);
#pragma unroll
              for (int i = 0; i < 16; ++i) Y[i] *= ea; }
            for (int stile = 0; stile <= lt; ++stile) {
                const bf16_t* bp = bcr + lnd((size_t)(t0 + 32 * stile + r) * 1024 + g * 128 + 8 * hh);
                const bf16_t* xp = xT + lnd(((size_t)b * 2048 + h * 64 + 32 * pt + r) * 2048 + c * 128 + 32 * stile + 8 * hh);
                bf16x8 bf[8];
#pragma unroll
                for (int st = 0; st < 8; ++st) bf[st] = ld8(bp + 16 * st);
                const bf16x8 xa = ld8(xp), xb2 = ld8(xp + 16);
                __builtin_amdgcn_sched_barrier(0);
                f32x16 G;
#pragma unroll
                for (int i = 0; i < 16; ++i) G[i] = 0.f;
#pragma unroll
                for (int st = 0; st < 8; ++st) G = MFMA32(bf[st], cf[st], G);
#pragma unroll
                for (int i = 0; i < 16; ++i) {
                    const int sl2 = 32 * stile + (i & 3) + 8 * (i >> 2) + 4 * hh, ll = 32 * lt + r;
                    float v = G[i] * __builtin_amdgcn_exp2f((acl - acs[sl2]) * L2E) * dts[sl2];
                    v = (sl2 <= ll) ? v : 0.f;
                    if (sl2 == ll) v += dskip;
                    G[i] = v;
                }
                const bf16x8 pg0 = pack8(G[0], G[1], G[2], G[3], G[4], G[5], G[6], G[7]);
                const bf16x8 pg1 = pack8(G[8], G[9], G[10], G[11], G[12], G[13], G[14], G[15]);
                Y = MFMA32(xa, pg0, Y); Y = MFMA32(xb2, pg1, Y);
            }
            {
                bf16_t* op = (bf16_t*)p.mix + (t0 + 32 * lt + r) * 4096 + h * 64 + 32 * pt + 4 * hh;
#pragma unroll
                for (int i4 = 0; i4 < 4; ++i4) {
                    u32x2 o; o.x = pk_bf16(Y[4 * i4] * siluf_(bflo(zv[i4].x)), Y[4 * i4 + 1] * siluf_(bfhi(zv[i4].x))); o.y = pk_bf16(Y[4 * i4 + 2] * siluf_(bflo(zv[i4].y)), Y[4 * i4 + 3] * siluf_(bfhi(zv[i4].y)));
                    *(u32x2*)(op + 8 * i4) = o;
                }
            }
            {
                f32x16 Sn;
#pragma unroll
                for (int i = 0; i < 16; ++i) Sn[i] = 0.f;
#pragma unroll
                for (int st = 0; st < 8; ++st) {
                    const bf16x8 xf = xs[st];
                    const f32x4 w0 = *(const LAS f32x4*)(wl + 16 * st + 4 * hh), w1 = *(const LAS f32x4*)(wl + 16 * st + 8 + 4 * hh);
                    const bf16x8 xw = pack8(bf2f((bf16_t)xf[0]) * w0[0], bf2f((bf16_t)xf[1]) * w0[1], bf2f((bf16_t)xf[2]) * w0[2], bf2f((bf16_t)xf[3]) * w0[3],
                                            bf2f((bf16_t)xf[4]) * w1[0], bf2f((bf16_t)xf[5]) * w1[1], bf2f((bf16_t)xf[6]) * w1[2], bf2f((bf16_t)xf[7]) * w1[3]);
                    Sn = MFMA32(xw, bs[st], Sn);
                }
                const float ed = __expf(acs[127]);
#pragma unroll
                for (int i = 0; i < 16; ++i) S[i] = S[i] * ed + Sn[i];
            }
        }
    }
    __syncthreads();
}

DI void ph_hgrn_chunk(LAS unsigned char* lds, const MP& p) {
    if (blockIdx.x >= NB * 16) return;
    const int tix = tid_opaque();
    const int w = tix >> 6, lane = tix & 63, r = lane & 31, hh = lane >> 5;
    LAS bf16_t* qt_l = (LAS bf16_t*)lds;
    LAS bf16_t* kt_l = qt_l + 64 * 136;
    LAS bf16_t* kendT = kt_l + 64 * 136;
    LAS bf16_t* S_l = kendT + 128 * 72;
    LAS float* bl = (LAS float*)(S_l + 2 * 128 * 136);
    LAS float* tot = bl + 128;
    const int b = blockIdx.x >> 4, h = blockIdx.x & 15;
    const bf16_t* viT = (const bf16_t*)p.bufB;
    const int d = tix & 127, tq = tix >> 7;
    const float lb = 1.f / (1.f + expf(p.lb_logits[h * 128 + d] - p.lb_logits[2048 + h * 128 + d]));
    const int vt = w >> 1, tt = w & 1;
    f32x16 S0, S1;
#pragma unroll
    for (int i = 0; i < 16; ++i) { S0[i] = 0.f; S1[i] = 0.f; }
    for (int i = tix; i < 128 * 136 / 2; i += NTHR) ((LAS unsigned*)S_l)[i] = 0u;
    bf16_t rawq[16], rawf[16];
#pragma unroll
    for (int i = 0; i < 16; ++i) { const size_t t = (size_t)b * SEQ + 16 * tq + i; rawq[i] = p.hbuf[t * CD_IN + CD_HQ + h * 128 + d]; rawf[i] = p.hbuf[t * CD_IN + CD_HF + h * 128 + d]; }
    for (int c = 0; c < 32; ++c) {
        const long t0 = (long)b * SEQ + c * 64;
        bf16x8 vfr[4];
        { const bf16_t* vp = viT + lnd(((size_t)(b * 16 + h) * 128 + 32 * vt + r) * 2048 + c * 64 + 8 * hh);
#pragma unroll
          for (int ks = 0; ks < 4; ++ks) vfr[ks] = ld8(vp + 16 * ks); }
        {
            float qv[16], kv[16], bq[16]; float cum = 0.f;
#pragma unroll
            for (int i = 0; i < 16; ++i) {
                const float hq = bf2f(rawq[i]), hf = bf2f(rawf[i]);
                const float sg = sigmoidf_(hf);
                cum += __logf(lb + (1.f - lb) * sg);
                bq[i] = cum; kv[i] = (1.f - lb) * (1.f - sg); qv[i] = siluf_(hq);
            }
            tot[tq * 128 + d] = cum;
            if (c + 1 < 32) {
#pragma unroll
                for (int i = 0; i < 16; ++i) { const size_t t = (size_t)t0 + 64 + 16 * tq + i; rawq[i] = p.hbuf[t * CD_IN + CD_HQ + h * 128 + d]; rawf[i] = p.hbuf[t * CD_IN + CD_HF + h * 128 + d]; }
            }
            __syncthreads();
            float off = 0.f, blast = 0.f;
#pragma unroll
            for (int q2 = 0; q2 < 4; ++q2) { const float tv = tot[q2 * 128 + d]; blast += tv; if (q2 < tq) off += tv; }
#pragma unroll
            for (int i = 0; i < 16; ++i) {
                const int tl = 16 * tq + i;
                const float bb = off + bq[i];
                qt_l[tl * 136 + d] = f2bf(qv[i] * __expf(bb));
                kt_l[tl * 136 + d] = f2bf(kv[i] * __expf(-bb));
                kendT[d * 72 + ((tl & ~12) | ((tl & 4) << 1) | ((tl & 8) >> 1))] = f2bf(kv[i] * __expf(blast - bb));
            }
            if (tq == 0) bl[d] = __expf(blast);
        }
        __syncthreads();
        const LAS bf16_t* Scur = S_l + (c & 1) * (128 * 136);
        LAS bf16_t* Snxt = S_l + ((c + 1) & 1) * (128 * 136);
        {
            bf16x8 qf[8], sf[8];
#pragma unroll
            for (int st = 0; st < 8; ++st) { qf[st] = *(const LAS bf16x8*)(qt_l + (32 * tt + r) * 136 + 16 * st + 8 * hh); sf[st] = *(const LAS bf16x8*)(Scur + (32 * vt + r) * 136 + 16 * st + 8 * hh); }
            __builtin_amdgcn_sched_barrier(0);
            f32x16 O;
#pragma unroll
            for (int i = 0; i < 16; ++i) O[i] = 0.f;
#pragma unroll
            for (int st = 0; st < 8; ++st) O = MFMA32(sf[st], qf[st], O);
            for (int stile = 0; stile <= tt; ++stile) {
                bf16x8 kf[8];
#pragma unroll
                for (int st = 0; st < 8; ++st) kf[st] = *(const LAS bf16x8*)(kt_l + (32 * stile + r) * 136 + 16 * st + 8 * hh);
                __builtin_amdgcn_sched_barrier(0);
                f32x16 AT;
#pragma unroll
                for (int i = 0; i < 16; ++i) AT[i] = 0.f;
#pragma unroll
                for (int st = 0; st < 8; ++st) AT = MFMA32(kf[st], qf[st], AT);
                if (stile == tt) {
#pragma unroll
                    for (int i = 0; i < 16; ++i) if (((i & 3) + 8 * (i >> 2) + 4 * hh) > r) AT[i] = 0.f;
                }
                const bf16x8 pa0 = pack8(AT[0], AT[1], AT[2], AT[3], AT[4], AT[5], AT[6], AT[7]);
                const bf16x8 pa1 = pack8(AT[8], AT[9], AT[10], AT[11], AT[12], AT[13], AT[14], AT[15]);
                if (stile == 0) { O = MFMA32(vfr[0], pa0, O); O = MFMA32(vfr[1], pa1, O); }
                else            { O = MFMA32(vfr[2], pa0, O); O = MFMA32(vfr[3], pa1, O); }
            }
            float* op = p.x3 + (t0 + 32 * tt + r) * 2048 + h * 128 + 32 * vt + 4 * hh;
#pragma unroll
            for (int i4 = 0; i4 < 4; ++i4) { f32x4 o; o[0] = O[4 * i4]; o[1] = O[4 * i4 + 1]; o[2] = O[4 * i4 + 2]; o[3] = O[4 * i4 + 3]; *(f32x4*)(op + 8 * i4) = o; }
        }
        {
            bf16x8 ke0[4], ke1[4];
#pragma unroll
            for (int ks = 0; ks < 4; ++ks) { ke0[ks] = *(const LAS bf16x8*)(kendT + (64 * tt + r) * 72 + 16 * ks + 8 * hh); ke1[ks] = *(const LAS bf16x8*)(kendT + (64 * tt + 32 + r) * 72 + 16 * ks + 8 * hh); }
            __builtin_amdgcn_sched_barrier(0);
            f32x16 N0, N1;
#pragma unroll
            for (int i = 0; i < 16; ++i) { N0[i] = 0.f; N1[i] = 0.f; }
#pragma unroll
            for (int ks = 0; ks < 4; ++ks) { N0 = MFMA32(vfr[ks], ke0[ks], N0); N1 = MFMA32(vfr[ks], ke1[ks], N1); }
            const float e0 = bl[64 * tt + r], e1 = bl[64 * tt + 32 + r];
#pragma unroll
            for (int i = 0; i < 16; ++i) { S0[i] = S0[i] * e0 + N0[i]; S1[i] = S1[i] * e1 + N1[i]; }
#pragma unroll
            for (int i = 0; i < 16; ++i) { const int v = 32 * vt + (i & 3) + 8 * (i >> 2) + 4 * hh; Snxt[v * 136 + 64 * tt + r] = f2bf(S0[i]); Snxt[v * 136 + 64 * tt + 32 + r] = f2bf(S1[i]); }
        }
        __syncthreads();
    }
}

DI gm::DenseProb mk_dense(const bf16_t* A, unsigned lda, const bf16_t* Bt, unsigned ldb, int M, int Npad, int K) {
    gm::DenseProb d; d.A = (const char*)A; d.Bt = (const char*)Bt; d.lda = lda; d.ldb = ldb; d.K = K; d.nM = M / 256; d.nN = Npad / 256; d.G = (int)gridDim.x; d.c = (int)blockIdx.x; return d;
}
DI void ph_gemm_bf16(LAS unsigned char* lds, const bf16_t* A, unsigned lda, const bf16_t* Bt, int M, int N, int Npad, int K, bf16_t* C, long ldc) {
    gm::EpiBf16 e; e.C = C; e.ldc = ldc; e.N = N; gm::gemm_phase(lds, mk_dense(A, lda, Bt, (unsigned)K, M, Npad, K), e);
}
DI void ph_gemm_f32(LAS unsigned char* lds, const bf16_t* A, unsigned lda, const bf16_t* Bt, int M, int N, int Npad, int K, float* C, long ldc) {
    gm::EpiF32 e; e.C = C; e.ldc = ldc; e.N = N; gm::gemm_phase(lds, mk_dense(A, lda, Bt, (unsigned)K, M, Npad, K), e);
}
DI int moe_tile_table(LAS unsigned char* lds, const MP& p) {
    const int tix = tid_opaque();
    LAS i32x2* ttab = (LAS i32x2*)(lds + LDS_TAB_OFF);
    const int nt = *p.ntiles;
    for (int i = tix; i < nt && i < 768; i += NTHR) { const int4 t = *(const int4*)(p.tiles + i * 4); i32x2 r; r.x = (t.x & 0xff) | (((t.z - 1) & 0xff) << 8) | (t.w << 16); r.y = t.y; ttab[i] = r; }
    __syncthreads();
    return nt < 768 ? nt : 768;
}
DI void ph_moe_gemm1(LAS unsigned char* lds, const MP& p) {
    const int nt = moe_tile_table(lds, p);
    gm::MoeG1Prob q; q.A = (const char*)p.xb; q.WgT = (const char*)p.WgT; q.WuT = (const char*)p.WuT; q.lda = DM; q.ldb = DM; q.K = DM; q.G = (int)gridDim.x; q.c = (int)blockIdx.x;
    q.ttab = (const LAS i32x2*)(lds + LDS_TAB_OFF); q.ntl = nt; q.row_tok = p.row_tok;
    gm::EpiSwiglu e; e.H = p.H; e.ttab = q.ttab;
    gm::gemm_phase(lds, q, e);
}
DI void ph_moe_gemm2(LAS unsigned char* lds, const MP& p) {
    const int nt = moe_tile_table(lds, p);
    gm::MoeG2Prob q; q.A = (const char*)p.H; q.WdT = (const char*)p.WdT; q.lda = 512; q.ldb = 512; q.K = 512; q.G = (int)gridDim.x; q.c = (int)blockIdx.x; q.ttab = (const LAS i32x2*)(lds + LDS_TAB_OFF); q.ntl = nt;
    gm::EpiMoeDown e; e.Y = p.Y; e.ttab = q.ttab;
    gm::gemm_phase(lds, q, e);
}

#ifndef PROBE_SEL
#define PROBE_SEL 0
#endif
#define RG(...) { __VA_ARGS__; if (PROBE_SEL == 1) { __VA_ARGS__; } }
#define RA(...) { __VA_ARGS__; if (PROBE_SEL == 2) { __VA_ARGS__; } }
#define RM(...) { __VA_ARGS__; if (PROBE_SEL == 3) { __VA_ARGS__; } }
#define RC(...) { __VA_ARGS__; if (PROBE_SEL == 4) { __VA_ARGS__; } }
__global__ __launch_bounds__(512, 2) void mega_fwd(MP p) {
    extern __shared__ __attribute__((aligned(16))) unsigned char shm[];
    LAS unsigned char* lds = (LAS unsigned char*)shm;
    volatile LAS unsigned* xbw = (volatile LAS unsigned*)(lds + LDS_BAR_OFF);
    if (threadIdx.x == 0) { xbw[0] = 0u; xbw[1] = 0u; xbw[2] = 0u; xbw[3] = 0u; }
    __syncthreads();
    (void)xcd_barrier_post(p.bar, xbw);
#define SYNC() do { XcdBarrier b_; b_.bar = p.bar; b_.x = xb_xcc_id(); b_.st = (volatile LAS unsigned*)(lds + LDS_BAR_OFF); xcd_barrier(b_); } while (0)
    RC(ph_cvt_wT(lds, p.ab_w_in, p.WinABt, DM, AB_IN, 8960, 1, (int)blockIdx.x, (int)gridDim.x);)
    RC(ph_cvt_x(p);)
    RC(ph_cmp_bias(p);)
    RC(ph_build_wr(p);)
    SYNC();
    { const int NG = (int)gridDim.x >= 256 ? CVQ_NG : (int)gridDim.x;
      if ((int)blockIdx.x < NG) { gm::EpiAB e; e.C = p.hbuf; e.vselT = p.vselT; e.vwinT = p.vwinT; e.ksf = p.ksf; e.kwf = p.kwf; gm::DenseProb d = mk_dense(p.xb, DM, p.WinABt, DM, T_TOK, 8960, DM); d.G = NG; d.c = (int)blockIdx.x; gm::gemm_phase(lds, d, e); }
      moe_cvt_queue(lds, p, 0, p.bar + XCD_BAR_WORDS); }
    SYNC();
    RG({ gm::CmpProb q; q.hb = (const char*)p.hbuf; q.Wt = (const char*)p.WcmpT; q.ldb = 4096; q.K = 4096; q.G = (int)gridDim.x; q.c = (int)blockIdx.x; gm::EpiCmp e; e.kc = p.kcb; e.vcT = p.vcT; e.cpart = p.cpart; gm::gemm_phase(lds, q, e); })
    RM(ph_conv_ssd(lds, p);)
    SYNC();
    RA(ph_ssd_chunk(lds, p);)
    RA(ph_nsa_attn(lds, p);)
    SYNC();
    RM(ph_ssd_norm(p);)
    SYNC();
    RG(ph_gemm_bf16(lds, p.mixb, 4096, p.WoutABt, T_TOK, DM, DM, 4096, (bf16_t*)p.bufA, DM);)
    SYNC();
    RM(ph_ln<false>(p, p.x, (const bf16_t*)p.bufA, p.ln_g, p.ln_b, p.xb, p.mixb);)
    SYNC();
    RG(ph_router_gemm(lds, p, 0, (float*)(p.mixb + (size_t)T_TOK * DM), p.mixb);)
    SYNC();
    RM(ph_route_select(p, (const float*)(p.mixb + (size_t)T_TOK * DM), p.router_bias);)
    SYNC();
    RM(ph_moe_scan(lds, p);)
    SYNC();
    RG(ph_moe_gemm1(lds, p);)
    SYNC();
    RG(ph_moe_gemm2(lds, p);)
    SYNC();
    RM(ph_moe_combine_ln(p, p.xb, p.mixb, p.ln_g + DM, p.ln_b + DM, (float*)nullptr, p.xb);)
    SYNC();
    { const int NG = (int)gridDim.x >= 256 ? CVQ_NG : (int)gridDim.x;
      if ((int)blockIdx.x < NG) { gm::EpiCD e; e.C = p.hbuf; e.viT = (bf16_t*)p.bufB; gm::DenseProb d = mk_dense(p.xb, DM, p.WinCDt, DM, T_TOK, 9472, DM); d.G = NG; d.c = (int)blockIdx.x; gm::gemm_phase(lds, d, e); }
      moe_cvt_queue(lds, p, 1, p.bar + XCD_BAR_WORDS + 32); }
    SYNC();
    RM(ph_mla_rms(p);)
    RM(ph_rope_k(p);)
    SYNC();
    if (gridDim.x >= 256) {
        if (blockIdx.x < 128) { RA(ph_hgrn_chunk(lds, p);) }
        else {
            const int G2 = (int)gridDim.x - 128, c2 = (int)blockIdx.x - 128;
            { gm::DenseProb d = mk_dense(p.cqb, 1024, p.Wuqt, 512, T_TOK, 3072, 512); d.G = G2; d.c = c2; gm::EpiBf16 e; e.C = (bf16_t*)p.xbc; e.ldc = 3072; e.N = 3072; RG(gm::gemm_phase(lds, d, e);) }
            { gm::DenseProb d = mk_dense(p.cqb + 512, 1024, p.Wukvt, 512, T_TOK, 4096, 512); d.G = G2; d.c = c2; gm::EpiKV e; e.kf = (bf16_t*)p.kvfrag; e.vf = (bf16_t*)p.kvfrag + (size_t)T_TOK * 2048; RG(gm::gemm_phase(lds, d, e);) }
        }
    } else {
        RA(ph_hgrn_chunk(lds, p);)
        SYNC();
        RG(ph_gemm_bf16(lds, p.cqb, 1024, p.Wuqt, T_TOK, 3072, 3072, 512, (bf16_t*)p.xbc, 3072);)
        RG({ gm::EpiKV e; e.kf = (bf16_t*)p.kvfrag; e.vf = (bf16_t*)p.kvfrag + (size_t)T_TOK * 2048; gm::gemm_phase(lds, mk_dense(p.cqb + 512, 1024, p.Wukvt, 512, T_TOK, 4096, 512), e); })
    }
    SYNC();
    RA(ph_mla_attn(lds, p);)
    RM(ph_hgrn_post(p);)
    SYNC();
    RG(ph_gemm_bf16(lds, p.mixb, 4096, p.WoutCDt, T_TOK, DM, DM, 4096, (bf16_t*)p.bufB, DM);)
    SYNC();
    RM(ph_ln<true>(p, p.xb, (const bf16_t*)p.bufB, p.ln_g + 2 * DM, p.ln_b + 2 * DM, p.xb, p.mixb);)
    SYNC();
    RG(ph_router_gemm(lds, p, 1, (float*)(p.mixb + (size_t)T_TOK * DM), p.mixb);)
    SYNC();
    RM(ph_route_select(p, (const float*)(p.mixb + (size_t)T_TOK * DM), p.router_bias + 64);)
    SYNC();
    RM(ph_moe_scan(lds, p);)
    SYNC();
    RG(ph_moe_gemm1(lds, p);)
    SYNC();
    RG(ph_moe_gemm2(lds, p);)
    SYNC();
    RM(ph_moe_combine_ln(p, p.xb, p.mixb, p.ln_g + 3 * DM, p.ln_b + 3 * DM, p.out, (bf16_t*)nullptr);)
    if (xb_ld(&p.bar[XB_TMO]) != 0u) { SYNC(); for (long i = (long)blockIdx.x * NTHR + threadIdx.x; i < (long)T_TOK * DM; i += (long)gridDim.x * NTHR) p.out[i] = __uint_as_float(0x7fc00000u); }
#undef SYNC
}

extern "C" void kernel_launch(void* const* d_in, const int* in_sizes, int n_in, void* d_out, int out_size, void* d_ws, size_t ws_size, hipStream_t stream) {
    static int grid = 0;
    if (!grid) {
        int dev = 0, cus = 0; (void)hipGetDevice(&dev); (void)hipDeviceGetAttribute(&cus, hipDeviceAttributeMultiprocessorCount, dev);
        (void)hipFuncSetAttribute((const void*)mega_fwd, hipFuncAttributeMaxDynamicSharedMemorySize, LDS_TOTAL);
        grid = cus > 0 ? cus : 256;
    }
    (void)in_sizes; (void)n_in; (void)out_size; (void)ws_size;
    MP p{};
    p.x = (const float*)d_in[0]; p.positions = (const int*)d_in[1]; p.ab_w_in = (const float*)d_in[2]; p.conv_w = (const float*)d_in[3]; p.conv_b = (const float*)d_in[4];
    p.dt_bias = (const float*)d_in[5]; p.a_log = (const float*)d_in[6]; p.ssm_d = (const float*)d_in[7]; p.ssm_norm_w = (const float*)d_in[8]; p.cmp_pos = (const float*)d_in[9];
    p.cmp_w = (const float*)d_in[10]; p.ab_w_out = (const float*)d_in[11]; p.cd_w_in = (const float*)d_in[12]; p.q_norm_w = (const float*)d_in[13]; p.w_uq = (const float*)d_in[14];
    p.kv_norm_w = (const float*)d_in[15]; p.w_ukv = (const float*)d_in[16]; p.lb_logits = (const float*)d_in[17]; p.hgrn_norm_w = (const float*)d_in[18]; p.cd_w_out = (const float*)d_in[19];
    p.ln_g = (const float*)d_in[20]; p.ln_b = (const float*)d_in[21]; p.w_router = (const float*)d_in[22]; p.router_bias = (const float*)d_in[23]; p.w_gate = (const float*)d_in[24];
    p.w_up = (const float*)d_in[25]; p.w_down = (const float*)d_in[26]; p.sg = (const float*)d_in[27]; p.su = (const float*)d_in[28]; p.sd = (const float*)d_in[29];
    p.out = (float*)d_out;
    char* wp = (char*)d_ws;
    auto carve = [&](size_t bytes) { char* q = wp; wp += (bytes + 255) & ~(size_t)255; return q; };
    p.bar = (unsigned*)carve((size_t)(XCD_BAR_WORDS + 64) * 4);
    p.WinABt = (bf16_t*)carve((size_t)8960 * DM * 2);
    p.WoutABt = (bf16_t*)carve((size_t)DM * 4096 * 2);
    p.WinCDt = (bf16_t*)carve((size_t)9472 * DM * 2);
    p.WoutCDt = (bf16_t*)carve((size_t)DM * 4096 * 2);
    p.Wuqt = (bf16_t*)carve((size_t)3072 * 512 * 2);
    p.Wukvt = (bf16_t*)carve((size_t)4096 * 512 * 2);
    p.WgT = (bf16_t*)carve((size_t)65 * 512 * DM * 2); p.WuT = (bf16_t*)carve((size_t)65 * 512 * DM * 2); p.WdT = (bf16_t*)carve((size_t)65 * DM * 512 * 2);
    char* big = carve((size_t)T_TOK * CD_IN * 2 + (size_t)T_TOK * 3072 * 4 + (size_t)T_TOK * 4096 * 4 + 1024);
    p.hbuf = (bf16_t*)big;
    p.xbc = (float*)(big + (((size_t)T_TOK * CD_IN * 2 + 255) & ~(size_t)255));
    p.mix = (float*)((char*)p.xbc + (size_t)T_TOK * 3072 * 4);
    p.H = (bf16_t*)big;
    p.Y = (bf16_t*)(big + (((size_t)(MOE_PMAX + T_TOK) * 512 * 2 + 255) & ~(size_t)255));
    p.kvfrag = (bf16_t*)p.mix;
    p.mixb = (bf16_t*)carve((size_t)T_TOK * 4096 * 2);
    p.bufA = (float*)carve((size_t)T_TOK * DM * 4);
    p.bufB = (float*)carve((size_t)T_TOK * DM * 4);
    p.x3 = (float*)carve((size_t)T_TOK * DM * 4);
    p.xb = (bf16_t*)carve((size_t)(T_TOK + 1) * DM * 2);
    p.cqb = (bf16_t*)carve((size_t)T_TOK * 1024 * 2);
    p.kr = (bf16_t*)carve((size_t)T_TOK * 64 * 2);
    p.rope_tab = (float*)carve((size_t)T_TOK * 32 * 8);
    p.kcb = (bf16_t*)carve((size_t)16 * 128 * 128 * 2); p.vcT = (bf16_t*)carve((size_t)16 * 128 * 128 * 2);
    p.vselT = (bf16_t*)carve((size_t)16 * 128 * 2048 * 2); p.vwinT = (bf16_t*)carve((size_t)16 * 128 * 2048 * 2); p.ksf = (bf16_t*)carve((size_t)16 * 128 * 2048 * 2); p.kwf = (bf16_t*)carve((size_t)16 * 128 * 2048 * 2);
    p.WcmpT = (bf16_t*)carve((size_t)2 * 256 * 4096 * 2); p.WrT3 = (bf16_t*)carve((size_t)2 * 256 * 4096 * 2); p.cpart = (float*)carve((size_t)2 * 128 * 128 * 4);
    p.kc = (float*)carve((size_t)NB * NCMP * 2 * 128 * 4);
    p.vc = (float*)carve((size_t)NB * NCMP * 2 * 128 * 4);
    p.top_e = (int*)carve((size_t)T_TOK * 8 * 4); p.top_w = (float*)carve((size_t)T_TOK * 8 * 4); p.lpos = (int*)carve((size_t)T_TOK * 8 * 4);
    p.cnt_tab = (int*)carve((size_t)MOE_NSLOT * 64 * 4); p.row_tok = (int*)carve((size_t)(MOE_PMAX + T_TOK) * 4); p.row_w = (float*)carve((size_t)(MOE_PMAX + T_TOK) * 4);
    p.row_slot = (int*)carve((size_t)(MOE_PMAX + T_TOK) * 4); p.tiles = (int*)carve((size_t)MOE_MAXTILES * 16); p.ntiles = (int*)carve(256);
    (void)hipMemsetAsync(p.bar, 0, (size_t)(XCD_BAR_WORDS + 64) * 4, stream);
    hipLaunchKernelGGL(mega_fwd, dim3(grid), dim3(NTHR), LDS_TOTAL, stream, p);
}
```

```cpp
#include <hip/hip_runtime.h>
#include <stdint.h>

#define DI __device__ __forceinline__

constexpr int T_TOK = 16384, DM = 2048, SEQ = 2048, NB = 8;
constexpr int AB_IN = 8784, CD_IN = 9280;
constexpr int AB_Z = 0, AB_XBC = 2048, AB_DT = 5120, AB_Q = 5152, AB_KV = 7200, AB_G = 8736;
constexpr int CD_CQ = 0, CD_CKV = 512, CD_KR = 1024, CD_HQ = 1088, CD_HF = 3136, CD_HI = 5184, CD_HG = 7232;
constexpr float DN_ALPHA = 1.41421356237309515f;
constexpr int NCMP = 127;
constexpr int MOE_TM = 256;
constexpr int MOE_SLOT_TOK = 8;
constexpr int MOE_NSLOT = T_TOK / MOE_SLOT_TOK;
constexpr int MOE_PMAX = T_TOK * 8 + 64 * MOE_TM;
constexpr int MOE_MAXTILES = MOE_PMAX / MOE_TM + T_TOK / MOE_TM;
constexpr int LDH_AB = AB_IN, LDH_CD = CD_IN;

typedef unsigned short bf16_t;
DI float ldh(const bf16_t* p, long i) { return __uint_as_float(((unsigned)p[i]) << 16); }
DI bf16_t f2bf(float f) { unsigned u = __float_as_uint(f); u += 0x7fffu + ((u >> 16) & 1u); return (bf16_t)(u >> 16); }
DI int tid_opaque() { int t = (int)threadIdx.x; asm volatile("" : "+v"(t)); return t; }
DI float sigmoidf_(float x) { return 1.f / (1.f + __expf(-x)); }
DI float siluf_(float x) { return x / (1.f + __expf(-x)); }
DI float softplusf_(float x) { return x > 20.f ? x : log1pf(__expf(x)); }
#define LAS __attribute__((address_space(3)))
typedef unsigned short bf16_t;
typedef short bf16x8 __attribute__((ext_vector_type(8)));
typedef float f32x4 __attribute__((ext_vector_type(4)));
typedef unsigned u32x2 __attribute__((ext_vector_type(2)));
typedef unsigned u32x4 __attribute__((ext_vector_type(4)));
typedef int i32x2 __attribute__((ext_vector_type(2)));

typedef float f32x2_t __attribute__((ext_vector_type(2)));
typedef __bf16 bf16x2_t __attribute__((ext_vector_type(2)));
DI unsigned pk_bf16(float lo, float hi) { const f32x2_t v = {lo, hi}; const bf16x2_t r = __builtin_convertvector(v, bf16x2_t); return __builtin_bit_cast(unsigned, r); }
DI float bf2f(bf16_t b) { return __uint_as_float(((unsigned)b) << 16); }
DI float bflo(unsigned u) { return __uint_as_float(u << 16); }
DI float bfhi(unsigned u) { return __uint_as_float(u & 0xffff0000u); }

namespace gm {
constexpr int BM = 256, BK = 64, HALF = 128, HTB = HALF * BK * 2, STAGE_BYTES = 8 * HTB, NXCD = 8, WGM = 8;
DI int lds_byte(int r, int c) { const int st = (r >> 4) * 2 + (c >> 5), rr = r & 15, cc = c & 31, ob = rr * 64 + cc * 2; return st * 1024 + (ob ^ (((ob >> 9) & 1) << 5)); }
DI void stage_rc(int b, int& R, int& C) { const int st = b / 1024, sb = b % 1024, swz = sb ^ (((sb >> 9) & 1) << 5); R = (st >> 1) * 16 + swz / 64; C = (st & 1) * 32 + (swz % 64) / 2; }

struct Unit { int p, q; };

DI bool static_order(int i, int G, int c, int nM, int nN, Unit& u) {
    const int nwg = nM * nN;
    const long L = (long)i * G + c; if (L >= nwg) return false;
    int wgid = (int)L; { const int q = nwg / NXCD, r = nwg % NXCD, xcd = wgid % NXCD, off = wgid / NXCD; wgid = (xcd < r ? xcd * (q + 1) : r * (q + 1) + (xcd - r) * q) + off; }
    const int nig = WGM * nN, gid = wgid / nig, fm = gid * WGM, gsz = (nM - fm) < WGM ? (nM - fm) : WGM;
    u.p = fm + ((wgid % nig) % gsz); u.q = (wgid % nig) / gsz; return true;
}

struct DenseProb {
    const char* A; const char* Bt; unsigned lda, ldb;
    int K, nM, nN, G, c;
    struct AState { const char* base; };
    DI bool next(int i, Unit& u) const { return static_order(i, G, c, nM, nN, u); }
    DI void a_state(const Unit& u, int R0, int C, AState& s) const { s.base = A + (size_t)u.p * 256 * lda * 2; }
    DI const char* a_addr(const AState& s, int h, int i, int R0, int C, size_t koff) const { return s.base + koff + (size_t)h * 128 * lda * 2 + (size_t)((unsigned)(R0 + 64 * i) * lda + (unsigned)C) * 2u; }
    static DI AState sel(bool c, const AState& a, const AState& b) { AState r; r.base = c ? a.base : b.base; return r; }
    DI size_t koff(int kt) const { return (size_t)kt * 128; }
    DI const char* b_ptr(const Unit& u, int h) const { return Bt + ((size_t)u.q * 256 + (size_t)h * 128) * ldb * 2; }
};

DI i32x2 lds_tab_read(const LAS i32x2* q) { i32x2 r; const unsigned a = (unsigned)(size_t)q; asm volatile("ds_read_b64 %0, %1\n\ts_waitcnt lgkmcnt(0)" : "=v"(r) : "v"(a) : "memory"); return r; }
struct MoeG1Prob {
    const char* A; const char* WgT; const char* WuT; unsigned lda, ldb;
    int K, G, c;
    const LAS i32x2* ttab; int ntl; const int* row_tok;
    struct AState { unsigned off[2][2]; };
    DI bool next(int i, Unit& u) const {
        if ((G & 7) == 0) { const int x = c & 7, W = G >> 3, tpx = (ntl + 7) >> 3; const int m = i * W + (c >> 3); const int tl = m >> 2; const int tile = x * tpx + tl;
            if (tl >= tpx || tile >= ntl) return false; u.p = tile; u.q = m & 3; return true; }
        const long L = (long)i * G + c; if (L >= (long)ntl * 4) return false; u.p = (int)(L >> 2); u.q = (int)(L & 3); return true; }
    DI void a_state(const Unit& u, int R0, int C, AState& s) const {
        const int row0 = lds_tab_read(ttab + u.p).y;
#pragma unroll
        for (int h = 0; h < 2; ++h)
#pragma unroll
            for (int i = 0; i < 2; ++i) { int t = row_tok[row0 + h * 128 + R0 + 64 * i]; if (t < 0) t = T_TOK; s.off[h][i] = ((unsigned)t * lda + (unsigned)C) * 2u; }
    }
    DI const char* a_addr(const AState& s, int h, int i, int R0, int C, size_t koff) const { return A + koff + s.off[h][i]; }
    static DI AState sel(bool c, const AState& a, const AState& b) { AState r;
#pragma unroll
        for (int h = 0; h < 2; ++h)
#pragma unroll
            for (int i = 0; i < 2; ++i) r.off[h][i] = c ? a.off[h][i] : b.off[h][i];
        return r; }
    DI size_t koff(int kt) const { return (size_t)kt * 128; }
    DI const char* b_ptr(const Unit& u, int h) const { const int e = lds_tab_read(ttab + u.p).x & 0xff; return (h ? WuT : WgT) + ((size_t)e * 512 + (size_t)u.q * 128) * ldb * 2; }
};

struct MoeG2Prob {
    const char* A; const char* WdT; unsigned lda, ldb;
    int K, G, c;
    const LAS i32x2* ttab; int ntl;
    struct AState { const char* base; };
    DI bool next(int i, Unit& u) const {
        if ((G & 7) == 0) { const int x = c & 7, W = G >> 3, tpx = (ntl + 7) >> 3; const int m = i * W + (c >> 3); const int tl = m >> 3; const int tile = x * tpx + tl;
            if (tl >= tpx || tile >= ntl) return false; u.p = tile; u.q = m & 7; return true; }
        const long L = (long)i * G + c; if (L >= (long)ntl * 8) return false; u.p = (int)(L >> 3); u.q = (int)(L & 7); return true; }
    DI void a_state(const Unit& u, int R0, int C, AState& s) const { const int row0 = lds_tab_read(ttab + u.p).y; s.base = A + (size_t)row0 * lda * 2; }
    DI const char* a_addr(const AState& s, int h, int i, int R0, int C, size_t koff) const { return s.base + koff + (size_t)h * 128 * lda * 2 + (size_t)((unsigned)(R0 + 64 * i) * lda + (unsigned)C) * 2u; }
    static DI AState sel(bool c, const AState& a, const AState& b) { AState r; r.base = c ? a.base : b.base; return r; }
    DI size_t koff(int kt) const { return (size_t)kt * 128; }
    DI const char* b_ptr(const Unit& u, int h) const { const int e = lds_tab_read(ttab + u.p).x & 0xff; return WdT + ((size_t)e * 2048 + (size_t)u.q * 256 + (size_t)h * 128) * ldb * 2; }
};

struct EpiF32 {
    static constexpr bool PERM = false;
    float* C; long ldc; int N;
    DI void operator()(const f32x4 (&acc)[2][2][4][2], const Unit& u, int wr, int wc, int fr, int fq) const {
        const int row0 = u.p * 256 + wr * 64 + fr, col0 = u.q * 256 + wc * 32 + 4 * fq;
#pragma unroll
        for (int ai = 0; ai < 2; ++ai)
#pragma unroll
            for (int m = 0; m < 4; ++m) { float* rowp = C + (size_t)(row0 + ai * 128 + m * 16) * ldc;
#pragma unroll
                for (int bj = 0; bj < 2; ++bj)
#pragma unroll
                    for (int n = 0; n < 2; ++n) { const int col = col0 + bj * 128 + n * 16; if (col < N) *(f32x4*)(rowp + col) = acc[ai][bj][m][n]; } }
    }
};
struct EpiBf16 {
    static constexpr bool PERM = true;
    bf16_t* C; long ldc; int N;
    DI void operator()(const f32x4 (&acc)[2][2][4][2], const Unit& u, int wr, int wc, int fr, int fq) const {
        const int row0 = u.p * 256 + wr * 64 + fr, col0 = u.q * 256 + wc * 32 + 8 * fq;
#pragma unroll
        for (int ai = 0; ai < 2; ++ai)
#pragma unroll
            for (int m = 0; m < 4; ++m) { bf16_t* rowp = C + (size_t)(row0 + ai * 128 + m * 16) * ldc;
#pragma unroll
                for (int bj = 0; bj < 2; ++bj) { const int col = col0 + bj * 128; const f32x4 v0 = acc[ai][bj][m][0], v1 = acc[ai][bj][m][1];
                    if (col < N) { u32x4 o; o.x = pk_bf16(v0[0], v0[1]); o.y = pk_bf16(v0[2], v0[3]); o.z = pk_bf16(v1[0], v1[1]); o.w = pk_bf16(v1[2], v1[3]); *(u32x4*)(rowp + col) = o; } } }
    }
};
DI int perm16(int s) { return (s & ~12) | ((s & 4) << 1) | ((s & 8) >> 1); }
DI int perm32(int s) { return (s & ~28) | ((s & 12) << 1) | ((s & 16) >> 2); }
struct EpiKV {
    static constexpr bool PERM = true;
    bf16_t* kf; bf16_t* vf;
    DI void operator()(const f32x4 (&acc)[2][2][4][2], const Unit& u, int wr, int wc, int fr, int fq) const {
        const int row0 = u.p * 256 + wr * 64 + fr, head = u.q, c = wc * 32 + 8 * fq;
#pragma unroll
        for (int ai = 0; ai < 2; ++ai)
#pragma unroll
            for (int m = 0; m < 4; ++m) { const int t = row0 + ai * 128 + m * 16; const int b = t >> 11, s = t & 2047;
                const int kt = s >> 5, r = s & 31, s2 = (s >> 4) & 1;
                const int p16 = perm16(s & 15);
                const size_t tb = (size_t)(b * 16 + head) * 64 + kt;
                { const f32x4 v0 = acc[ai][0][m][0], v1 = acc[ai][0][m][1]; u32x4 o; o.x = pk_bf16(v0[0], v0[1]); o.y = pk_bf16(v0[2], v0[3]); o.z = pk_bf16(v1[0], v1[1]); o.w = pk_bf16(v1[2], v1[3]);
                  *(u32x4*)(kf + (tb * 8 + (c >> 4)) * 512 + (((c >> 3) & 1) * 32 + r) * 8) = o; }
                { bf16_t* vp = vf + ((tb * 4 + (c >> 5)) * 2 + s2) * 512 + ((p16 >> 3) * 32 + (c & 31)) * 8 + (p16 & 7);
#pragma unroll
                  for (int n = 0; n < 2; ++n) { const f32x4 vv = acc[ai][1][m][n];
#pragma unroll
                      for (int j = 0; j < 4; ++j) vp[(n * 4 + j) * 8] = f2bf(vv[j]); } } }
    }
};
struct CmpProb {
    const char* hb; const char* Wt;
    unsigned ldb; int K, G, c;
    struct AState { unsigned off[2][2]; };
    DI bool next(int i, Unit& u) const { const int L = i * G + c; if (L >= 16) return false; u.p = L & 7; u.q = L >> 3; return true; }
    DI void a_state(const Unit& u, int R0, int C, AState& s) const {
#pragma unroll
        for (int h = 0; h < 2; ++h)
#pragma unroll
            for (int i = 0; i < 2; ++i) { const int m = u.p * 256 + h * 128 + R0 + 64 * i; const int bg = m >> 7; int ci = m & 127; if (ci > 126) ci = 126;
                s.off[h][i] = (unsigned)(((size_t)((bg >> 1) * SEQ + 16 * ci) * AB_IN + AB_KV + u.q * 256 + (bg & 1) * 128 + C) * 2); }
    }
    DI const char* a_addr(const AState& s, int h, int i, int R0, int C, size_t koff) const { return hb + koff + s.off[h][i]; }
    static DI AState sel(bool c, const AState& a, const AState& b) { AState r;
#pragma unroll
        for (int h = 0; h < 2; ++h)
#pragma unroll
            for (int i = 0; i < 2; ++i) r.off[h][i] = c ? a.off[h][i] : b.off[h][i];
        return r; }
    DI size_t koff(int kt) const { return (size_t)(kt >> 1) * (AB_IN * 2) + (size_t)(kt & 1) * 128; }
    DI const char* b_ptr(const Unit& u, int h) const { return Wt + ((size_t)u.q * 256 + (size_t)h * 128) * ldb * 2; }
};
struct EpiCmp {
    static constexpr bool PERM = false;
    bf16_t* kc; bf16_t* vcT; const float* cpart;
    DI void operator()(const f32x4 (&acc)[2][2][4][2], const Unit& u, int wr, int wc, int fr, int fq) const {
        const int which = u.q, row0 = u.p * 256 + wr * 64 + fr, c0 = wc * 32 + 4 * fq;
        f32x4 bias[2];
#pragma unroll
        for (int n = 0; n < 2; ++n) { f32x4 a = {0.f, 0.f, 0.f, 0.f};
            for (int l = 0; l < 128; ++l) { const f32x4 v = *(const f32x4*)(cpart + ((size_t)which * 128 + l) * 128 + c0 + n * 16); a += v; }
            bias[n] = a; }
#pragma unroll
        for (int ai = 0; ai < 2; ++ai)
#pragma unroll
            for (int m = 0; m < 4; ++m) { const int mm = row0 + ai * 128 + m * 16; const int bg = mm >> 7, ci = mm & 127;
#pragma unroll
                for (int n = 0; n < 2; ++n) { const int c = c0 + n * 16; const f32x4 v = acc[ai][0][m][n] + bias[n];
                    if (which == 0) { u32x2 o; o.x = pk_bf16(v[0], v[1]); o.y = pk_bf16(v[2], v[3]); *(u32x2*)(kc + (size_t)mm * 128 + c) = o; }
                    else { bf16_t* vp = vcT + ((size_t)bg * 128 + c) * 128 + perm16(ci);
#pragma unroll
                        for (int j = 0; j < 4; ++j) vp[(size_t)j * 128] = f2bf(v[j]); } } }
    }
};
struct EpiAB {
    static constexpr bool PERM = true;
    bf16_t* C; bf16_t* vselT; bf16_t* vwinT; bf16_t* ksf; bf16_t* kwf;
    DI void operator()(const f32x4 (&acc)[2][2][4][2], const Unit& u, int wr, int wc, int fr, int fq) const {
        const int row0 = u.p * 256 + wr * 64 + fr, col0 = u.q * 256 + wc * 32 + 8 * fq;
        const bool special = (u.q >= 30);
#pragma unroll
        for (int ai = 0; ai < 2; ++ai)
#pragma unroll
            for (int m = 0; m < 4; ++m) { const int t = row0 + ai * 128 + m * 16; const int b = t >> 11, sp = t & 2047;
                bf16_t* rowp = C + (size_t)t * AB_IN;
#pragma unroll
                for (int bj = 0; bj < 2; ++bj) { const int col = col0 + bj * 128; const f32x4 v0 = acc[ai][bj][m][0], v1 = acc[ai][bj][m][1];
                    u32x4 o; o.x = pk_bf16(v0[0], v0[1]); o.y = pk_bf16(v0[2], v0[3]); o.z = pk_bf16(v1[0], v1[1]); o.w = pk_bf16(v1[2], v1[3]);
                    if (col < AB_IN) *(u32x4*)(rowp + col) = o;
                    if (special) {
                        if (col >= AB_KV + 512 && col < AB_KV + 768) { const int cc = col - (AB_KV + 512); const int bg = b * 2 + (cc >> 7), d = cc & 127;
                            *(u32x4*)(ksf + ((((size_t)bg * 128 + (sp >> 4)) * 4 + (d >> 5)) * 64 + ((d >> 3) & 3) * 16 + (sp & 15)) * 8) = o; }
                        if (col >= AB_KV + 768 && col < AB_KV + 1024) { const int cc = col - (AB_KV + 768); const int bg = b * 2 + (cc >> 7), d = cc & 127;
                            const int p32 = perm32(sp & 31);
                            bf16_t* vp = vselT + ((((size_t)bg * 64 + (sp >> 5)) * 8 + (d >> 4)) * 64 + (p32 >> 3) * 16 + (d & 15)) * 8 + (p32 & 7);
#pragma unroll
                            for (int j = 0; j < 4; ++j) { vp[j * 8] = f2bf(v0[j]); vp[(4 + j) * 8] = f2bf(v1[j]); } }
                        if (col >= AB_KV + 1024 && col < AB_KV + 1280) { const int cc = col - (AB_KV + 1024); const int bg = b * 2 + (cc >> 7), d = cc & 127;
                            *(u32x4*)(kwf + ((((size_t)bg * 64 + (sp >> 5)) * 8 + (d >> 4)) * 64 + ((d >> 3) & 1) * 32 + (sp & 31)) * 8) = o; }
                        if (col >= AB_KV + 1280 && col < AB_KV + 1536) { const int cc = col - (AB_KV + 1280); const int bg = b * 2 + (cc >> 7), d = cc & 127;
                            const int p16 = perm16(sp & 15);
                            bf16_t* vp = vwinT + (((((size_t)bg * 64 + (sp >> 5)) * 4 + (d >> 5)) * 2 + ((sp >> 4) & 1)) * 64 + (p16 >> 3) * 32 + (d & 31)) * 8 + (p16 & 7);
#pragma unroll
                            for (int j = 0; j < 4; ++j) { vp[j * 8] = f2bf(v0[j]); vp[(4 + j) * 8] = f2bf(v1[j]); } }
                    } } }
    }
};
struct EpiCD {
    static constexpr bool PERM = true;
    bf16_t* C; bf16_t* viT;
    DI void operator()(const f32x4 (&acc)[2][2][4][2], const Unit& u, int wr, int wc, int fr, int fq) const {
        const int row0 = u.p * 256 + wr * 64 + fr, col0 = u.q * 256 + wc * 32 + 8 * fq;
        const bool special = (u.q >= 20 && u.q <= 28);
#pragma unroll
        for (int ai = 0; ai < 2; ++ai)
#pragma unroll
            for (int m = 0; m < 4; ++m) { const int t = row0 + ai * 128 + m * 16; const int b = t >> 11, sp = t & 2047;
                bf16_t* rowp = C + (size_t)t * CD_IN;
#pragma unroll
                for (int bj = 0; bj < 2; ++bj) { const int col = col0 + bj * 128; const f32x4 v0 = acc[ai][bj][m][0], v1 = acc[ai][bj][m][1];
                    if (col < CD_IN) { u32x4 o; o.x = pk_bf16(v0[0], v0[1]); o.y = pk_bf16(v0[2], v0[3]); o.z = pk_bf16(v1[0], v1[1]); o.w = pk_bf16(v1[2], v1[3]); *(u32x4*)(rowp + col) = o; }
                    if (special && col >= CD_HI && col < CD_HI + 2048) { const int cc = col - CD_HI;
                        bf16_t* vp = viT + ((size_t)(b * 16 + (cc >> 7)) * 128 + (cc & 127)) * 2048 + perm16(sp);
#pragma unroll
                        for (int j = 0; j < 4; ++j) { vp[(size_t)j * 2048] = f2bf(v0[j]); vp[(size_t)(4 + j) * 2048] = f2bf(v1[j]); } } } }
    }
};
struct RouterProb {
    const char* xhi; long dlo; const char* Bt;
    int K, G, c;
    struct AState { const char* base; };
    DI bool next(int i, Unit& u) const { const int L = i * G + c; if (L >= 256) return false; u.p = L >> 2; u.q = L & 3; return true; }
    DI void a_state(const Unit& u, int R0, int C, AState& s) const { s.base = xhi + (long)((u.q >> 1) & 1) * dlo + (size_t)u.p * 256 * 4096 + (size_t)(u.q & 1) * 2048; }
    DI const char* a_addr(const AState& s, int h, int i, int R0, int C, size_t koff) const { return s.base + koff + (size_t)h * 128 * 4096 + (size_t)((unsigned)(R0 + 64 * i) * 2048u + (unsigned)C) * 2u; }
    static DI AState sel(bool c, const AState& a, const AState& b) { AState r; r.base = c ? a.base : b.base; return r; }
    DI size_t koff(int kt) const { return (size_t)kt * 128; }
    DI const char* b_ptr(const Unit& u, int h) const { return Bt + ((size_t)h * 128 * 4096 + (size_t)u.q * 1024) * 2; }
    unsigned ldb;
};
struct EpiRouter {
    static constexpr bool PERM = false;
    float* Cpart;
    DI void operator()(const f32x4 (&acc)[2][2][4][2], const Unit& u, int wr, int wc, int fr, int fq) const {
        const int row0 = u.p * 256 + wr * 64 + fr, col0 = wc * 32 + 4 * fq;
#pragma unroll
        for (int ai = 0; ai < 2; ++ai)
#pragma unroll
            for (int m = 0; m < 4; ++m) { float* rowp = Cpart + ((size_t)u.q * T_TOK + (size_t)(row0 + ai * 128 + m * 16)) * 128 + col0;
#pragma unroll
                for (int n = 0; n < 2; ++n) *(f32x4*)(rowp + n * 16) = acc[ai][0][m][n]; }
    }
};
struct EpiSwiglu {
    static constexpr bool PERM = true;
    bf16_t* H; const LAS i32x2* ttab;
    DI void operator()(const f32x4 (&acc)[2][2][4][2], const Unit& u, int wr, int wc, int fr, int fq) const {
        const int row0 = lds_tab_read(ttab + u.p).y + wr * 64 + fr, col0 = u.q * 128 + wc * 32 + 8 * fq;
#pragma unroll
        for (int ai = 0; ai < 2; ++ai)
#pragma unroll
            for (int m = 0; m < 4; ++m) { bf16_t* rowp = H + (size_t)(row0 + ai * 128 + m * 16) * 512 + col0;
                float hv[8];
#pragma unroll
                for (int n = 0; n < 2; ++n) { const f32x4 g = acc[ai][0][m][n], up = acc[ai][1][m][n];
#pragma unroll
                    for (int j = 0; j < 4; ++j) hv[n * 4 + j] = g[j] / (1.f + __expf(-g[j])) * up[j]; }
                u32x4 o; o.x = pk_bf16(hv[0], hv[1]); o.y = pk_bf16(hv[2], hv[3]); o.z = pk_bf16(hv[4], hv[5]); o.w = pk_bf16(hv[6], hv[7]); *(u32x4*)rowp = o; }
    }
};
struct EpiMoeDown {
    static constexpr bool PERM = true;
    bf16_t* Y; const LAS i32x2* ttab;
    DI void operator()(const f32x4 (&acc)[2][2][4][2], const Unit& u, int wr, int wc, int fr, int fq) const {
        const i32x2 rec = lds_tab_read(ttab + u.p);
        const int nrows = ((rec.x >> 8) & 0xff) + 1, delta = (int)((unsigned)rec.x >> 16);
        const int r0 = wr * 64 + fr, col0 = u.q * 256 + wc * 32 + 8 * fq;
#pragma unroll
        for (int ai = 0; ai < 2; ++ai)
#pragma unroll
            for (int m = 0; m < 4; ++m) { const int rt = r0 + ai * 128 + m * 16;
                if (rt < nrows) {
                    bf16_t* rowp = Y + (size_t)(rec.y + rt - delta) * 2048 + col0;
#pragma unroll
                    for (int bj = 0; bj < 2; ++bj) { const f32x4 v0 = acc[ai][bj][m][0], v1 = acc[ai][bj][m][1];
                        u32x4 o; o.x = pk_bf16(v0[0], v0[1]); o.y = pk_bf16(v0[2], v0[3]); o.z = pk_bf16(v1[0], v1[1]); o.w = pk_bf16(v1[2], v1[3]); *(u32x4*)(rowp + bj * 128) = o; } } }
    }
};

template <class Prob, class Epi>
DI void gemm_phase(LAS unsigned char* lds, const Prob& P, const Epi& E) {
    const int tid = tid_opaque(), wid = __builtin_amdgcn_readfirstlane(tid >> 6), lane = tid & 63, wr = wid >> 2, wc = wid & 3, fr = lane & 15, fq = lane >> 4;
    const int K = P.K, nt = K / BK;
    int R0, C; stage_rc(tid * 16, R0, C);
    unsigned voffB[2];
#pragma unroll
    for (int i = 0; i < 2; ++i) { const int R = R0 + 64 * i;
        const int Rb = Epi::PERM ? ((R & ~31) + 8 * ((R & 15) >> 2) + 4 * ((R >> 4) & 1) + (R & 3)) : R;
        voffB[i] = ((unsigned)Rb * P.ldb + (unsigned)C) * 2u; }
    const size_t kstep = (size_t)(BK * 2);
    const unsigned ldsw = (unsigned)wid * 1024u;
    const int aoff = lds_byte(wr * 64 + fr, fq * 8), boff = lds_byte(wc * 32 + fr, fq * 8);
#define GM_SA(b, h) (((b) * 2 + (h)) * HTB)
#define GM_SB(b, h) ((4 + (b) * 2 + (h)) * HTB)
#define GM_STAGE_B(bufoff, gbase) do { _Pragma("unroll") for (int _i = 0; _i < 2; ++_i) \
        __builtin_amdgcn_global_load_lds((const unsigned*)((const char*)(gbase) + voffB[_i]), (LAS unsigned*)(lds + (bufoff) + ldsw + _i * 8192), 16, 0, 0); } while (0)
#define GM_STAGE_A(bufoff, st, h, koff) do { _Pragma("unroll") for (int _i = 0; _i < 2; ++_i) \
        __builtin_amdgcn_global_load_lds((const unsigned*)(P.a_addr(st, h, _i, R0, C, koff)), (LAS unsigned*)(lds + (bufoff) + ldsw + _i * 8192), 16, 0, 0); } while (0)
#define GM_LDA(dst, b, h) do { _Pragma("unroll") for (int m = 0; m < 4; ++m) _Pragma("unroll") for (int k = 0; k < 2; ++k) dst[m][k] = *(const LAS bf16x8*)(lds + GM_SA(b, h) + aoff + m * 2048 + k * 1024); } while (0)
#define GM_LDB(dst, b, h) do { _Pragma("unroll") for (int n = 0; n < 2; ++n) _Pragma("unroll") for (int k = 0; k < 2; ++k) dst[n][k] = *(const LAS bf16x8*)(lds + GM_SB(b, h) + boff + n * 2048 + k * 1024); } while (0)
#define GM_MMA(ai, bj, At, Bt) do { __builtin_amdgcn_s_setprio(1); _Pragma("unroll") for (int m = 0; m < 4; ++m) _Pragma("unroll") for (int n = 0; n < 2; ++n) _Pragma("unroll") for (int k = 0; k < 2; ++k) \
        acc[ai][bj][m][n] = __builtin_amdgcn_mfma_f32_16x16x32_bf16(Bt[n][k], At[m][k], acc[ai][bj][m][n], 0, 0, 0); __builtin_amdgcn_s_setprio(0); } while (0)
#define GM_WAIT_V(n) asm volatile("s_waitcnt vmcnt(" #n ")" ::: "memory")
#define GM_WAIT_L(n) asm volatile("s_waitcnt lgkmcnt(" #n ")" ::: "memory")
#define GM_BAR __builtin_amdgcn_s_barrier()
#define GM_SCHED __builtin_amdgcn_sched_barrier(0)
    Unit cur, nxt; int ui = 0;
    if (!P.next(0, cur)) return;
    f32x4 acc[2][2][4][2];
#pragma unroll
    for (int a = 0; a < 2; ++a)
#pragma unroll
        for (int b = 0; b < 2; ++b)
#pragma unroll
            for (int m = 0; m < 4; ++m)
#pragma unroll
                for (int n = 0; n < 2; ++n) acc[a][b][m][n] = (f32x4){0.f, 0.f, 0.f, 0.f};
    bf16x8 At[4][2], B0[2][2], B1[2][2];
    typename Prob::AState cs, ns; P.a_state(cur, R0, C, cs);
    const char* cB0 = P.b_ptr(cur, 0); const char* cB1 = P.b_ptr(cur, 1);
    GM_STAGE_B(GM_SB(0, 0), cB0); GM_STAGE_A(GM_SA(0, 0), cs, 0, 0); GM_STAGE_B(GM_SB(0, 1), cB1); GM_STAGE_A(GM_SA(0, 1), cs, 1, 0);
    if (wr == 1) GM_BAR;
    GM_WAIT_V(4); GM_BAR;
    GM_STAGE_B(GM_SB(1, 0), cB0 + kstep); GM_STAGE_A(GM_SA(1, 0), cs, 0, P.koff(1)); GM_STAGE_B(GM_SB(1, 1), cB1 + kstep);
    GM_WAIT_V(6); GM_BAR;
    for (;;) {
        const bool has_next = P.next(ui + 1, nxt);
        if (has_next) P.a_state(nxt, R0, C, ns); else ns = cs;
        const char* nB0 = has_next ? P.b_ptr(nxt, 0) : cB0; const char* nB1 = has_next ? P.b_ptr(nxt, 1) : cB1;
        for (int t = 0; t < nt; t += 2) {
            const bool last = (t == nt - 2);
            const size_t k1 = P.koff(t + 1);
            const size_t k2 = last ? (size_t)0 : P.koff(t + 2), k3 = last ? P.koff(1) : P.koff(t + 3);
            const typename Prob::AState s2 = Prob::sel(last, ns, cs);
            const char* b20 = last ? nB0 : cB0 + (size_t)(t + 2) * kstep; const char* b21 = last ? nB1 : cB1 + (size_t)(t + 2) * kstep;
            const char* b30 = b20 + kstep; const char* b31 = b21 + kstep;
            GM_LDB(B0, 0, 0); GM_SCHED; GM_LDA(At, 0, 0); GM_STAGE_A(GM_SA(1, 1), cs, 1, k1);
            GM_WAIT_L(8); GM_BAR; GM_WAIT_L(0); GM_MMA(0, 0, At, B0); GM_BAR; GM_SCHED;
            GM_LDB(B1, 0, 1); GM_STAGE_B(GM_SB(0, 0), b20);
            GM_BAR; GM_WAIT_L(0); GM_MMA(0, 1, At, B1); GM_BAR;
            GM_LDA(At, 0, 1); GM_STAGE_A(GM_SA(0, 0), s2, 0, k2);
            GM_BAR; GM_WAIT_L(0); GM_MMA(1, 0, At, B0); GM_BAR; GM_SCHED;
            GM_STAGE_B(GM_SB(0, 1), b21);
            GM_WAIT_V(6); GM_BAR; GM_MMA(1, 1, At, B1); GM_BAR;
            GM_LDB(B0, 1, 0); GM_SCHED; GM_LDA(At, 1, 0); GM_STAGE_A(GM_SA(0, 1), s2, 1, k2);
            GM_WAIT_L(8); GM_BAR; GM_WAIT_L(0); GM_MMA(0, 0, At, B0); GM_BAR; GM_SCHED;
            GM_LDB(B1, 1, 1); GM_STAGE_B(GM_SB(1, 0), b30);
            GM_BAR; GM_WAIT_L(0); GM_MMA(0, 1, At, B1); GM_BAR;
            GM_LDA(At, 1, 1); GM_STAGE_A(GM_SA(1, 0), s2, 0, k3);
            GM_BAR; GM_WAIT_L(0); GM_MMA(1, 0, At, B0); GM_BAR; GM_SCHED;
            GM_STAGE_B(GM_SB(1, 1), b31);
            GM_WAIT_V(6); GM_BAR; GM_MMA(1, 1, At, B1); GM_BAR;
        }
        E(acc, cur, wr, wc, fr, fq);
        if (!has_next) break;
#pragma unroll
        for (int a = 0; a < 2; ++a)
#pragma unroll
            for (int b = 0; b < 2; ++b)
#pragma unroll
                for (int m = 0; m < 4; ++m)
#pragma unroll
                    for (int n = 0; n < 2; ++n) acc[a][b][m][n] = (f32x4){0.f, 0.f, 0.f, 0.f};
        cur = nxt; cs = ns; cB0 = nB0; cB1 = nB1; ++ui;
    }
    GM_WAIT_V(0);
    if (wr == 0) GM_BAR;
    GM_BAR;
#undef GM_SA
#undef GM_SB
#undef GM_STAGE_A
#undef GM_STAGE_B
#undef GM_LDA
#undef GM_LDB
#undef GM_MMA
#undef GM_WAIT_V
#undef GM_WAIT_L
#undef GM_BAR
#undef GM_SCHED
}
}


#define XB_TMO      128
#define XB_XCNT(j)  (256  + 64 * (j))
#define XB_XSUB(j)  (1280 + 64 * (j))
#define XB_XGEN(j)  (2304 + 64 * (j))
#define XB_TOP      3328
#define XB_TOPGEN   3392
#define XCD_BAR_WORDS 3456
#define XB_SPIN_CAP (1u << 22)
#define LAS __attribute__((address_space(3)))

__device__ __forceinline__ unsigned xb_ld(unsigned* p)              { return __hip_atomic_load(p, __ATOMIC_RELAXED, __HIP_MEMORY_SCOPE_AGENT); }
__device__ __forceinline__ unsigned xb_add(unsigned* p, unsigned v) { return __hip_atomic_fetch_add(p, v, __ATOMIC_RELAXED, __HIP_MEMORY_SCOPE_AGENT); }
__device__ __forceinline__ unsigned xb_xcc_id() { return (unsigned)__builtin_amdgcn_s_getreg((3 << 11) | 20) & 0xFu; }
#define XB_SPIN(cond, bar) do { unsigned _sp = 0; while (cond) { __builtin_amdgcn_s_sleep(1); \
    if ((++_sp & 255u) == 0u) { if (xb_ld(&(bar)[XB_TMO])) break; if (_sp > XB_SPIN_CAP) { atomicAdd(&(bar)[XB_TMO], 1u); break; } } } } while (0)

struct XcdBarrier {
    unsigned* bar; unsigned x;
    volatile LAS unsigned* st;
};

__device__ __forceinline__ XcdBarrier xcd_barrier_post(unsigned* bar, volatile LAS unsigned* st) {
    XcdBarrier b; b.bar = bar; b.x = xb_xcc_id(); b.st = st;
    if (threadIdx.x == 0) (void)xb_add(&bar[XB_XCNT(b.x)], 1u);
    return b;
}
__device__ __forceinline__ void xcd_barrier_complete(unsigned* bar, unsigned x, unsigned& nloc, unsigned& nx) {
    const unsigned G = gridDim.x * gridDim.y * gridDim.z;
    unsigned sum, cnt, mine, sp = 0u;
    for (;;) {
        sum = 0u; cnt = 0u; mine = 0u;
#pragma unroll
        for (unsigned j = 0; j < 16; ++j) { const unsigned c = xb_ld(&bar[XB_XCNT(j)]); sum += c; cnt += (c > 0u) ? 1u : 0u; mine = (j == x) ? c : mine; }
        if (sum == G) break;
        __builtin_amdgcn_s_sleep(1);
        if ((++sp & 255u) == 0u) { if (xb_ld(&bar[XB_TMO])) break; if (sp > XB_SPIN_CAP) { atomicAdd(&bar[XB_TMO], 1u); break; } }
    }
    nloc = mine > 0u ? mine : 1u; nx = cnt > 0u ? cnt : 1u;
}

__device__ __forceinline__ void xcd_barrier(const XcdBarrier& b) {
    asm volatile("s_waitcnt vmcnt(0)" ::: "memory");
    __syncthreads();
    if (threadIdx.x == 0) {
        unsigned* bar = b.bar;
        __builtin_amdgcn_s_waitcnt(0);
        unsigned nloc = b.st[0], nx = b.st[1];
        if (nloc == 0u) { xcd_barrier_complete(bar, b.x, nloc, nx); b.st[0] = nloc; b.st[1] = nx; }
        const unsigned old = xb_add(&bar[XB_XSUB(b.x)], 1u);
        const unsigned gen = old / nloc;
        if (old + 1u == (gen + 1u) * nloc) {
            __builtin_amdgcn_fence(__ATOMIC_RELEASE, "agent");
            asm volatile("s_waitcnt vmcnt(0)" ::: "memory");
            const unsigned og = xb_add(&bar[XB_TOP], 1u);
            const unsigned tg = og / nx;
            if (og + 1u == (tg + 1u) * nx) xb_add(&bar[XB_TOPGEN], 1u);
            else XB_SPIN(xb_ld(&bar[XB_TOPGEN]) == tg, bar);
            __builtin_amdgcn_fence(__ATOMIC_ACQUIRE, "agent");
            xb_add(&bar[XB_XGEN(b.x)], 1u);
            asm volatile("s_waitcnt vmcnt(0)" ::: "memory");
        } else {
            XB_SPIN(xb_ld(&bar[XB_XGEN(b.x)]) == gen, bar);
            __builtin_amdgcn_fence(__ATOMIC_ACQUIRE, "agent");
            asm volatile("s_waitcnt vmcnt(0)" ::: "memory");
        }
    }
    __syncthreads();
}


struct MP {
    const float* x; const int* positions; const float* ab_w_in; const float* conv_w; const float* conv_b; const float* dt_bias; const float* a_log; const float* ssm_d;
    const float* ssm_norm_w; const float* cmp_pos; const float* cmp_w; const float* ab_w_out; const float* cd_w_in; const float* q_norm_w; const float* w_uq;
    const float* kv_norm_w; const float* w_ukv; const float* lb_logits; const float* hgrn_norm_w; const float* cd_w_out; const float* ln_g; const float* ln_b;
    const float* w_router; const float* router_bias; const float* w_gate; const float* w_up; const float* w_down; const float* sg; const float* su; const float* sd;
    float* out;
    bf16_t* WinABt; bf16_t* WoutABt; bf16_t* WinCDt; bf16_t* WoutCDt; bf16_t* Wuqt; bf16_t* Wukvt; bf16_t* WgT; bf16_t* WuT; bf16_t* WdT;
    bf16_t* hbuf; float* xbc; float* mix; bf16_t* H; bf16_t* Y; bf16_t* mixb; float* bufA; float* bufB; float* x3; bf16_t* xb; bf16_t* cqb; bf16_t* kr; float* kc; float* vc;
    float* rope_tab; bf16_t* kcb; bf16_t* vcT; bf16_t* vselT; bf16_t* vwinT; bf16_t* ksf; bf16_t* kwf; bf16_t* kvfrag; bf16_t* WcmpT; float* cpart; bf16_t* WrT3; int* top_e; float* top_w; int* lpos; int* cnt_tab; int* row_tok; float* row_w; int* row_slot; int* tiles; int* ntiles;
    unsigned* bar;
};

constexpr int NTHR = 512, NWAVE = 8;
constexpr int LDS_BAR_OFF = 135168;
constexpr int LDS_TAB_OFF = LDS_BAR_OFF + 64;
constexpr int LDS_TOTAL = LDS_TAB_OFF + 768 * 8;

DI float wave_sum(float v) {
#pragma unroll
    for (int o = 1; o < 64; o <<= 1) v += __shfl_xor(v, o);
    return v;
}

DI void cvt_wT_range(LAS unsigned char* lds, const float* __restrict__ W, bf16_t* __restrict__ Wt, int K, int N, int Npad, int bid, int nblk, int ntile) {
    const int tix = tid_opaque();
    LAS float* tile = (LAS float*)lds;
    const int tn = Npad / 64, tk = K / 64;
    const int tx = tix & 63, ty = tix >> 6;
    const int wn = tix >> 3, wk = (tix & 7) * 8;
    float cur[8];
    int tp = bid;
    if (tp < ntile) {
        int tq = tp; const int nx = tq % tn; tq /= tn; const int ky = tq % tk; const int bz = tq / tk;
        const float* Wb = W + (size_t)bz * K * N + (size_t)(ky * 64) * N + nx * 64 + tx;
        const bool nin = (nx * 64 + tx) < N;
#pragma unroll
        for (int i = 0; i < 8; ++i) cur[i] = nin ? __builtin_nontemporal_load(Wb + (size_t)(ty + 8 * i) * N) : 0.f;
    }
    for (; tp < ntile; tp += nblk) {
        int tq = tp; const int nx = tq % tn; tq /= tn; const int ky = tq % tk; const int bz = tq / tk;
        const int n0 = nx * 64, k0 = ky * 64;
        bf16_t* Wtb = Wt + (size_t)bz * Npad * K;
#pragma unroll
        for (int i = 0; i < 8; ++i) tile[(ty + 8 * i) * 65 + tx] = cur[i];
        const int tp2 = tp + nblk;
        if (tp2 < ntile) {
            int tq2 = tp2; const int nx2 = tq2 % tn; tq2 /= tn; const int ky2 = tq2 % tk; const int bz2 = tq2 / tk;
            const float* Wb2 = W + (size_t)bz2 * K * N + (size_t)(ky2 * 64) * N + nx2 * 64 + tx;
            const bool nin2 = (nx2 * 64 + tx) < N;
#pragma unroll
            for (int i = 0; i < 8; ++i) cur[i] = nin2 ? __builtin_nontemporal_load(Wb2 + (size_t)(ty + 8 * i) * N) : 0.f;
        }
        __syncthreads();
        u32x4 o;
        o.x = pk_bf16(tile[(wk + 0) * 65 + wn], tile[(wk + 1) * 65 + wn]); o.y = pk_bf16(tile[(wk + 2) * 65 + wn], tile[(wk + 3) * 65 + wn]);
        o.z = pk_bf16(tile[(wk + 4) * 65 + wn], tile[(wk + 5) * 65 + wn]); o.w = pk_bf16(tile[(wk + 6) * 65 + wn], tile[(wk + 7) * 65 + wn]);
        *(u32x4*)(Wtb + (size_t)(n0 + wn) * K + k0 + wk) = o;
        __syncthreads();
    }
}
DI void ph_cvt_wT(LAS unsigned char* lds, const float* __restrict__ W, bf16_t* __restrict__ Wt, int K, int N, int Npad, int batch, int bid, int nblk) {
    cvt_wT_range(lds, W, Wt, K, N, Npad, bid, nblk, (Npad / 64) * (K / 64) * batch);
}
DI void ph_cvt_moe_weights(LAS unsigned char* lds, const MP& p, int layer, int bid, int nblk) {
    const size_t eo = (size_t)layer * 64 * DM * 512, so = (size_t)layer * DM * 512;
    ph_cvt_wT(lds, p.w_gate + eo, p.WgT, DM, 512, 512, 64, bid, nblk); ph_cvt_wT(lds, p.sg + so, p.WgT + (size_t)64 * 512 * DM, DM, 512, 512, 1, bid, nblk);
    ph_cvt_wT(lds, p.w_up + eo, p.WuT, DM, 512, 512, 64, bid, nblk);   ph_cvt_wT(lds, p.su + so, p.WuT + (size_t)64 * 512 * DM, DM, 512, 512, 1, bid, nblk);
    ph_cvt_wT(lds, p.w_down + eo, p.WdT, 512, DM, DM, 64, bid, nblk);  ph_cvt_wT(lds, p.sd + so, p.WdT + (size_t)64 * DM * 512, 512, DM, DM, 1, bid, nblk);
}

struct CvqPos { int nx, ky, bz; };
DI void cvq_adv4(CvqPos& s, int tn, int tk) { s.nx += 4; if (s.nx >= tn) { s.nx = 0; if (++s.ky == tk) { s.ky = 0; ++s.bz; } } }
DI void cvt_wT_quad(LAS unsigned char* lds, const float* __restrict__ W, bf16_t* __restrict__ Wt, int K, int N, int Npad, int t0, int t1) {
    const int tix = tid_opaque();
    const int tn = Npad / 64, tk = K / 64;
    const int tx = tix & 63, ty = tix >> 6;
    const int wn = tix >> 3, wq = tix & 7;
    float ca[4][8], cb[4][8];
#define CVQ_ISSUE(C_, S_) do { \
        _Pragma("unroll") for (int j = 0; j < 4; ++j) { \
            const int cn = (S_.nx + j) * 64 < N ? (S_.nx + j) * 64 : 0;        \
            const float* Wb = W + (size_t)S_.bz * K * N + (size_t)(S_.ky * 64 + 2 * ty) * N + cn + tx; \
            _Pragma("unroll") for (int i = 0; i < 4; ++i) { C_[j][2 * i] = __builtin_nontemporal_load(Wb + (size_t)(16 * i) * N); C_[j][2 * i + 1] = __builtin_nontemporal_load(Wb + (size_t)(16 * i + 1) * N); } } } while (0)
#define CVQ_STEP(C_, S_, BUF_, ISSUE_) do { \
        LAS unsigned* tile = (LAS unsigned*)lds + (BUF_) * (4 * 2080); \
        const CvqPos cur_ = S_; \
        _Pragma("unroll") for (int j = 0; j < 4; ++j) { \
            if ((cur_.nx + j) * 64 >= N) { _Pragma("unroll") for (int i = 0; i < 8; ++i) C_[j][i] = 0.f; } \
            _Pragma("unroll") for (int i = 0; i < 4; ++i) tile[j * 2080 + (ty + 8 * i) * 65 + tx] = pk_bf16(C_[j][2 * i], C_[j][2 * i + 1]); } \
        if (ISSUE_) { cvq_adv4(S_, tn, tk); cvq_adv4(S_, tn, tk); CVQ_ISSUE(C_, S_); } \
        __syncthreads(); \
        _Pragma("unroll") for (int j = 0; j < 4; ++j) { \
            const LAS unsigned* tl = tile + j * 2080 + (4 * wq) * 65 + wn; \
            u32x4 o; o.x = tl[0]; o.y = tl[65]; o.z = tl[130]; o.w = tl[195]; \
            __builtin_nontemporal_store(o, (u32x4*)(Wt + (size_t)cur_.bz * Npad * K + (size_t)((cur_.nx + j) * 64 + wn) * K + cur_.ky * 64 + 8 * wq));        \
        } } while (0)
    CvqPos sa, sb;
    { int tq = t0; sa.nx = tq % tn; tq /= tn; sa.ky = tq % tk; sa.bz = tq / tk; sb = sa; cvq_adv4(sb, tn, tk); }
    CVQ_ISSUE(ca, sa); CVQ_ISSUE(cb, sb);
    int tp = t0;
    for (; tp + 8 < t1; tp += 8) {
        CVQ_STEP(ca, sa, 0, true);
        CVQ_STEP(cb, sb, 1, true);
    }
    CVQ_STEP(ca, sa, 0, false);
    CVQ_STEP(cb, sb, 1, false);
    __syncthreads();
#undef CVQ_STEP
#undef CVQ_ISSUE
}
constexpr int CVQ_NG = 208;
constexpr int CVQ_SEG_E = 64 * 256, CVQ_SEG_S = 256, CVQ_BATCH = 32, CVQ_MOE_TILES = 3 * (CVQ_SEG_E + CVQ_SEG_S);
constexpr int CVQ_X0 = (9472 / 64) * (DM / 64), CVQ_X1 = (DM / 64) * (4096 / 64), CVQ_X2 = (3072 / 64) * (512 / 64), CVQ_X3 = (4096 / 64) * (512 / 64), CVQ_X4 = CVQ_X1, CVQ_X5 = 2 * (256 / 64) * (4096 / 64);
constexpr int CVQ_XTRA = CVQ_X0 + CVQ_X1 + CVQ_X2 + CVQ_X3 + CVQ_X4 + CVQ_X5;
static_assert(CVQ_X0 % CVQ_BATCH == 0 && CVQ_X1 % CVQ_BATCH == 0 && CVQ_X2 % CVQ_BATCH == 0 && CVQ_X3 % CVQ_BATCH == 0 && CVQ_X5 % CVQ_BATCH == 0 && CVQ_SEG_S % CVQ_BATCH == 0, "batches must not straddle matrices");
DI void moe_cvt_queue(LAS unsigned char* lds, const MP& p, int layer, unsigned* ctr) {
    const size_t eo = (size_t)layer * 64 * DM * 512, so = (size_t)layer * DM * 512;
    volatile LAS int* slot = (volatile LAS int*)(lds + LDS_BAR_OFF + 32);
    const int nbatch = (CVQ_MOE_TILES + (layer == 0 ? CVQ_XTRA : 0)) / CVQ_BATCH;
    asm volatile("s_waitcnt vmcnt(0)" ::: "memory");
    for (;;) {
        __syncthreads();
        if (threadIdx.x == 0) *slot = (int)__hip_atomic_fetch_add(ctr, 1u, __ATOMIC_RELAXED, __HIP_MEMORY_SCOPE_AGENT);
        __syncthreads();
        const int bt = __builtin_amdgcn_readfirstlane(*slot);
        if (bt >= nbatch) break;
        int g = bt * CVQ_BATCH;
        const float* W; bf16_t* Wt; int K, N, Npad;
        if (g < CVQ_MOE_TILES) {
            const int m = g / (CVQ_SEG_E + CVQ_SEG_S); g -= m * (CVQ_SEG_E + CVQ_SEG_S);
            const bool sh = g >= CVQ_SEG_E; if (sh) g -= CVQ_SEG_E;
            W = (m == 0) ? (sh ? p.sg + so : p.w_gate + eo) : (m == 1) ? (sh ? p.su + so : p.w_up + eo) : (sh ? p.sd + so : p.w_down + eo);
            Wt = ((m == 0) ? p.WgT : (m == 1) ? p.WuT : p.WdT) + (sh ? (size_t)64 * 512 * DM : (size_t)0);
            K = (m == 2) ? 512 : DM; N = (m == 2) ? DM : 512; Npad = N;
        } else {
            g -= CVQ_MOE_TILES;
            if (g < CVQ_X0) { W = p.cd_w_in; Wt = p.WinCDt; K = DM; N = CD_IN; Npad = 9472; }
            else if ((g -= CVQ_X0) < CVQ_X1) { W = p.cd_w_out; Wt = p.WoutCDt; K = 4096; N = DM; Npad = DM; }
            else if ((g -= CVQ_X1) < CVQ_X2) { W = p.w_uq; Wt = p.Wuqt; K = 512; N = 3072; Npad = 3072; }
            else if ((g -= CVQ_X2) < CVQ_X3) { W = p.w_ukv; Wt = p.Wukvt; K = 512; N = 4096; Npad = 4096; }
            else if ((g -= CVQ_X3) < CVQ_X4) { W = p.ab_w_out; Wt = p.WoutABt; K = 4096; N = DM; Npad = DM; }
            else { g -= CVQ_X4; W = p.cmp_w; Wt = p.WcmpT; K = 4096; N = 128; Npad = 256; }
        }
        cvt_wT_quad(lds, W, Wt, K, N, Npad, g, g + CVQ_BATCH);
    }
    __syncthreads();
}

DI void ph_cvt_x(const MP& p) {
    const int tix = tid_opaque();
    const long gt = (long)blockIdx.x * NTHR + tix, gs = (long)gridDim.x * NTHR;
    for (long i = gt; i < (long)T_TOK * DM / 4; i += gs) { const f32x4 v = __builtin_nontemporal_load((const f32x4*)p.x + i); u32x2 o; o.x = pk_bf16(v[0], v[1]); o.y = pk_bf16(v[2], v[3]); ((u32x2*)p.xb)[i] = o; }
    for (long i = gt; i < DM / 2; i += gs) ((unsigned*)(p.xb + (size_t)T_TOK * DM))[i] = 0u;
}


DI void ph_ssd_norm(const MP& p) {
    const int tix = tid_opaque();
    const int lane = tix & 63, gw = blockIdx.x * NWAVE + (tix >> 6), nw = gridDim.x * NWAVE;
    const bf16_t* mixh = (const bf16_t*)p.mix;
    u32x2 nv[8];
    if (gw < T_TOK) {
#pragma unroll
        for (int j = 0; j < 8; ++j) nv[j] = __builtin_nontemporal_load((const u32x2*)(mixh + (long)gw * 4096 + j * 256 + lane * 4));
    }
    for (int row = gw; row < T_TOK; row += nw) {
        float4 v[8]; float ss = 0.f;
#pragma unroll
        for (int j = 0; j < 8; ++j) { v[j].x = bflo(nv[j].x); v[j].y = bfhi(nv[j].x); v[j].z = bflo(nv[j].y); v[j].w = bfhi(nv[j].y); ss += v[j].x * v[j].x + v[j].y * v[j].y + v[j].z * v[j].z + v[j].w * v[j].w; }
        if (row + nw < T_TOK) {
#pragma unroll
            for (int j = 0; j < 8; ++j) nv[j] = __builtin_nontemporal_load((const u32x2*)(mixh + (long)(row + nw) * 4096 + j * 256 + lane * 4));
        }
        const float r = rsqrtf(wave_sum(ss) / 2048.f + 1e-6f);
#pragma unroll
        for (int j = 0; j < 8; ++j) { const float4 w = *(const float4*)(p.ssm_norm_w + j * 256 + lane * 4);
            u32x2 o; o.x = pk_bf16(v[j].x * r * w.x, v[j].y * r * w.y); o.y = pk_bf16(v[j].z * r * w.z, v[j].w * r * w.w);
            *(u32x2*)(p.mixb + (long)row * 4096 + j * 256 + lane * 4) = o; }
    }
}

DI void ph_build_wr(const MP& p) {
    const int tix = tid_opaque();
    const long gt = (long)blockIdx.x * NTHR + tix, gs = (long)gridDim.x * NTHR;
    for (long idx = gt; idx < (long)2 * 256 * 4096; idx += gs) {
        const int k = (int)(idx & 4095), n = (int)((idx >> 12) & 255), layer = (int)(idx >> 20);
        float v = 0.f;
        if (n < 128) {
            const float wv = p.w_router[((size_t)layer * DM + (k & 2047)) * 64 + (n & 63)];
            const float hi = bf2f(f2bf(wv));
            if (n < 64) v = hi; else v = (k < 2048) ? (wv - hi) : 0.f;
        }
        p.WrT3[idx] = f2bf(v);
    }
}
template <bool XBF> DI void ph_ln(const MP& p, const void* xin_, const bf16_t* add, const float* gg, const float* bb, bf16_t* xob, bf16_t* xlo) {
    const int tix = tid_opaque();
    const int lane = tix & 63, gw = blockIdx.x * NWAVE + (tix >> 6), nw = gridDim.x * NWAVE;
    float4 na[8]; u32x2 nc[8];
    const float* xin = (const float*)xin_; const bf16_t* xinb = (const bf16_t*)xin_;
#define LN_LOADX(row_, j_) do { if constexpr (XBF) { const u32x2 h_ = __builtin_nontemporal_load((const u32x2*)(xinb + (long)(row_) * DM + (j_) * 256 + lane * 4)); na[j_] = make_float4(bflo(h_.x), bfhi(h_.x), bflo(h_.y), bfhi(h_.y)); } \
        else { const f32x4 f_ = __builtin_nontemporal_load((const f32x4*)(xin + (long)(row_) * DM + (j_) * 256 + lane * 4)); na[j_] = make_float4(f_[0], f_[1], f_[2], f_[3]); } } while (0)
    if (gw < T_TOK) {
#pragma unroll
        for (int j = 0; j < 8; ++j) { LN_LOADX(gw, j); nc[j] = __builtin_nontemporal_load((const u32x2*)(add + (long)gw * DM + j * 256 + lane * 4)); }
    }
    for (int t = gw; t < T_TOK; t += nw) {
        float4 v[8]; float s = 0.f;
#pragma unroll
        for (int j = 0; j < 8; ++j) { const float4 a = na[j]; const u32x2 c = nc[j];
            v[j].x = DN_ALPHA * a.x + bflo(c.x); v[j].y = DN_ALPHA * a.y + bfhi(c.x); v[j].z = DN_ALPHA * a.z + bflo(c.y); v[j].w = DN_ALPHA * a.w + bfhi(c.y); s += (v[j].x + v[j].y) + (v[j].z + v[j].w); }
        if (t + nw < T_TOK) {
#pragma unroll
            for (int j = 0; j < 8; ++j) { LN_LOADX(t + nw, j); nc[j] = __builtin_nontemporal_load((const u32x2*)(add + (long)(t + nw) * DM + j * 256 + lane * 4)); }
        }
        const float mu = wave_sum(s) / DM;
        float q = 0.f;
#pragma unroll
        for (int j = 0; j < 8; ++j) { v[j].x -= mu; v[j].y -= mu; v[j].z -= mu; v[j].w -= mu; q += v[j].x * v[j].x + v[j].y * v[j].y + v[j].z * v[j].z + v[j].w * v[j].w; }
        const float rs = rsqrtf(wave_sum(q) / DM + 1e-5f);
#pragma unroll
        for (int j = 0; j < 8; ++j) { const int c0 = j * 256 + lane * 4; const float4 g4 = *(const float4*)(gg + c0), b4 = *(const float4*)(bb + c0);
            float4 o; o.x = v[j].x * rs * g4.x + b4.x; o.y = v[j].y * rs * g4.y + b4.y; o.z = v[j].z * rs * g4.z + b4.z; o.w = v[j].w * rs * g4.w + b4.w;
            u32x2 hb; hb.x = pk_bf16(o.x, o.y); hb.y = pk_bf16(o.z, o.w); *(u32x2*)(xob + (long)t * DM + c0) = hb;
            u32x2 lb2; lb2.x = pk_bf16(o.x - bflo(hb.x), o.y - bfhi(hb.x)); lb2.y = pk_bf16(o.z - bflo(hb.y), o.w - bfhi(hb.y)); *(u32x2*)(xlo + (long)t * DM + c0) = lb2; }
    }
}
#undef LN_LOADX
DI void ph_route_select(const MP& p, const float* Cpart, const float* rbias) {
    const int tix = tid_opaque();
    const int lane = tix & 63, gw = blockIdx.x * NWAVE + (tix >> 6), nw = gridDim.x * NWAVE;
    const float bias = rbias[lane];
    const int grp = lane >> 3;
    for (int slot = gw; slot < MOE_NSLOT; slot += nw) {
        int cnt = 0;
        for (int i = 0; i < MOE_SLOT_TOK; ++i) {
            const int t = slot * MOE_SLOT_TOK + i;
            float logit = 0.f;
#pragma unroll
            for (int q = 0; q < 4; ++q) { const float* cp = Cpart + ((size_t)q * T_TOK + t) * 128; logit += cp[lane] + cp[64 + lane]; }
            if (!(logit == logit)) logit = 0.f;
            const float score = 1.f / (1.f + expf(-logit));
            const float biased = score + bias;
            float m1 = biased;
            m1 = fmaxf(m1, __shfl_xor(m1, 1)); m1 = fmaxf(m1, __shfl_xor(m1, 2)); m1 = fmaxf(m1, __shfl_xor(m1, 4));
            const unsigned long long bm = __ballot(biased == m1);
            const unsigned gb = (unsigned)((bm >> (8 * grp)) & 0xffull);
            const int first = __ffs(gb) - 1;
            float v2 = ((lane & 7) == first) ? -3.0e38f : biased;
            v2 = fmaxf(v2, __shfl_xor(v2, 1)); v2 = fmaxf(v2, __shfl_xor(v2, 2)); v2 = fmaxf(v2, __shfl_xor(v2, 4));
            const float gs = m1 + v2;
            int grank = 0;
#pragma unroll
            for (int g2 = 0; g2 < 8; ++g2) { const float o = __shfl(gs, g2 * 8); grank += (o > gs || (o == gs && g2 < grp)) ? 1 : 0; }
            const bool gsel = grank < 4;
            const float masked = gsel ? biased : -3.0e38f;
            int erank = 0;
            for (int e2 = 0; e2 < 64; ++e2) { const float o = __shfl(masked, e2); erank += (o > masked || (o == masked && e2 < lane)) ? 1 : 0; }
            const bool selected = gsel && erank < 8;
            const float ws = wave_sum(selected ? score : 0.f);
            if (selected) { p.top_e[t * 8 + erank] = lane; p.top_w[t * 8 + erank] = score / ws * 2.5f; p.lpos[t * 8 + erank] = cnt; ++cnt; }
        }
        p.cnt_tab[slot * 64 + lane] = cnt;
    }
}
DI void ph_router_gemm(LAS unsigned char* lds, const MP& p, int layer, float* Cpart, const bf16_t* xlo) {
    gm::RouterProb q; q.xhi = (const char*)p.xb; q.dlo = (long)((const char*)xlo - (const char*)p.xb); q.Bt = (const char*)(p.WrT3 + (size_t)layer * 256 * 4096); q.K = 1024; q.G = (int)gridDim.x; q.c = (int)blockIdx.x; q.ldb = 4096;
    gm::EpiRouter e; e.Cpart = Cpart;
    gm::gemm_phase(lds, q, e);
}

DI void ph_moe_scan(LAS unsigned char* lds, const MP& p) {
    const int tix = tid_opaque();
    LAS int* part_b = (LAS int*)lds;
    LAS int* part_a = part_b + 512;
    LAS int* total = part_a + 512; LAS int* base = total + 64; LAS int* pre = base + 64; LAS int* pc = pre + 64;
    const int tid = tix, e = tid & 63, part = tid >> 6;
    const int spb = (MOE_NSLOT + gridDim.x - 1) / gridDim.x;
    const int s0 = blockIdx.x * spb, s1 = min(MOE_NSLOT, s0 + spb);
    int sb = 0, sa = 0;
#pragma unroll 16
    for (int sl = part; sl < MOE_NSLOT; sl += NWAVE) { const int c = p.cnt_tab[sl * 64 + e]; sa += c; if (sl < s0) sb += c; }
    part_b[part * 64 + e] = sb; part_a[part * 64 + e] = sa;
    __syncthreads();
    if (tid < 64) {
        int ta = 0, tb = 0;
#pragma unroll
        for (int i = 0; i < NWAVE; ++i) { ta += part_a[i * 64 + tid]; tb += part_b[i * 64 + tid]; }
        total[tid] = ta; pre[tid] = tb; pc[tid] = (ta + MOE_TM - 1) / MOE_TM * MOE_TM;
    }
    __syncthreads();
    LAS int* ubase = pc + 64 + 512;
    if (tid == 0) { int a = 0, ua = 0; for (int i = 0; i < 64; ++i) { base[i] = a; a += pc[i]; ubase[i] = ua; ua += total[i]; } }
    __syncthreads();
    if (spb <= 8) {
        LAS int* cl = pc + 64;
        const int sll = tid >> 6;
        cl[tid] = (s0 + sll < s1) ? p.cnt_tab[(s0 + sll) * 64 + e] : 0;
        __syncthreads();
        if (tid < 64) { int run = pre[tid]; for (int i = 0; i < 8; ++i) { const int c = cl[i * 64 + tid]; cl[i * 64 + tid] = run; run += c; } }
        __syncthreads();
        if (s0 + sll < s1) {
            const int a = tid & 63; const int t = (s0 + sll) * MOE_SLOT_TOK + (a >> 3), k = a & 7;
            const int ex = p.top_e[t * 8 + k] & 63;
            const int pp = base[ex] + cl[sll * 64 + ex] + p.lpos[t * 8 + k];
            if (pp >= 0 && pp < MOE_PMAX) { p.row_tok[pp] = t; p.row_slot[t * 8 + k] = pp - (base[ex] - ubase[ex]); }
        }
    } else
    for (int sl = s0; sl < s1; ++sl) {
        if (tid < 64) {
            const int t = sl * MOE_SLOT_TOK + (tid >> 3), k = tid & 7;
            const int ex = p.top_e[t * 8 + k] & 63;
            const int pp = base[ex] + pre[ex] + p.lpos[t * 8 + k];
            if (pp >= 0 && pp < MOE_PMAX) { p.row_tok[pp] = t; p.row_slot[t * 8 + k] = pp - (base[ex] - ubase[ex]); }
        }
        __syncthreads();
        if (tid < 64) pre[tid] += p.cnt_tab[sl * 64 + tid];
        __syncthreads();
    }
    for (int ex = blockIdx.x; ex < 64; ex += gridDim.x)
        for (int pp = base[ex] + total[ex] + tid; pp < base[ex] + pc[ex]; pp += NTHR) p.row_tok[pp] = -1;
    for (int i = blockIdx.x * NTHR + tid; i < T_TOK; i += gridDim.x * NTHR) p.row_tok[MOE_PMAX + i] = i;
    if (blockIdx.x == 0 && tid < 64) {
        const int ex = tid, nt = pc[ex] / MOE_TM, t0 = base[ex] / MOE_TM;
        for (int j = 0; j < nt; ++j) { p.tiles[(t0 + j) * 4 + 0] = ex; p.tiles[(t0 + j) * 4 + 1] = base[ex] + j * MOE_TM; p.tiles[(t0 + j) * 4 + 2] = min(MOE_TM, total[ex] - j * MOE_TM); p.tiles[(t0 + j) * 4 + 3] = base[ex] - ubase[ex]; }
        const int nr = (base[63] + pc[63]) / MOE_TM;
        if (ex == 63) *p.ntiles = nr + T_TOK / MOE_TM;
        for (int j = ex; j < T_TOK / MOE_TM; j += 64) { p.tiles[(nr + j) * 4 + 0] = 64; p.tiles[(nr + j) * 4 + 1] = MOE_PMAX + j * MOE_TM; p.tiles[(nr + j) * 4 + 2] = MOE_TM; p.tiles[(nr + j) * 4 + 3] = MOE_PMAX - T_TOK * 8; }
    }
    __syncthreads();
}

DI void ph_moe_combine_ln(const MP& p, const bf16_t* xhi, const bf16_t* xlo, const float* gg, const float* bb, float* out, bf16_t* ob) {
    const int tix = tid_opaque();
    const int lane = tix & 63, gw = blockIdx.x * NWAVE + (tix >> 6), nw = gridDim.x * NWAVE;
    int myslot = 0; float myw = 0.f;
    { const long rr = (long)gw + (long)(lane >> 3) * nw; if (rr < T_TOK) { myslot = p.row_slot[rr * 8 + (lane & 7)]; myw = p.top_w[rr * 8 + (lane & 7)]; } }
    int ri = 0;
    for (int row = gw; row < T_TOK; row += nw, ++ri) {
        if (ri == 8) { ri = 0; const long rr = (long)row + (long)(lane >> 3) * nw; if (rr < T_TOK) { myslot = p.row_slot[rr * 8 + (lane & 7)]; myw = p.top_w[rr * 8 + (lane & 7)]; } }
        float v[32];
#pragma unroll
        for (int j = 0; j < 4; ++j) { const u32x4 a = __builtin_nontemporal_load((const u32x4*)(xhi + (long)row * DM + j * 512 + lane * 8)), b = __builtin_nontemporal_load((const u32x4*)(xlo + (long)row * DM + j * 512 + lane * 8));
            v[j * 8 + 0] = DN_ALPHA * (bflo(a.x) + bflo(b.x)); v[j * 8 + 1] = DN_ALPHA * (bfhi(a.x) + bfhi(b.x)); v[j * 8 + 2] = DN_ALPHA * (bflo(a.y) + bflo(b.y)); v[j * 8 + 3] = DN_ALPHA * (bfhi(a.y) + bfhi(b.y));
            v[j * 8 + 4] = DN_ALPHA * (bflo(a.z) + bflo(b.z)); v[j * 8 + 5] = DN_ALPHA * (bfhi(a.z) + bfhi(b.z)); v[j * 8 + 6] = DN_ALPHA * (bflo(a.w) + bflo(b.w)); v[j * 8 + 7] = DN_ALPHA * (bfhi(a.w) + bfhi(b.w)); }
#pragma unroll 3
        for (int k = 0; k < 9; ++k) {
            const size_t yr = (k < 8) ? (size_t)__builtin_amdgcn_readfirstlane(__shfl(myslot, ri * 8 + (k & 7))) : (size_t)((long)T_TOK * 8 + row);
            const float wk = (k < 8) ? __shfl(myw, ri * 8 + (k & 7)) : 1.f;
#pragma unroll
            for (int j = 0; j < 4; ++j) { const u32x4 y = __builtin_nontemporal_load((const u32x4*)(p.Y + yr * 2048 + j * 512 + lane * 8));
                v[j * 8 + 0] += wk * bflo(y.x); v[j * 8 + 1] += wk * bfhi(y.x); v[j * 8 + 2] += wk * bflo(y.y); v[j * 8 + 3] += wk * bfhi(y.y);
                v[j * 8 + 4] += wk * bflo(y.z); v[j * 8 + 5] += wk * bfhi(y.z); v[j * 8 + 6] += wk * bflo(y.w); v[j * 8 + 7] += wk * bfhi(y.w); }
        }
        float s = 0.f;
#pragma unroll
        for (int i = 0; i < 32; ++i) s += v[i];
        const float mu = wave_sum(s) / DM;
        float q = 0.f;
#pragma unroll
        for (int i = 0; i < 32; ++i) { v[i] -= mu; q += v[i] * v[i]; }
        const float rs = rsqrtf(wave_sum(q) / DM + 1e-5f);
#pragma unroll
        for (int j = 0; j < 4; ++j) { const int c0 = j * 512 + lane * 8;
            float o8[8];
#pragma unroll
            for (int i = 0; i < 8; ++i) o8[i] = v[j * 8 + i] * rs * gg[c0 + i] + bb[c0 + i];
            if (out) { *(float4*)(out + (long)row * DM + c0) = make_float4(o8[0], o8[1], o8[2], o8[3]);
                       *(float4*)(out + (long)row * DM + c0 + 4) = make_float4(o8[4], o8[5], o8[6], o8[7]); }
            if (ob) { u32x4 pk; pk.x = pk_bf16(o8[0], o8[1]); pk.y = pk_bf16(o8[2], o8[3]); pk.z = pk_bf16(o8[4], o8[5]); pk.w = pk_bf16(o8[6], o8[7]); *(u32x4*)(ob + (long)row * DM + c0) = pk; } }
    }
}

DI void ph_mla_rms(const MP& p) {
    const int tix = tid_opaque();
    const int lane = tix & 63, gw = blockIdx.x * NWAVE + (tix >> 6), nw = gridDim.x * NWAVE;
    for (int u = gw; u < T_TOK * 2; u += nw) {
        const int row = u >> 1, which = u & 1;
        const bf16_t* src = p.hbuf + (long)row * CD_IN + which * 512 + lane * 8;
        const u32x4 y = *(const u32x4*)src;
        float v[8] = {bflo(y.x), bfhi(y.x), bflo(y.y), bfhi(y.y), bflo(y.z), bfhi(y.z), bflo(y.w), bfhi(y.w)};
        float ss = 0.f;
#pragma unroll
        for (int i = 0; i < 8; ++i) ss += v[i] * v[i];
        const float r = rsqrtf(wave_sum(ss) / 512.f + 1e-6f);
        const float* w = (which ? p.kv_norm_w : p.q_norm_w) + lane * 8;
        u32x4 o; o.x = pk_bf16(v[0] * r * w[0], v[1] * r * w[1]); o.y = pk_bf16(v[2] * r * w[2], v[3] * r * w[3]); o.z = pk_bf16(v[4] * r * w[4], v[5] * r * w[5]); o.w = pk_bf16(v[6] * r * w[6], v[7] * r * w[7]);
        *(u32x4*)(p.cqb + (long)row * 1024 + which * 512 + lane * 8) = o;
    }
}
DI void ph_rope_k(const MP& p) {
    const int tix = tid_opaque();
    const long gt = (long)blockIdx.x * NTHR + tix, gs = (long)gridDim.x * NTHR;
    for (long idx = gt; idx < (long)T_TOK * 32; idx += gs) {
        const int j = (int)(idx & 31); const int t = (int)(idx >> 5);
        const float inv = powf(10000.f, -(float)(2 * j) / 64.f);
        const float ang = (float)p.positions[t] * inv;
        const float c = cosf(ang), sn = sinf(ang);
        const bf16_t* pp = p.hbuf + (long)t * CD_IN + CD_KR;
        const float t1 = ldh(pp, j), t2 = ldh(pp, j + 32);
        { const int b = t >> 11, sq = t & 2047; const size_t tb = ((size_t)b * 64 + (sq >> 5)) * 4; const int r = sq & 31;
          p.kr[(tb + (j >> 4)) * 512 + (((j >> 3) & 1) * 32 + r) * 8 + (j & 7)] = f2bf(t1 * c - t2 * sn);
          p.kr[(tb + ((j + 32) >> 4)) * 512 + ((((j + 32) >> 3) & 1) * 32 + r) * 8 + (j & 7)] = f2bf(t1 * sn + t2 * c); }
        *(float2*)(p.rope_tab + ((long)t * 32 + j) * 2) = make_float2(c, sn);
    }
}
DI void ph_hgrn_post(const MP& p) {
    const int tix = tid_opaque();
    const int lane = tix & 63, gw = blockIdx.x * NWAVE + (tix >> 6), nw = gridDim.x * NWAVE;
    for (int t = gw; t < T_TOK; t += nw) {
#pragma unroll
        for (int j = 0; j < 4; ++j) {
            const int col = j * 512 + lane * 8;
            const float4 a = *(const float4*)(p.x3 + (long)t * 2048 + col), c = *(const float4*)(p.x3 + (long)t * 2048 + col + 4);
            float ss = a.x * a.x + a.y * a.y + a.z * a.z + a.w * a.w + c.x * c.x + c.y * c.y + c.z * c.z + c.w * c.w;
            ss += __shfl_xor(ss, 1); ss += __shfl_xor(ss, 2); ss += __shfl_xor(ss, 4); ss += __shfl_xor(ss, 8);
            const float r = rsqrtf(ss / 128.f + 1e-6f);
            const u32x4 gv = *(const u32x4*)(p.hbuf + (long)t * CD_IN + CD_HG + col);
            const float4 w0 = *(const float4*)(p.hgrn_norm_w + (col & 127)), w1 = *(const float4*)(p.hgrn_norm_w + (col & 127) + 4);
            u32x4 o;
            o.x = pk_bf16(a.x * r * w0.x * siluf_(bflo(gv.x)), a.y * r * w0.y * siluf_(bfhi(gv.x)));
            o.y = pk_bf16(a.z * r * w0.z * siluf_(bflo(gv.y)), a.w * r * w0.w * siluf_(bfhi(gv.y)));
            o.z = pk_bf16(c.x * r * w1.x * siluf_(bflo(gv.z)), c.y * r * w1.y * siluf_(bfhi(gv.z)));
            o.w = pk_bf16(c.z * r * w1.z * siluf_(bflo(gv.w)), c.w * r * w1.w * siluf_(bfhi(gv.w)));
            *(u32x4*)(p.mixb + (long)t * 4096 + 2048 + col) = o;
        }
    }
}


typedef float f32x16 __attribute__((ext_vector_type(16)));
#define MFMA32(a, b, c) __builtin_amdgcn_mfma_f32_32x32x16_bf16((a), (b), (c), 0, 0, 0)
DI bf16x8 ld8(const bf16_t* q) { return *(const bf16x8*)q; }
DI size_t lnd(size_t v) { asm volatile("" : "+v"(v)); return v; }
DI const bf16_t* launder(const bf16_t* q) { asm volatile("" : "+v"(q)); return q; }
DI bf16x8 pack8(float a0, float a1, float a2, float a3, float a4, float a5, float a6, float a7) {
    u32x4 u; u.x = pk_bf16(a0, a1); u.y = pk_bf16(a2, a3); u.z = pk_bf16(a4, a5); u.w = pk_bf16(a6, a7); return __builtin_bit_cast(bf16x8, u);
}
DI void ph_mla_attn(LAS unsigned char* lds, const MP& p) {
    const int tix = tid_opaque();
    const int w = tix >> 6, lane = tix & 63, r = lane & 31, hh = lane >> 5;
    const bf16_t* qm = (const bf16_t*)p.xbc;
    const bf16_t* kfr = (const bf16_t*)p.kvfrag;
    const bf16_t* vfr = kfr + (size_t)T_TOK * 2048;
    const float sc2 = 0.07216878364870322f * 1.4426950408889634f;
    constexpr int SLOT = 20 * 1024;
    for (int unit = blockIdx.x; unit < NB * 16 * 4; unit += gridDim.x) {
        const int pair = unit & 3, head = (unit >> 2) & 15, b = unit >> 6;
        const bf16_t* g0 = kfr + (((size_t)(b * 16 + head) * 64) * 8 + w) * 512 + lane * 8;
        const bf16_t* g1 = (w < 4) ? p.kr + (((size_t)b * 64) * 4 + w) * 512 + lane * 8
                                   : vfr + (((size_t)(b * 16 + head) * 64) * 8 + (w - 4)) * 512 + lane * 8;
        const size_t g1step = (w < 4) ? 2048 : 4096;
        const bf16_t* g2 = vfr + (((size_t)(b * 16 + head) * 64) * 8 + 4 + (w & 3)) * 512 + lane * 8;
        const unsigned l0 = (unsigned)w * 1024u, l1 = (unsigned)(8 + w) * 1024u, l2 = (unsigned)(16 + (w & 3)) * 1024u;
#define MLA_DMA(kt_, slot_) do { LAS unsigned char* sb_ = lds + (slot_) * SLOT; \
        __builtin_amdgcn_global_load_lds((const unsigned*)(g0 + (size_t)(kt_) * 4096), (LAS unsigned*)(sb_ + l0), 16, 0, 0); \
        __builtin_amdgcn_global_load_lds((const unsigned*)(g1 + (size_t)(kt_) * g1step), (LAS unsigned*)(sb_ + l1), 16, 0, 0); \
        __builtin_amdgcn_global_load_lds((const unsigned*)(g2 + (size_t)(kt_) * 4096), (LAS unsigned*)(sb_ + l2), 16, 0, 0); } while (0)
        for (int half = 0; half < 2; ++half) {
            const int qb = half ? 7 - pair : pair;
            const int row0 = qb * 256 + 32 * w;
            const long tq = (long)b * SEQ + row0 + r;
            bf16x8 qf[12];
#pragma unroll
            for (int st = 0; st < 12; ++st) qf[st] = ld8(qm + tq * 3072 + head * 192 + 16 * st + 8 * hh);
#pragma unroll
            for (int g2i = 0; g2i < 2; ++g2i) {
                float o1[8], o2[8];
#pragma unroll
                for (int j = 0; j < 8; ++j) {
                    const float2 cs = *(const float2*)(p.rope_tab + (tq * 32 + 16 * g2i + 8 * hh + j) * 2);
                    const float t1 = bf2f((bf16_t)qf[8 + g2i][j]), t2 = bf2f((bf16_t)qf[10 + g2i][j]);
                    o1[j] = t1 * cs.x - t2 * cs.y; o2[j] = t1 * cs.y + t2 * cs.x;
                }
                qf[8 + g2i] = pack8(o1[0], o1[1], o1[2], o1[3], o1[4], o1[5], o1[6], o1[7]);
                qf[10 + g2i] = pack8(o2[0], o2[1], o2[2], o2[3], o2[4], o2[5], o2[6], o2[7]);
            }
            f32x16 O[4];
#pragma unroll
            for (int dt = 0; dt < 4; ++dt)
#pragma unroll
                for (int i = 0; i < 16; ++i) O[dt][i] = 0.f;
            float m = -INFINITY, l = 0.f;
            const int ktd = row0 >> 5;
            const int nt = qb * 8 + 8;
            asm volatile("s_waitcnt vmcnt(0)" ::: "memory");
            __syncthreads();
            MLA_DMA(0, 0); MLA_DMA(1, 1);
            for (int kt = 0; kt < nt; ++kt) {
                asm volatile("s_waitcnt vmcnt(3)" ::: "memory");
                __builtin_amdgcn_s_barrier();
                { const int kn2 = (kt + 2 < nt) ? kt + 2 : kt; MLA_DMA(kn2, (kt + 2) % 3); }
                if (kt <= ktd) {
                    const LAS unsigned char* sb = lds + (kt % 3) * SLOT + lane * 16;
                    bf16x8 kfr[12];
#pragma unroll
                    for (int st = 0; st < 12; ++st) kfr[st] = *(const LAS bf16x8*)(sb + st * 1024);
                    __builtin_amdgcn_sched_barrier(0);
                    f32x16 S, S2;
#pragma unroll
                    for (int i = 0; i < 16; ++i) { S[i] = 0.f; S2[i] = 0.f; }
#pragma unroll
                    for (int st = 0; st < 12; st += 2) { S = MFMA32(kfr[st], qf[st], S); S2 = MFMA32(kfr[st + 1], qf[st + 1], S2); }
                    bf16x8 vfr[8];
#pragma unroll
                    for (int f = 0; f < 8; ++f) vfr[f] = *(const LAS bf16x8*)(sb + (12 + f) * 1024);
                    __builtin_amdgcn_sched_barrier(0);
#pragma unroll
                    for (int i = 0; i < 16; ++i) S[i] += S2[i];
                    if (kt == ktd) {
#pragma unroll
                        for (int i = 0; i < 16; ++i) if (((i & 3) + 8 * (i >> 2) + 4 * hh) > r) S[i] = -INFINITY;
                    }
                    float mx = S[0];
#pragma unroll
                    for (int i = 1; i < 16; ++i) mx = fmaxf(mx, S[i]);
                    if (__any((mx - m) * sc2 > 24.f)) {
                        const float cm = fmaxf(mx, __shfl_xor(mx, 32));
                        const float mn = fmaxf(m, cm);
                        const float alpha = (m == -INFINITY) ? 0.f : __builtin_amdgcn_exp2f((m - mn) * sc2);
                        l *= alpha;
#pragma unroll
                        for (int dt = 0; dt < 4; ++dt)
#pragma unroll
                            for (int i = 0; i < 16; ++i) O[dt][i] *= alpha;
                        m = mn;
                    }
#pragma unroll
                    for (int i = 0; i < 16; ++i) { S[i] = __builtin_amdgcn_exp2f((S[i] - m) * sc2); l += S[i]; }
                    const bf16x8 pf0 = pack8(S[0], S[1], S[2], S[3], S[4], S[5], S[6], S[7]);
                    const bf16x8 pf1 = pack8(S[8], S[9], S[10], S[11], S[12], S[13], S[14], S[15]);
#pragma unroll
                    for (int dt = 0; dt < 4; ++dt) O[dt] = MFMA32(vfr[dt * 2], pf0, O[dt]);
#pragma unroll
                    for (int dt = 0; dt < 4; ++dt) O[dt] = MFMA32(vfr[dt * 2 + 1], pf1, O[dt]);
                }
            }
            asm volatile("s_waitcnt vmcnt(0)" ::: "memory");
            l += __shfl_xor(l, 32);
            const float il = 1.f / l;
            bf16_t* orow = p.mixb + tq * 4096 + head * 128;
#pragma unroll
            for (int dt = 0; dt < 4; ++dt)
#pragma unroll
                for (int i4 = 0; i4 < 4; ++i4) {
                    u32x2 o; o.x = pk_bf16(O[dt][i4 * 4 + 0] * il, O[dt][i4 * 4 + 1] * il); o.y = pk_bf16(O[dt][i4 * 4 + 2] * il, O[dt][i4 * 4 + 3] * il);
                    *(u32x2*)(orow + 32 * dt + 8 * i4 + 4 * hh) = o;
                }
        }
#undef MLA_DMA
    }
    __syncthreads();
}

DI void ph_cmp_bias(const MP& p) {
    const int tix = tid_opaque();
    const int e = tix & 127, sub = tix >> 7;
    for (int u = blockIdx.x; u < 64; u += gridDim.x) {
        const int which = u >> 5, l = u & 31;
        const float* pp = p.cmp_pos + ((size_t)which * 32 + l) * 128;
        const float* ww = p.cmp_w + ((size_t)which * 4096 + (size_t)l * 128) * 128;
        float a = 0.f;
        for (int d = sub * 32; d < sub * 32 + 32; ++d) a += pp[d] * ww[(size_t)d * 128 + e];
        p.cpart[(((size_t)which * 32 + l) * 4 + sub) * 128 + e] = a;
    }
}

#define MFMA16(a, b, c) __builtin_amdgcn_mfma_f32_16x16x32_bf16((a), (b), (c), 0, 0, 0)
constexpr int NSA_ACC_STRIDE = 132;
constexpr int NSA_ACC_WAVE = 32 * NSA_ACC_STRIDE;
template <int BR = 7> DI void ph_nsa_attn(LAS unsigned char* lds, const MP& p) {
    const int tix = tid_opaque();
    const int w = tix >> 6, lane = tix & 63, r = lane & 31, hh = lane >> 5, c16 = lane & 15, kg = lane >> 4;
    LAS float* acc = (LAS float*)lds + w * NSA_ACC_WAVE;
    const bf16_t* hb = p.hbuf;
    const float c2 = 0.08838834764831845f * 1.4426950408889634f;
    for (int unit = blockIdx.x; unit < NB * 2 * 32; unit += gridDim.x) {
        const int bg = unit & 15, qb = unit >> 4, b = bg >> 1, g = bg & 1;
        for (int sub = 0; sub < 2; ++sub) {
            const int s0 = qb * 64 + __builtin_amdgcn_readfirstlane(w) * 8 + sub * 4;
            unsigned selp0 = 0u, selp1 = 0u;
            if constexpr ((BR & 1) != 0) {
                const int lz = tid_opaque(); const int r = lz & 31, hh = (lz >> 5) & 1; LAS float* acc = (LAS float*)lds + (lz >> 6) * NSA_ACC_WAVE;
                const int sq = s0 + (r >> 3), head = r & 7;
                const long tq = (long)b * SEQ + sq;
                const float g0 = sigmoidf_(ldh(hb + tq * AB_IN + AB_G + (g * 8 + head) * 3, 0));
                bf16x8 qf[8];
#pragma unroll
                for (int st = 0; st < 8; ++st) qf[st] = ld8(hb + tq * AB_IN + AB_Q + (g * 8 + head) * 128 + 16 * st + 8 * hh);
                const int nv_lane = sq >= 31 ? (sq - 31) / 16 + 1 : 0;
                const int nv_max = (s0 + 3 >= 31) ? (s0 + 3 - 31) / 16 + 1 : 0;
                const int nkt = (nv_max + 31) >> 5;
                float m = -INFINITY, l = 0.f;
                for (int kt = 0; kt < nkt; ++kt) {
                    const bf16_t* kp = p.kcb + lnd(((size_t)(bg * 128 + 32 * kt + r)) * 128 + 8 * hh);
                    bf16x8 kf[8];
#pragma unroll
                    for (int st = 0; st < 8; ++st) kf[st] = ld8(kp + 16 * st);
                    __builtin_amdgcn_sched_barrier(0);
                    f32x16 S;
#pragma unroll
                    for (int i = 0; i < 16; ++i) S[i] = 0.f;
#pragma unroll
                    for (int st = 0; st < 8; ++st) S = MFMA32(kf[st], qf[st], S);
                    float mx = -INFINITY;
#pragma unroll
                    for (int i = 0; i < 16; ++i) { const int key = 32 * kt + (i & 3) + 8 * (i >> 2) + 4 * hh; if (key >= nv_lane) S[i] = -INFINITY; mx = fmaxf(mx, S[i]); }
                    mx = fmaxf(mx, __shfl_xor(mx, 32));
                    const float mn = fmaxf(m, mx);
                    const float mm = (mn == -INFINITY) ? 0.f : mn;
                    float rs = 0.f;
#pragma unroll
                    for (int i = 0; i < 16; ++i) rs += __builtin_amdgcn_exp2f((S[i] - mm) * c2);
                    rs += __shfl_xor(rs, 32);
                    l = l * __builtin_amdgcn_exp2f((m - mm) * c2) + rs;
                    m = mn;
                }
                const float mm = (m == -INFINITY) ? 0.f : m;
                const float il = l > 0.f ? 1.f / l : 0.f;
                float A[16];
                float prev_same = 0.f;
                f32x16 O[4];
#pragma unroll
                for (int dt = 0; dt < 4; ++dt)
#pragma unroll
                    for (int i = 0; i < 16; ++i) O[dt][i] = 0.f;
#pragma unroll
                for (int kt = 0; kt < 4; ++kt) {
                    if (kt < nkt) {
                        f32x16 S;
#pragma unroll
                        for (int i = 0; i < 16; ++i) S[i] = 0.f;
                        const bf16_t* kp = p.kcb + lnd(((size_t)(bg * 128 + 32 * kt + r)) * 128 + 8 * hh);
                        const bf16_t* vp = p.vcT + lnd(((size_t)(bg * 128 + r)) * 128 + 32 * kt + 8 * hh);
                        bf16x8 kf[8], vf[4];
#pragma unroll
                        for (int st = 0; st < 8; ++st) kf[st] = ld8(kp + 16 * st);
                        __builtin_amdgcn_sched_barrier(0);
#pragma unroll
                        for (int st = 0; st < 8; ++st) S = MFMA32(kf[st], qf[st], S);
                        __builtin_amdgcn_sched_barrier(0);
#pragma unroll
                        for (int dt = 0; dt < 2; ++dt) { vf[2 * dt] = ld8(vp + (size_t)(32 * dt) * 128); vf[2 * dt + 1] = ld8(vp + (size_t)(32 * dt) * 128 + 16); }
                        __builtin_amdgcn_sched_barrier(0);
#pragma unroll
                        for (int i = 0; i < 16; ++i) { const int key = 32 * kt + (i & 3) + 8 * (i >> 2) + 4 * hh; S[i] = (key < nv_lane) ? __builtin_amdgcn_exp2f((S[i] - mm) * c2) * il : 0.f; }
#pragma unroll
                        for (int c4 = 0; c4 < 4; ++c4) { const int i = 4 * c4;
                            const float part = S[i] + S[i + 1] + S[i + 2] + 0.5f * S[i + 3], car = 0.5f * S[i + 3];
                            const float same = __shfl_xor(car, 32);
                            float av = part + (hh ? same : prev_same); prev_same = same;
                            av += __shfl_xor(av, 1); av += __shfl_xor(av, 2); av += __shfl_xor(av, 4);
                            A[4 * kt + c4] = av; }
                        const bf16x8 pf0 = pack8(S[0], S[1], S[2], S[3], S[4], S[5], S[6], S[7]);
                        const bf16x8 pf1 = pack8(S[8], S[9], S[10], S[11], S[12], S[13], S[14], S[15]);
#pragma unroll
                        for (int dt = 0; dt < 2; ++dt) { O[dt] = MFMA32(vf[2 * dt], pf0, O[dt]); O[dt] = MFMA32(vf[2 * dt + 1], pf1, O[dt]); }
                        __builtin_amdgcn_sched_barrier(0);
#pragma unroll
                        for (int dt = 2; dt < 4; ++dt) { vf[2 * dt - 4] = ld8(vp + (size_t)(32 * dt) * 128); vf[2 * dt - 3] = ld8(vp + (size_t)(32 * dt) * 128 + 16); }
                        __builtin_amdgcn_sched_barrier(0);
#pragma unroll
                        for (int dt = 2; dt < 4; ++dt) { O[dt] = MFMA32(vf[2 * dt - 4], pf0, O[dt]); O[dt] = MFMA32(vf[2 * dt - 3], pf1, O[dt]); }
                    } else {
#pragma unroll
                        for (int c4 = 0; c4 < 4; ++c4) { float av = hh ? 0.f : prev_same; prev_same = 0.f; av += __shfl_xor(av, 1); av += __shfl_xor(av, 2); av += __shfl_xor(av, 4); A[4 * kt + c4] = av; }
                    }
                    __builtin_amdgcn_sched_barrier(0);
                }
#pragma unroll
                for (int dt = 0; dt < 4; ++dt)
#pragma unroll
                    for (int i4 = 0; i4 < 4; ++i4) { f32x4 o4; o4[0] = g0 * O[dt][4 * i4]; o4[1] = g0 * O[dt][4 * i4 + 1]; o4[2] = g0 * O[dt][4 * i4 + 2]; o4[3] = g0 * O[dt][4 * i4 + 3];
                        *(LAS f32x4*)(acc + r * NSA_ACC_STRIDE + 32 * dt + 8 * i4 + 4 * hh) = o4; }
                __builtin_amdgcn_sched_barrier(0);
                const int cur = sq >> 6;
#pragma unroll
                for (int q = 0; q < 16; ++q) { const int j = 2 * q + hh; const bool forced = (j == 0) || (j == cur) || (j == cur - 1); A[q] = forced ? 1.0e6f : (j <= cur ? A[q] : -1.0f); }
#pragma unroll
                for (int n = 0; n < 8; ++n) {
                    float bv = A[0]; int bj = hh;
#pragma unroll
                    for (int q = 1; q < 16; ++q) { if (A[q] > bv) { bv = A[q]; bj = 2 * q + hh; } }
                    const float ov = __shfl_xor(bv, 32); const int oj = __shfl_xor(bj, 32);
                    const bool take_other = (ov > bv) || (ov == bv && oj < bj);
                    const int wj = take_other ? oj : bj;
                    if (n < 4) selp0 |= (unsigned)wj << (8 * n); else selp1 |= (unsigned)wj << (8 * (n - 4));
#pragma unroll
                    for (int q = 0; q < 16; ++q) if (2 * q + hh == wj) A[q] = -INFINITY;
                }
            }
            __builtin_amdgcn_sched_barrier(0);
            if constexpr ((BR & 2) != 0) {
                const int lz = tid_opaque(); const int r = lz & 31, hh = (lz >> 5) & 1; LAS float* acc = (LAS float*)lds + (lz >> 6) * NSA_ACC_WAVE;
                const int sq = s0 + (r >> 3), head = r & 7;
                const long tq = (long)b * SEQ + sq;
                bf16x8 qw[8];
                { const bf16_t* qp = hb + lnd((size_t)tq * AB_IN + AB_Q + (g * 8 + head) * 128 + 8 * hh);
#pragma unroll
                  for (int st = 0; st < 8; ++st) qw[st] = ld8(qp + 16 * st); }
                f32x16 O[4];
#pragma unroll
                for (int dt = 0; dt < 4; ++dt)
#pragma unroll
                    for (int i = 0; i < 16; ++i) O[dt][i] = 0.f;
                float m = -INFINITY, l = 0.f;
                const int klo = s0 - 511 > 0 ? s0 - 511 : 0;
                const int kt_lo = klo >> 5, kt_hi = (s0 + 3) >> 5;
                for (int kt = kt_lo; kt <= kt_hi; ++kt) {
                    const size_t fo = lnd((((size_t)bg * 64 + kt) * 8 * 64 + (lz & 63)) * 8);
                    const bf16_t* kp = p.kwf + fo; const bf16_t* vb = p.vwinT + fo;
                    bf16x8 kf[8], vf[8];
#pragma unroll
                    for (int st = 0; st < 8; ++st) kf[st] = ld8(kp + st * 512);
                    __builtin_amdgcn_sched_barrier(0);
                    f32x16 S;
#pragma unroll
                    for (int i = 0; i < 16; ++i) S[i] = 0.f;
#pragma unroll
                    for (int st = 0; st < 8; ++st) S = MFMA32(kf[st], qw[st], S);
                    __builtin_amdgcn_sched_barrier(0);
#pragma unroll
                    for (int f = 0; f < 8; ++f) vf[f] = ld8(vb + f * 512);
                    __builtin_amdgcn_sched_barrier(0);
#pragma unroll
                    for (int i = 0; i < 16; ++i) { const int key = 32 * kt + (i & 3) + 8 * (i >> 2) + 4 * hh; if (key > sq || key <= sq - 512) S[i] = -INFINITY; }
                    float mx = S[0];
#pragma unroll
                    for (int i = 1; i < 16; ++i) mx = fmaxf(mx, S[i]);
                    if (__any((mx - m) * c2 > 24.f)) {
                        const float cm = fmaxf(mx, __shfl_xor(mx, 32));
                        const float mn = fmaxf(m, cm);
                        const float alpha = (m == -INFINITY) ? 0.f : __builtin_amdgcn_exp2f((m - mn) * c2);
                        l *= alpha;
#pragma unroll
                        for (int dt = 0; dt < 4; ++dt)
#pragma unroll
                            for (int i = 0; i < 16; ++i) O[dt][i] *= alpha;
                        m = mn;
                    }
                    const float mr = (m == -INFINITY) ? 0.f : m;
#pragma unroll
                    for (int i = 0; i < 16; ++i) { S[i] = __builtin_amdgcn_exp2f((S[i] - mr) * c2); l += S[i]; }
                    const bf16x8 pf0 = pack8(S[0], S[1], S[2], S[3], S[4], S[5], S[6], S[7]);
                    const bf16x8 pf1 = pack8(S[8], S[9], S[10], S[11], S[12], S[13], S[14], S[15]);
#pragma unroll
                    for (int dt = 0; dt < 4; ++dt) { O[dt] = MFMA32(vf[dt * 2], pf0, O[dt]); O[dt] = MFMA32(vf[dt * 2 + 1], pf1, O[dt]); }
                }
                l += __shfl_xor(l, 32);
                const float sc = sigmoidf_(ldh(hb + tq * AB_IN + AB_G + (g * 8 + head) * 3, 2)) / l;
#pragma unroll
                for (int dt = 0; dt < 4; ++dt)
#pragma unroll
                    for (int i4 = 0; i4 < 4; ++i4) { LAS f32x4* ap = (LAS f32x4*)(acc + r * NSA_ACC_STRIDE + 32 * dt + 8 * i4 + 4 * hh); f32x4 o4 = *ap;
                        o4[0] += sc * O[dt][4 * i4]; o4[1] += sc * O[dt][4 * i4 + 1]; o4[2] += sc * O[dt][4 * i4 + 2]; o4[3] += sc * O[dt][4 * i4 + 3]; *ap = o4; }
            }
            __builtin_amdgcn_sched_barrier(0); asm volatile("" ::: "memory");
            if constexpr ((BR & 4) != 0)
#pragma unroll 1
            for (int pr = 0; pr < 2; ++pr) {
                const int lz = tid_opaque(); const int c16 = lz & 15, kg = (lz >> 4) & 3; LAS float* acc = (LAS float*)lds + (lz >> 6) * NSA_ACC_WAVE;
                const bf16_t* kbase = p.ksf + (((size_t)bg * 128) * 4 * 64 + (lz & 63)) * 8;
                const bf16_t* vbase = p.vselT + (((size_t)bg * 64) * 8 * 64 + (lz & 63)) * 8;
                const int cur = qb;
#define NSA_KEY0(it_) ((int)((((it_) < 8 ? sp0 : sp1) >> (8 * (((it_) >> 1) & 3))) & 0xffu) * 64 + 32 * ((it_) & 1))
#define NSA_LOADK(it_) do { const int k0_ = NSA_KEY0(it_); const bf16_t* kp_ = kbase + (size_t)(k0_ >> 4) * 2048; \
        _Pragma("unroll") for (int st = 0; st < 4; ++st) { kR[st] = ld8(kp_ + st * 512); kR[4 + st] = ld8(kp_ + 2048 + st * 512); } } while (0)
#define NSA_LOADV(it_) do { const int k0_ = NSA_KEY0(it_); const bf16_t* vp_ = vbase + (size_t)(k0_ >> 5) * 4096; \
        _Pragma("unroll") for (int dt = 0; dt < 8; ++dt) vR[dt] = ld8(vp_ + dt * 512); } while (0)
#define NSA_SOFTMAX_PV(SQL_, SQMIN_, O_, M_, L_) do { \
                        if (key0 + 31 > (SQMIN_)) { \
                            _Pragma("unroll") for (int i = 0; i < 4; ++i) { if (key0 + 4 * kg + i > (SQL_)) Sa[i] = -INFINITY; if (key0 + 16 + 4 * kg + i > (SQL_)) Sb[i] = -INFINITY; } \
                        } \
                        const float mx = fmaxf(fmaxf(fmaxf(Sa[0], Sa[1]), fmaxf(Sa[2], Sa[3])), fmaxf(fmaxf(Sb[0], Sb[1]), fmaxf(Sb[2], Sb[3]))); \
                        if (__any((mx - M_) * c2 > 24.f)) { \
                            float cm = fmaxf(mx, __shfl_xor(mx, 16)); cm = fmaxf(cm, __shfl_xor(cm, 32)); \
                            const float mn = fmaxf(M_, cm); \
                            const float alpha = (M_ == -INFINITY) ? 0.f : __builtin_amdgcn_exp2f((M_ - mn) * c2); \
                            L_ *= alpha; \
                            _Pragma("unroll") for (int dt = 0; dt < 8; ++dt) O_[dt] *= alpha; \
                            M_ = mn; \
                        } \
                        const float mr_ = (M_ == -INFINITY) ? 0.f : -M_ * c2; \
                        float pa[4], pb[4]; \
                        _Pragma("unroll") for (int i = 0; i < 4; ++i) { pa[i] = __builtin_amdgcn_exp2f(__builtin_fmaf(Sa[i], c2, mr_)); pb[i] = __builtin_amdgcn_exp2f(__builtin_fmaf(Sb[i], c2, mr_)); L_ += pa[i] + pb[i]; } \
                        const bf16x8 pf = pack8(pa[0], pa[1], pa[2], pa[3], pb[0], pb[1], pb[2], pb[3]); \
                        _Pragma("unroll") for (int dt = 0; dt < 8; ++dt) O_[dt] = MFMA16(vR[dt], pf, O_[dt]); \
                    } while (0)
#define NSA_CHUNKS(SQL_, SQMIN_, Q_, O_, M_, L_) do { \
                    bf16x8 kR[8], vR[8]; \
                    int it = vmask ? (__builtin_ctz(vmask)) : 16; \
                    { const int i0_ = it < 16 ? it : 0; NSA_LOADK(i0_); NSA_LOADV(i0_); } \
                    if (it < 16) { \
                        f32x4 Sa, Sb; int key0; \
                        __builtin_amdgcn_s_waitcnt(0x0F70);      \
                        for (;;) { \
                            const unsigned rem = (it < 15) ? (vmask >> (it + 1)) : 0u; \
                            const int nx = rem ? it + 1 + __builtin_ctz(rem) : 16; \
                            key0 = NSA_KEY0(it); \
                            Sa = (f32x4){0.f, 0.f, 0.f, 0.f}; Sb = (f32x4){0.f, 0.f, 0.f, 0.f}; \
                            _Pragma("unroll") for (int st = 0; st < 4; ++st) { Sa = MFMA16(kR[st], Q_[st], Sa); Sb = MFMA16(kR[4 + st], Q_[st], Sb); } \
                            __builtin_amdgcn_sched_barrier(0); \
                            if (nx >= 16) break; \
                            NSA_LOADK(nx); \
                            __builtin_amdgcn_sched_barrier(0); \
                            NSA_SOFTMAX_PV(SQL_, SQMIN_, O_, M_, L_); \
                            __builtin_amdgcn_sched_barrier(0); \
                            NSA_LOADV(nx); \
                            it = nx; \
                        } \
                        NSA_SOFTMAX_PV(SQL_, SQMIN_, O_, M_, L_); \
                    } } while (0)
                f32x4 O1[8];
#pragma unroll
                for (int dt = 0; dt < 8; ++dt) O1[dt] = (f32x4){0.f, 0.f, 0.f, 0.f};
                float m1 = -INFINITY, l1 = 0.f;
                {
                    const int sqL = s0 + 2 * pr + (c16 >> 3);
                    const long tqL = (long)b * SEQ + sqL;
                    bf16x8 qP[4];
#pragma unroll
                    for (int st = 0; st < 4; ++st) qP[st] = ld8(hb + tqL * AB_IN + AB_Q + (g * 8 + (c16 & 7)) * 128 + 32 * st + 8 * kg);
                    const int sqmax = s0 + 2 * pr + 1;
                    const unsigned sp0 = cur >= 2 ? (((unsigned)(cur - 1) << 8) | ((unsigned)cur << 16)) : (cur == 1 ? (1u << 8) : 0u), sp1 = 0u;
                    const int nf = cur >= 2 ? 3 : cur + 1;
                    unsigned vmask = 0u;
#pragma unroll
                    for (int n = 0; n < 3; ++n) { const int jb = (int)((sp0 >> (8 * n)) & 0xffu); if (n < nf) { if (jb * 64 <= sqmax) vmask |= 1u << (2 * n); if (jb * 64 + 32 <= sqmax) vmask |= 2u << (2 * n); } }
                    NSA_CHUNKS(sqL, s0 + 2 * pr, qP, O1, m1, l1);
                }
                __builtin_amdgcn_sched_barrier(0);
#pragma unroll 1
                for (int qi = 0; qi < 2; ++qi) {
                    const int ql = 2 * pr + qi;
                    const int sq2 = s0 + ql; const long tq2 = (long)b * SEQ + sq2;
                    bf16x8 q16[4];
#pragma unroll
                    for (int st = 0; st < 4; ++st) q16[st] = ld8(hb + tq2 * AB_IN + AB_Q + (g * 8 + (c16 & 7)) * 128 + 32 * st + 8 * kg);
                    const float g1q = sigmoidf_(ldh(hb + tq2 * AB_IN + AB_G + (g * 8 + (c16 & 7)) * 3, 1));
                    f32x4 O16[8];
#pragma unroll
                    for (int dt = 0; dt < 8; ++dt) O16[dt] = (f32x4){0.f, 0.f, 0.f, 0.f};
                    const int src = (lz & 0x37) | (qi << 3);
                    const float m0 = __shfl(m1, src);
                    float m = m0, l = __shfl(l1, src);
                    const unsigned sp0 = (unsigned)__builtin_amdgcn_readfirstlane(__shfl((int)selp0, ql * 8)), sp1 = (unsigned)__builtin_amdgcn_readfirstlane(__shfl((int)selp1, ql * 8));
                    unsigned vmask = 0u;
#pragma unroll
                    for (int n = 0; n < 8; ++n) { const int jb = (int)(((n < 4 ? sp0 : sp1) >> (8 * (n & 3))) & 0xffu);
                        const bool forced = (jb == 0) || (jb == cur) || (jb == cur - 1);
                        if (!forced) { if (jb * 64 <= sq2) vmask |= 1u << (2 * n); if (jb * 64 + 32 <= sq2) vmask |= 2u << (2 * n); } }
                    NSA_CHUNKS(sq2, sq2, q16, O16, m, l);
                    l += __shfl_xor(l, 16); l += __shfl_xor(l, 32);
                    const float sc = g1q / l;
                    const float f1 = sc * __builtin_amdgcn_exp2f((m0 - m) * c2);
                    if ((c16 >> 3) == qi) {
#pragma unroll
                        for (int dt = 0; dt < 8; ++dt) { LAS f32x4* ap = (LAS f32x4*)(acc + (ql * 8 + (c16 & 7)) * NSA_ACC_STRIDE + 16 * dt + 4 * kg); f32x4 o4 = *ap;
                            o4[0] += sc * O16[dt][0] + f1 * O1[dt][0]; o4[1] += sc * O16[dt][1] + f1 * O1[dt][1]; o4[2] += sc * O16[dt][2] + f1 * O1[dt][2]; o4[3] += sc * O16[dt][3] + f1 * O1[dt][3]; *ap = o4; }
                    }
                }
#undef NSA_CHUNKS
#undef NSA_SOFTMAX_PV
#undef NSA_LOADK
#undef NSA_LOADV
#undef NSA_KEY0
            }
            asm volatile("s_waitcnt lgkmcnt(0)" ::: "memory");
            {
                const int lz = tid_opaque(); const int lane = lz & 63; LAS float* acc = (LAS float*)lds + (lz >> 6) * NSA_ACC_WAVE;
                const int row = lane >> 1, dh = (lane & 1) * 64;
                const long tt = (long)b * SEQ + s0 + (row >> 3);
                bf16_t* op = p.mixb + tt * 4096 + 2048 + (g * 8 + (row & 7)) * 128 + dh;
#pragma unroll
                for (int k8 = 0; k8 < 8; ++k8) {
                    const f32x4 a = *(const LAS f32x4*)(acc + row * NSA_ACC_STRIDE + dh + 8 * k8), c = *(const LAS f32x4*)(acc + row * NSA_ACC_STRIDE + dh + 8 * k8 + 4);
                    u32x4 o; o.x = pk_bf16(a[0], a[1]); o.y = pk_bf16(a[2], a[3]); o.z = pk_bf16(c[0], c[1]); o.w = pk_bf16(c[2], c[3]);
                    *(u32x4*)(op + 8 * k8) = o;
                }
            }
            asm volatile("s_waitcnt lgkmcnt(0)" ::: "memory");
        }
    }
}

DI void ph_conv_ssd(LAS unsigned char* lds, const MP& p) {
    const int tix = tid_opaque();
    LAS bf16_t* tile = (LAS bf16_t*)lds;
    const int tok = tix >> 3, c8 = (tix & 7) * 8;
    bf16_t* xT = (bf16_t*)p.xbc; bf16_t* BT = xT + (size_t)NB * 2048 * 2048; bf16_t* bcr = BT + (size_t)NB * 512 * 2048;
    const int cskip = (gridDim.x >= 64) ? 16 : 0;
    if ((int)blockIdx.x < cskip) return;
    for (int u = blockIdx.x - cskip; u < NB * 32 * 48; u += gridDim.x - cskip) {
        const int ct = u % 48, tt = (u / 48) & 31, b = u / (48 * 32);
        const int c0 = ct * 64, s = tt * 64 + tok; const long t = (long)b * SEQ + s;
        float a[8];
        { const float4 b0 = *(const float4*)(p.conv_b + c0 + c8), b1 = *(const float4*)(p.conv_b + c0 + c8 + 4); a[0] = b0.x; a[1] = b0.y; a[2] = b0.z; a[3] = b0.w; a[4] = b1.x; a[5] = b1.y; a[6] = b1.z; a[7] = b1.w; }
#pragma unroll
        for (int k = 0; k < 4; ++k) {
            if (s - 3 + k >= 0) {
                const u32x4 hv = *(const u32x4*)(p.hbuf + (t - 3 + k) * AB_IN + AB_XBC + c0 + c8);
                const float4 w0 = *(const float4*)(p.conv_w + k * 3072 + c0 + c8), w1 = *(const float4*)(p.conv_w + k * 3072 + c0 + c8 + 4);
                a[0] += w0.x * bflo(hv.x); a[1] += w0.y * bfhi(hv.x); a[2] += w0.z * bflo(hv.y); a[3] += w0.w * bfhi(hv.y);
                a[4] += w1.x * bflo(hv.z); a[5] += w1.y * bfhi(hv.z); a[6] += w1.z * bflo(hv.w); a[7] += w1.w * bfhi(hv.w);
            }
        }
#pragma unroll
        for (int e = 0; e < 8; ++e) a[e] = siluf_(a[e]);
        if (ct >= 32) { u32x4 o; o.x = pk_bf16(a[0], a[1]); o.y = pk_bf16(a[2], a[3]); o.z = pk_bf16(a[4], a[5]); o.w = pk_bf16(a[6], a[7]); *(u32x4*)(bcr + t * 1024 + (c0 - 2048) + c8) = o; }
        if (ct < 40) {
#pragma unroll
            for (int e = 0; e < 8; ++e) tile[(c8 + e) * 72 + tok] = f2bf(a[e]);
        }
        __syncthreads();
        if (ct < 40) {
            const int ch = tix >> 3, tg = tix & 7;
            const u32x4 v = *(const LAS u32x4*)(tile + ch * 72 + 8 * tg);
            const int c = c0 + ch;
            bf16_t* dst = (ct < 32) ? xT + ((size_t)b * 2048 + c) * 2048 : BT + ((size_t)b * 512 + (c - 2048)) * 2048;
            const int pos = tt * 64 + 16 * (tg >> 1) + 4 * (tg & 1);
            u32x2 lo; lo.x = v.x; lo.y = v.y; u32x2 hi; hi.x = v.z; hi.y = v.w;
            *(u32x2*)(dst + pos) = lo; *(u32x2*)(dst + pos + 8) = hi;
        }
        __syncthreads();
    }
}

DI void ph_ssd_chunk(LAS unsigned char* lds, const MP& p) {
    const int tix = tid_opaque();
    const int w = tix >> 6, lane = tix & 63, r = lane & 31, hh = lane >> 5, pt = w >> 2, lt = w & 3;
    LAS bf16_t* S_base = (LAS bf16_t*)lds;
    LAS float* acs_all = (LAS float*)(lds + 2 * 64 * 136 * 2);
    LAS float* dts_all = acs_all + 2048;
    LAS float* wl_all = dts_all + 2048;
    const bf16_t* xT = (const bf16_t*)p.xbc; const bf16_t* BT = xT + (size_t)NB * 2048 * 2048; const bf16_t* bcr = BT + (size_t)NB * 512 * 2048;
    const float L2E = 1.4426950408889634f;
    for (int unit = blockIdx.x; unit < NB * 32; unit += gridDim.x) {
        const int b = unit >> 5, h = unit & 31, g = h >> 3;
        const float a = -__expf(p.a_log[h]), dbias = p.dt_bias[h], dskip = p.ssm_d[h];
        f32x16 S;
#pragma unroll
        for (int i = 0; i < 16; ++i) S[i] = 0.f;
        __syncthreads();
#pragma unroll
        for (int cc = 0; cc < 2; ++cc) {
            const int c = 2 * w + cc; const long t0 = (long)b * SEQ + c * 128;
            const float d0 = softplusf_(ldh(p.hbuf, (t0 + 2 * lane) * AB_IN + AB_DT + h) + dbias), d1 = softplusf_(ldh(p.hbuf, (t0 + 2 * lane + 1) * AB_IN + AB_DT + h) + dbias);
            const float a0 = d0 * a, a1 = d1 * a;
            float run = a0 + a1;
#pragma unroll
            for (int o = 1; o < 64; o <<= 1) { const float v = __shfl_up(run, o); if (lane >= o) run += v; }
            const float tot = __shfl(run, 63);
            const float cs1 = run, cs0 = run - a1;
            acs_all[c * 128 + 2 * lane] = cs0; acs_all[c * 128 + 2 * lane + 1] = cs1; dts_all[c * 128 + 2 * lane] = d0; dts_all[c * 128 + 2 * lane + 1] = d1;
            wl_all[c * 128 + 2 * lane] = d0 * __expf(tot - cs0); wl_all[c * 128 + 2 * lane + 1] = d1 * __expf(tot - cs1);
        }
        for (int c = 0; c < 16; ++c) {
            const long t0 = (long)b * SEQ + c * 128;
            LAS bf16_t* S_lds = S_base + (c & 1) * (64 * 136);
            const LAS float* acs = acs_all + c * 128; const LAS float* dts = dts_all + c * 128; const LAS float* wl = wl_all + c * 128;
#pragma unroll
            for (int i = 0; i < 16; ++i) S_lds[(32 * pt + (i & 3) + 8 * (i >> 2) + 4 * hh) * 136 + 32 * lt + r] = f2bf(S[i]);
            __syncthreads();
            const float acl = acs[32 * lt + r];
            bf16x8 cf[8], xs[8], bs[8];
            u32x2 zv[4];
            {
                const bf16_t* cp = bcr + lnd((size_t)(t0 + 32 * lt + r) * 1024 + 512 + g * 128 + 8 * hh);
                const bf16_t* xsp = xT + lnd(((size_t)b * 2048 + h * 64 + 32 * pt + r) * 2048 + c * 128 + 8 * hh);
                const bf16_t* bsp = BT + lnd(((size_t)b * 512 + g * 128 + 32 * lt + r) * 2048 + c * 128 + 8 * hh);
                const bf16_t* zp = p.hbuf + lnd((size_t)(t0 + 32 * lt + r) * AB_IN + AB_Z + h * 64 + 32 * pt + 4 * hh);
#pragma unroll
                for (int st = 0; st < 8; ++st) cf[st] = ld8(cp + 16 * st);
#pragma unroll
                for (int st = 0; st < 8; ++st) { xs[st] = ld8(xsp + 16 * st); bs[st] = ld8(bsp + 16 * st); }
#pragma unroll
                for (int i4 = 0; i4 < 4; ++i4) zv[i4] = *(const u32x2*)(zp + 8 * i4);
            }
            bf16x8 sl[8];
#pragma unroll
            for (int st = 0; st < 8; ++st) sl[st] = *(const LAS bf16x8*)(S_lds + (32 * pt + r) * 136 + 16 * st + 8 * hh);
            __builtin_amdgcn_sched_barrier(0);
            f32x16 Y;
#pragma unroll
            for (int i = 0; i < 16; ++i) Y[i] = 0.f;
#pragma unroll
            for (int st = 0; st < 8; ++st) Y = MFMA32(sl[st], cf[st], Y);
            { const float ea = __expf(acl);
#pragma unroll
              for (int i = 0; i < 16; ++i) Y[i] *= ea; }
            for (int stile = 0; stile <= lt; ++stile) {
                const bf16_t* bp = bcr + lnd((size_t)(t0 + 32 * stile + r) * 1024 + g * 128 + 8 * hh);
                const bf16_t* xp = xT + lnd(((size_t)b * 2048 + h * 64 + 32 * pt + r) * 2048 + c * 128 + 32 * stile + 8 * hh);
                bf16x8 bf[8];
#pragma unroll
                for (int st = 0; st < 8; ++st) bf[st] = ld8(bp + 16 * st);
                const bf16x8 xa = ld8(xp), xb2 = ld8(xp + 16);
                __builtin_amdgcn_sched_barrier(0);
                f32x16 G;
#pragma unroll
                for (int i = 0; i < 16; ++i) G[i] = 0.f;
#pragma unroll
                for (int st = 0; st < 8; ++st) G = MFMA32(bf[st], cf[st], G);
#pragma unroll
                for (int i = 0; i < 16; ++i) {
                    const int sl2 = 32 * stile + (i & 3) + 8 * (i >> 2) + 4 * hh, ll = 32 * lt + r;
                    float v = G[i] * __builtin_amdgcn_exp2f((acl - acs[sl2]) * L2E) * dts[sl2];
                    v = (sl2 <= ll) ? v : 0.f;
                    if (sl2 == ll) v += dskip;
                    G[i] = v;
                }
                const bf16x8 pg0 = pack8(G[0], G[1], G[2], G[3], G[4], G[5], G[6], G[7]);
                const bf16x8 pg1 = pack8(G[8], G[9], G[10], G[11], G[12], G[13], G[14], G[15]);
                Y = MFMA32(xa, pg0, Y); Y = MFMA32(xb2, pg1, Y);
            }
            {
                bf16_t* op = (bf16_t*)p.mix + (t0 + 32 * lt + r) * 4096 + h * 64 + 32 * pt + 4 * hh;
#pragma unroll
                for (int i4 = 0; i4 < 4; ++i4) {
                    u32x2 o; o.x = pk_bf16(Y[4 * i4] * siluf_(bflo(zv[i4].x)), Y[4 * i4 + 1] * siluf_(bfhi(zv[i4].x))); o.y = pk_bf16(Y[4 * i4 + 2] * siluf_(bflo(zv[i4].y)), Y[4 * i4 + 3] * siluf_(bfhi(zv[i4].y)));
                    *(u32x2*)(op + 8 * i4) = o;
                }
            }
            {
                f32x16 Sn;
#pragma unroll
                for (int i = 0; i < 16; ++i) Sn[i] = 0.f;
#pragma unroll
                for (int st = 0; st < 8; ++st) {
                    const bf16x8 xf = xs[st];
                    const f32x4 w0 = *(const LAS f32x4*)(wl + 16 * st + 4 * hh), w1 = *(const LAS f32x4*)(wl + 16 * st + 8 + 4 * hh);
                    const bf16x8 xw = pack8(bf2f((bf16_t)xf[0]) * w0[0], bf2f((bf16_t)xf[1]) * w0[1], bf2f((bf16_t)xf[2]) * w0[2], bf2f((bf16_t)xf[3]) * w0[3],
                                            bf2f((bf16_t)xf[4]) * w1[0], bf2f((bf16_t)xf[5]) * w1[1], bf2f((bf16_t)xf[6]) * w1[2], bf2f((bf16_t)xf[7]) * w1[3]);
                    Sn = MFMA32(xw, bs[st], Sn);
                }
                const float ed = __expf(acs[127]);
#pragma unroll
                for (int i = 0; i < 16; ++i) S[i] = S[i] * ed + Sn[i];
            }
        }
    }
    __syncthreads();
}

DI void ph_hgrn_chunk(LAS unsigned char* lds, const MP& p) {
    if (blockIdx.x >= NB * 16) return;
    const int tix = tid_opaque();
    const int w = tix >> 6, lane = tix & 63, r = lane & 31, hh = lane >> 5;
    LAS bf16_t* qt_l = (LAS bf16_t*)lds;
    LAS bf16_t* kt_l = qt_l + 64 * 136;
    LAS bf16_t* kendT = kt_l + 64 * 136;
    LAS bf16_t* S_l = kendT + 128 * 72;
    LAS float* bl = (LAS float*)(S_l + 2 * 128 * 136);
    LAS float* tot = bl + 128;
    const int b = blockIdx.x >> 4, h = blockIdx.x & 15;
    const bf16_t* viT = (const bf16_t*)p.bufB;
    const int d = tix & 127, tq = tix >> 7;
    const float lb = 1.f / (1.f + expf(p.lb_logits[h * 128 + d] - p.lb_logits[2048 + h * 128 + d]));
    const int vt = w >> 1, tt = w & 1;
    f32x16 S0, S1;
#pragma unroll
    for (int i = 0; i < 16; ++i) { S0[i] = 0.f; S1[i] = 0.f; }
    for (int i = tix; i < 128 * 136 / 2; i += NTHR) ((LAS unsigned*)S_l)[i] = 0u;
    bf16_t rawq[16], rawf[16];
#pragma unroll
    for (int i = 0; i < 16; ++i) { const size_t t = (size_t)b * SEQ + 16 * tq + i; rawq[i] = p.hbuf[t * CD_IN + CD_HQ + h * 128 + d]; rawf[i] = p.hbuf[t * CD_IN + CD_HF + h * 128 + d]; }
    for (int c = 0; c < 32; ++c) {
        const long t0 = (long)b * SEQ + c * 64;
        bf16x8 vfr[4];
        { const bf16_t* vp = viT + lnd(((size_t)(b * 16 + h) * 128 + 32 * vt + r) * 2048 + c * 64 + 8 * hh);
#pragma unroll
          for (int ks = 0; ks < 4; ++ks) vfr[ks] = ld8(vp + 16 * ks); }
        {
            float qv[16], kv[16], bq[16]; float cum = 0.f;
#pragma unroll
            for (int i = 0; i < 16; ++i) {
                const float hq = bf2f(rawq[i]), hf = bf2f(rawf[i]);
                const float sg = sigmoidf_(hf);
                cum += __logf(lb + (1.f - lb) * sg);
                bq[i] = cum; kv[i] = (1.f - lb) * (1.f - sg); qv[i] = siluf_(hq);
            }
            tot[tq * 128 + d] = cum;
            if (c + 1 < 32) {
#pragma unroll
                for (int i = 0; i < 16; ++i) { const size_t t = (size_t)t0 + 64 + 16 * tq + i; rawq[i] = p.hbuf[t * CD_IN + CD_HQ + h * 128 + d]; rawf[i] = p.hbuf[t * CD_IN + CD_HF + h * 128 + d]; }
            }
            __syncthreads();
            float off = 0.f, blast = 0.f;
#pragma unroll
            for (int q2 = 0; q2 < 4; ++q2) { const float tv = tot[q2 * 128 + d]; blast += tv; if (q2 < tq) off += tv; }
#pragma unroll
            for (int i = 0; i < 16; ++i) {
                const int tl = 16 * tq + i;
                const float bb = off + bq[i];
                qt_l[tl * 136 + d] = f2bf(qv[i] * __expf(bb));
                kt_l[tl * 136 + d] = f2bf(kv[i] * __expf(-bb));
                kendT[d * 72 + ((tl & ~12) | ((tl & 4) << 1) | ((tl & 8) >> 1))] = f2bf(kv[i] * __expf(blast - bb));
            }
            if (tq == 0) bl[d] = __expf(blast);
        }
        __syncthreads();
        const LAS bf16_t* Scur = S_l + (c & 1) * (128 * 136);
        LAS bf16_t* Snxt = S_l + ((c + 1) & 1) * (128 * 136);
        {
            bf16x8 qf[8], sf[8];
#pragma unroll
            for (int st = 0; st < 8; ++st) { qf[st] = *(const LAS bf16x8*)(qt_l + (32 * tt + r) * 136 + 16 * st + 8 * hh); sf[st] = *(const LAS bf16x8*)(Scur + (32 * vt + r) * 136 + 16 * st + 8 * hh); }
            __builtin_amdgcn_sched_barrier(0);
            f32x16 O;
#pragma unroll
            for (int i = 0; i < 16; ++i) O[i] = 0.f;
#pragma unroll
            for (int st = 0; st < 8; ++st) O = MFMA32(sf[st], qf[st], O);
            for (int stile = 0; stile <= tt; ++stile) {
                bf16x8 kf[8];
#pragma unroll
                for (int st = 0; st < 8; ++st) kf[st] = *(const LAS bf16x8*)(kt_l + (32 * stile + r) * 136 + 16 * st + 8 * hh);
                __builtin_amdgcn_sched_barrier(0);
                f32x16 AT;
#pragma unroll
                for (int i = 0; i < 16; ++i) AT[i] = 0.f;
#pragma unroll
                for (int st = 0; st < 8; ++st) AT = MFMA32(kf[st], qf[st], AT);
                if (stile == tt) {
#pragma unroll
                    for (int i = 0; i < 16; ++i) if (((i & 3) + 8 * (i >> 2) + 4 * hh) > r) AT[i] = 0.f;
                }
                const bf16x8 pa0 = pack8(AT[0], AT[1], AT[2], AT[3], AT[4], AT[5], AT[6], AT[7]);
                const bf16x8 pa1 = pack8(AT[8], AT[9], AT[10], AT[11], AT[12], AT[13], AT[14], AT[15]);
                if (stile == 0) { O = MFMA32(vfr[0], pa0, O); O = MFMA32(vfr[1], pa1, O); }
                else            { O = MFMA32(vfr[2], pa0, O); O = MFMA32(vfr[3], pa1, O); }
            }
            float* op = p.x3 + (t0 + 32 * tt + r) * 2048 + h * 128 + 32 * vt + 4 * hh;
#pragma unroll
            for (int i4 = 0; i4 < 4; ++i4) { f32x4 o; o[0] = O[4 * i4]; o[1] = O[4 * i4 + 1]; o[2] = O[4 * i4 + 2]; o[3] = O[4 * i4 + 3]; *(f32x4*)(op + 8 * i4) = o; }
        }
        {
            bf16x8 ke0[4], ke1[4];
#pragma unroll
            for (int ks = 0; ks < 4; ++ks) { ke0[ks] = *(const LAS bf16x8*)(kendT + (64 * tt + r) * 72 + 16 * ks + 8 * hh); ke1[ks] = *(const LAS bf16x8*)(kendT + (64 * tt + 32 + r) * 72 + 16 * ks + 8 * hh); }
            __builtin_amdgcn_sched_barrier(0);
            f32x16 N0, N1;
#pragma unroll
            for (int i = 0; i < 16; ++i) { N0[i] = 0.f; N1[i] = 0.f; }
#pragma unroll
            for (int ks = 0; ks < 4; ++ks) { N0 = MFMA32(vfr[ks], ke0[ks], N0); N1 = MFMA32(vfr[ks], ke1[ks], N1); }
            const float e0 = bl[64 * tt + r], e1 = bl[64 * tt + 32 + r];
#pragma unroll
            for (int i = 0; i < 16; ++i) { S0[i] = S0[i] * e0 + N0[i]; S1[i] = S1[i] * e1 + N1[i]; }
#pragma unroll
            for (int i = 0; i < 16; ++i) { const int v = 32 * vt + (i & 3) + 8 * (i >> 2) + 4 * hh; Snxt[v * 136 + 64 * tt + r] = f2bf(S0[i]); Snxt[v * 136 + 64 * tt + 32 + r] = f2bf(S1[i]); }
        }
        __syncthreads();
    }
}

DI gm::DenseProb mk_dense(const bf16_t* A, unsigned lda, const bf16_t* Bt, unsigned ldb, int M, int Npad, int K) {
    gm::DenseProb d; d.A = (const char*)A; d.Bt = (const char*)Bt; d.lda = lda; d.ldb = ldb; d.K = K; d.nM = M / 256; d.nN = Npad / 256; d.G = (int)gridDim.x; d.c = (int)blockIdx.x; return d;
}
DI void ph_gemm_bf16(LAS unsigned char* lds, const bf16_t* A, unsigned lda, const bf16_t* Bt, int M, int N, int Npad, int K, bf16_t* C, long ldc) {
    gm::EpiBf16 e; e.C = C; e.ldc = ldc; e.N = N; gm::gemm_phase(lds, mk_dense(A, lda, Bt, (unsigned)K, M, Npad, K), e);
}
DI void ph_gemm_f32(LAS unsigned char* lds, const bf16_t* A, unsigned lda, const bf16_t* Bt, int M, int N, int Npad, int K, float* C, long ldc) {
    gm::EpiF32 e; e.C = C; e.ldc = ldc; e.N = N; gm::gemm_phase(lds, mk_dense(A, lda, Bt, (unsigned)K, M, Npad, K), e);
}
DI int moe_tile_table(LAS unsigned char* lds, const MP& p) {
    const int tix = tid_opaque();
    LAS i32x2* ttab = (LAS i32x2*)(lds + LDS_TAB_OFF);
    const int nt = *p.ntiles;
    for (int i = tix; i < nt && i < 768; i += NTHR) { const int4 t = *(const int4*)(p.tiles + i * 4); i32x2 r; r.x = (t.x & 0xff) | (((t.z - 1) & 0xff) << 8) | (t.w << 16); r.y = t.y; ttab[i] = r; }
    __syncthreads();
    return nt < 768 ? nt : 768;
}
DI void ph_moe_gemm1(LAS unsigned char* lds, const MP& p) {
    const int nt = moe_tile_table(lds, p);
    gm::MoeG1Prob q; q.A = (const char*)p.xb; q.WgT = (const char*)p.WgT; q.WuT = (const char*)p.WuT; q.lda = DM; q.ldb = DM; q.K = DM; q.G = (int)gridDim.x; q.c = (int)blockIdx.x;
    q.ttab = (const LAS i32x2*)(lds + LDS_TAB_OFF); q.ntl = nt; q.row_tok = p.row_tok;
    gm::EpiSwiglu e; e.H = p.H; e.ttab = q.ttab;
    gm::gemm_phase(lds, q, e);
}
DI void ph_moe_gemm2(LAS unsigned char* lds, const MP& p) {
    const int nt = moe_tile_table(lds, p);
    gm::MoeG2Prob q; q.A = (const char*)p.H; q.WdT = (const char*)p.WdT; q.lda = 512; q.ldb = 512; q.K = 512; q.G = (int)gridDim.x; q.c = (int)blockIdx.x; q.ttab = (const LAS i32x2*)(lds + LDS_TAB_OFF); q.ntl = nt;
    gm::EpiMoeDown e; e.Y = p.Y; e.ttab = q.ttab;
    gm::gemm_phase(lds, q, e);
}

#ifndef PROBE_SEL
#define PROBE_SEL 0
#endif
#define RG(...) { __VA_ARGS__; if (PROBE_SEL == 1) { __VA_ARGS__; } }
#define RA(...) { __VA_ARGS__; if (PROBE_SEL == 2) { __VA_ARGS__; } }
#define RM(...) { __VA_ARGS__; if (PROBE_SEL == 3) { __VA_ARGS__; } }
#define RC(...) { __VA_ARGS__; if (PROBE_SEL == 4) { __VA_ARGS__; } }
__global__ __launch_bounds__(512, 2) void mega_fwd(MP p) {
    extern __shared__ __attribute__((aligned(16))) unsigned char shm[];
    LAS unsigned char* lds = (LAS unsigned char*)shm;
    volatile LAS unsigned* xbw = (volatile LAS unsigned*)(lds + LDS_BAR_OFF);
    if (threadIdx.x == 0) { xbw[0] = 0u; xbw[1] = 0u; xbw[2] = 0u; xbw[3] = 0u; }
    __syncthreads();
    (void)xcd_barrier_post(p.bar, xbw);
#define SYNC() do { XcdBarrier b_; b_.bar = p.bar; b_.x = xb_xcc_id(); b_.st = (volatile LAS unsigned*)(lds + LDS_BAR_OFF); xcd_barrier(b_); } while (0)
    RC(ph_cvt_wT(lds, p.ab_w_in, p.WinABt, DM, AB_IN, 8960, 1, (int)blockIdx.x, (int)gridDim.x);)
    RC(ph_cvt_x(p);)
    RC(ph_cmp_bias(p);)
    RC(ph_build_wr(p);)
    SYNC();
    { const int NG = (int)gridDim.x >= 256 ? CVQ_NG : (int)gridDim.x;
      if ((int)blockIdx.x < NG) { gm::EpiAB e; e.C = p.hbuf; e.vselT = p.vselT; e.vwinT = p.vwinT; e.ksf = p.ksf; e.kwf = p.kwf; gm::DenseProb d = mk_dense(p.xb, DM, p.WinABt, DM, T_TOK, 8960, DM); d.G = NG; d.c = (int)blockIdx.x; gm::gemm_phase(lds, d, e); }
      moe_cvt_queue(lds, p, 0, p.bar + XCD_BAR_WORDS); }
    SYNC();
    RG({ gm::CmpProb q; q.hb = (const char*)p.hbuf; q.Wt = (const char*)p.WcmpT; q.ldb = 4096; q.K = 4096; q.G = (int)gridDim.x; q.c = (int)blockIdx.x; gm::EpiCmp e; e.kc = p.kcb; e.vcT = p.vcT; e.cpart = p.cpart; gm::gemm_phase(lds, q, e); })
    RM(ph_conv_ssd(lds, p);)
    SYNC();
    RA(ph_ssd_chunk(lds, p);)
    RA(ph_nsa_attn(lds, p);)
    SYNC();
    RM(ph_ssd_norm(p);)
    SYNC();
    RG(ph_gemm_bf16(lds, p.mixb, 4096, p.WoutABt, T_TOK, DM, DM, 4096, (bf16_t*)p.bufA, DM);)
    SYNC();
    RM(ph_ln<false>(p, p.x, (const bf16_t*)p.bufA, p.ln_g, p.ln_b, p.xb, p.mixb);)
    SYNC();
    RG(ph_router_gemm(lds, p, 0, (float*)(p.mixb + (size_t)T_TOK * DM), p.mixb);)
    SYNC();
    RM(ph_route_select(p, (const float*)(p.mixb + (size_t)T_TOK * DM), p.router_bias);)
    SYNC();
    RM(ph_moe_scan(lds, p);)
    SYNC();
    RG(ph_moe_gemm1(lds, p);)
    SYNC();
    RG(ph_moe_gemm2(lds, p);)
    SYNC();
    RM(ph_moe_combine_ln(p, p.xb, p.mixb, p.ln_g + DM, p.ln_b + DM, (float*)nullptr, p.xb);)
    SYNC();
    { const int NG = (int)gridDim.x >= 256 ? CVQ_NG : (int)gridDim.x;
      if ((int)blockIdx.x < NG) { gm::EpiCD e; e.C = p.hbuf; e.viT = (bf16_t*)p.bufB; gm::DenseProb d = mk_dense(p.xb, DM, p.WinCDt, DM, T_TOK, 9472, DM); d.G = NG; d.c = (int)blockIdx.x; gm::gemm_phase(lds, d, e); }
      moe_cvt_queue(lds, p, 1, p.bar + XCD_BAR_WORDS + 32); }
    SYNC();
    RM(ph_mla_rms(p);)
    RM(ph_rope_k(p);)
    SYNC();
    if (gridDim.x >= 256) {
        if (blockIdx.x < 128) { RA(ph_hgrn_chunk(lds, p);) }
        else {
            const int G2 = (int)gridDim.x - 128, c2 = (int)blockIdx.x - 128;
            { gm::DenseProb d = mk_dense(p.cqb, 1024, p.Wuqt, 512, T_TOK, 3072, 512); d.G = G2; d.c = c2; gm::EpiBf16 e; e.C = (bf16_t*)p.xbc; e.ldc = 3072; e.N = 3072; RG(gm::gemm_phase(lds, d, e);) }
            { gm::DenseProb d = mk_dense(p.cqb + 512, 1024, p.Wukvt, 512, T_TOK, 4096, 512); d.G = G2; d.c = c2; gm::EpiKV e; e.kf = (bf16_t*)p.kvfrag; e.vf = (bf16_t*)p.kvfrag + (size_t)T_TOK * 2048; RG(gm::gemm_phase(lds, d, e);) }
        }
    } else {
        RA(ph_hgrn_chunk(lds, p);)
        SYNC();
        RG(ph_gemm_bf16(lds, p.cqb, 1024, p.Wuqt, T_TOK, 3072, 3072, 512, (bf16_t*)p.xbc, 3072);)
        RG({ gm::EpiKV e; e.kf = (bf16_t*)p.kvfrag; e.vf = (bf16_t*)p.kvfrag + (size_t)T_TOK * 2048; gm::gemm_phase(lds, mk_dense(p.cqb + 512, 1024, p.Wukvt, 512, T_TOK, 4096, 512), e); })
    }
    SYNC();
    RA(ph_mla_attn(lds, p);)
    RM(ph_hgrn_post(p);)
    SYNC();
    RG(ph_gemm_bf16(lds, p.mixb, 4096, p.WoutCDt, T_TOK, DM, DM, 4096, (bf16_t*)p.bufB, DM);)
    SYNC();
    RM(ph_ln<true>(p, p.xb, (const bf16_t*)p.bufB, p.ln_g + 2 * DM, p.ln_b + 2 * DM, p.xb, p.mixb);)
    SYNC();
    RG(ph_router_gemm(lds, p, 1, (float*)(p.mixb + (size_t)T_TOK * DM), p.mixb);)
    SYNC();
    RM(ph_route_select(p, (const float*)(p.mixb + (size_t)T_TOK * DM), p.router_bias + 64);)
    SYNC();
    RM(ph_moe_scan(lds, p);)
    SYNC();
    RG(ph_moe_gemm1(lds, p);)
    SYNC();
    RG(ph_moe_gemm2(lds, p);)
    SYNC();
    RM(ph_moe_combine_ln(p, p.xb, p.mixb, p.ln_g + 3 * DM, p.ln_b + 3 * DM, p.out, (bf16_t*)nullptr);)
    if (xb_ld(&p.bar[XB_TMO]) != 0u) { SYNC(); for (long i = (long)blockIdx.x * NTHR + threadIdx.x; i < (long)T_TOK * DM; i += (long)gridDim.x * NTHR) p.out[i] = __uint_as_float(0x7fc00000u); }
#undef SYNC
}

extern "C" void kernel_launch(void* const* d_in, const int* in_sizes, int n_in, void* d_out, int out_size, void* d_ws, size_t ws_size, hipStream_t stream) {
    static int grid = 0;
    if (!grid) {
        int dev = 0, cus = 0; (void)hipGetDevice(&dev); (void)hipDeviceGetAttribute(&cus, hipDeviceAttributeMultiprocessorCount, dev);
        (void)hipFuncSetAttribute((const void*)mega_fwd, hipFuncAttributeMaxDynamicSharedMemorySize, LDS_TOTAL);
        grid = cus > 0 ? cus : 256;
    }
    (void)in_sizes; (void)n_in; (void)out_size; (void)ws_size;
    MP p{};
    p.x = (const float*)d_in[0]; p.positions = (const int*)d_in[1]; p.ab_w_in = (const float*)d_in[2]; p.conv_w = (const float*)d_in[3]; p.conv_b = (const float*)d_in[4];
    p.dt_bias = (const float*)d_in[5]; p.a_log = (const float*)d_in[6]; p.ssm_d = (const float*)d_in[7]; p.ssm_norm_w = (const float*)d_in[8]; p.cmp_pos = (const float*)d_in[9];
    p.cmp_w = (const float*)d_in[10]; p.ab_w_out = (const float*)d_in[11]; p.cd_w_in = (const float*)d_in[12]; p.q_norm_w = (const float*)d_in[13]; p.w_uq = (const float*)d_in[14];
    p.kv_norm_w = (const float*)d_in[15]; p.w_ukv = (const float*)d_in[16]; p.lb_logits = (const float*)d_in[17]; p.hgrn_norm_w = (const float*)d_in[18]; p.cd_w_out = (const float*)d_in[19];
    p.ln_g = (const float*)d_in[20]; p.ln_b = (const float*)d_in[21]; p.w_router = (const float*)d_in[22]; p.router_bias = (const float*)d_in[23]; p.w_gate = (const float*)d_in[24];
    p.w_up = (const float*)d_in[25]; p.w_down = (const float*)d_in[26]; p.sg = (const float*)d_in[27]; p.su = (const float*)d_in[28]; p.sd = (const float*)d_in[29];
    p.out = (float*)d_out;
    char* wp = (char*)d_ws;
    auto carve = [&](size_t bytes) { char* q = wp; wp += (bytes + 255) & ~(size_t)255; return q; };
    p.bar = (unsigned*)carve((size_t)(XCD_BAR_WORDS + 64) * 4);
    p.WinABt = (bf16_t*)carve((size_t)8960 * DM * 2);
    p.WoutABt = (bf16_t*)carve((size_t)DM * 4096 * 2);
    p.WinCDt = (bf16_t*)carve((size_t)9472 * DM * 2);
    p.WoutCDt = (bf16_t*)carve((size_t)DM * 4096 * 2);
    p.Wuqt = (bf16_t*)carve((size_t)3072 * 512 * 2);
    p.Wukvt = (bf16_t*)carve((size_t)4096 * 512 * 2);
    p.WgT = (bf16_t*)carve((size_t)65 * 512 * DM * 2); p.WuT = (bf16_t*)carve((size_t)65 * 512 * DM * 2); p.WdT = (bf16_t*)carve((size_t)65 * DM * 512 * 2);
    char* big = carve((size_t)T_TOK * CD_IN * 2 + (size_t)T_TOK * 3072 * 4 + (size_t)T_TOK * 4096 * 4 + 1024);
    p.hbuf = (bf16_t*)big;
    p.xbc = (float*)(big + (((size_t)T_TOK * CD_IN * 2 + 255) & ~(size_t)255));
    p.mix = (float*)((char*)p.xbc + (size_t)T_TOK * 3072 * 4);
    p.H = (bf16_t*)big;
    p.Y = (bf16_t*)(big + (((size_t)(MOE_PMAX + T_TOK) * 512 * 2 + 255) & ~(size_t)255));
    p.kvfrag = (bf16_t*)p.mix;
    p.mixb = (bf16_t*)carve((size_t)T_TOK * 4096 * 2);
    p.bufA = (float*)carve((size_t)T_TOK * DM * 4);
    p.bufB = (float*)carve((size_t)T_TOK * DM * 4);
    p.x3 = (float*)carve((size_t)T_TOK * DM * 4);
    p.xb = (bf16_t*)carve((size_t)(T_TOK + 1) * DM * 2);
    p.cqb = (bf16_t*)carve((size_t)T_TOK * 1024 * 2);
    p.kr = (bf16_t*)carve((size_t)T_TOK * 64 * 2);
    p.rope_tab = (float*)carve((size_t)T_TOK * 32 * 8);
    p.kcb = (bf16_t*)carve((size_t)16 * 128 * 128 * 2); p.vcT = (bf16_t*)carve((size_t)16 * 128 * 128 * 2);
    p.vselT = (bf16_t*)carve((size_t)16 * 128 * 2048 * 2); p.vwinT = (bf16_t*)carve((size_t)16 * 128 * 2048 * 2); p.ksf = (bf16_t*)carve((size_t)16 * 128 * 2048 * 2); p.kwf = (bf16_t*)carve((size_t)16 * 128 * 2048 * 2);
    p.WcmpT = (bf16_t*)carve((size_t)2 * 256 * 4096 * 2); p.WrT3 = (bf16_t*)carve((size_t)2 * 256 * 4096 * 2); p.cpart = (float*)carve((size_t)2 * 128 * 128 * 4);
    p.kc = (float*)carve((size_t)NB * NCMP * 2 * 128 * 4);
    p.vc = (float*)carve((size_t)NB * NCMP * 2 * 128 * 4);
    p.top_e = (int*)carve((size_t)T_TOK * 8 * 4); p.top_w = (float*)carve((size_t)T_TOK * 8 * 4); p.lpos = (int*)carve((size_t)T_TOK * 8 * 4);
    p.cnt_tab = (int*)carve((size_t)MOE_NSLOT * 64 * 4); p.row_tok = (int*)carve((size_t)(MOE_PMAX + T_TOK) * 4); p.row_w = (float*)carve((size_t)(MOE_PMAX + T_TOK) * 4);
    p.row_slot = (int*)carve((size_t)(MOE_PMAX + T_TOK) * 4); p.tiles = (int*)carve((size_t)MOE_MAXTILES * 16); p.ntiles = (int*)carve(256);
    (void)hipMemsetAsync(p.bar, 0, (size_t)(XCD_BAR_WORDS + 64) * 4, stream);
    hipLaunchKernelGGL(mega_fwd, dim3(grid), dim3(NTHR), LDS_TOTAL, stream, p);
}
```

```cpp
#include <hip/hip_runtime.h>
#include <stdint.h>

#define DI __device__ __forceinline__

constexpr int T_TOK = 16384, DM = 2048, SEQ = 2048, NB = 8;
constexpr int AB_IN = 8784, CD_IN = 9280;
constexpr int AB_Z = 0, AB_XBC = 2048, AB_DT = 5120, AB_Q = 5152, AB_KV = 7200, AB_G = 8736;
constexpr int CD_CQ = 0, CD_CKV = 512, CD_KR = 1024, CD_HQ = 1088, CD_HF = 3136, CD_HI = 5184, CD_HG = 7232;
constexpr float DN_ALPHA = 1.41421356237309515f;
constexpr int NCMP = 127;
constexpr int MOE_TM = 256;
constexpr int MOE_SLOT_TOK = 8;
constexpr int MOE_NSLOT = T_TOK / MOE_SLOT_TOK;
constexpr int MOE_PMAX = T_TOK * 8 + 64 * MOE_TM;
constexpr int MOE_MAXTILES = MOE_PMAX / MOE_TM + T_TOK / MOE_TM;
constexpr int LDH_AB = AB_IN, LDH_CD = CD_IN;

typedef unsigned short bf16_t;
DI float ldh(const bf16_t* p, long i) { return __uint_as_float(((unsigned)p[i]) << 16); }
DI bf16_t f2bf(float f) { unsigned u = __float_as_uint(f); u += 0x7fffu + ((u >> 16) & 1u); return (bf16_t)(u >> 16); }
DI int tid_opaque() { int t = (int)threadIdx.x; asm volatile("" : "+v"(t)); return t; }
DI float sigmoidf_(float x) { return 1.f / (1.f + __expf(-x)); }
DI float siluf_(float x) { return x / (1.f + __expf(-x)); }
DI float softplusf_(float x) { return x > 20.f ? x : log1pf(__expf(x)); }
#define LAS __attribute__((address_space(3)))
typedef unsigned short bf16_t;
typedef short bf16x8 __attribute__((ext_vector_type(8)));
typedef float f32x4 __attribute__((ext_vector_type(4)));
typedef unsigned u32x2 __attribute__((ext_vector_type(2)));
typedef unsigned u32x4 __attribute__((ext_vector_type(4)));
typedef int i32x2 __attribute__((ext_vector_type(2)));

typedef float f32x2_t __attribute__((ext_vector_type(2)));
typedef __bf16 bf16x2_t __attribute__((ext_vector_type(2)));
DI unsigned pk_bf16(float lo, float hi) { const f32x2_t v = {lo, hi}; const bf16x2_t r = __builtin_convertvector(v, bf16x2_t); return __builtin_bit_cast(unsigned, r); }
DI float bf2f(bf16_t b) { return __uint_as_float(((unsigned)b) << 16); }
DI float bflo(unsigned u) { return __uint_as_float(u << 16); }
DI float bfhi(unsigned u) { return __uint_as_float(u & 0xffff0000u); }

namespace gm {
constexpr int BM = 256, BK = 64, HALF = 128, HTB = HALF * BK * 2, STAGE_BYTES = 8 * HTB, NXCD = 8, WGM = 8;
DI int lds_byte(int r, int c) { const int st = (r >> 4) * 2 + (c >> 5), rr = r & 15, cc = c & 31, ob = rr * 64 + cc * 2; return st * 1024 + (ob ^ (((ob >> 9) & 1) << 5)); }
DI void stage_rc(int b, int& R, int& C) { const int st = b / 1024, sb = b % 1024, swz = sb ^ (((sb >> 9) & 1) << 5); R = (st >> 1) * 16 + swz / 64; C = (st & 1) * 32 + (swz % 64) / 2; }

struct Unit { int p, q; };

DI bool static_order(int i, int G, int c, int nM, int nN, Unit& u) {
    const int nwg = nM * nN;
    const long L = (long)i * G + c; if (L >= nwg) return false;
    int wgid = (int)L; { const int q = nwg / NXCD, r = nwg % NXCD, xcd = wgid % NXCD, off = wgid / NXCD; wgid = (xcd < r ? xcd * (q + 1) : r * (q + 1) + (xcd - r) * q) + off; }
    const int nig = WGM * nN, gid = wgid / nig, fm = gid * WGM, gsz = (nM - fm) < WGM ? (nM - fm) : WGM;
    u.p = fm + ((wgid % nig) % gsz); u.q = (wgid % nig) / gsz; return true;
}

struct DenseProb {
    const char* A; const char* Bt; unsigned lda, ldb;
    int K, nM, nN, G, c;
    struct AState { const char* base; };
    DI bool next(int i, Unit& u) const { return static_order(i, G, c, nM, nN, u); }
    DI void a_state(const Unit& u, int R0, int C, AState& s) const { s.base = A + (size_t)u.p * 256 * lda * 2; }
    DI const char* a_addr(const AState& s, int h, int i, int R0, int C, size_t koff) const { return s.base + koff + (size_t)h * 128 * lda * 2 + (size_t)((unsigned)(R0 + 64 * i) * lda + (unsigned)C) * 2u; }
    static DI AState sel(bool c, const AState& a, const AState& b) { AState r; r.base = c ? a.base : b.base; return r; }
    DI size_t koff(int kt) const { return (size_t)kt * 128; }
    DI const char* b_ptr(const Unit& u, int h) const { return Bt + ((size_t)u.q * 256 + (size_t)h * 128) * ldb * 2; }
};

DI i32x2 lds_tab_read(const LAS i32x2* q) { i32x2 r; const unsigned a = (unsigned)(size_t)q; asm volatile("ds_read_b64 %0, %1\n\ts_waitcnt lgkmcnt(0)" : "=v"(r) : "v"(a) : "memory"); return r; }
struct MoeG1Prob {
    const char* A; const char* WgT; const char* WuT; unsigned lda, ldb;
    int K, G, c;
    const LAS i32x2* ttab; int ntl; const int* row_tok;
    struct AState { unsigned off[2][2]; };
    DI bool next(int i, Unit& u) const {
        if ((G & 7) == 0) { const int x = c & 7, W = G >> 3, tpx = (ntl + 7) >> 3; const int m = i * W + (c >> 3); const int tl = m >> 2; const int tile = x * tpx + tl;
            if (tl >= tpx || tile >= ntl) return false; u.p = tile; u.q = m & 3; return true; }
        const long L = (long)i * G + c; if (L >= (long)ntl * 4) return false; u.p = (int)(L >> 2); u.q = (int)(L & 3); return true; }
    DI void a_state(const Unit& u, int R0, int C, AState& s) const {
        const int row0 = lds_tab_read(ttab + u.p).y;
#pragma unroll
        for (int h = 0; h < 2; ++h)
#pragma unroll
            for (int i = 0; i < 2; ++i) { int t = row_tok[row0 + h * 128 + R0 + 64 * i]; if (t < 0) t = T_TOK; s.off[h][i] = ((unsigned)t * lda + (unsigned)C) * 2u; }
    }
    DI const char* a_addr(const AState& s, int h, int i, int R0, int C, size_t koff) const { return A + koff + s.off[h][i]; }
    static DI AState sel(bool c, const AState& a, const AState& b) { AState r;
#pragma unroll
        for (int h = 0; h < 2; ++h)
#pragma unroll
            for (int i = 0; i < 2; ++i) r.off[h][i] = c ? a.off[h][i] : b.off[h][i];
        return r; }
    DI size_t koff(int kt) const { return (size_t)kt * 128; }
    DI const char* b_ptr(const Unit& u, int h) const { const int e = lds_tab_read(ttab + u.p).x & 0xff; return (h ? WuT : WgT) + ((size_t)e * 512 + (size_t)u.q * 128) * ldb * 2; }
};

struct MoeG2Prob {
    const char* A; const char* WdT; unsigned lda, ldb;
    int K, G, c;
    const LAS i32x2* ttab; int ntl;
    struct AState { const char* base; };
    DI bool next(int i, Unit& u) const {
        if ((G & 7) == 0) { const int x = c & 7, W = G >> 3, tpx = (ntl + 7) >> 3; const int m = i * W + (c >> 3); const int tl = m >> 3; const int tile = x * tpx + tl;
            if (tl >= tpx || tile >= ntl) return false; u.p = tile; u.q = m & 7; return true; }
        const long L = (long)i * G + c; if (L >= (long)ntl * 8) return false; u.p = (int)(L >> 3); u.q = (int)(L & 7); return true; }
    DI void a_state(const Unit& u, int R0, int C, AState& s) const { const int row0 = lds_tab_read(ttab + u.p).y; s.base = A + (size_t)row0 * lda * 2; }
    DI const char* a_addr(const AState& s, int h, int i, int R0, int C, size_t koff) const { return s.base + koff + (size_t)h * 128 * lda * 2 + (size_t)((unsigned)(R0 + 64 * i) * lda + (unsigned)C) * 2u; }
    static DI AState sel(bool c, const AState& a, const AState& b) { AState r; r.base = c ? a.base : b.base; return r; }
    DI size_t koff(int kt) const { return (size_t)kt * 128; }
    DI const char* b_ptr(const Unit& u, int h) const { const int e = lds_tab_read(ttab + u.p).x & 0xff; return WdT + ((size_t)e * 2048 + (size_t)u.q * 256 + (size_t)h * 128) * ldb * 2; }
};

struct EpiF32 {
    static constexpr bool PERM = false;
    float* C; long ldc; int N;
    DI void operator()(const f32x4 (&acc)[2][2][4][2], const Unit& u, int wr, int wc, int fr, int fq) const {
        const int row0 = u.p * 256 + wr * 64 + fr, col0 = u.q * 256 + wc * 32 + 4 * fq;
#pragma unroll
        for (int ai = 0; ai < 2; ++ai)
#pragma unroll
            for (int m = 0; m < 4; ++m) { float* rowp = C + (size_t)(row0 + ai * 128 + m * 16) * ldc;
#pragma unroll
                for (int bj = 0; bj < 2; ++bj)
#pragma unroll
                    for (int n = 0; n < 2; ++n) { const int col = col0 + bj * 128 + n * 16; if (col < N) *(f32x4*)(rowp + col) = acc[ai][bj][m][n]; } }
    }
};
struct EpiBf16 {
    static constexpr bool PERM = true;
    bf16_t* C; long ldc; int N;
    DI void operator()(const f32x4 (&acc)[2][2][4][2], const Unit& u, int wr, int wc, int fr, int fq) const {
        const int row0 = u.p * 256 + wr * 64 + fr, col0 = u.q * 256 + wc * 32 + 8 * fq;
#pragma unroll
        for (int ai = 0; ai < 2; ++ai)
#pragma unroll
            for (int m = 0; m < 4; ++m) { bf16_t* rowp = C + (size_t)(row0 + ai * 128 + m * 16) * ldc;
#pragma unroll
                for (int bj = 0; bj < 2; ++bj) { const int col = col0 + bj * 128; const f32x4 v0 = acc[ai][bj][m][0], v1 = acc[ai][bj][m][1];
                    if (col < N) { u32x4 o; o.x = pk_bf16(v0[0], v0[1]); o.y = pk_bf16(v0[2], v0[3]); o.z = pk_bf16(v1[0], v1[1]); o.w = pk_bf16(v1[2], v1[3]); *(u32x4*)(rowp + col) = o; } } }
    }
};
DI int perm16(int s) { return (s & ~12) | ((s & 4) << 1) | ((s & 8) >> 1); }
DI int perm32(int s) { return (s & ~28) | ((s & 12) << 1) | ((s & 16) >> 2); }
struct EpiKV {
    static constexpr bool PERM = true;
    bf16_t* kf; bf16_t* vf;
    DI void operator()(const f32x4 (&acc)[2][2][4][2], const Unit& u, int wr, int wc, int fr, int fq) const {
        const int row0 = u.p * 256 + wr * 64 + fr, head = u.q, c = wc * 32 + 8 * fq;
#pragma unroll
        for (int ai = 0; ai < 2; ++ai)
#pragma unroll
            for (int m = 0; m < 4; ++m) { const int t = row0 + ai * 128 + m * 16; const int b = t >> 11, s = t & 2047;
                const int kt = s >> 5, r = s & 31, s2 = (s >> 4) & 1;
                const int p16 = perm16(s & 15);
                const size_t tb = (size_t)(b * 16 + head) * 64 + kt;
                { const f32x4 v0 = acc[ai][0][m][0], v1 = acc[ai][0][m][1]; u32x4 o; o.x = pk_bf16(v0[0], v0[1]); o.y = pk_bf16(v0[2], v0[3]); o.z = pk_bf16(v1[0], v1[1]); o.w = pk_bf16(v1[2], v1[3]);
                  *(u32x4*)(kf + (tb * 8 + (c >> 4)) * 512 + (((c >> 3) & 1) * 32 + r) * 8) = o; }
                { bf16_t* vp = vf + ((tb * 4 + (c >> 5)) * 2 + s2) * 512 + ((p16 >> 3) * 32 + (c & 31)) * 8 + (p16 & 7);
#pragma unroll
                  for (int n = 0; n < 2; ++n) { const f32x4 vv = acc[ai][1][m][n];
#pragma unroll
                      for (int j = 0; j < 4; ++j) vp[(n * 4 + j) * 8] = f2bf(vv[j]); } } }
    }
};
struct CmpProb {
    const char* hb; const char* Wt;
    unsigned ldb; int K, G, c;
    struct AState { unsigned off[2][2]; };
    DI bool next(int i, Unit& u) const { const int L = i * G + c; if (L >= 16) return false; u.p = L & 7; u.q = L >> 3; return true; }
    DI void a_state(const Unit& u, int R0, int C, AState& s) const {
#pragma unroll
        for (int h = 0; h < 2; ++h)
#pragma unroll
            for (int i = 0; i < 2; ++i) { const int m = u.p * 256 + h * 128 + R0 + 64 * i; const int bg = m >> 7; int ci = m & 127; if (ci > 126) ci = 126;
                s.off[h][i] = (unsigned)(((size_t)((bg >> 1) * SEQ + 16 * ci) * AB_IN + AB_KV + u.q * 256 + (bg & 1) * 128 + C) * 2); }
    }
    DI const char* a_addr(const AState& s, int h, int i, int R0, int C, size_t koff) const { return hb + koff + s.off[h][i]; }
    static DI AState sel(bool c, const AState& a, const AState& b) { AState r;
#pragma unroll
        for (int h = 0; h < 2; ++h)
#pragma unroll
            for (int i = 0; i < 2; ++i) r.off[h][i] = c ? a.off[h][i] : b.off[h][i];
        return r; }
    DI size_t koff(int kt) const { return (size_t)(kt >> 1) * (AB_IN * 2) + (size_t)(kt & 1) * 128; }
    DI const char* b_ptr(const Unit& u, int h) const { return Wt + ((size_t)u.q * 256 + (size_t)h * 128) * ldb * 2; }
};
struct EpiCmp {
    static constexpr bool PERM = false;
    bf16_t* kc; bf16_t* vcT; const float* cpart;
    DI void operator()(const f32x4 (&acc)[2][2][4][2], const Unit& u, int wr, int wc, int fr, int fq) const {
        const int which = u.q, row0 = u.p * 256 + wr * 64 + fr, c0 = wc * 32 + 4 * fq;
        f32x4 bias[2];
#pragma unroll
        for (int n = 0; n < 2; ++n) { f32x4 a = {0.f, 0.f, 0.f, 0.f};
            for (int l = 0; l < 128; ++l) { const f32x4 v = *(const f32x4*)(cpart + ((size_t)which * 128 + l) * 128 + c0 + n * 16); a += v; }
            bias[n] = a; }
#pragma unroll
        for (int ai = 0; ai < 2; ++ai)
#pragma unroll
            for (int m = 0; m < 4; ++m) { const int mm = row0 + ai * 128 + m * 16; const int bg = mm >> 7, ci = mm & 127;
#pragma unroll
                for (int n = 0; n < 2; ++n) { const int c = c0 + n * 16; const f32x4 v = acc[ai][0][m][n] + bias[n];
                    if (which == 0) { u32x2 o; o.x = pk_bf16(v[0], v[1]); o.y = pk_bf16(v[2], v[3]); *(u32x2*)(kc + (size_t)mm * 128 + c) = o; }
                    else { bf16_t* vp = vcT + ((size_t)bg * 128 + c) * 128 + perm16(ci);
#pragma unroll
                        for (int j = 0; j < 4; ++j) vp[(size_t)j * 128] = f2bf(v[j]); } } }
    }
};
struct EpiAB {
    static constexpr bool PERM = true;
    bf16_t* C; bf16_t* vselT; bf16_t* vwinT; bf16_t* ksf; bf16_t* kwf;
    DI void operator()(const f32x4 (&acc)[2][2][4][2], const Unit& u, int wr, int wc, int fr, int fq) const {
        const int row0 = u.p * 256 + wr * 64 + fr, col0 = u.q * 256 + wc * 32 + 8 * fq;
        const bool special = (u.q >= 30);
#pragma unroll
        for (int ai = 0; ai < 2; ++ai)
#pragma unroll
            for (int m = 0; m < 4; ++m) { const int t = row0 + ai * 128 + m * 16; const int b = t >> 11, sp = t & 2047;
                bf16_t* rowp = C + (size_t)t * AB_IN;
#pragma unroll
                for (int bj = 0; bj < 2; ++bj) { const int col = col0 + bj * 128; const f32x4 v0 = acc[ai][bj][m][0], v1 = acc[ai][bj][m][1];
                    u32x4 o; o.x = pk_bf16(v0[0], v0[1]); o.y = pk_bf16(v0[2], v0[3]); o.z = pk_bf16(v1[0], v1[1]); o.w = pk_bf16(v1[2], v1[3]);
                    if (col < AB_IN) *(u32x4*)(rowp + col) = o;
                    if (special) {
                        if (col >= AB_KV + 512 && col < AB_KV + 768) { const int cc = col - (AB_KV + 512); const int bg = b * 2 + (cc >> 7), d = cc & 127;
                            *(u32x4*)(ksf + ((((size_t)bg * 128 + (sp >> 4)) * 4 + (d >> 5)) * 64 + ((d >> 3) & 3) * 16 + (sp & 15)) * 8) = o; }
                        if (col >= AB_KV + 768 && col < AB_KV + 1024) { const int cc = col - (AB_KV + 768); const int bg = b * 2 + (cc >> 7), d = cc & 127;
                            const int p32 = perm32(sp & 31);
                            bf16_t* vp = vselT + ((((size_t)bg * 64 + (sp >> 5)) * 8 + (d >> 4)) * 64 + (p32 >> 3) * 16 + (d & 15)) * 8 + (p32 & 7);
#pragma unroll
                            for (int j = 0; j < 4; ++j) { vp[j * 8] = f2bf(v0[j]); vp[(4 + j) * 8] = f2bf(v1[j]); } }
                        if (col >= AB_KV + 1024 && col < AB_KV + 1280) { const int cc = col - (AB_KV + 1024); const int bg = b * 2 + (cc >> 7), d = cc & 127;
                            *(u32x4*)(kwf + ((((size_t)bg * 64 + (sp >> 5)) * 8 + (d >> 4)) * 64 + ((d >> 3) & 1) * 32 + (sp & 31)) * 8) = o; }
                        if (col >= AB_KV + 1280 && col < AB_KV + 1536) { const int cc = col - (AB_KV + 1280); const int bg = b * 2 + (cc >> 7), d = cc & 127;
                            const int p16 = perm16(sp & 15);
                            bf16_t* vp = vwinT + (((((size_t)bg * 64 + (sp >> 5)) * 4 + (d >> 5)) * 2 + ((sp >> 4) & 1)) * 64 + (p16 >> 3) * 32 + (d & 31)) * 8 + (p16 & 7);
#pragma unroll
                            for (int j = 0; j < 4; ++j) { vp[j * 8] = f2bf(v0[j]); vp[(4 + j) * 8] = f2bf(v1[j]); } }
                    } } }
    }
};
struct EpiCD {
    static constexpr bool PERM = true;
    bf16_t* C; bf16_t* viT;
    DI void operator()(const f32x4 (&acc)[2][2][4][2], const Unit& u, int wr, int wc, int fr, int fq) const {
        const int row0 = u.p * 256 + wr * 64 + fr, col0 = u.q * 256 + wc * 32 + 8 * fq;
        const bool special = (u.q >= 20 && u.q <= 28);
#pragma unroll
        for (int ai = 0; ai < 2; ++ai)
#pragma unroll
            for (int m = 0; m < 4; ++m) { const int t = row0 + ai * 128 + m * 16; const int b = t >> 11, sp = t & 2047;
                bf16_t* rowp = C + (size_t)t * CD_IN;
#pragma unroll
                for (int bj = 0; bj < 2; ++bj) { const int col = col0 + bj * 128; const f32x4 v0 = acc[ai][bj][m][0], v1 = acc[ai][bj][m][1];
                    if (col < CD_IN) { u32x4 o; o.x = pk_bf16(v0[0], v0[1]); o.y = pk_bf16(v0[2], v0[3]); o.z = pk_bf16(v1[0], v1[1]); o.w = pk_bf16(v1[2], v1[3]); *(u32x4*)(rowp + col) = o; }
                    if (special && col >= CD_HI && col < CD_HI + 2048) { const int cc = col - CD_HI;
                        bf16_t* vp = viT + ((size_t)(b * 16 + (cc >> 7)) * 128 + (cc & 127)) * 2048 + perm16(sp);
#pragma unroll
                        for (int j = 0; j < 4; ++j) { vp[(size_t)j * 2048] = f2bf(v0[j]); vp[(size_t)(4 + j) * 2048] = f2bf(v1[j]); } } } }
    }
};
struct RouterProb {
    const char* xhi; long dlo; const char* Bt;
    int K, G, c;
    struct AState { const char* base; };
    DI bool next(int i, Unit& u) const { const int L = i * G + c; if (L >= 256) return false; u.p = L >> 2; u.q = L & 3; return true; }
    DI void a_state(const Unit& u, int R0, int C, AState& s) const { s.base = xhi + (long)((u.q >> 1) & 1) * dlo + (size_t)u.p * 256 * 4096 + (size_t)(u.q & 1) * 2048; }
    DI const char* a_addr(const AState& s, int h, int i, int R0, int C, size_t koff) const { return s.base + koff + (size_t)h * 128 * 4096 + (size_t)((unsigned)(R0 + 64 * i) * 2048u + (unsigned)C) * 2u; }
    static DI AState sel(bool c, const AState& a, const AState& b) { AState r; r.base = c ? a.base : b.base; return r; }
    DI size_t koff(int kt) const { return (size_t)kt * 128; }
    DI const char* b_ptr(const Unit& u, int h) const { return Bt + ((size_t)h * 128 * 4096 + (size_t)u.q * 1024) * 2; }
    unsigned ldb;
};
struct EpiRouter {
    static constexpr bool PERM = false;
    float* Cpart;
    DI void operator()(const f32x4 (&acc)[2][2][4][2], const Unit& u, int wr, int wc, int fr, int fq) const {
        const int row0 = u.p * 256 + wr * 64 + fr, col0 = wc * 32 + 4 * fq;
#pragma unroll
        for (int ai = 0; ai < 2; ++ai)
#pragma unroll
            for (int m = 0; m < 4; ++m) { float* rowp = Cpart + ((size_t)u.q * T_TOK + (size_t)(row0 + ai * 128 + m * 16)) * 128 + col0;
#pragma unroll
                for (int n = 0; n < 2; ++n) *(f32x4*)(rowp + n * 16) = acc[ai][0][m][n]; }
    }
};
struct EpiSwiglu {
    static constexpr bool PERM = true;
    bf16_t* H; const LAS i32x2* ttab;
    DI void operator()(const f32x4 (&acc)[2][2][4][2], const Unit& u, int wr, int wc, int fr, int fq) const {
        const int row0 = lds_tab_read(ttab + u.p).y + wr * 64 + fr, col0 = u.q * 128 + wc * 32 + 8 * fq;
#pragma unroll
        for (int ai = 0; ai < 2; ++ai)
#pragma unroll
            for (int m = 0; m < 4; ++m) { bf16_t* rowp = H + (size_t)(row0 + ai * 128 + m * 16) * 512 + col0;
                float hv[8];
#pragma unroll
                for (int n = 0; n < 2; ++n) { const f32x4 g = acc[ai][0][m][n], up = acc[ai][1][m][n];
#pragma unroll
                    for (int j = 0; j < 4; ++j) hv[n * 4 + j] = g[j] / (1.f + __expf(-g[j])) * up[j]; }
                u32x4 o; o.x = pk_bf16(hv[0], hv[1]); o.y = pk_bf16(hv[2], hv[3]); o.z = pk_bf16(hv[4], hv[5]); o.w = pk_bf16(hv[6], hv[7]); *(u32x4*)rowp = o; }
    }
};
struct EpiMoeDown {
    static constexpr bool PERM = true;
    bf16_t* Y; const LAS i32x2* ttab;
    DI void operator()(const f32x4 (&acc)[2][2][4][2], const Unit& u, int wr, int wc, int fr, int fq) const {
        const i32x2 rec = lds_tab_read(ttab + u.p);
        const int nrows = ((rec.x >> 8) & 0xff) + 1, delta = (int)((unsigned)rec.x >> 16);
        const int r0 = wr * 64 + fr, col0 = u.q * 256 + wc * 32 + 8 * fq;
#pragma unroll
        for (int ai = 0; ai < 2; ++ai)
#pragma unroll
            for (int m = 0; m < 4; ++m) { const int rt = r0 + ai * 128 + m * 16;
                if (rt < nrows) {
                    bf16_t* rowp = Y + (size_t)(rec.y + rt - delta) * 2048 + col0;
#pragma unroll
                    for (int bj = 0; bj < 2; ++bj) { const f32x4 v0 = acc[ai][bj][m][0], v1 = acc[ai][bj][m][1];
                        u32x4 o; o.x = pk_bf16(v0[0], v0[1]); o.y = pk_bf16(v0[2], v0[3]); o.z = pk_bf16(v1[0], v1[1]); o.w = pk_bf16(v1[2], v1[3]); *(u32x4*)(rowp + bj * 128) = o; } } }
    }
};

template <class Prob, class Epi>
DI void gemm_phase(LAS unsigned char* lds, const Prob& P, const Epi& E) {
    const int tid = tid_opaque(), wid = __builtin_amdgcn_readfirstlane(tid >> 6), lane = tid & 63, wr = wid >> 2, wc = wid & 3, fr = lane & 15, fq = lane >> 4;
    const int K = P.K, nt = K / BK;
    int R0, C; stage_rc(tid * 16, R0, C);
    unsigned voffB[2];
#pragma unroll
    for (int i = 0; i < 2; ++i) { const int R = R0 + 64 * i;
        const int Rb = Epi::PERM ? ((R & ~31) + 8 * ((R & 15) >> 2) + 4 * ((R >> 4) & 1) + (R & 3)) : R;
        voffB[i] = ((unsigned)Rb * P.ldb + (unsigned)C) * 2u; }
    const size_t kstep = (size_t)(BK * 2);
    const unsigned ldsw = (unsigned)wid * 1024u;
    const int aoff = lds_byte(wr * 64 + fr, fq * 8), boff = lds_byte(wc * 32 + fr, fq * 8);
#define GM_SA(b, h) (((b) * 2 + (h)) * HTB)
#define GM_SB(b, h) ((4 + (b) * 2 + (h)) * HTB)
#define GM_STAGE_B(bufoff, gbase) do { _Pragma("unroll") for (int _i = 0; _i < 2; ++_i) \
        __builtin_amdgcn_global_load_lds((const unsigned*)((const char*)(gbase) + voffB[_i]), (LAS unsigned*)(lds + (bufoff) + ldsw + _i * 8192), 16, 0, 0); } while (0)
#define GM_STAGE_A(bufoff, st, h, koff) do { _Pragma("unroll") for (int _i = 0; _i < 2; ++_i) \
        __builtin_amdgcn_global_load_lds((const unsigned*)(P.a_addr(st, h, _i, R0, C, koff)), (LAS unsigned*)(lds + (bufoff) + ldsw + _i * 8192), 16, 0, 0); } while (0)
#define GM_LDA(dst, b, h) do { _Pragma("unroll") for (int m = 0; m < 4; ++m) _Pragma("unroll") for (int k = 0; k < 2; ++k) dst[m][k] = *(const LAS bf16x8*)(lds + GM_SA(b, h) + aoff + m * 2048 + k * 1024); } while (0)
#define GM_LDB(dst, b, h) do { _Pragma("unroll") for (int n = 0; n < 2; ++n) _Pragma("unroll") for (int k = 0; k < 2; ++k) dst[n][k] = *(const LAS bf16x8*)(lds + GM_SB(b, h) + boff + n * 2048 + k * 1024); } while (0)
#define GM_MMA(ai, bj, At, Bt) do { __builtin_amdgcn_s_setprio(1); _Pragma("unroll") for (int m = 0; m < 4; ++m) _Pragma("unroll") for (int n = 0; n < 2; ++n) _Pragma("unroll") for (int k = 0; k < 2; ++k) \
        acc[ai][bj][m][n] = __builtin_amdgcn_mfma_f32_16x16x32_bf16(Bt[n][k], At[m][k], acc[ai][bj][m][n], 0, 0, 0); __builtin_amdgcn_s_setprio(0); } while (0)
#define GM_WAIT_V(n) asm volatile("s_waitcnt vmcnt(" #n ")" ::: "memory")
#define GM_WAIT_L(n) asm volatile("s_waitcnt lgkmcnt(" #n ")" ::: "memory")
#define GM_BAR __builtin_amdgcn_s_barrier()
#define GM_SCHED __builtin_amdgcn_sched_barrier(0)
    Unit cur, nxt; int ui = 0;
    if (!P.next(0, cur)) return;
    f32x4 acc[2][2][4][2];
#pragma unroll
    for (int a = 0; a < 2; ++a)
#pragma unroll
        for (int b = 0; b < 2; ++b)
#pragma unroll
            for (int m = 0; m < 4; ++m)
#pragma unroll
                for (int n = 0; n < 2; ++n) acc[a][b][m][n] = (f32x4){0.f, 0.f, 0.f, 0.f};
    bf16x8 At[4][2], B0[2][2], B1[2][2];
    typename Prob::AState cs, ns; P.a_state(cur, R0, C, cs);
    const char* cB0 = P.b_ptr(cur, 0); const char* cB1 = P.b_ptr(cur, 1);
    GM_STAGE_B(GM_SB(0, 0), cB0); GM_STAGE_A(GM_SA(0, 0), cs, 0, 0); GM_STAGE_B(GM_SB(0, 1), cB1); GM_STAGE_A(GM_SA(0, 1), cs, 1, 0);
    if (wr == 1) GM_BAR;
    GM_WAIT_V(4); GM_BAR;
    GM_STAGE_B(GM_SB(1, 0), cB0 + kstep); GM_STAGE_A(GM_SA(1, 0), cs, 0, P.koff(1)); GM_STAGE_B(GM_SB(1, 1), cB1 + kstep);
    GM_WAIT_V(6); GM_BAR;
    for (;;) {
        const bool has_next = P.next(ui + 1, nxt);
        if (has_next) P.a_state(nxt, R0, C, ns); else ns = cs;
        const char* nB0 = has_next ? P.b_ptr(nxt, 0) : cB0; const char* nB1 = has_next ? P.b_ptr(nxt, 1) : cB1;
        for (int t = 0; t < nt; t += 2) {
            const bool last = (t == nt - 2);
            const size_t k1 = P.koff(t + 1);
            const size_t k2 = last ? (size_t)0 : P.koff(t + 2), k3 = last ? P.koff(1) : P.koff(t + 3);
            const typename Prob::AState s2 = Prob::sel(last, ns, cs);
            const char* b20 = last ? nB0 : cB0 + (size_t)(t + 2) * kstep; const char* b21 = last ? nB1 : cB1 + (size_t)(t + 2) * kstep;
            const char* b30 = b20 + kstep; const char* b31 = b21 + kstep;
            GM_LDB(B0, 0, 0); GM_SCHED; GM_LDA(At, 0, 0); GM_STAGE_A(GM_SA(1, 1), cs, 1, k1);
            GM_WAIT_L(8); GM_BAR; GM_WAIT_L(0); GM_MMA(0, 0, At, B0); GM_BAR; GM_SCHED;
            GM_LDB(B1, 0, 1); GM_STAGE_B(GM_SB(0, 0), b20);
            GM_BAR; GM_WAIT_L(0); GM_MMA(0, 1, At, B1); GM_BAR;
            GM_LDA(At, 0, 1); GM_STAGE_A(GM_SA(0, 0), s2, 0, k2);
            GM_BAR; GM_WAIT_L(0); GM_MMA(1, 0, At, B0); GM_BAR; GM_SCHED;
            GM_STAGE_B(GM_SB(0, 1), b21);
            GM_WAIT_V(6); GM_BAR; GM_MMA(1, 1, At, B1); GM_BAR;
            GM_LDB(B0, 1, 0); GM_SCHED; GM_LDA(At, 1, 0); GM_STAGE_A(GM_SA(0, 1), s2, 1, k2);
            GM_WAIT_L(8); GM_BAR; GM_WAIT_L(0); GM_MMA(0, 0, At, B0); GM_BAR; GM_SCHED;
            GM_LDB(B1, 1, 1); GM_STAGE_B(GM_SB(1, 0), b30);
            GM_BAR; GM_WAIT_L(0); GM_MMA(0, 1, At, B1); GM_BAR;
            GM_LDA(At, 1, 1); GM_STAGE_A(GM_SA(1, 0), s2, 0, k3);
            GM_BAR; GM_WAIT_L(0); GM_MMA(1, 0, At, B0); GM_BAR; GM_SCHED;
            GM_STAGE_B(GM_SB(1, 1), b31);
            GM_WAIT_V(6); GM_BAR; GM_MMA(1, 1, At, B1); GM_BAR;
        }
        E(acc, cur, wr, wc, fr, fq);
        if (!has_next) break;
#pragma unroll
        for (int a = 0; a < 2; ++a)
#pragma unroll
            for (int b = 0; b < 2; ++b)
#pragma unroll
                for (int m = 0; m < 4; ++m)
#pragma unroll
                    for (int n = 0; n < 2; ++n) acc[a][b][m][n] = (f32x4){0.f, 0.f, 0.f, 0.f};
        cur = nxt; cs = ns; cB0 = nB0; cB1 = nB1; ++ui;
    }
    GM_WAIT_V(0);
    if (wr == 0) GM_BAR;
    GM_BAR;
#undef GM_SA
#undef GM_SB
#undef GM_STAGE_A
#undef GM_STAGE_B
#undef GM_LDA
#undef GM_LDB
#undef GM_MMA
#undef GM_WAIT_V
#undef GM_WAIT_L
#undef GM_BAR
#undef GM_SCHED
}
}


#define XB_TMO      128
#define XB_XCNT(j)  (256  + 64 * (j))
#define XB_XSUB(j)  (1280 + 64 * (j))
#define XB_XGEN(j)  (2304 + 64 * (j))
#define XB_TOP      3328
#define XB_TOPGEN   3392
#define XCD_BAR_WORDS 3456
#define XB_SPIN_CAP (1u << 22)
#define LAS __attribute__((address_space(3)))

__device__ __forceinline__ unsigned xb_ld(unsigned* p)              { return __hip_atomic_load(p, __ATOMIC_RELAXED, __HIP_MEMORY_SCOPE_AGENT); }
__device__ __forceinline__ unsigned xb_add(unsigned* p, unsigned v) { return __hip_atomic_fetch_add(p, v, __ATOMIC_RELAXED, __HIP_MEMORY_SCOPE_AGENT); }
__device__ __forceinline__ unsigned xb_xcc_id() { return (unsigned)__builtin_amdgcn_s_getreg((3 << 11) | 20) & 0xFu; }
#define XB_SPIN(cond, bar) do { unsigned _sp = 0; while (cond) { __builtin_amdgcn_s_sleep(1); \
    if ((++_sp & 255u) == 0u) { if (xb_ld(&(bar)[XB_TMO])) break; if (_sp > XB_SPIN_CAP) { atomicAdd(&(bar)[XB_TMO], 1u); break; } } } } while (0)

struct XcdBarrier {
    unsigned* bar; unsigned x;
    volatile LAS unsigned* st;
};

__device__ __forceinline__ XcdBarrier xcd_barrier_post(unsigned* bar, volatile LAS unsigned* st) {
    XcdBarrier b; b.bar = bar; b.x = xb_xcc_id(); b.st = st;
    if (threadIdx.x == 0) (void)xb_add(&bar[XB_XCNT(b.x)], 1u);
    return b;
}
__device__ __forceinline__ void xcd_barrier_complete(unsigned* bar, unsigned x, unsigned& nloc, unsigned& nx) {
    const unsigned G = gridDim.x * gridDim.y * gridDim.z;
    unsigned sum, cnt, mine, sp = 0u;
    for (;;) {
        sum = 0u; cnt = 0u; mine = 0u;
#pragma unroll
        for (unsigned j = 0; j < 16; ++j) { const unsigned c = xb_ld(&bar[XB_XCNT(j)]); sum += c; cnt += (c > 0u) ? 1u : 0u; mine = (j == x) ? c : mine; }
        if (sum == G) break;
        __builtin_amdgcn_s_sleep(1);
        if ((++sp & 255u) == 0u) { if (xb_ld(&bar[XB_TMO])) break; if (sp > XB_SPIN_CAP) { atomicAdd(&bar[XB_TMO], 1u); break; } }
    }
    nloc = mine > 0u ? mine : 1u; nx = cnt > 0u ? cnt : 1u;
}

__device__ __forceinline__ void xcd_barrier(const XcdBarrier& b) {
    asm volatile("s_waitcnt vmcnt(0)" ::: "memory");
    __syncthreads();
    if (threadIdx.x == 0) {
        unsigned* bar = b.bar;
        __builtin_amdgcn_s_waitcnt(0);
        unsigned nloc = b.st[0], nx = b.st[1];
        if (nloc == 0u) { xcd_barrier_complete(bar, b.x, nloc, nx); b.st[0] = nloc; b.st[1] = nx; }
        const unsigned old = xb_add(&bar[XB_XSUB(b.x)], 1u);
        const unsigned gen = old / nloc;
        if (old + 1u == (gen + 1u) * nloc) {
            __builtin_amdgcn_fence(__ATOMIC_RELEASE, "agent");
            asm volatile("s_waitcnt vmcnt(0)" ::: "memory");
            const unsigned og = xb_add(&bar[XB_TOP], 1u);
            const unsigned tg = og / nx;
            if (og + 1u == (tg + 1u) * nx) xb_add(&bar[XB_TOPGEN], 1u);
            else XB_SPIN(xb_ld(&bar[XB_TOPGEN]) == tg, bar);
            __builtin_amdgcn_fence(__ATOMIC_ACQUIRE, "agent");
            xb_add(&bar[XB_XGEN(b.x)], 1u);
            asm volatile("s_waitcnt vmcnt(0)" ::: "memory");
        } else {
            XB_SPIN(xb_ld(&bar[XB_XGEN(b.x)]) == gen, bar);
            __builtin_amdgcn_fence(__ATOMIC_ACQUIRE, "agent");
            asm volatile("s_waitcnt vmcnt(0)" ::: "memory");
        }
    }
    __syncthreads();
}


struct MP {
    const float* x; const int* positions; const float* ab_w_in; const float* conv_w; const float* conv_b; const float* dt_bias; const float* a_log; const float* ssm_d;
    const float* ssm_norm_w; const float* cmp_pos; const float* cmp_w; const float* ab_w_out; const float* cd_w_in; const float* q_norm_w; const float* w_uq;
    const float* kv_norm_w; const float* w_ukv; const float* lb_logits; const float* hgrn_norm_w; const float* cd_w_out; const float* ln_g; const float* ln_b;
    const float* w_router; const float* router_bias; const float* w_gate; const float* w_up; const float* w_down; const float* sg; const float* su; const float* sd;
    float* out;
    bf16_t* WinABt; bf16_t* WoutABt; bf16_t* WinCDt; bf16_t* WoutCDt; bf16_t* Wuqt; bf16_t* Wukvt; bf16_t* WgT; bf16_t* WuT; bf16_t* WdT;
    bf16_t* hbuf; float* xbc; float* mix; bf16_t* H; bf16_t* Y; bf16_t* mixb; float* bufA; float* bufB; float* x3; bf16_t* xb; bf16_t* cqb; bf16_t* kr; float* kc; float* vc;
    float* rope_tab; bf16_t* kcb; bf16_t* vcT; bf16_t* vselT; bf16_t* vwinT; bf16_t* ksf; bf16_t* kwf; bf16_t* kvfrag; bf16_t* WcmpT; float* cpart; bf16_t* WrT3; int* top_e; float* top_w; int* lpos; int* cnt_tab; int* row_tok; float* row_w; int* row_slot; int* tiles; int* ntiles;
    unsigned* bar;
};

constexpr int NTHR = 512, NWAVE = 8;
constexpr int LDS_BAR_OFF = 135168;
constexpr int LDS_TAB_OFF = LDS_BAR_OFF + 64;
constexpr int LDS_TOTAL = LDS_TAB_OFF + 768 * 8;

DI float wave_sum(float v) {
#pragma unroll
    for (int o = 1; o < 64; o <<= 1) v += __shfl_xor(v, o);
    return v;
}

DI void cvt_wT_range(LAS unsigned char* lds, const float* __restrict__ W, bf16_t* __restrict__ Wt, int K, int N, int Npad, int bid, int nblk, int ntile) {
    const int tix = tid_opaque();
    LAS float* tile = (LAS float*)lds;
    const int tn = Npad / 64, tk = K / 64;
    const int tx = tix & 63, ty = tix >> 6;
    const int wn = tix >> 3, wk = (tix & 7) * 8;
    float cur[8];
    int tp = bid;
    if (tp < ntile) {
        int tq = tp; const int nx = tq % tn; tq /= tn; const int ky = tq % tk; const int bz = tq / tk;
        const float* Wb = W + (size_t)bz * K * N + (size_t)(ky * 64) * N + nx * 64 + tx;
        const bool nin = (nx * 64 + tx) < N;
#pragma unroll
        for (int i = 0; i < 8; ++i) cur[i] = nin ? __builtin_nontemporal_load(Wb + (size_t)(ty + 8 * i) * N) : 0.f;
    }
    for (; tp < ntile; tp += nblk) {
        int tq = tp; const int nx = tq % tn; tq /= tn; const int ky = tq % tk; const int bz = tq / tk;
        const int n0 = nx * 64, k0 = ky * 64;
        bf16_t* Wtb = Wt + (size_t)bz * Npad * K;
#pragma unroll
        for (int i = 0; i < 8; ++i) tile[(ty + 8 * i) * 65 + tx] = cur[i];
        const int tp2 = tp + nblk;
        if (tp2 < ntile) {
            int tq2 = tp2; const int nx2 = tq2 % tn; tq2 /= tn; const int ky2 = tq2 % tk; const int bz2 = tq2 / tk;
            const float* Wb2 = W + (size_t)bz2 * K * N + (size_t)(ky2 * 64) * N + nx2 * 64 + tx;
            const bool nin2 = (nx2 * 64 + tx) < N;
#pragma unroll
            for (int i = 0; i < 8; ++i) cur[i] = nin2 ? __builtin_nontemporal_load(Wb2 + (size_t)(ty + 8 * i) * N) : 0.f;
        }
        __syncthreads();
        u32x4 o;
        o.x = pk_bf16(tile[(wk + 0) * 65 + wn], tile[(wk + 1) * 65 + wn]); o.y = pk_bf16(tile[(wk + 2) * 65 + wn], tile[(wk + 3) * 65 + wn]);
        o.z = pk_bf16(tile[(wk + 4) * 65 + wn], tile[(wk + 5) * 65 + wn]); o.w = pk_bf16(tile[(wk + 6) * 65 + wn], tile[(wk + 7) * 65 + wn]);
        *(u32x4*)(Wtb + (size_t)(n0 + wn) * K + k0 + wk) = o;
        __syncthreads();
    }
}
DI void ph_cvt_wT(LAS unsigned char* lds, const float* __restrict__ W, bf16_t* __restrict__ Wt, int K, int N, int Npad, int batch, int bid, int nblk) {
    cvt_wT_range(lds, W, Wt, K, N, Npad, bid, nblk, (Npad / 64) * (K / 64) * batch);
}
DI void ph_cvt_moe_weights(LAS unsigned char* lds, const MP& p, int layer, int bid, int nblk) {
    const size_t eo = (size_t)layer * 64 * DM * 512, so = (size_t)layer * DM * 512;
    ph_cvt_wT(lds, p.w_gate + eo, p.WgT, DM, 512, 512, 64, bid, nblk); ph_cvt_wT(lds, p.sg + so, p.WgT + (size_t)64 * 512 * DM, DM, 512, 512, 1, bid, nblk);
    ph_cvt_wT(lds, p.w_up + eo, p.WuT, DM, 512, 512, 64, bid, nblk);   ph_cvt_wT(lds, p.su + so, p.WuT + (size_t)64 * 512 * DM, DM, 512, 512, 1, bid, nblk);
    ph_cvt_wT(lds, p.w_down + eo, p.WdT, 512, DM, DM, 64, bid, nblk);  ph_cvt_wT(lds, p.sd + so, p.WdT + (size_t)64 * DM * 512, 512, DM, DM, 1, bid, nblk);
}

struct CvqPos { int nx, ky, bz; };
DI void cvq_adv4(CvqPos& s, int tn, int tk) { s.nx += 4; if (s.nx >= tn) { s.nx = 0; if (++s.ky == tk) { s.ky = 0; ++s.bz; } } }
DI void cvt_wT_quad(LAS unsigned char* lds, const float* __restrict__ W, bf16_t* __restrict__ Wt, int K, int N, int Npad, int t0, int t1) {
    const int tix = tid_opaque();
    const int tn = Npad / 64, tk = K / 64;
    const int tx = tix & 63, ty = tix >> 6;
    const int wn = tix >> 3, wq = tix & 7;
    float ca[4][8], cb[4][8];
#define CVQ_ISSUE(C_, S_) do { \
        _Pragma("unroll") for (int j = 0; j < 4; ++j) { \
            const int cn = (S_.nx + j) * 64 < N ? (S_.nx + j) * 64 : 0;        \
            const float* Wb = W + (size_t)S_.bz * K * N + (size_t)(S_.ky * 64 + 2 * ty) * N + cn + tx; \
            _Pragma("unroll") for (int i = 0; i < 4; ++i) { C_[j][2 * i] = __builtin_nontemporal_load(Wb + (size_t)(16 * i) * N); C_[j][2 * i + 1] = __builtin_nontemporal_load(Wb + (size_t)(16 * i + 1) * N); } } } while (0)
#define CVQ_STEP(C_, S_, BUF_, ISSUE_) do { \
        LAS unsigned* tile = (LAS unsigned*)lds + (BUF_) * (4 * 2080); \
        const CvqPos cur_ = S_; \
        _Pragma("unroll") for (int j = 0; j < 4; ++j) { \
            if ((cur_.nx + j) * 64 >= N) { _Pragma("unroll") for (int i = 0; i < 8; ++i) C_[j][i] = 0.f; } \
            _Pragma("unroll") for (int i = 0; i < 4; ++i) tile[j * 2080 + (ty + 8 * i) * 65 + tx] = pk_bf16(C_[j][2 * i], C_[j][2 * i + 1]); } \
        if (ISSUE_) { cvq_adv4(S_, tn, tk); cvq_adv4(S_, tn, tk); CVQ_ISSUE(C_, S_); } \
        __syncthreads(); \
        _Pragma("unroll") for (int j = 0; j < 4; ++j) { \
            const LAS unsigned* tl = tile + j * 2080 + (4 * wq) * 65 + wn; \
            u32x4 o; o.x = tl[0]; o.y = tl[65]; o.z = tl[130]; o.w = tl[195]; \
            __builtin_nontemporal_store(o, (u32x4*)(Wt + (size_t)cur_.bz * Npad * K + (size_t)((cur_.nx + j) * 64 + wn) * K + cur_.ky * 64 + 8 * wq));        \
        } } while (0)
    CvqPos sa, sb;
    { int tq = t0; sa.nx = tq % tn; tq /= tn; sa.ky = tq % tk; sa.bz = tq / tk; sb = sa; cvq_adv4(sb, tn, tk); }
    CVQ_ISSUE(ca, sa); CVQ_ISSUE(cb, sb);
    int tp = t0;
    for (; tp + 8 < t1; tp += 8) {
        CVQ_STEP(ca, sa, 0, true);
        CVQ_STEP(cb, sb, 1, true);
    }
    CVQ_STEP(ca, sa, 0, false);
    CVQ_STEP(cb, sb, 1, false);
    __syncthreads();
#undef CVQ_STEP
#undef CVQ_ISSUE
}
constexpr int CVQ_NG = 208;
constexpr int CVQ_SEG_E = 64 * 256, CVQ_SEG_S = 256, CVQ_BATCH = 32, CVQ_MOE_TILES = 3 * (CVQ_SEG_E + CVQ_SEG_S);
constexpr int CVQ_X0 = (9472 / 64) * (DM / 64), CVQ_X1 = (DM / 64) * (4096 / 64), CVQ_X2 = (3072 / 64) * (512 / 64), CVQ_X3 = (4096 / 64) * (512 / 64), CVQ_X4 = CVQ_X1, CVQ_X5 = 2 * (256 / 64) * (4096 / 64);
constexpr int CVQ_XTRA = CVQ_X0 + CVQ_X1 + CVQ_X2 + CVQ_X3 + CVQ_X4 + CVQ_X5;
static_assert(CVQ_X0 % CVQ_BATCH == 0 && CVQ_X1 % CVQ_BATCH == 0 && CVQ_X2 % CVQ_BATCH == 0 && CVQ_X3 % CVQ_BATCH == 0 && CVQ_X5 % CVQ_BATCH == 0 && CVQ_SEG_S % CVQ_BATCH == 0, "batches must not straddle matrices");
DI void moe_cvt_queue(LAS unsigned char* lds, const MP& p, int layer, unsigned* ctr) {
    const size_t eo = (size_t)layer * 64 * DM * 512, so = (size_t)layer * DM * 512;
    volatile LAS int* slot = (volatile LAS int*)(lds + LDS_BAR_OFF + 32);
    const int nbatch = (CVQ_MOE_TILES + (layer == 0 ? CVQ_XTRA : 0)) / CVQ_BATCH;
    asm volatile("s_waitcnt vmcnt(0)" ::: "memory");
    for (;;) {
        __syncthreads();
        if (threadIdx.x == 0) *slot = (int)__hip_atomic_fetch_add(ctr, 1u, __ATOMIC_RELAXED, __HIP_MEMORY_SCOPE_AGENT);
        __syncthreads();
        const int bt = __builtin_amdgcn_readfirstlane(*slot);
        if (bt >= nbatch) break;
        int g = bt * CVQ_BATCH;
        const float* W; bf16_t* Wt; int K, N, Npad;
        if (g < CVQ_MOE_TILES) {
            const int m = g / (CVQ_SEG_E + CVQ_SEG_S); g -= m * (CVQ_SEG_E + CVQ_SEG_S);
            const bool sh = g >= CVQ_SEG_E; if (sh) g -= CVQ_SEG_E;
            W = (m == 0) ? (sh ? p.sg + so : p.w_gate + eo) : (m == 1) ? (sh ? p.su + so : p.w_up + eo) : (sh ? p.sd + so : p.w_down + eo);
            Wt = ((m == 0) ? p.WgT : (m == 1) ? p.WuT : p.WdT) + (sh ? (size_t)64 * 512 * DM : (size_t)0);
            K = (m == 2) ? 512 : DM; N = (m == 2) ? DM : 512; Npad = N;
        } else {
            g -= CVQ_MOE_TILES;
            if (g < CVQ_X0) { W = p.cd_w_in; Wt = p.WinCDt; K = DM; N = CD_IN; Npad = 9472; }
            else if ((g -= CVQ_X0) < CVQ_X1) { W = p.cd_w_out; Wt = p.WoutCDt; K = 4096; N = DM; Npad = DM; }
            else if ((g -= CVQ_X1) < CVQ_X2) { W = p.w_uq; Wt = p.Wuqt; K = 512; N = 3072; Npad = 3072; }
            else if ((g -= CVQ_X2) < CVQ_X3) { W = p.w_ukv; Wt = p.Wukvt; K = 512; N = 4096; Npad = 4096; }
            else if ((g -= CVQ_X3) < CVQ_X4) { W = p.ab_w_out; Wt = p.WoutABt; K = 4096; N = DM; Npad = DM; }
            else { g -= CVQ_X4; W = p.cmp_w; Wt = p.WcmpT; K = 4096; N = 128; Npad = 256; }
        }
        cvt_wT_quad(lds, W, Wt, K, N, Npad, g, g + CVQ_BATCH);
    }
    __syncthreads();
}

DI void ph_cvt_x(const MP& p) {
    const int tix = tid_opaque();
    const long gt = (long)blockIdx.x * NTHR + tix, gs = (long)gridDim.x * NTHR;
    for (long i = gt; i < (long)T_TOK * DM / 4; i += gs) { const f32x4 v = __builtin_nontemporal_load((const f32x4*)p.x + i); u32x2 o; o.x = pk_bf16(v[0], v[1]); o.y = pk_bf16(v[2], v[3]); ((u32x2*)p.xb)[i] = o; }
    for (long i = gt; i < DM / 2; i += gs) ((unsigned*)(p.xb + (size_t)T_TOK * DM))[i] = 0u;
}


DI void ph_ssd_norm(const MP& p) {
    const int tix = tid_opaque();
    const int lane = tix & 63, gw = blockIdx.x * NWAVE + (tix >> 6), nw = gridDim.x * NWAVE;
    const bf16_t* mixh = (const bf16_t*)p.mix;
    u32x2 nv[8];
    if (gw < T_TOK) {
#pragma unroll
        for (int j = 0; j < 8; ++j) nv[j] = __builtin_nontemporal_load((const u32x2*)(mixh + (long)gw * 4096 + j * 256 + lane * 4));
    }
    for (int row = gw; row < T_TOK; row += nw) {
        float4 v[8]; float ss = 0.f;
#pragma unroll
        for (int j = 0; j < 8; ++j) { v[j].x = bflo(nv[j].x); v[j].y = bfhi(nv[j].x); v[j].z = bflo(nv[j].y); v[j].w = bfhi(nv[j].y); ss += v[j].x * v[j].x + v[j].y * v[j].y + v[j].z * v[j].z + v[j].w * v[j].w; }
        if (row + nw < T_TOK) {
#pragma unroll
            for (int j = 0; j < 8; ++j) nv[j] = __builtin_nontemporal_load((const u32x2*)(mixh + (long)(row + nw) * 4096 + j * 256 + lane * 4));
        }
        const float r = rsqrtf(wave_sum(ss) / 2048.f + 1e-6f);
#pragma unroll
        for (int j = 0; j < 8; ++j) { const float4 w = *(const float4*)(p.ssm_norm_w + j * 256 + lane * 4);
            u32x2 o; o.x = pk_bf16(v[j].x * r * w.x, v[j].y * r * w.y); o.y = pk_bf16(v[j].z * r * w.z, v[j].w * r * w.w);
            *(u32x2*)(p.mixb + (long)row * 4096 + j * 256 + lane * 4) = o; }
    }
}

DI void ph_build_wr(const MP& p) {
    const int tix = tid_opaque();
    const long gt = (long)blockIdx.x * NTHR + tix, gs = (long)gridDim.x * NTHR;
    for (long idx = gt; idx < (long)2 * 256 * 4096; idx += gs) {
        const int k = (int)(idx & 4095), n = (int)((idx >> 12) & 255), layer = (int)(idx >> 20);
        float v = 0.f;
        if (n < 128) {
            const float wv = p.w_router[((size_t)layer * DM + (k & 2047)) * 64 + (n & 63)];
            const float hi = bf2f(f2bf(wv));
            if (n < 64) v = hi; else v = (k < 2048) ? (wv - hi) : 0.f;
        }
        p.WrT3[idx] = f2bf(v);
    }
}
template <bool XBF> DI void ph_ln(const MP& p, const void* xin_, const bf16_t* add, const float* gg, const float* bb, bf16_t* xob, bf16_t* xlo) {
    const int tix = tid_opaque();
    const int lane = tix & 63, gw = blockIdx.x * NWAVE + (tix >> 6), nw = gridDim.x * NWAVE;
    float4 na[8]; u32x2 nc[8];
    const float* xin = (const float*)xin_; const bf16_t* xinb = (const bf16_t*)xin_;
#define LN_LOADX(row_, j_) do { if constexpr (XBF) { const u32x2 h_ = __builtin_nontemporal_load((const u32x2*)(xinb + (long)(row_) * DM + (j_) * 256 + lane * 4)); na[j_] = make_float4(bflo(h_.x), bfhi(h_.x), bflo(h_.y), bfhi(h_.y)); } \
        else { const f32x4 f_ = __builtin_nontemporal_load((const f32x4*)(xin + (long)(row_) * DM + (j_) * 256 + lane * 4)); na[j_] = make_float4(f_[0], f_[1], f_[2], f_[3]); } } while (0)
    if (gw < T_TOK) {
#pragma unroll
        for (int j = 0; j < 8; ++j) { LN_LOADX(gw, j); nc[j] = __builtin_nontemporal_load((const u32x2*)(add + (long)gw * DM + j * 256 + lane * 4)); }
    }
    for (int t = gw; t < T_TOK; t += nw) {
        float4 v[8]; float s = 0.f;
#pragma unroll
        for (int j = 0; j < 8; ++j) { const float4 a = na[j]; const u32x2 c = nc[j];
            v[j].x = DN_ALPHA * a.x + bflo(c.x); v[j].y = DN_ALPHA * a.y + bfhi(c.x); v[j].z = DN_ALPHA * a.z + bflo(c.y); v[j].w = DN_ALPHA * a.w + bfhi(c.y); s += (v[j].x + v[j].y) + (v[j].z + v[j].w); }
        if (t + nw < T_TOK) {
#pragma unroll
            for (int j = 0; j < 8; ++j) { LN_LOADX(t + nw, j); nc[j] = __builtin_nontemporal_load((const u32x2*)(add + (long)(t + nw) * DM + j * 256 + lane * 4)); }
        }
        const float mu = wave_sum(s) / DM;
        float q = 0.f;
#pragma unroll
        for (int j = 0; j < 8; ++j) { v[j].x -= mu; v[j].y -= mu; v[j].z -= mu; v[j].w -= mu; q += v[j].x * v[j].x + v[j].y * v[j].y + v[j].z * v[j].z + v[j].w * v[j].w; }
        const float rs = rsqrtf(wave_sum(q) / DM + 1e-5f);
#pragma unroll
        for (int j = 0; j < 8; ++j) { const int c0 = j * 256 + lane * 4; const float4 g4 = *(const float4*)(gg + c0), b4 = *(const float4*)(bb + c0);
            float4 o; o.x = v[j].x * rs * g4.x + b4.x; o.y = v[j].y * rs * g4.y + b4.y; o.z = v[j].z * rs * g4.z + b4.z; o.w = v[j].w * rs * g4.w + b4.w;
            u32x2 hb; hb.x = pk_bf16(o.x, o.y); hb.y = pk_bf16(o.z, o.w); *(u32x2*)(xob + (long)t * DM + c0) = hb;
            u32x2 lb2; lb2.x = pk_bf16(o.x - bflo(hb.x), o.y - bfhi(hb.x)); lb2.y = pk_bf16(o.z - bflo(hb.y), o.w - bfhi(hb.y)); *(u32x2*)(xlo + (long)t * DM + c0) = lb2; }
    }
}
#undef LN_LOADX
DI void ph_route_select(const MP& p, const float* Cpart, const float* rbias) {
    const int tix = tid_opaque();
    const int lane = tix & 63, gw = blockIdx.x * NWAVE + (tix >> 6), nw = gridDim.x * NWAVE;
    const float bias = rbias[lane];
    const int grp = lane >> 3;
    for (int slot = gw; slot < MOE_NSLOT; slot += nw) {
        int cnt = 0;
        for (int i = 0; i < MOE_SLOT_TOK; ++i) {
            const int t = slot * MOE_SLOT_TOK + i;
            float logit = 0.f;
#pragma unroll
            for (int q = 0; q < 4; ++q) { const float* cp = Cpart + ((size_t)q * T_TOK + t) * 128; logit += cp[lane] + cp[64 + lane]; }
            if (!(logit == logit)) logit = 0.f;
            const float score = 1.f / (1.f + expf(-logit));
            const float biased = score + bias;
            float m1 = biased;
            m1 = fmaxf(m1, __shfl_xor(m1, 1)); m1 = fmaxf(m1, __shfl_xor(m1, 2)); m1 = fmaxf(m1, __shfl_xor(m1, 4));
            const unsigned long long bm = __ballot(biased == m1);
            const unsigned gb = (unsigned)((bm >> (8 * grp)) & 0xffull);
            const int first = __ffs(gb) - 1;
            float v2 = ((lane & 7) == first) ? -3.0e38f : biased;
            v2 = fmaxf(v2, __shfl_xor(v2, 1)); v2 = fmaxf(v2, __shfl_xor(v2, 2)); v2 = fmaxf(v2, __shfl_xor(v2, 4));
            const float gs = m1 + v2;
            int grank = 0;
#pragma unroll
            for (int g2 = 0; g2 < 8; ++g2) { const float o = __shfl(gs, g2 * 8); grank += (o > gs || (o == gs && g2 < grp)) ? 1 : 0; }
            const bool gsel = grank < 4;
            const float masked = gsel ? biased : -3.0e38f;
            int erank = 0;
            for (int e2 = 0; e2 < 64; ++e2) { const float o = __shfl(masked, e2); erank += (o > masked || (o == masked && e2 < lane)) ? 1 : 0; }
            const bool selected = gsel && erank < 8;
            const float ws = wave_sum(selected ? score : 0.f);
            if (selected) { p.top_e[t * 8 + erank] = lane; p.top_w[t * 8 + erank] = score / ws * 2.5f; p.lpos[t * 8 + erank] = cnt; ++cnt; }
        }
        p.cnt_tab[slot * 64 + lane] = cnt;
    }
}
DI void ph_router_gemm(LAS unsigned char* lds, const MP& p, int layer, float* Cpart, const bf16_t* xlo) {
    gm::RouterProb q; q.xhi = (const char*)p.xb; q.dlo = (long)((const char*)xlo - (const char*)p.xb); q.Bt = (const char*)(p.WrT3 + (size_t)layer * 256 * 4096); q.K = 1024; q.G = (int)gridDim.x; q.c = (int)blockIdx.x; q.ldb = 4096;
    gm::EpiRouter e; e.Cpart = Cpart;
    gm::gemm_phase(lds, q, e);
}

DI void ph_moe_scan(LAS unsigned char* lds, const MP& p) {
    const int tix = tid_opaque();
    LAS int* part_b = (LAS int*)lds;
    LAS int* part_a = part_b + 512;
    LAS int* total = part_a + 512; LAS int* base = total + 64; LAS int* pre = base + 64; LAS int* pc = pre + 64;
    const int tid = tix, e = tid & 63, part = tid >> 6;
    const int spb = (MOE_NSLOT + gridDim.x - 1) / gridDim.x;
    const int s0 = blockIdx.x * spb, s1 = min(MOE_NSLOT, s0 + spb);
    int sb = 0, sa = 0;
#pragma unroll 16
    for (int sl = part; sl < MOE_NSLOT; sl += NWAVE) { const int c = p.cnt_tab[sl * 64 + e]; sa += c; if (sl < s0) sb += c; }
    part_b[part * 64 + e] = sb; part_a[part * 64 + e] = sa;
    __syncthreads();
    if (tid < 64) {
        int ta = 0, tb = 0;
#pragma unroll
        for (int i = 0; i < NWAVE; ++i) { ta += part_a[i * 64 + tid]; tb += part_b[i * 64 + tid]; }
        total[tid] = ta; pre[tid] = tb; pc[tid] = (ta + MOE_TM - 1) / MOE_TM * MOE_TM;
    }
    __syncthreads();
    LAS int* ubase = pc + 64 + 512;
    if (tid == 0) { int a = 0, ua = 0; for (int i = 0; i < 64; ++i) { base[i] = a; a += pc[i]; ubase[i] = ua; ua += total[i]; } }
    __syncthreads();
    if (spb <= 8) {
        LAS int* cl = pc + 64;
        const int sll = tid >> 6;
        cl[tid] = (s0 + sll < s1) ? p.cnt_tab[(s0 + sll) * 64 + e] : 0;
        __syncthreads();
        if (tid < 64) { int run = pre[tid]; for (int i = 0; i < 8; ++i) { const int c = cl[i * 64 + tid]; cl[i * 64 + tid] = run; run += c; } }
        __syncthreads();
        if (s0 + sll < s1) {
            const int a = tid & 63; const int t = (s0 + sll) * MOE_SLOT_TOK + (a >> 3), k = a & 7;
            const int ex = p.top_e[t * 8 + k] & 63;
            const int pp = base[ex] + cl[sll * 64 + ex] + p.lpos[t * 8 + k];
            if (pp >= 0 && pp < MOE_PMAX) { p.row_tok[pp] = t; p.row_slot[t * 8 + k] = pp - (base[ex] - ubase[ex]); }
        }
    } else
    for (int sl = s0; sl < s1; ++sl) {
        if (tid < 64) {
            const int t = sl * MOE_SLOT_TOK + (tid >> 3), k = tid & 7;
            const int ex = p.top_e[t * 8 + k] & 63;
            const int pp = base[ex] + pre[ex] + p.lpos[t * 8 + k];
            if (pp >= 0 && pp < MOE_PMAX) { p.row_tok[pp] = t; p.row_slot[t * 8 + k] = pp - (base[ex] - ubase[ex]); }
        }
        __syncthreads();
        if (tid < 64) pre[tid] += p.cnt_tab[sl * 64 + tid];
        __syncthreads();
    }
    for (int ex = blockIdx.x; ex < 64; ex += gridDim.x)
        for (int pp = base[ex] + total[ex] + tid; pp < base[ex] + pc[ex]; pp += NTHR) p.row_tok[pp] = -1;
    for (int i = blockIdx.x * NTHR + tid; i < T_TOK; i += gridDim.x * NTHR) p.row_tok[MOE_PMAX + i] = i;
    if (blockIdx.x == 0 && tid < 64) {
        const int ex = tid, nt = pc[ex] / MOE_TM, t0 = base[ex] / MOE_TM;
        for (int j = 0; j < nt; ++j) { p.tiles[(t0 + j) * 4 + 0] = ex; p.tiles[(t0 + j) * 4 + 1] = base[ex] + j * MOE_TM; p.tiles[(t0 + j) * 4 + 2] = min(MOE_TM, total[ex] - j * MOE_TM); p.tiles[(t0 + j) * 4 + 3] = base[ex] - ubase[ex]; }
        const int nr = (base[63] + pc[63]) / MOE_TM;
        if (ex == 63) *p.ntiles = nr + T_TOK / MOE_TM;
        for (int j = ex; j < T_TOK / MOE_TM; j += 64) { p.tiles[(nr + j) * 4 + 0] = 64; p.tiles[(nr + j) * 4 + 1] = MOE_PMAX + j * MOE_TM; p.tiles[(nr + j) * 4 + 2] = MOE_TM; p.tiles[(nr + j) * 4 + 3] = MOE_PMAX - T_TOK * 8; }
    }
    __syncthreads();
}

DI void ph_moe_combine_ln(const MP& p, const bf16_t* xhi, const bf16_t* xlo, const float* gg, const float* bb, float* out, bf16_t* ob) {
    const int tix = tid_opaque();
    const int lane = tix & 63, gw = blockIdx.x * NWAVE + (tix >> 6), nw = gridDim.x * NWAVE;
    int myslot = 0; float myw = 0.f;
    { const long rr = (long)gw + (long)(lane >> 3) * nw; if (rr < T_TOK) { myslot = p.row_slot[rr * 8 + (lane & 7)]; myw = p.top_w[rr * 8 + (lane & 7)]; } }
    int ri = 0;
    for (int row = gw; row < T_TOK; row += nw, ++ri) {
        if (ri == 8) { ri = 0; const long rr = (long)row + (long)(lane >> 3) * nw; if (rr < T_TOK) { myslot = p.row_slot[rr * 8 + (lane & 7)]; myw = p.top_w[rr * 8 + (lane & 7)]; } }
        float v[32];
#pragma unroll
        for (int j = 0; j < 4; ++j) { const u32x4 a = __builtin_nontemporal_load((const u32x4*)(xhi + (long)row * DM + j * 512 + lane * 8)), b = __builtin_nontemporal_load((const u32x4*)(xlo + (long)row * DM + j * 512 + lane * 8));
            v[j * 8 + 0] = DN_ALPHA * (bflo(a.x) + bflo(b.x)); v[j * 8 + 1] = DN_ALPHA * (bfhi(a.x) + bfhi(b.x)); v[j * 8 + 2] = DN_ALPHA * (bflo(a.y) + bflo(b.y)); v[j * 8 + 3] = DN_ALPHA * (bfhi(a.y) + bfhi(b.y));
            v[j * 8 + 4] = DN_ALPHA * (bflo(a.z) + bflo(b.z)); v[j * 8 + 5] = DN_ALPHA * (bfhi(a.z) + bfhi(b.z)); v[j * 8 + 6] = DN_ALPHA * (bflo(a.w) + bflo(b.w)); v[j * 8 + 7] = DN_ALPHA * (bfhi(a.w) + bfhi(b.w)); }
#pragma unroll 3
        for (int k = 0; k < 9; ++k) {
            const size_t yr = (k < 8) ? (size_t)__builtin_amdgcn_readfirstlane(__shfl(myslot, ri * 8 + (k & 7))) : (size_t)((long)T_TOK * 8 + row);
            const float wk = (k < 8) ? __shfl(myw, ri * 8 + (k & 7)) : 1.f;
#pragma unroll
            for (int j = 0; j < 4; ++j) { const u32x4 y = __builtin_nontemporal_load((const u32x4*)(p.Y + yr * 2048 + j * 512 + lane * 8));
                v[j * 8 + 0] += wk * bflo(y.x); v[j * 8 + 1] += wk * bfhi(y.x); v[j * 8 + 2] += wk * bflo(y.y); v[j * 8 + 3] += wk * bfhi(y.y);
                v[j * 8 + 4] += wk * bflo(y.z); v[j * 8 + 5] += wk * bfhi(y.z); v[j * 8 + 6] += wk * bflo(y.w); v[j * 8 + 7] += wk * bfhi(y.w); }
        }
        float s = 0.f;
#pragma unroll
        for (int i = 0; i < 32; ++i) s += v[i];
        const float mu = wave_sum(s) / DM;
        float q = 0.f;
#pragma unroll
        for (int i = 0; i < 32; ++i) { v[i] -= mu; q += v[i] * v[i]; }
        const float rs = rsqrtf(wave_sum(q) / DM + 1e-5f);
#pragma unroll
        for (int j = 0; j < 4; ++j) { const int c0 = j * 512 + lane * 8;
            float o8[8];
#pragma unroll
            for (int i = 0; i < 8; ++i) o8[i] = v[j * 8 + i] * rs * gg[c0 + i] + bb[c0 + i];
            if (out) { *(float4*)(out + (long)row * DM + c0) = make_float4(o8[0], o8[1], o8[2], o8[3]);
                       *(float4*)(out + (long)row * DM + c0 + 4) = make_float4(o8[4], o8[5], o8[6], o8[7]); }
            if (ob) { u32x4 pk; pk.x = pk_bf16(o8[0], o8[1]); pk.y = pk_bf16(o8[2], o8[3]); pk.z = pk_bf16(o8[4], o8[5]); pk.w = pk_bf16(o8[6], o8[7]); *(u32x4*)(ob + (long)row * DM + c0) = pk; } }
    }
}

DI void ph_mla_rms(const MP& p) {
    const int tix = tid_opaque();
    const int lane = tix & 63, gw = blockIdx.x * NWAVE + (tix >> 6), nw = gridDim.x * NWAVE;
    for (int u = gw; u < T_TOK * 2; u += nw) {
        const int row = u >> 1, which = u & 1;
        const bf16_t* src = p.hbuf + (long)row * CD_IN + which * 512 + lane * 8;
        const u32x4 y = *(const u32x4*)src;
        float v[8] = {bflo(y.x), bfhi(y.x), bflo(y.y), bfhi(y.y), bflo(y.z), bfhi(y.z), bflo(y.w), bfhi(y.w)};
        float ss = 0.f;
#pragma unroll
        for (int i = 0; i < 8; ++i) ss += v[i] * v[i];
        const float r = rsqrtf(wave_sum(ss) / 512.f + 1e-6f);
        const float* w = (which ? p.kv_norm_w : p.q_norm_w) + lane * 8;
        u32x4 o; o.x = pk_bf16(v[0] * r * w[0], v[1] * r * w[1]); o.y = pk_bf16(v[2] * r * w[2], v[3] * r * w[3]); o.z = pk_bf16(v[4] * r * w[4], v[5] * r * w[5]); o.w = pk_bf16(v[6] * r * w[6], v[7] * r * w[7]);
        *(u32x4*)(p.cqb + (long)row * 1024 + which * 512 + lane * 8) = o;
    }
}
DI void ph_rope_k(const MP& p) {
    const int tix = tid_opaque();
    const long gt = (long)blockIdx.x * NTHR + tix, gs = (long)gridDim.x * NTHR;
    for (long idx = gt; idx < (long)T_TOK * 32; idx += gs) {
        const int j = (int)(idx & 31); const int t = (int)(idx >> 5);
        const float inv = powf(10000.f, -(float)(2 * j) / 64.f);
        const float ang = (float)p.positions[t] * inv;
        const float c = cosf(ang), sn = sinf(ang);
        const bf16_t* pp = p.hbuf + (long)t * CD_IN + CD_KR;
        const float t1 = ldh(pp, j), t2 = ldh(pp, j + 32);
        { const int b = t >> 11, sq = t & 2047; const size_t tb = ((size_t)b * 64 + (sq >> 5)) * 4; const int r = sq & 31;
          p.kr[(tb + (j >> 4)) * 512 + (((j >> 3) & 1) * 32 + r) * 8 + (j & 7)] = f2bf(t1 * c - t2 * sn);
          p.kr[(tb + ((j + 32) >> 4)) * 512 + ((((j + 32) >> 3) & 1) * 32 + r) * 8 + (j & 7)] = f2bf(t1 * sn + t2 * c); }
        *(float2*)(p.rope_tab + ((long)t * 32 + j) * 2) = make_float2(c, sn);
    }
}
DI void ph_hgrn_post(const MP& p) {
    const int tix = tid_opaque();
    const int lane = tix & 63, gw = blockIdx.x * NWAVE + (tix >> 6), nw = gridDim.x * NWAVE;
    for (int t = gw; t < T_TOK; t += nw) {
#pragma unroll
        for (int j = 0; j < 4; ++j) {
            const int col = j * 512 + lane * 8;
            const f32x4 a_ = __builtin_nontemporal_load((const f32x4*)(p.x3 + (long)t * 2048 + col)), c_ = __builtin_nontemporal_load((const f32x4*)(p.x3 + (long)t * 2048 + col + 4));
            const float4 a = make_float4(a_[0], a_[1], a_[2], a_[3]), c = make_float4(c_[0], c_[1], c_[2], c_[3]);
            float ss = a.x * a.x + a.y * a.y + a.z * a.z + a.w * a.w + c.x * c.x + c.y * c.y + c.z * c.z + c.w * c.w;
            ss += __shfl_xor(ss, 1); ss += __shfl_xor(ss, 2); ss += __shfl_xor(ss, 4); ss += __shfl_xor(ss, 8);
            const float r = rsqrtf(ss / 128.f + 1e-6f);
            const u32x4 gv = __builtin_nontemporal_load((const u32x4*)(p.hbuf + (long)t * CD_IN + CD_HG + col));
            const float4 w0 = *(const float4*)(p.hgrn_norm_w + (col & 127)), w1 = *(const float4*)(p.hgrn_norm_w + (col & 127) + 4);
            u32x4 o;
            o.x = pk_bf16(a.x * r * w0.x * siluf_(bflo(gv.x)), a.y * r * w0.y * siluf_(bfhi(gv.x)));
            o.y = pk_bf16(a.z * r * w0.z * siluf_(bflo(gv.y)), a.w * r * w0.w * siluf_(bfhi(gv.y)));
            o.z = pk_bf16(c.x * r * w1.x * siluf_(bflo(gv.z)), c.y * r * w1.y * siluf_(bfhi(gv.z)));
            o.w = pk_bf16(c.z * r * w1.z * siluf_(bflo(gv.w)), c.w * r * w1.w * siluf_(bfhi(gv.w)));
            *(u32x4*)(p.mixb + (long)t * 4096 + 2048 + col) = o;
        }
    }
}


typedef float f32x16 __attribute__((ext_vector_type(16)));
#define MFMA32(a, b, c) __builtin_amdgcn_mfma_f32_32x32x16_bf16((a), (b), (c), 0, 0, 0)
DI bf16x8 ld8(const bf16_t* q) { return *(const bf16x8*)q; }
DI size_t lnd(size_t v) { asm volatile("" : "+v"(v)); return v; }
DI const bf16_t* launder(const bf16_t* q) { asm volatile("" : "+v"(q)); return q; }
DI bf16x8 pack8(float a0, float a1, float a2, float a3, float a4, float a5, float a6, float a7) {
    u32x4 u; u.x = pk_bf16(a0, a1); u.y = pk_bf16(a2, a3); u.z = pk_bf16(a4, a5); u.w = pk_bf16(a6, a7); return __builtin_bit_cast(bf16x8, u);
}
DI void ph_mla_attn(LAS unsigned char* lds, const MP& p) {
    const int tix = tid_opaque();
    const int w = tix >> 6, lane = tix & 63, r = lane & 31, hh = lane >> 5;
    const bf16_t* qm = (const bf16_t*)p.xbc;
    const bf16_t* kfr = (const bf16_t*)p.kvfrag;
    const bf16_t* vfr = kfr + (size_t)T_TOK * 2048;
    const float sc2 = 0.07216878364870322f * 1.4426950408889634f;
    constexpr int SLOT = 20 * 1024;
    for (int unit = blockIdx.x; unit < NB * 16 * 4; unit += gridDim.x) {
        const int pair = unit & 3, head = (unit >> 2) & 15, b = unit >> 6;
        const bf16_t* g0 = kfr + (((size_t)(b * 16 + head) * 64) * 8 + w) * 512 + lane * 8;
        const bf16_t* g1 = (w < 4) ? p.kr + (((size_t)b * 64) * 4 + w) * 512 + lane * 8
                                   : vfr + (((size_t)(b * 16 + head) * 64) * 8 + (w - 4)) * 512 + lane * 8;
        const size_t g1step = (w < 4) ? 2048 : 4096;
        const bf16_t* g2 = vfr + (((size_t)(b * 16 + head) * 64) * 8 + 4 + (w & 3)) * 512 + lane * 8;
        const unsigned l0 = (unsigned)w * 1024u, l1 = (unsigned)(8 + w) * 1024u, l2 = (unsigned)(16 + (w & 3)) * 1024u;
#define MLA_DMA(kt_, slot_) do { LAS unsigned char* sb_ = lds + (slot_) * SLOT; \
        __builtin_amdgcn_global_load_lds((const unsigned*)(g0 + (size_t)(kt_) * 4096), (LAS unsigned*)(sb_ + l0), 16, 0, 0); \
        __builtin_amdgcn_global_load_lds((const unsigned*)(g1 + (size_t)(kt_) * g1step), (LAS unsigned*)(sb_ + l1), 16, 0, 0); \
        __builtin_amdgcn_global_load_lds((const unsigned*)(g2 + (size_t)(kt_) * 4096), (LAS unsigned*)(sb_ + l2), 16, 0, 0); } while (0)
        for (int half = 0; half < 2; ++half) {
            const int qb = half ? 7 - pair : pair;
            const int row0 = qb * 256 + 32 * w;
            const long tq = (long)b * SEQ + row0 + r;
            bf16x8 qf[12];
#pragma unroll
            for (int st = 0; st < 12; ++st) qf[st] = ld8(qm + tq * 3072 + head * 192 + 16 * st + 8 * hh);
#pragma unroll
            for (int g2i = 0; g2i < 2; ++g2i) {
                float o1[8], o2[8];
#pragma unroll
                for (int j = 0; j < 8; ++j) {
                    const float2 cs = *(const float2*)(p.rope_tab + (tq * 32 + 16 * g2i + 8 * hh + j) * 2);
                    const float t1 = bf2f((bf16_t)qf[8 + g2i][j]), t2 = bf2f((bf16_t)qf[10 + g2i][j]);
                    o1[j] = t1 * cs.x - t2 * cs.y; o2[j] = t1 * cs.y + t2 * cs.x;
                }
                qf[8 + g2i] = pack8(o1[0], o1[1], o1[2], o1[3], o1[4], o1[5], o1[6], o1[7]);
                qf[10 + g2i] = pack8(o2[0], o2[1], o2[2], o2[3], o2[4], o2[5], o2[6], o2[7]);
            }
            f32x16 O[4];
#pragma unroll
            for (int dt = 0; dt < 4; ++dt)
#pragma unroll
                for (int i = 0; i < 16; ++i) O[dt][i] = 0.f;
            float m = -INFINITY, l = 0.f;
            const int ktd = row0 >> 5;
            const int nt = qb * 8 + 8;
            asm volatile("s_waitcnt vmcnt(0)" ::: "memory");
            __syncthreads();
            MLA_DMA(0, 0); MLA_DMA(1, 1);
            for (int kt = 0; kt < nt; ++kt) {
                asm volatile("s_waitcnt vmcnt(3)" ::: "memory");
                __builtin_amdgcn_s_barrier();
                { const int kn2 = (kt + 2 < nt) ? kt + 2 : kt; MLA_DMA(kn2, (kt + 2) % 3); }
                if (kt <= ktd) {
                    const LAS unsigned char* sb = lds + (kt % 3) * SLOT + lane * 16;
                    bf16x8 kfr[12];
#pragma unroll
                    for (int st = 0; st < 12; ++st) kfr[st] = *(const LAS bf16x8*)(sb + st * 1024);
                    __builtin_amdgcn_sched_barrier(0);
                    f32x16 S, S2;
#pragma unroll
                    for (int i = 0; i < 16; ++i) { S[i] = 0.f; S2[i] = 0.f; }
#pragma unroll
                    for (int st = 0; st < 12; st += 2) { S = MFMA32(kfr[st], qf[st], S); S2 = MFMA32(kfr[st + 1], qf[st + 1], S2); }
                    bf16x8 vfr[8];
#pragma unroll
                    for (int f = 0; f < 8; ++f) vfr[f] = *(const LAS bf16x8*)(sb + (12 + f) * 1024);
                    __builtin_amdgcn_sched_barrier(0);
#pragma unroll
                    for (int i = 0; i < 16; ++i) S[i] += S2[i];
                    if (kt == ktd) {
#pragma unroll
                        for (int i = 0; i < 16; ++i) if (((i & 3) + 8 * (i >> 2) + 4 * hh) > r) S[i] = -INFINITY;
                    }
                    float mx = S[0];
#pragma unroll
                    for (int i = 1; i < 16; ++i) mx = fmaxf(mx, S[i]);
                    if (__any((mx - m) * sc2 > 24.f)) {
                        const float cm = fmaxf(mx, __shfl_xor(mx, 32));
                        const float mn = fmaxf(m, cm);
                        const float alpha = (m == -INFINITY) ? 0.f : __builtin_amdgcn_exp2f((m - mn) * sc2);
                        l *= alpha;
#pragma unroll
                        for (int dt = 0; dt < 4; ++dt)
#pragma unroll
                            for (int i = 0; i < 16; ++i) O[dt][i] *= alpha;
                        m = mn;
                    }
#pragma unroll
                    for (int i = 0; i < 16; ++i) { S[i] = __builtin_amdgcn_exp2f((S[i] - m) * sc2); l += S[i]; }
                    const bf16x8 pf0 = pack8(S[0], S[1], S[2], S[3], S[4], S[5], S[6], S[7]);
                    const bf16x8 pf1 = pack8(S[8], S[9], S[10], S[11], S[12], S[13], S[14], S[15]);
#pragma unroll
                    for (int dt = 0; dt < 4; ++dt) O[dt] = MFMA32(vfr[dt * 2], pf0, O[dt]);
#pragma unroll
                    for (int dt = 0; dt < 4; ++dt) O[dt] = MFMA32(vfr[dt * 2 + 1], pf1, O[dt]);
                }
            }
            asm volatile("s_waitcnt vmcnt(0)" ::: "memory");
            l += __shfl_xor(l, 32);
            const float il = 1.f / l;
            bf16_t* orow = p.mixb + tq * 4096 + head * 128;
#pragma unroll
            for (int dt = 0; dt < 4; ++dt)
#pragma unroll
                for (int i4 = 0; i4 < 4; ++i4) {
                    u32x2 o; o.x = pk_bf16(O[dt][i4 * 4 + 0] * il, O[dt][i4 * 4 + 1] * il); o.y = pk_bf16(O[dt][i4 * 4 + 2] * il, O[dt][i4 * 4 + 3] * il);
                    *(u32x2*)(orow + 32 * dt + 8 * i4 + 4 * hh) = o;
                }
        }
#undef MLA_DMA
    }
    __syncthreads();
}

DI void ph_cmp_bias(const MP& p) {
    const int tix = tid_opaque();
    const int e = tix & 127, sub = tix >> 7;
    for (int u = blockIdx.x; u < 64; u += gridDim.x) {
        const int which = u >> 5, l = u & 31;
        const float* pp = p.cmp_pos + ((size_t)which * 32 + l) * 128;
        const float* ww = p.cmp_w + ((size_t)which * 4096 + (size_t)l * 128) * 128;
        float a = 0.f;
        for (int d = sub * 32; d < sub * 32 + 32; ++d) a += pp[d] * ww[(size_t)d * 128 + e];
        p.cpart[(((size_t)which * 32 + l) * 4 + sub) * 128 + e] = a;
    }
}

#define MFMA16(a, b, c) __builtin_amdgcn_mfma_f32_16x16x32_bf16((a), (b), (c), 0, 0, 0)
constexpr int NSA_ACC_STRIDE = 132;
constexpr int NSA_ACC_WAVE = 32 * NSA_ACC_STRIDE;
template <int BR = 7> DI void ph_nsa_attn(LAS unsigned char* lds, const MP& p) {
    const int tix = tid_opaque();
    const int w = tix >> 6, lane = tix & 63, r = lane & 31, hh = lane >> 5, c16 = lane & 15, kg = lane >> 4;
    LAS float* acc = (LAS float*)lds + w * NSA_ACC_WAVE;
    const bf16_t* hb = p.hbuf;
    const float c2 = 0.08838834764831845f * 1.4426950408889634f;
    for (int unit = blockIdx.x; unit < NB * 2 * 32; unit += gridDim.x) {
        const int bg = unit & 15, qb = unit >> 4, b = bg >> 1, g = bg & 1;
        for (int sub = 0; sub < 2; ++sub) {
            const int s0 = qb * 64 + __builtin_amdgcn_readfirstlane(w) * 8 + sub * 4;
            unsigned selp0 = 0u, selp1 = 0u;
            if constexpr ((BR & 1) != 0) {
                const int lz = tid_opaque(); const int r = lz & 31, hh = (lz >> 5) & 1; LAS float* acc = (LAS float*)lds + (lz >> 6) * NSA_ACC_WAVE;
                const int sq = s0 + (r >> 3), head = r & 7;
                const long tq = (long)b * SEQ + sq;
                const float g0 = sigmoidf_(ldh(hb + tq * AB_IN + AB_G + (g * 8 + head) * 3, 0));
                bf16x8 qf[8];
#pragma unroll
                for (int st = 0; st < 8; ++st) qf[st] = ld8(hb + tq * AB_IN + AB_Q + (g * 8 + head) * 128 + 16 * st + 8 * hh);
                const int nv_lane = sq >= 31 ? (sq - 31) / 16 + 1 : 0;
                const int nv_max = (s0 + 3 >= 31) ? (s0 + 3 - 31) / 16 + 1 : 0;
                const int nkt = (nv_max + 31) >> 5;
                float m = -INFINITY, l = 0.f;
                for (int kt = 0; kt < nkt; ++kt) {
                    const bf16_t* kp = p.kcb + lnd(((size_t)(bg * 128 + 32 * kt + r)) * 128 + 8 * hh);
                    bf16x8 kf[8];
#pragma unroll
                    for (int st = 0; st < 8; ++st) kf[st] = ld8(kp + 16 * st);
                    __builtin_amdgcn_sched_barrier(0);
                    f32x16 S;
#pragma unroll
                    for (int i = 0; i < 16; ++i) S[i] = 0.f;
#pragma unroll
                    for (int st = 0; st < 8; ++st) S = MFMA32(kf[st], qf[st], S);
                    float mx = -INFINITY;
#pragma unroll
                    for (int i = 0; i < 16; ++i) { const int key = 32 * kt + (i & 3) + 8 * (i >> 2) + 4 * hh; if (key >= nv_lane) S[i] = -INFINITY; mx = fmaxf(mx, S[i]); }
                    mx = fmaxf(mx, __shfl_xor(mx, 32));
                    const float mn = fmaxf(m, mx);
                    const float mm = (mn == -INFINITY) ? 0.f : mn;
                    float rs = 0.f;
#pragma unroll
                    for (int i = 0; i < 16; ++i) rs += __builtin_amdgcn_exp2f((S[i] - mm) * c2);
                    rs += __shfl_xor(rs, 32);
                    l = l * __builtin_amdgcn_exp2f((m - mm) * c2) + rs;
                    m = mn;
                }
                const float mm = (m == -INFINITY) ? 0.f : m;
                const float il = l > 0.f ? 1.f / l : 0.f;
                float A[16];
                float prev_same = 0.f;
                f32x16 O[4];
#pragma unroll
                for (int dt = 0; dt < 4; ++dt)
#pragma unroll
                    for (int i = 0; i < 16; ++i) O[dt][i] = 0.f;
#pragma unroll
                for (int kt = 0; kt < 4; ++kt) {
                    if (kt < nkt) {
                        f32x16 S;
#pragma unroll
                        for (int i = 0; i < 16; ++i) S[i] = 0.f;
                        const bf16_t* kp = p.kcb + lnd(((size_t)(bg * 128 + 32 * kt + r)) * 128 + 8 * hh);
                        const bf16_t* vp = p.vcT + lnd(((size_t)(bg * 128 + r)) * 128 + 32 * kt + 8 * hh);
                        bf16x8 kf[8], vf[4];
#pragma unroll
                        for (int st = 0; st < 8; ++st) kf[st] = ld8(kp + 16 * st);
                        __builtin_amdgcn_sched_barrier(0);
#pragma unroll
                        for (int st = 0; st < 8; ++st) S = MFMA32(kf[st], qf[st], S);
                        __builtin_amdgcn_sched_barrier(0);
#pragma unroll
                        for (int dt = 0; dt < 2; ++dt) { vf[2 * dt] = ld8(vp + (size_t)(32 * dt) * 128); vf[2 * dt + 1] = ld8(vp + (size_t)(32 * dt) * 128 + 16); }
                        __builtin_amdgcn_sched_barrier(0);
#pragma unroll
                        for (int i = 0; i < 16; ++i) { const int key = 32 * kt + (i & 3) + 8 * (i >> 2) + 4 * hh; S[i] = (key < nv_lane) ? __builtin_amdgcn_exp2f((S[i] - mm) * c2) * il : 0.f; }
#pragma unroll
                        for (int c4 = 0; c4 < 4; ++c4) { const int i = 4 * c4;
                            const float part = S[i] + S[i + 1] + S[i + 2] + 0.5f * S[i + 3], car = 0.5f * S[i + 3];
                            const float same = __shfl_xor(car, 32);
                            float av = part + (hh ? same : prev_same); prev_same = same;
                            av += __shfl_xor(av, 1); av += __shfl_xor(av, 2); av += __shfl_xor(av, 4);
                            A[4 * kt + c4] = av; }
                        const bf16x8 pf0 = pack8(S[0], S[1], S[2], S[3], S[4], S[5], S[6], S[7]);
                        const bf16x8 pf1 = pack8(S[8], S[9], S[10], S[11], S[12], S[13], S[14], S[15]);
#pragma unroll
                        for (int dt = 0; dt < 2; ++dt) { O[dt] = MFMA32(vf[2 * dt], pf0, O[dt]); O[dt] = MFMA32(vf[2 * dt + 1], pf1, O[dt]); }
                        __builtin_amdgcn_sched_barrier(0);
#pragma unroll
                        for (int dt = 2; dt < 4; ++dt) { vf[2 * dt - 4] = ld8(vp + (size_t)(32 * dt) * 128); vf[2 * dt - 3] = ld8(vp + (size_t)(32 * dt) * 128 + 16); }
                        __builtin_amdgcn_sched_barrier(0);
#pragma unroll
                        for (int dt = 2; dt < 4; ++dt) { O[dt] = MFMA32(vf[2 * dt - 4], pf0, O[dt]); O[dt] = MFMA32(vf[2 * dt - 3], pf1, O[dt]); }
                    } else {
#pragma unroll
                        for (int c4 = 0; c4 < 4; ++c4) { float av = hh ? 0.f : prev_same; prev_same = 0.f; av += __shfl_xor(av, 1); av += __shfl_xor(av, 2); av += __shfl_xor(av, 4); A[4 * kt + c4] = av; }
                    }
                    __builtin_amdgcn_sched_barrier(0);
                }
#pragma unroll
                for (int dt = 0; dt < 4; ++dt)
#pragma unroll
                    for (int i4 = 0; i4 < 4; ++i4) { f32x4 o4; o4[0] = g0 * O[dt][4 * i4]; o4[1] = g0 * O[dt][4 * i4 + 1]; o4[2] = g0 * O[dt][4 * i4 + 2]; o4[3] = g0 * O[dt][4 * i4 + 3];
                        *(LAS f32x4*)(acc + r * NSA_ACC_STRIDE + 32 * dt + 8 * i4 + 4 * hh) = o4; }
                __builtin_amdgcn_sched_barrier(0);
                const int cur = sq >> 6;
#pragma unroll
                for (int q = 0; q < 16; ++q) { const int j = 2 * q + hh; const bool forced = (j == 0) || (j == cur) || (j == cur - 1); A[q] = forced ? 1.0e6f : (j <= cur ? A[q] : -1.0f); }
#pragma unroll
                for (int n = 0; n < 8; ++n) {
                    float bv = A[0]; int bj = hh;
#pragma unroll
                    for (int q = 1; q < 16; ++q) { if (A[q] > bv) { bv = A[q]; bj = 2 * q + hh; } }
                    const float ov = __shfl_xor(bv, 32); const int oj = __shfl_xor(bj, 32);
                    const bool take_other = (ov > bv) || (ov == bv && oj < bj);
                    const int wj = take_other ? oj : bj;
                    if (n < 4) selp0 |= (unsigned)wj << (8 * n); else selp1 |= (unsigned)wj << (8 * (n - 4));
#pragma unroll
                    for (int q = 0; q < 16; ++q) if (2 * q + hh == wj) A[q] = -INFINITY;
                }
            }
            __builtin_amdgcn_sched_barrier(0);
            if constexpr ((BR & 2) != 0) {
                const int lz = tid_opaque(); const int r = lz & 31, hh = (lz >> 5) & 1; LAS float* acc = (LAS float*)lds + (lz >> 6) * NSA_ACC_WAVE;
                const int sq = s0 + (r >> 3), head = r & 7;
                const long tq = (long)b * SEQ + sq;
                bf16x8 qw[8];
                { const bf16_t* qp = hb + lnd((size_t)tq * AB_IN + AB_Q + (g * 8 + head) * 128 + 8 * hh);
#pragma unroll
                  for (int st = 0; st < 8; ++st) qw[st] = ld8(qp + 16 * st); }
                f32x16 O[4];
#pragma unroll
                for (int dt = 0; dt < 4; ++dt)
#pragma unroll
                    for (int i = 0; i < 16; ++i) O[dt][i] = 0.f;
                float m = -INFINITY, l = 0.f;
                const int klo = s0 - 511 > 0 ? s0 - 511 : 0;
                const int kt_lo = klo >> 5, kt_hi = (s0 + 3) >> 5;
                for (int kt = kt_lo; kt <= kt_hi; ++kt) {
                    const size_t fo = lnd((((size_t)bg * 64 + kt) * 8 * 64 + (lz & 63)) * 8);
                    const bf16_t* kp = p.kwf + fo; const bf16_t* vb = p.vwinT + fo;
                    bf16x8 kf[8], vf[8];
#pragma unroll
                    for (int st = 0; st < 8; ++st) kf[st] = ld8(kp + st * 512);
                    __builtin_amdgcn_sched_barrier(0);
                    f32x16 S;
#pragma unroll
                    for (int i = 0; i < 16; ++i) S[i] = 0.f;
#pragma unroll
                    for (int st = 0; st < 8; ++st) S = MFMA32(kf[st], qw[st], S);
                    __builtin_amdgcn_sched_barrier(0);
#pragma unroll
                    for (int f = 0; f < 8; ++f) vf[f] = ld8(vb + f * 512);
                    __builtin_amdgcn_sched_barrier(0);
#pragma unroll
                    for (int i = 0; i < 16; ++i) { const int key = 32 * kt + (i & 3) + 8 * (i >> 2) + 4 * hh; if (key > sq || key <= sq - 512) S[i] = -INFINITY; }
                    float mx = S[0];
#pragma unroll
                    for (int i = 1; i < 16; ++i) mx = fmaxf(mx, S[i]);
                    if (__any((mx - m) * c2 > 24.f)) {
                        const float cm = fmaxf(mx, __shfl_xor(mx, 32));
                        const float mn = fmaxf(m, cm);
                        const float alpha = (m == -INFINITY) ? 0.f : __builtin_amdgcn_exp2f((m - mn) * c2);
                        l *= alpha;
#pragma unroll
                        for (int dt = 0; dt < 4; ++dt)
#pragma unroll
                            for (int i = 0; i < 16; ++i) O[dt][i] *= alpha;
                        m = mn;
                    }
                    const float mr = (m == -INFINITY) ? 0.f : m;
#pragma unroll
                    for (int i = 0; i < 16; ++i) { S[i] = __builtin_amdgcn_exp2f((S[i] - mr) * c2); l += S[i]; }
                    const bf16x8 pf0 = pack8(S[0], S[1], S[2], S[3], S[4], S[5], S[6], S[7]);
                    const bf16x8 pf1 = pack8(S[8], S[9], S[10], S[11], S[12], S[13], S[14], S[15]);
#pragma unroll
                    for (int dt = 0; dt < 4; ++dt) { O[dt] = MFMA32(vf[dt * 2], pf0, O[dt]); O[dt] = MFMA32(vf[dt * 2 + 1], pf1, O[dt]); }
                }
                l += __shfl_xor(l, 32);
                const float sc = sigmoidf_(ldh(hb + tq * AB_IN + AB_G + (g * 8 + head) * 3, 2)) / l;
#pragma unroll
                for (int dt = 0; dt < 4; ++dt)
#pragma unroll
                    for (int i4 = 0; i4 < 4; ++i4) { LAS f32x4* ap = (LAS f32x4*)(acc + r * NSA_ACC_STRIDE + 32 * dt + 8 * i4 + 4 * hh); f32x4 o4 = *ap;
                        o4[0] += sc * O[dt][4 * i4]; o4[1] += sc * O[dt][4 * i4 + 1]; o4[2] += sc * O[dt][4 * i4 + 2]; o4[3] += sc * O[dt][4 * i4 + 3]; *ap = o4; }
            }
            __builtin_amdgcn_sched_barrier(0); asm volatile("" ::: "memory");
            if constexpr ((BR & 4) != 0)
#pragma unroll 1
            for (int pr = 0; pr < 2; ++pr) {
                const int lz = tid_opaque(); const int c16 = lz & 15, kg = (lz >> 4) & 3; LAS float* acc = (LAS float*)lds + (lz >> 6) * NSA_ACC_WAVE;
                const bf16_t* kbase = p.ksf + (((size_t)bg * 128) * 4 * 64 + (lz & 63)) * 8;
                const bf16_t* vbase = p.vselT + (((size_t)bg * 64) * 8 * 64 + (lz & 63)) * 8;
                const int cur = qb;
#define NSA_KEY0(it_) ((int)((((it_) < 8 ? sp0 : sp1) >> (8 * (((it_) >> 1) & 3))) & 0xffu) * 64 + 32 * ((it_) & 1))
#define NSA_LOADK(it_) do { const int k0_ = NSA_KEY0(it_); const bf16_t* kp_ = kbase + (size_t)(k0_ >> 4) * 2048; \
        _Pragma("unroll") for (int st = 0; st < 4; ++st) { kR[st] = ld8(kp_ + st * 512); kR[4 + st] = ld8(kp_ + 2048 + st * 512); } } while (0)
#define NSA_LOADV(it_) do { const int k0_ = NSA_KEY0(it_); const bf16_t* vp_ = vbase + (size_t)(k0_ >> 5) * 4096; \
        _Pragma("unroll") for (int dt = 0; dt < 8; ++dt) vR[dt] = ld8(vp_ + dt * 512); } while (0)
#define NSA_SOFTMAX_PV(SQL_, SQMIN_, O_, M_, L_) do { \
                        if (key0 + 31 > (SQMIN_)) { \
                            _Pragma("unroll") for (int i = 0; i < 4; ++i) { if (key0 + 4 * kg + i > (SQL_)) Sa[i] = -INFINITY; if (key0 + 16 + 4 * kg + i > (SQL_)) Sb[i] = -INFINITY; } \
                        } \
                        const float mx = fmaxf(fmaxf(fmaxf(Sa[0], Sa[1]), fmaxf(Sa[2], Sa[3])), fmaxf(fmaxf(Sb[0], Sb[1]), fmaxf(Sb[2], Sb[3]))); \
                        if (__any((mx - M_) * c2 > 24.f)) { \
                            float cm = fmaxf(mx, __shfl_xor(mx, 16)); cm = fmaxf(cm, __shfl_xor(cm, 32)); \
                            const float mn = fmaxf(M_, cm); \
                            const float alpha = (M_ == -INFINITY) ? 0.f : __builtin_amdgcn_exp2f((M_ - mn) * c2); \
                            L_ *= alpha; \
                            _Pragma("unroll") for (int dt = 0; dt < 8; ++dt) O_[dt] *= alpha; \
                            M_ = mn; \
                        } \
                        const float mr_ = (M_ == -INFINITY) ? 0.f : -M_ * c2; \
                        float pa[4], pb[4]; \
                        _Pragma("unroll") for (int i = 0; i < 4; ++i) { pa[i] = __builtin_amdgcn_exp2f(__builtin_fmaf(Sa[i], c2, mr_)); pb[i] = __builtin_amdgcn_exp2f(__builtin_fmaf(Sb[i], c2, mr_)); L_ += pa[i] + pb[i]; } \
                        const bf16x8 pf = pack8(pa[0], pa[1], pa[2], pa[3], pb[0], pb[1], pb[2], pb[3]); \
                        _Pragma("unroll") for (int dt = 0; dt < 8; ++dt) O_[dt] = MFMA16(vR[dt], pf, O_[dt]); \
                    } while (0)
#define NSA_CHUNKS(SQL_, SQMIN_, Q_, O_, M_, L_) do { \
                    bf16x8 kR[8], vR[8]; \
                    int it = vmask ? (__builtin_ctz(vmask)) : 16; \
                    { const int i0_ = it < 16 ? it : 0; NSA_LOADK(i0_); NSA_LOADV(i0_); } \
                    if (it < 16) { \
                        f32x4 Sa, Sb; int key0; \
                        __builtin_amdgcn_s_waitcnt(0x0F70);      \
                        for (;;) { \
                            const unsigned rem = (it < 15) ? (vmask >> (it + 1)) : 0u; \
                            const int nx = rem ? it + 1 + __builtin_ctz(rem) : 16; \
                            key0 = NSA_KEY0(it); \
                            Sa = (f32x4){0.f, 0.f, 0.f, 0.f}; Sb = (f32x4){0.f, 0.f, 0.f, 0.f}; \
                            _Pragma("unroll") for (int st = 0; st < 4; ++st) { Sa = MFMA16(kR[st], Q_[st], Sa); Sb = MFMA16(kR[4 + st], Q_[st], Sb); } \
                            __builtin_amdgcn_sched_barrier(0); \
                            if (nx >= 16) break; \
                            NSA_LOADK(nx); \
                            __builtin_amdgcn_sched_barrier(0); \
                            NSA_SOFTMAX_PV(SQL_, SQMIN_, O_, M_, L_); \
                            __builtin_amdgcn_sched_barrier(0); \
                            NSA_LOADV(nx); \
                            it = nx; \
                        } \
                        NSA_SOFTMAX_PV(SQL_, SQMIN_, O_, M_, L_); \
                    } } while (0)
                f32x4 O1[8];
#pragma unroll
                for (int dt = 0; dt < 8; ++dt) O1[dt] = (f32x4){0.f, 0.f, 0.f, 0.f};
                float m1 = -INFINITY, l1 = 0.f;
                {
                    const int sqL = s0 + 2 * pr + (c16 >> 3);
                    const long tqL = (long)b * SEQ + sqL;
                    bf16x8 qP[4];
#pragma unroll
                    for (int st = 0; st < 4; ++st) qP[st] = ld8(hb + tqL * AB_IN + AB_Q + (g * 8 + (c16 & 7)) * 128 + 32 * st + 8 * kg);
                    const int sqmax = s0 + 2 * pr + 1;
                    const unsigned sp0 = cur >= 2 ? (((unsigned)(cur - 1) << 8) | ((unsigned)cur << 16)) : (cur == 1 ? (1u << 8) : 0u), sp1 = 0u;
                    const int nf = cur >= 2 ? 3 : cur + 1;
                    unsigned vmask = 0u;
#pragma unroll
                    for (int n = 0; n < 3; ++n) { const int jb = (int)((sp0 >> (8 * n)) & 0xffu); if (n < nf) { if (jb * 64 <= sqmax) vmask |= 1u << (2 * n); if (jb * 64 + 32 <= sqmax) vmask |= 2u << (2 * n); } }
                    NSA_CHUNKS(sqL, s0 + 2 * pr, qP, O1, m1, l1);
                }
                __builtin_amdgcn_sched_barrier(0);
#pragma unroll 1
                for (int qi = 0; qi < 2; ++qi) {
                    const int ql = 2 * pr + qi;
                    const int sq2 = s0 + ql; const long tq2 = (long)b * SEQ + sq2;
                    bf16x8 q16[4];
#pragma unroll
                    for (int st = 0; st < 4; ++st) q16[st] = ld8(hb + tq2 * AB_IN + AB_Q + (g * 8 + (c16 & 7)) * 128 + 32 * st + 8 * kg);
                    const float g1q = sigmoidf_(ldh(hb + tq2 * AB_IN + AB_G + (g * 8 + (c16 & 7)) * 3, 1));
                    f32x4 O16[8];
#pragma unroll
                    for (int dt = 0; dt < 8; ++dt) O16[dt] = (f32x4){0.f, 0.f, 0.f, 0.f};
                    const int src = (lz & 0x37) | (qi << 3);
                    const float m0 = __shfl(m1, src);
                    float m = m0, l = __shfl(l1, src);
                    const unsigned sp0 = (unsigned)__builtin_amdgcn_readfirstlane(__shfl((int)selp0, ql * 8)), sp1 = (unsigned)__builtin_amdgcn_readfirstlane(__shfl((int)selp1, ql * 8));
                    unsigned vmask = 0u;
#pragma unroll
                    for (int n = 0; n < 8; ++n) { const int jb = (int)(((n < 4 ? sp0 : sp1) >> (8 * (n & 3))) & 0xffu);
                        const bool forced = (jb == 0) || (jb == cur) || (jb == cur - 1);
                        if (!forced) { if (jb * 64 <= sq2) vmask |= 1u << (2 * n); if (jb * 64 + 32 <= sq2) vmask |= 2u << (2 * n); } }
                    NSA_CHUNKS(sq2, sq2, q16, O16, m, l);
                    l += __shfl_xor(l, 16); l += __shfl_xor(l, 32);
                    const float sc = g1q / l;
                    const float f1 = sc * __builtin_amdgcn_exp2f((m0 - m) * c2);
                    if ((c16 >> 3) == qi) {
#pragma unroll
                        for (int dt = 0; dt < 8; ++dt) { LAS f32x4* ap = (LAS f32x4*)(acc + (ql * 8 + (c16 & 7)) * NSA_ACC_STRIDE + 16 * dt + 4 * kg); f32x4 o4 = *ap;
                            o4[0] += sc * O16[dt][0] + f1 * O1[dt][0]; o4[1] += sc * O16[dt][1] + f1 * O1[dt][1]; o4[2] += sc * O16[dt][2] + f1 * O1[dt][2]; o4[3] += sc * O16[dt][3] + f1 * O1[dt][3]; *ap = o4; }
                    }
                }
#undef NSA_CHUNKS
#undef NSA_SOFTMAX_PV
#undef NSA_LOADK
#undef NSA_LOADV
#undef NSA_KEY0
            }
            asm volatile("s_waitcnt lgkmcnt(0)" ::: "memory");
            {
                const int lz = tid_opaque(); const int lane = lz & 63; LAS float* acc = (LAS float*)lds + (lz >> 6) * NSA_ACC_WAVE;
                const int row = lane >> 1, dh = (lane & 1) * 64;
                const long tt = (long)b * SEQ + s0 + (row >> 3);
                bf16_t* op = p.mixb + tt * 4096 + 2048 + (g * 8 + (row & 7)) * 128 + dh;
#pragma unroll
                for (int k8 = 0; k8 < 8; ++k8) {
                    const f32x4 a = *(const LAS f32x4*)(acc + row * NSA_ACC_STRIDE + dh + 8 * k8), c = *(const LAS f32x4*)(acc + row * NSA_ACC_STRIDE + dh + 8 * k8 + 4);
                    u32x4 o; o.x = pk_bf16(a[0], a[1]); o.y = pk_bf16(a[2], a[3]); o.z = pk_bf16(c[0], c[1]); o.w = pk_bf16(c[2], c[3]);
                    *(u32x4*)(op + 8 * k8) = o;
                }
            }
            asm volatile("s_waitcnt lgkmcnt(0)" ::: "memory");
        }
    }
}

DI void ph_conv_ssd(LAS unsigned char* lds, const MP& p) {
    const int tix = tid_opaque();
    LAS bf16_t* tile = (LAS bf16_t*)lds;
    const int tok = tix >> 3, c8 = (tix & 7) * 8;
    bf16_t* xT = (bf16_t*)p.xbc; bf16_t* BT = xT + (size_t)NB * 2048 * 2048; bf16_t* bcr = BT + (size_t)NB * 512 * 2048;
    const int cskip = (gridDim.x >= 64) ? 16 : 0;
    if ((int)blockIdx.x < cskip) return;
    for (int u = blockIdx.x - cskip; u < NB * 32 * 48; u += gridDim.x - cskip) {
        const int ct = u % 48, tt = (u / 48) & 31, b = u / (48 * 32);
        const int c0 = ct * 64, s = tt * 64 + tok; const long t = (long)b * SEQ + s;
        float a[8];
        { const float4 b0 = *(const float4*)(p.conv_b + c0 + c8), b1 = *(const float4*)(p.conv_b + c0 + c8 + 4); a[0] = b0.x; a[1] = b0.y; a[2] = b0.z; a[3] = b0.w; a[4] = b1.x; a[5] = b1.y; a[6] = b1.z; a[7] = b1.w; }
#pragma unroll
        for (int k = 0; k < 4; ++k) {
            if (s - 3 + k >= 0) {
                const u32x4 hv = *(const u32x4*)(p.hbuf + (t - 3 + k) * AB_IN + AB_XBC + c0 + c8);
                const float4 w0 = *(const float4*)(p.conv_w + k * 3072 + c0 + c8), w1 = *(const float4*)(p.conv_w + k * 3072 + c0 + c8 + 4);
                a[0] += w0.x * bflo(hv.x); a[1] += w0.y * bfhi(hv.x); a[2] += w0.z * bflo(hv.y); a[3] += w0.w * bfhi(hv.y);
                a[4] += w1.x * bflo(hv.z); a[5] += w1.y * bfhi(hv.z); a[6] += w1.z * bflo(hv.w); a[7] += w1.w * bfhi(hv.w);
            }
        }
#pragma unroll
        for (int e = 0; e < 8; ++e) a[e] = siluf_(a[e]);
        if (ct >= 32) { u32x4 o; o.x = pk_bf16(a[0], a[1]); o.y = pk_bf16(a[2], a[3]); o.z = pk_bf16(a[4], a[5]); o.w = pk_bf16(a[6], a[7]); *(u32x4*)(bcr + t * 1024 + (c0 - 2048) + c8) = o; }
        if (ct < 40) {
#pragma unroll
            for (int e = 0; e < 8; ++e) tile[(c8 + e) * 72 + tok] = f2bf(a[e]);
        }
        __syncthreads();
        if (ct < 40) {
            const int ch = tix >> 3, tg = tix & 7;
            const u32x4 v = *(const LAS u32x4*)(tile + ch * 72 + 8 * tg);
            const int c = c0 + ch;
            bf16_t* dst = (ct < 32) ? xT + ((size_t)b * 2048 + c) * 2048 : BT + ((size_t)b * 512 + (c - 2048)) * 2048;
            const int pos = tt * 64 + 16 * (tg >> 1) + 4 * (tg & 1);
            u32x2 lo; lo.x = v.x; lo.y = v.y; u32x2 hi; hi.x = v.z; hi.y = v.w;
            *(u32x2*)(dst + pos) = lo; *(u32x2*)(dst + pos + 8) = hi;
        }
        __syncthreads();
    }
}

DI void ph_ssd_chunk(LAS unsigned char* lds, const MP& p) {
    const int tix = tid_opaque();
    const int w = tix >> 6, lane = tix & 63, r = lane & 31, hh = lane >> 5, pt = w >> 2, lt = w & 3;
    LAS bf16_t* S_base = (LAS bf16_t*)lds;
    LAS float* acs_all = (LAS float*)(lds + 2 * 64 * 136 * 2);
    LAS float* dts_all = acs_all + 2048;
    LAS float* wl_all = dts_all + 2048;
    const bf16_t* xT = (const bf16_t*)p.xbc; const bf16_t* BT = xT + (size_t)NB * 2048 * 2048; const bf16_t* bcr = BT + (size_t)NB * 512 * 2048;
    const float L2E = 1.4426950408889634f;
    for (int unit = blockIdx.x; unit < NB * 32; unit += gridDim.x) {
        const int b = unit >> 5, h = unit & 31, g = h >> 3;
        const float a = -__expf(p.a_log[h]), dbias = p.dt_bias[h], dskip = p.ssm_d[h];
        f32x16 S;
#pragma unroll
        for (int i = 0; i < 16; ++i) S[i] = 0.f;
        __syncthreads();
#pragma unroll
        for (int cc = 0; cc < 2; ++cc) {
            const int c = 2 * w + cc; const long t0 = (long)b * SEQ + c * 128;
            const float d0 = softplusf_(ldh(p.hbuf, (t0 + 2 * lane) * AB_IN + AB_DT + h) + dbias), d1 = softplusf_(ldh(p.hbuf, (t0 + 2 * lane + 1) * AB_IN + AB_DT + h) + dbias);
            const float a0 = d0 * a, a1 = d1 * a;
            float run = a0 + a1;
#pragma unroll
            for (int o = 1; o < 64; o <<= 1) { const float v = __shfl_up(run, o); if (lane >= o) run += v; }
            const float tot = __shfl(run, 63);
            const float cs1 = run, cs0 = run - a1;
            acs_all[c * 128 + 2 * lane] = cs0; acs_all[c * 128 + 2 * lane + 1] = cs1; dts_all[c * 128 + 2 * lane] = d0; dts_all[c * 128 + 2 * lane + 1] = d1;
            wl_all[c * 128 + 2 * lane] = d0 * __expf(tot - cs0); wl_all[c * 128 + 2 * lane + 1] = d1 * __expf(tot - cs1);
        }
        for (int c = 0; c < 16; ++c) {
            const long t0 = (long)b * SEQ + c * 128;
            LAS bf16_t* S_lds = S_base + (c & 1) * (64 * 136);
            const LAS float* acs = acs_all + c * 128; const LAS float* dts = dts_all + c * 128; const LAS float* wl = wl_all + c * 128;
#pragma unroll
            for (int i = 0; i < 16; ++i) S_lds[(32 * pt + (i & 3) + 8 * (i >> 2) + 4 * hh) * 136 + 32 * lt + r] = f2bf(S[i]);
            __syncthreads();
            const float acl = acs[32 * lt + r];
            bf16x8 cf[8], xs[8], bs[8];
            u32x2 zv[4];
            {
                const bf16_t* cp = bcr + lnd((size_t)(t0 + 32 * lt + r) * 1024 + 512 + g * 128 + 8 * hh);
                const bf16_t* xsp = xT + lnd(((size_t)b * 2048 + h * 64 + 32 * pt + r) * 2048 + c * 128 + 8 * hh);
                const bf16_t* bsp = BT + lnd(((size_t)b * 512 + g * 128 + 32 * lt + r) * 2048 + c * 128 + 8 * hh);
                const bf16_t* zp = p.hbuf + lnd((size_t)(t0 + 32 * lt + r) * AB_IN + AB_Z + h * 64 + 32 * pt + 4 * hh);
#pragma unroll
                for (int st = 0; st < 8; ++st) cf[st] = ld8(cp + 16 * st);
#pragma unroll
                for (int st = 0; st < 8; ++st) { xs[st] = ld8(xsp + 16 * st); bs[st] = ld8(bsp + 16 * st); }
#pragma unroll
                for (int i4 = 0; i4 < 4; ++i4) zv[i4] = *(const u32x2*)(zp + 8 * i4);
            }
            bf16x8 sl[8];
#pragma unroll
            for (int st = 0; st < 8; ++st) sl[st] = *(const LAS bf16x8*)(S_lds + (32 * pt + r) * 136 + 16 * st + 8 * hh);
            __builtin_amdgcn_sched_barrier(0);
            f32x16 Y;
#pragma unroll
            for (int i = 0; i < 16; ++i) Y[i] = 0.f;
#pragma unroll
            for (int st = 0; st < 8; ++st) Y = MFMA32(sl[st], cf[st], Y);
            { const float ea = __expf(acl);
#pragma unroll
              for (int i = 0; i < 16; ++i) Y[i] *= ea; }
            for (int stile = 0; stile <= lt; ++stile) {
                const bf16_t* bp = bcr + lnd((size_t)(t0 + 32 * stile + r) * 1024 + g * 128 + 8 * hh);
                const bf16_t* xp = xT + lnd(((size_t)b * 2048 + h * 64 + 32 * pt + r) * 2048 + c * 128 + 32 * stile + 8 * hh);
                bf16x8 bf[8];
#pragma unroll
                for (int st = 0; st < 8; ++st) bf[st] = ld8(bp + 16 * st);
                const bf16x8 xa = ld8(xp), xb2 = ld8(xp + 16);
                __builtin_amdgcn_sched_barrier(0);
                f32x16 G;
#pragma unroll
                for (int i = 0; i < 16; ++i) G[i] = 0.f;
#pragma unroll
                for (int st = 0; st < 8; ++st) G = MFMA32(bf[st], cf[st], G);
#pragma unroll
                for (int i = 0; i < 16; ++i) {
                    const int sl2 = 32 * stile + (i & 3) + 8 * (i >> 2) + 4 * hh, ll = 32 * lt + r;
                    float v = G[i] * __builtin_amdgcn_exp2f((acl - acs[sl2]) * L2E) * dts[sl2];
                    v = (sl2 <= ll) ? v : 0.f;
                    if (sl2 == ll) v += dskip;
                    G[i] = v;
                }
                const bf16x8 pg0 = pack8(G[0], G[1], G[2], G[3], G[4], G[5], G[6], G[7]);
                const bf16x8 pg1 = pack8(G[8], G[9], G[10], G[11], G[12], G[13], G[14], G[15]);
                Y = MFMA32(xa, pg0, Y); Y = MFMA32(xb2, pg1, Y);
            }
            {
                bf16_t* op = (bf16_t*)p.mix + (t0 + 32 * lt + r) * 4096 + h * 64 + 32 * pt + 4 * hh;
#pragma unroll
                for (int i4 = 0; i4 < 4; ++i4) {
                    u32x2 o; o.x = pk_bf16(Y[4 * i4] * siluf_(bflo(zv[i4].x)), Y[4 * i4 + 1] * siluf_(bfhi(zv[i4].x))); o.y = pk_bf16(Y[4 * i4 + 2] * siluf_(bflo(zv[i4].y)), Y[4 * i4 + 3] * siluf_(bfhi(zv[i4].y)));
                    *(u32x2*)(op + 8 * i4) = o;
                }
            }
            {
                f32x16 Sn;
#pragma unroll
                for (int i = 0; i < 16; ++i) Sn[i] = 0.f;
#pragma unroll
                for (int st = 0; st < 8; ++st) {
                    const bf16x8 xf = xs[st];
                    const f32x4 w0 = *(const LAS f32x4*)(wl + 16 * st + 4 * hh), w1 = *(const LAS f32x4*)(wl + 16 * st + 8 + 4 * hh);
                    const bf16x8 xw = pack8(bf2f((bf16_t)xf[0]) * w0[0], bf2f((bf16_t)xf[1]) * w0[1], bf2f((bf16_t)xf[2]) * w0[2], bf2f((bf16_t)xf[3]) * w0[3],
                                            bf2f((bf16_t)xf[4]) * w1[0], bf2f((bf16_t)xf[5]) * w1[1], bf2f((bf16_t)xf[6]) * w1[2], bf2f((bf16_t)xf[7]) * w1[3]);
                    Sn = MFMA32(xw, bs[st], Sn);
                }
                const float ed = __expf(acs[127]);
#pragma unroll
                for (int i = 0; i < 16; ++i) S[i] = S[i] * ed + Sn[i];
            }
        }
    }
    __syncthreads();
}

DI void ph_hgrn_chunk(LAS unsigned char* lds, const MP& p) {
    if (blockIdx.x >= NB * 16) return;
    const int tix = tid_opaque();
    const int w = tix >> 6, lane = tix & 63, r = lane & 31, hh = lane >> 5;
    LAS bf16_t* qt_l = (LAS bf16_t*)lds;
    LAS bf16_t* kt_l = qt_l + 64 * 136;
    LAS bf16_t* kendT = kt_l + 64 * 136;
    LAS bf16_t* S_l = kendT + 128 * 72;
    LAS float* bl = (LAS float*)(S_l + 2 * 128 * 136);
    LAS float* tot = bl + 128;
    const int b = blockIdx.x >> 4, h = blockIdx.x & 15;
    const bf16_t* viT = (const bf16_t*)p.bufB;
    const int d = tix & 127, tq = tix >> 7;
    const float lb = 1.f / (1.f + expf(p.lb_logits[h * 128 + d] - p.lb_logits[2048 + h * 128 + d]));
    const int vt = w >> 1, tt = w & 1;
    f32x16 S0, S1;
#pragma unroll
    for (int i = 0; i < 16; ++i) { S0[i] = 0.f; S1[i] = 0.f; }
    for (int i = tix; i < 128 * 136 / 2; i += NTHR) ((LAS unsigned*)S_l)[i] = 0u;
    bf16_t rawq[16], rawf[16];
#pragma unroll
    for (int i = 0; i < 16; ++i) { const size_t t = (size_t)b * SEQ + 16 * tq + i; rawq[i] = p.hbuf[t * CD_IN + CD_HQ + h * 128 + d]; rawf[i] = p.hbuf[t * CD_IN + CD_HF + h * 128 + d]; }
    for (int c = 0; c < 32; ++c) {
        const long t0 = (long)b * SEQ + c * 64;
        bf16x8 vfr[4];
        { const bf16_t* vp = viT + lnd(((size_t)(b * 16 + h) * 128 + 32 * vt + r) * 2048 + c * 64 + 8 * hh);
#pragma unroll
          for (int ks = 0; ks < 4; ++ks) vfr[ks] = ld8(vp + 16 * ks); }
        {
            float qv[16], kv[16], bq[16]; float cum = 0.f;
#pragma unroll
            for (int i = 0; i < 16; ++i) {
                const float hq = bf2f(rawq[i]), hf = bf2f(rawf[i]);
                const float sg = sigmoidf_(hf);
                cum += __logf(lb + (1.f - lb) * sg);
                bq[i] = cum; kv[i] = (1.f - lb) * (1.f - sg); qv[i] = siluf_(hq);
            }
            tot[tq * 128 + d] = cum;
            if (c + 1 < 32) {
#pragma unroll
                for (int i = 0; i < 16; ++i) { const size_t t = (size_t)t0 + 64 + 16 * tq + i; rawq[i] = p.hbuf[t * CD_IN + CD_HQ + h * 128 + d]; rawf[i] = p.hbuf[t * CD_IN + CD_HF + h * 128 + d]; }
            }
            __syncthreads();
            float off = 0.f, blast = 0.f;
#pragma unroll
            for (int q2 = 0; q2 < 4; ++q2) { const float tv = tot[q2 * 128 + d]; blast += tv; if (q2 < tq) off += tv; }
#pragma unroll
            for (int i = 0; i < 16; ++i) {
                const int tl = 16 * tq + i;
                const float bb = off + bq[i];
                qt_l[tl * 136 + d] = f2bf(qv[i] * __expf(bb));
                kt_l[tl * 136 + d] = f2bf(kv[i] * __expf(-bb));
                kendT[d * 72 + ((tl & ~12) | ((tl & 4) << 1) | ((tl & 8) >> 1))] = f2bf(kv[i] * __expf(blast - bb));
            }
            if (tq == 0) bl[d] = __expf(blast);
        }
        __syncthreads();
        const LAS bf16_t* Scur = S_l + (c & 1) * (128 * 136);
        LAS bf16_t* Snxt = S_l + ((c + 1) & 1) * (128 * 136);
        {
            bf16x8 qf[8], sf[8];
#pragma unroll
            for (int st = 0; st < 8; ++st) { qf[st] = *(const LAS bf16x8*)(qt_l + (32 * tt + r) * 136 + 16 * st + 8 * hh); sf[st] = *(const LAS bf16x8*)(Scur + (32 * vt + r) * 136 + 16 * st + 8 * hh); }
            __builtin_amdgcn_sched_barrier(0);
            f32x16 O;
#pragma unroll
            for (int i = 0; i < 16; ++i) O[i] = 0.f;
#pragma unroll
            for (int st = 0; st < 8; ++st) O = MFMA32(sf[st], qf[st], O);
            for (int stile = 0; stile <= tt; ++stile) {
                bf16x8 kf[8];
#pragma unroll
                for (int st = 0; st < 8; ++st) kf[st] = *(const LAS bf16x8*)(kt_l + (32 * stile + r) * 136 + 16 * st + 8 * hh);
                __builtin_amdgcn_sched_barrier(0);
                f32x16 AT;
#pragma unroll
                for (int i = 0; i < 16; ++i) AT[i] = 0.f;
#pragma unroll
                for (int st = 0; st < 8; ++st) AT = MFMA32(kf[st], qf[st], AT);
                if (stile == tt) {
#pragma unroll
                    for (int i = 0; i < 16; ++i) if (((i & 3) + 8 * (i >> 2) + 4 * hh) > r) AT[i] = 0.f;
                }
                const bf16x8 pa0 = pack8(AT[0], AT[1], AT[2], AT[3], AT[4], AT[5], AT[6], AT[7]);
                const bf16x8 pa1 = pack8(AT[8], AT[9], AT[10], AT[11], AT[12], AT[13], AT[14], AT[15]);
                if (stile == 0) { O = MFMA32(vfr[0], pa0, O); O = MFMA32(vfr[1], pa1, O); }
                else            { O = MFMA32(vfr[2], pa0, O); O = MFMA32(vfr[3], pa1, O); }
            }
            float* op = p.x3 + (t0 + 32 * tt + r) * 2048 + h * 128 + 32 * vt + 4 * hh;
#pragma unroll
            for (int i4 = 0; i4 < 4; ++i4) { f32x4 o; o[0] = O[4 * i4]; o[1] = O[4 * i4 + 1]; o[2] = O[4 * i4 + 2]; o[3] = O[4 * i4 + 3]; *(f32x4*)(op + 8 * i4) = o; }
        }
        {
            bf16x8 ke0[4], ke1[4];
#pragma unroll
            for (int ks = 0; ks < 4; ++ks) { ke0[ks] = *(const LAS bf16x8*)(kendT + (64 * tt + r) * 72 + 16 * ks + 8 * hh); ke1[ks] = *(const LAS bf16x8*)(kendT + (64 * tt + 32 + r) * 72 + 16 * ks + 8 * hh); }
            __builtin_amdgcn_sched_barrier(0);
            f32x16 N0, N1;
#pragma unroll
            for (int i = 0; i < 16; ++i) { N0[i] = 0.f; N1[i] = 0.f; }
#pragma unroll
            for (int ks = 0; ks < 4; ++ks) { N0 = MFMA32(vfr[ks], ke0[ks], N0); N1 = MFMA32(vfr[ks], ke1[ks], N1); }
            const float e0 = bl[64 * tt + r], e1 = bl[64 * tt + 32 + r];
#pragma unroll
            for (int i = 0; i < 16; ++i) { S0[i] = S0[i] * e0 + N0[i]; S1[i] = S1[i] * e1 + N1[i]; }
#pragma unroll
            for (int i = 0; i < 16; ++i) { const int v = 32 * vt + (i & 3) + 8 * (i >> 2) + 4 * hh; Snxt[v * 136 + 64 * tt + r] = f2bf(S0[i]); Snxt[v * 136 + 64 * tt + 32 + r] = f2bf(S1[i]); }
        }
        __syncthreads();
    }
}

DI gm::DenseProb mk_dense(const bf16_t* A, unsigned lda, const bf16_t* Bt, unsigned ldb, int M, int Npad, int K) {
    gm::DenseProb d; d.A = (const char*)A; d.Bt = (const char*)Bt; d.lda = lda; d.ldb = ldb; d.K = K; d.nM = M / 256; d.nN = Npad / 256; d.G = (int)gridDim.x; d.c = (int)blockIdx.x; return d;
}
DI void ph_gemm_bf16(LAS unsigned char* lds, const bf16_t* A, unsigned lda, const bf16_t* Bt, int M, int N, int Npad, int K, bf16_t* C, long ldc) {
    gm::EpiBf16 e; e.C = C; e.ldc = ldc; e.N = N; gm::gemm_phase(lds, mk_dense(A, lda, Bt, (unsigned)K, M, Npad, K), e);
}
DI void ph_gemm_f32(LAS unsigned char* lds, const bf16_t* A, unsigned lda, const bf16_t* Bt, int M, int N, int Npad, int K, float* C, long ldc) {
    gm::EpiF32 e; e.C = C; e.ldc = ldc; e.N = N; gm::gemm_phase(lds, mk_dense(A, lda, Bt, (unsigned)K, M, Npad, K), e);
}
DI int moe_tile_table(LAS unsigned char* lds, const MP& p) {
    const int tix = tid_opaque();
    LAS i32x2* ttab = (LAS i32x2*)(lds + LDS_TAB_OFF);
    const int nt = *p.ntiles;
    for (int i = tix; i < nt && i < 768; i += NTHR) { const int4 t = *(const int4*)(p.tiles + i * 4); i32x2 r; r.x = (t.x & 0xff) | (((t.z - 1) & 0xff) << 8) | (t.w << 16); r.y = t.y; ttab[i] = r; }
    __syncthreads();
    return nt < 768 ? nt : 768;
}
DI void ph_moe_gemm1(LAS unsigned char* lds, const MP& p) {
    const int nt = moe_tile_table(lds, p);
    gm::MoeG1Prob q; q.A = (const char*)p.xb; q.WgT = (const char*)p.WgT; q.WuT = (const char*)p.WuT; q.lda = DM; q.ldb = DM; q.K = DM; q.G = (int)gridDim.x; q.c = (int)blockIdx.x;
    q.ttab = (const LAS i32x2*)(lds + LDS_TAB_OFF); q.ntl = nt; q.row_tok = p.row_tok;
    gm::EpiSwiglu e; e.H = p.H; e.ttab = q.ttab;
    gm::gemm_phase(lds, q, e);
}
DI void ph_moe_gemm2(LAS unsigned char* lds, const MP& p) {
    const int nt = moe_tile_table(lds, p);
    gm::MoeG2Prob q; q.A = (const char*)p.H; q.WdT = (const char*)p.WdT; q.lda = 512; q.ldb = 512; q.K = 512; q.G = (int)gridDim.x; q.c = (int)blockIdx.x; q.ttab = (const LAS i32x2*)(lds + LDS_TAB_OFF); q.ntl = nt;
    gm::EpiMoeDown e; e.Y = p.Y; e.ttab = q.ttab;
    gm::gemm_phase(lds, q, e);
}

#ifndef PROBE_SEL
#define PROBE_SEL 0
#endif
#define RG(...) { __VA_ARGS__; if (PROBE_SEL == 1) { __VA_ARGS__; } }
#define RA(...) { __VA_ARGS__; if (PROBE_SEL == 2) { __VA_ARGS__; } }
#define RM(...) { __VA_ARGS__; if (PROBE_SEL == 3) { __VA_ARGS__; } }
#define RC(...) { __VA_ARGS__; if (PROBE_SEL == 4) { __VA_ARGS__; } }
__global__ __launch_bounds__(512, 2) void mega_fwd(MP p) {
    extern __shared__ __attribute__((aligned(16))) unsigned char shm[];
    LAS unsigned char* lds = (LAS unsigned char*)shm;
    volatile LAS unsigned* xbw = (volatile LAS unsigned*)(lds + LDS_BAR_OFF);
    if (threadIdx.x == 0) { xbw[0] = 0u; xbw[1] = 0u; xbw[2] = 0u; xbw[3] = 0u; }
    __syncthreads();
    (void)xcd_barrier_post(p.bar, xbw);
#define SYNC() do { XcdBarrier b_; b_.bar = p.bar; b_.x = xb_xcc_id(); b_.st = (volatile LAS unsigned*)(lds + LDS_BAR_OFF); xcd_barrier(b_); } while (0)
    RC(ph_cvt_wT(lds, p.ab_w_in, p.WinABt, DM, AB_IN, 8960, 1, (int)blockIdx.x, (int)gridDim.x);)
    RC(ph_cvt_x(p);)
    RC(ph_cmp_bias(p);)
    RC(ph_build_wr(p);)
    SYNC();
    { const int NG = (int)gridDim.x >= 256 ? CVQ_NG : (int)gridDim.x;
      if ((int)blockIdx.x < NG) { gm::EpiAB e; e.C = p.hbuf; e.vselT = p.vselT; e.vwinT = p.vwinT; e.ksf = p.ksf; e.kwf = p.kwf; gm::DenseProb d = mk_dense(p.xb, DM, p.WinABt, DM, T_TOK, 8960, DM); d.G = NG; d.c = (int)blockIdx.x; gm::gemm_phase(lds, d, e); }
      moe_cvt_queue(lds, p, 0, p.bar + XCD_BAR_WORDS); }
    SYNC();
    RG({ gm::CmpProb q; q.hb = (const char*)p.hbuf; q.Wt = (const char*)p.WcmpT; q.ldb = 4096; q.K = 4096; q.G = (int)gridDim.x; q.c = (int)blockIdx.x; gm::EpiCmp e; e.kc = p.kcb; e.vcT = p.vcT; e.cpart = p.cpart; gm::gemm_phase(lds, q, e); })
    RM(ph_conv_ssd(lds, p);)
    SYNC();
    RA(ph_ssd_chunk(lds, p);)
    RA(ph_nsa_attn(lds, p);)
    SYNC();
    RM(ph_ssd_norm(p);)
    SYNC();
    RG(ph_gemm_bf16(lds, p.mixb, 4096, p.WoutABt, T_TOK, DM, DM, 4096, (bf16_t*)p.bufA, DM);)
    SYNC();
    RM(ph_ln<false>(p, p.x, (const bf16_t*)p.bufA, p.ln_g, p.ln_b, p.xb, p.mixb);)
    SYNC();
    RG(ph_router_gemm(lds, p, 0, (float*)(p.mixb + (size_t)T_TOK * DM), p.mixb);)
    SYNC();
    RM(ph_route_select(p, (const float*)(p.mixb + (size_t)T_TOK * DM), p.router_bias);)
    SYNC();
    RM(ph_moe_scan(lds, p);)
    SYNC();
    RG(ph_moe_gemm1(lds, p);)
    SYNC();
    RG(ph_moe_gemm2(lds, p);)
    SYNC();
    RM(ph_moe_combine_ln(p, p.xb, p.mixb, p.ln_g + DM, p.ln_b + DM, (float*)nullptr, p.xb);)
    SYNC();
    { const int NG = (int)gridDim.x >= 256 ? CVQ_NG : (int)gridDim.x;
      if ((int)blockIdx.x < NG) { gm::EpiCD e; e.C = p.hbuf; e.viT = (bf16_t*)p.bufB; gm::DenseProb d = mk_dense(p.xb, DM, p.WinCDt, DM, T_TOK, 9472, DM); d.G = NG; d.c = (int)blockIdx.x; gm::gemm_phase(lds, d, e); }
      moe_cvt_queue(lds, p, 1, p.bar + XCD_BAR_WORDS + 32); }
    SYNC();
    RM(ph_mla_rms(p);)
    RM(ph_rope_k(p);)
    SYNC();
    if (gridDim.x >= 256) {
        if (blockIdx.x < 128) { RA(ph_hgrn_chunk(lds, p);) }
        else {
            const int G2 = (int)gridDim.x - 128, c2 = (int)blockIdx.x - 128;
            { gm::DenseProb d = mk_dense(p.cqb, 1024, p.Wuqt, 512, T_TOK, 3072, 512); d.G = G2; d.c = c2; gm::EpiBf16 e; e.C = (bf16_t*)p.xbc; e.ldc = 3072; e.N = 3072; RG(gm::gemm_phase(lds, d, e);) }
            { gm::DenseProb d = mk_dense(p.cqb + 512, 1024, p.Wukvt, 512, T_TOK, 4096, 512); d.G = G2; d.c = c2; gm::EpiKV e; e.kf = (bf16_t*)p.kvfrag; e.vf = (bf16_t*)p.kvfrag + (size_t)T_TOK * 2048; RG(gm::gemm_phase(lds, d, e);) }
        }
    } else {
        RA(ph_hgrn_chunk(lds, p);)
        SYNC();
        RG(ph_gemm_bf16(lds, p.cqb, 1024, p.Wuqt, T_TOK, 3072, 3072, 512, (bf16_t*)p.xbc, 3072);)
        RG({ gm::EpiKV e; e.kf = (bf16_t*)p.kvfrag; e.vf = (bf16_t*)p.kvfrag + (size_t)T_TOK * 2048; gm::gemm_phase(lds, mk_dense(p.cqb + 512, 1024, p.Wukvt, 512, T_TOK, 4096, 512), e); })
    }
    SYNC();
    RA(ph_mla_attn(lds, p);)
    RM(ph_hgrn_post(p);)
    SYNC();
    RG(ph_gemm_bf16(lds, p.mixb, 4096, p.WoutCDt, T_TOK, DM, DM, 4096, (bf16_t*)p.bufB, DM);)
    SYNC();
    RM(ph_ln<true>(p, p.xb, (const bf16_t*)p.bufB, p.ln_g + 2 * DM, p.ln_b + 2 * DM, p.xb, p.mixb);)
    SYNC();
    RG(ph_router_gemm(lds, p, 1, (float*)(p.mixb + (size_t)T_TOK * DM), p.mixb);)
    SYNC();
    RM(ph_route_select(p, (const float*)(p.mixb + (size_t)T_TOK * DM), p.router_bias + 64);)
    SYNC();
    RM(ph_moe_scan(lds, p);)
    SYNC();
    RG(ph_moe_gemm1(lds, p);)
    SYNC();
    RG(ph_moe_gemm2(lds, p);)
    SYNC();
    RM(ph_moe_combine_ln(p, p.xb, p.mixb, p.ln_g + 3 * DM, p.ln_b + 3 * DM, p.out, (bf16_t*)nullptr);)
    if (xb_ld(&p.bar[XB_TMO]) != 0u) { SYNC(); for (long i = (long)blockIdx.x * NTHR + threadIdx.x; i < (long)T_TOK * DM; i += (long)gridDim.x * NTHR) p.out[i] = __uint_as_float(0x7fc00000u); }
#undef SYNC
}

extern "C" void kernel_launch(void* const* d_in, const int* in_sizes, int n_in, void* d_out, int out_size, void* d_ws, size_t ws_size, hipStream_t stream) {
    static int grid = 0;
    if (!grid) {
        int dev = 0, cus = 0; (void)hipGetDevice(&dev); (void)hipDeviceGetAttribute(&cus, hipDeviceAttributeMultiprocessorCount, dev);
        (void)hipFuncSetAttribute((const void*)mega_fwd, hipFuncAttributeMaxDynamicSharedMemorySize, LDS_TOTAL);
        grid = cus > 0 ? cus : 256;
    }
    (void)in_sizes; (void)n_in; (void)out_size; (void)ws_size;
    MP p{};
    p.x = (const float*)d_in[0]; p.positions = (const int*)d_in[1]; p.ab_w_in = (const float*)d_in[2]; p.conv_w = (const float*)d_in[3]; p.conv_b = (const float*)d_in[4];
    p.dt_bias = (const float*)d_in[5]; p.a_log = (const float*)d_in[6]; p.ssm_d = (const float*)d_in[7]; p.ssm_norm_w = (const float*)d_in[8]; p.cmp_pos = (const float*)d_in[9];
    p.cmp_w = (const float*)d_in[10]; p.ab_w_out = (const float*)d_in[11]; p.cd_w_in = (const float*)d_in[12]; p.q_norm_w = (const float*)d_in[13]; p.w_uq = (const float*)d_in[14];
    p.kv_norm_w = (const float*)d_in[15]; p.w_ukv = (const float*)d_in[16]; p.lb_logits = (const float*)d_in[17]; p.hgrn_norm_w = (const float*)d_in[18]; p.cd_w_out = (const float*)d_in[19];
    p.ln_g = (const float*)d_in[20]; p.ln_b = (const float*)d_in[21]; p.w_router = (const float*)d_in[22]; p.router_bias = (const float*)d_in[23]; p.w_gate = (const float*)d_in[24];
    p.w_up = (const float*)d_in[25]; p.w_down = (const float*)d_in[26]; p.sg = (const float*)d_in[27]; p.su = (const float*)d_in[28]; p.sd = (const float*)d_in[29];
    p.out = (float*)d_out;
    char* wp = (char*)d_ws;
    auto carve = [&](size_t bytes) { char* q = wp; wp += (bytes + 255) & ~(size_t)255; return q; };
    p.bar = (unsigned*)carve((size_t)(XCD_BAR_WORDS + 64) * 4);
    p.WinABt = (bf16_t*)carve((size_t)8960 * DM * 2);
    p.WoutABt = (bf16_t*)carve((size_t)DM * 4096 * 2);
    p.WinCDt = (bf16_t*)carve((size_t)9472 * DM * 2);
    p.WoutCDt = (bf16_t*)carve((size_t)DM * 4096 * 2);
    p.Wuqt = (bf16_t*)carve((size_t)3072 * 512 * 2);
    p.Wukvt = (bf16_t*)carve((size_t)4096 * 512 * 2);
    p.WgT = (bf16_t*)carve((size_t)65 * 512 * DM * 2); p.WuT = (bf16_t*)carve((size_t)65 * 512 * DM * 2); p.WdT = (bf16_t*)carve((size_t)65 * DM * 512 * 2);
    char* big = carve((size_t)T_TOK * CD_IN * 2 + (size_t)T_TOK * 3072 * 4 + (size_t)T_TOK * 4096 * 4 + 1024);
    p.hbuf = (bf16_t*)big;
    p.xbc = (float*)(big + (((size_t)T_TOK * CD_IN * 2 + 255) & ~(size_t)255));
    p.mix = (float*)((char*)p.xbc + (size_t)T_TOK * 3072 * 4);
    p.H = (bf16_t*)big;
    p.Y = (bf16_t*)(big + (((size_t)(MOE_PMAX + T_TOK) * 512 * 2 + 255) & ~(size_t)255));
    p.kvfrag = (bf16_t*)p.mix;
    p.mixb = (bf16_t*)carve((size_t)T_TOK * 4096 * 2);
    p.bufA = (float*)carve((size_t)T_TOK * DM * 4);
    p.bufB = (float*)carve((size_t)T_TOK * DM * 4);
    p.x3 = (float*)carve((size_t)T_TOK * DM * 4);
    p.xb = (bf16_t*)carve((size_t)(T_TOK + 1) * DM * 2);
    p.cqb = (bf16_t*)carve((size_t)T_TOK * 1024 * 2);
    p.kr = (bf16_t*)carve((size_t)T_TOK * 64 * 2);
    p.rope_tab = (float*)carve((size_t)T_TOK * 32 * 8);
    p.kcb = (bf16_t*)carve((size_t)16 * 128 * 128 * 2); p.vcT = (bf16_t*)carve((size_t)16 * 128 * 128 * 2);
    p.vselT = (bf16_t*)carve((size_t)16 * 128 * 2048 * 2); p.vwinT = (bf16_t*)carve((size_t)16 * 128 * 2048 * 2); p.ksf = (bf16_t*)carve((size_t)16 * 128 * 2048 * 2); p.kwf = (bf16_t*)carve((size_t)16 * 128 * 2048 * 2);
    p.WcmpT = (bf16_t*)carve((size_t)2 * 256 * 4096 * 2); p.WrT3 = (bf16_t*)carve((size_t)2 * 256 * 4096 * 2); p.cpart = (float*)carve((size_t)2 * 128 * 128 * 4);
    p.kc = (float*)carve((size_t)NB * NCMP * 2 * 128 * 4);
    p.vc = (float*)carve((size_t)NB * NCMP * 2 * 128 * 4);
    p.top_e = (int*)carve((size_t)T_TOK * 8 * 4); p.top_w = (float*)carve((size_t)T_TOK * 8 * 4); p.lpos = (int*)carve((size_t)T_TOK * 8 * 4);
    p.cnt_tab = (int*)carve((size_t)MOE_NSLOT * 64 * 4); p.row_tok = (int*)carve((size_t)(MOE_PMAX + T_TOK) * 4); p.row_w = (float*)carve((size_t)(MOE_PMAX + T_TOK) * 4);
    p.row_slot = (int*)carve((size_t)(MOE_PMAX + T_TOK) * 4); p.tiles = (int*)carve((size_t)MOE_MAXTILES * 16); p.ntiles = (int*)carve(256);
    (void)hipMemsetAsync(p.bar, 0, (size_t)(XCD_BAR_WORDS + 64) * 4, stream);
    hipLaunchKernelGGL(mega_fwd, dim3(grid), dim3(NTHR), LDS_TOTAL, stream, p);
}
```
